# Optimizing an MI355X kernel written in HIP

```python
import jax, jax.numpy as jnp
from jax import lax
import numpy as np

D_MODEL = 2048
BATCH = 2
SEQ = 8192
DEPTH = 2

GRID_W = 64
CTX_LEN = 256
N_MIXERS = 2
N_HEADS = 16
N_KV_HEADS = 4
HEAD_DIM = D_MODEL // N_HEADS
Q_PER_KV = N_HEADS // N_KV_HEADS
KV_DIM = N_KV_HEADS * HEAD_DIM
QKV_DIM = D_MODEL + 2 * KV_DIM
ATTN_SCALE = HEAD_DIM ** -0.5
ROPE_THETA = 10000.0
ROPE_PAIRS = HEAD_DIM // 4
Q_BLOCK = 128
POOL_WINDOWS = (2, 4, 8, 16)
N_POOL_GROUPS = len(POOL_WINDOWS)
POOL_GROUP_DIM = D_MODEL // N_POOL_GROUPS
N_EXPERTS = 32
N_EXPERT_GROUPS = 8
EXPERTS_PER_GROUP = N_EXPERTS // N_EXPERT_GROUPS
TOP_K = 2
D_EXPERT = D_MODEL // 2
MOE_BLOCK = 256
N_ATTN_LAYERS = (DEPTH + 1) // 2
N_POOL_LAYERS = DEPTH // 2
DEEPNORM_ALPHA = (2 * DEPTH) ** 0.25
DEEPNORM_BETA = (8 * DEPTH) ** -0.25
LN_EPS = 1e-6
RMS_EPS = 1e-6

kernel_name = 'hybrid_gqa_pool_grouped_moe_deepnorm_dit'


def layer_norm(x, g, b):
    xf = x.astype(jnp.float32)
    mu = jnp.mean(xf, axis=-1, keepdims=True)
    var = jnp.mean(jnp.square(xf - mu), axis=-1, keepdims=True)
    y = (xf - mu) * lax.rsqrt(var + LN_EPS) * g.astype(jnp.float32) + b.astype(jnp.float32)
    return y.astype(x.dtype)


def rms_norm(x, g):
    xf = x.astype(jnp.float32)
    y = xf * lax.rsqrt(jnp.mean(jnp.square(xf), axis=-1, keepdims=True) + RMS_EPS) * g.astype(jnp.float32)
    return y.astype(x.dtype)


def modulate(x, shift, scale):
    return x * (1 + scale) + shift


def axial_rope_tables(n_rows, dtype):
    t = jnp.arange(n_rows * GRID_W)
    row = (t // GRID_W).astype(jnp.float32)
    col = (t % GRID_W).astype(jnp.float32)
    inv_freq = ROPE_THETA ** (-jnp.arange(ROPE_PAIRS, dtype=jnp.float32) / ROPE_PAIRS)
    ang_r = row[:, None] * inv_freq
    ang_c = col[:, None] * inv_freq
    ang = jnp.concatenate([ang_r, ang_r, ang_c, ang_c], axis=-1)
    return jnp.cos(ang).astype(dtype), jnp.sin(ang).astype(dtype)


def apply_axial_rope(x, cos, sin):
    xr = x.reshape(x.shape[:-1] + (2, 2, ROPE_PAIRS))
    rot = jnp.stack([-xr[..., 1, :], xr[..., 0, :]], axis=-2).reshape(x.shape)
    return x * cos[:, None, :] + rot * sin[:, None, :]


def project_qkv(u, w_qkv, q_gain, k_gain):
    B, L, _ = u.shape
    qkv = u @ w_qkv
    q = qkv[..., :D_MODEL].reshape(B, L, N_HEADS, HEAD_DIM)
    k = qkv[..., D_MODEL:D_MODEL + KV_DIM].reshape(B, L, N_KV_HEADS, HEAD_DIM)
    v = qkv[..., D_MODEL + KV_DIM:].reshape(B, L, N_KV_HEADS, HEAD_DIM)
    return rms_norm(q, q_gain), rms_norm(k, k_gain), v


def project_kv(u, w_kv, k_gain):
    B, L, _ = u.shape
    kv = u @ w_kv
    k = kv[..., :KV_DIM].reshape(B, L, N_KV_HEADS, HEAD_DIM)
    v = kv[..., KV_DIM:].reshape(B, L, N_KV_HEADS, HEAD_DIM)
    return rms_norm(k, k_gain), v


def gqa_attend(q, k, v):
    s = jnp.einsum('bqkgd,bskd->bkgqs', q, k, preferred_element_type=jnp.float32) * ATTN_SCALE
    p = jax.nn.softmax(s, axis=-1).astype(v.dtype)
    return jnp.einsum('bkgqs,bskd->bqkgd', p, v)


def attention_mixer(u, uc, rope_cos, rope_sin, w_qkv, q_gain, k_gain, w_o, need_ctx):
    B, L, _ = u.shape
    C = uc.shape[1]
    q, k, v = project_qkv(u, w_qkv, q_gain, k_gain)
    q = apply_axial_rope(q, rope_cos, rope_sin)
    k = apply_axial_rope(k, rope_cos, rope_sin)
    if need_ctx:
        qc, kc, vc = project_qkv(uc, w_qkv, q_gain, k_gain)
    else:
        kc, vc = project_kv(uc, w_qkv[:, D_MODEL:], k_gain)
    k_all = jnp.concatenate([kc, k], axis=1)
    v_all = jnp.concatenate([vc, v], axis=1)
    n_blk = L // Q_BLOCK
    q_blocks = q.reshape(B, n_blk, Q_BLOCK, N_KV_HEADS, Q_PER_KV, HEAD_DIM).swapaxes(0, 1)
    o = lax.map(lambda qb: gqa_attend(qb, k_all, v_all), q_blocks)
    y = o.swapaxes(0, 1).reshape(B, L, D_MODEL) @ w_o
    if not need_ctx:
        return y, None
    oc = gqa_attend(qc.reshape(B, C, N_KV_HEADS, Q_PER_KV, HEAD_DIM), kc, vc)
    return y, oc.reshape(B, C, D_MODEL) @ w_o


def pool_mixer(u, w_pool, pool_scale):
    B, L, D = u.shape
    uf = u.astype(jnp.float32)
    cs = jnp.concatenate([jnp.zeros((B, 1, D), jnp.float32), jnp.cumsum(uf, axis=1)], axis=1)
    t = jnp.arange(L)
    outs = []
    for g, w in enumerate(POOL_WINDOWS):
        sl = slice(g * POOL_GROUP_DIM, (g + 1) * POOL_GROUP_DIM)
        lo = jnp.clip(t - w // 2, 0, L)
        hi = jnp.clip(t + w // 2, 0, L)
        cnt = (hi - lo).astype(jnp.float32)[:, None]
        csg = cs[..., sl]
        mean = (csg[:, hi] - csg[:, lo]) / cnt
        d = (mean - uf[..., sl]).astype(u.dtype)
        outs.append(d @ w_pool[g])
    return jnp.concatenate(outs, axis=-1) * pool_scale


def moe_ffn(h, w_router, router_bias, w_gate, w_up, w_down):
    T = h.shape[0]
    n_assign = T * TOP_K
    logits = jnp.einsum('td,de->te', h, w_router, preferred_element_type=jnp.float32)
    aff = jax.nn.sigmoid(logits)
    sel = (aff + router_bias.astype(jnp.float32)).reshape(T, N_EXPERT_GROUPS, EXPERTS_PER_GROUP)
    group_score = jnp.sum(lax.top_k(sel, 2)[0], axis=-1)
    g_idx = jnp.argmax(group_score, axis=-1)
    in_group = sel[jnp.arange(T), g_idx]
    _, local = lax.top_k(in_group, TOP_K)
    e_idx = g_idx[:, None] * EXPERTS_PER_GROUP + local
    gate = jnp.take_along_axis(aff, e_idx, axis=1)
    gate = gate / jnp.sum(gate, axis=-1, keepdims=True)
    flat_e = e_idx.reshape(-1).astype(jnp.int32)
    flat_tok = jnp.repeat(jnp.arange(T, dtype=jnp.int32), TOP_K)
    flat_gate = gate.reshape(-1)
    order = jnp.argsort(flat_e, stable=True)
    se = flat_e[order]
    counts = jnp.bincount(flat_e, length=N_EXPERTS)
    padded = (counts + MOE_BLOCK - 1) // MOE_BLOCK * MOE_BLOCK
    starts = jnp.cumsum(counts) - counts
    p_ends = jnp.cumsum(padded)
    p_starts = p_ends - padded
    dest = p_starts[se] + jnp.arange(n_assign, dtype=jnp.int32) - starts[se]
    n_blocks = (n_assign + N_EXPERTS * (MOE_BLOCK - 1) + MOE_BLOCK - 1) // MOE_BLOCK
    slots = n_blocks * MOE_BLOCK
    buf_tok = jnp.zeros((slots,), jnp.int32).at[dest].set(flat_tok[order])
    buf_gate = jnp.zeros((slots,), jnp.float32).at[dest].set(flat_gate[order])
    blk_start = jnp.arange(n_blocks, dtype=jnp.int32) * MOE_BLOCK
    blk_expert = jnp.minimum(jnp.searchsorted(p_ends, blk_start, side='right'), N_EXPERTS - 1)

    def expert_block(args):
        e, tok, g = args
        xb = h[tok]
        a = xb @ w_gate[e]
        b = xb @ w_up[e]
        yb = (jax.nn.silu(a) * b) @ w_down[e]
        return yb * g[:, None].astype(yb.dtype)

    ys = lax.map(expert_block, (blk_expert, buf_tok.reshape(n_blocks, MOE_BLOCK), buf_gate.reshape(n_blocks, MOE_BLOCK)))
    return jax.ops.segment_sum(ys.reshape(slots, -1), buf_tok, num_segments=T)


def setup_inputs(seed: int = 0) -> dict:
    key = jax.random.key(seed)
    ks = jax.random.split(key, 19)
    D = D_MODEL
    f32 = jnp.float32

    def nrm(k, shape, scale):
        return jax.random.normal(k, shape, f32) * scale

    return {
        'x': nrm(ks[0], (BATCH, SEQ, D), 1.0),
        'c': nrm(ks[1], (BATCH, D), 1.0),
        'ctx': nrm(ks[2], (BATCH, CTX_LEN, D), 1.0),
        'c_ctx': nrm(ks[3], (D,), 1.0),
        'w_mod': nrm(ks[4], (DEPTH, D, 6 * D), 0.5 * D ** -0.5),
        'b_mod': nrm(ks[5], (DEPTH, 6 * D), 0.02),
        'ln_g': 1.0 + nrm(ks[6], (DEPTH, 2, D), 0.02),
        'ln_b': nrm(ks[7], (DEPTH, 2, D), 0.02),
        'w_qkv': nrm(ks[8], (N_ATTN_LAYERS, D, QKV_DIM), D ** -0.5),
        'q_gain': 1.0 + nrm(ks[9], (N_ATTN_LAYERS, HEAD_DIM), 0.02),
        'k_gain': 1.0 + nrm(ks[10], (N_ATTN_LAYERS, HEAD_DIM), 0.02),
        'w_o': nrm(ks[11], (N_ATTN_LAYERS, D, D), DEEPNORM_BETA * D ** -0.5),
        'w_pool': nrm(ks[12], (N_POOL_LAYERS, N_POOL_GROUPS, POOL_GROUP_DIM, POOL_GROUP_DIM), DEEPNORM_BETA * POOL_GROUP_DIM ** -0.5),
        'pool_scale': 1.0 + nrm(ks[13], (N_POOL_LAYERS, D), 0.02),
        'w_router': nrm(ks[14], (D, N_EXPERTS), D ** -0.5),
        'router_bias': nrm(ks[15], (N_EXPERTS,), 0.01),
        'w_gate': nrm(ks[16], (DEPTH, N_EXPERTS, D, D_EXPERT), D ** -0.5),
        'w_up': nrm(ks[17], (DEPTH, N_EXPERTS, D, D_EXPERT), D ** -0.5),
        'w_down': nrm(ks[18], (DEPTH, N_EXPERTS, D_EXPERT, D), DEEPNORM_BETA * D_EXPERT ** -0.5),
    }


def reference(x, c, ctx, c_ctx, w_mod, b_mod, ln_g, ln_b, w_qkv, q_gain, k_gain, w_o, w_pool, pool_scale, w_router, router_bias, w_gate, w_up, w_down):
    B, L, D = x.shape
    C = ctx.shape[1]
    n_rows = L // GRID_W
    rope_cos, rope_sin = axial_rope_tables(n_rows, x.dtype)
    xc = ctx
    s_lat = jax.nn.silu(c)
    s_ctx = jax.nn.silu(c_ctx)
    for i in range(DEPTH):
        need_ctx = i < DEPTH - 1
        mixer = i % N_MIXERS
        idx = i // N_MIXERS
        mod = (s_lat @ w_mod[i] + b_mod[i])[:, None, :]
        sh1, sc1, g1, sh2, sc2, g2 = jnp.split(mod, 6, axis=-1)
        u = modulate(x, sh1, sc1)
        if mixer == 0 or need_ctx:
            modc = s_ctx @ w_mod[i] + b_mod[i]
            csh1, csc1, cg1, csh2, csc2, cg2 = jnp.split(modc, 6, axis=-1)
            uc = modulate(xc, csh1, csc1)
        if mixer == 0:
            y, yc = attention_mixer(u, uc, rope_cos, rope_sin, w_qkv[idx], q_gain[idx], k_gain[idx], w_o[idx], need_ctx)
        else:
            y = pool_mixer(u, w_pool[idx], pool_scale[idx])
            yc = pool_mixer(uc, w_pool[idx], pool_scale[idx]) if need_ctx else None
        x = layer_norm(DEEPNORM_ALPHA * x + g1 * y, ln_g[i, 0], ln_b[i, 0])
        h = modulate(x, sh2, sc2).reshape(B * L, D)
        if need_ctx:
            xc = layer_norm(DEEPNORM_ALPHA * xc + cg1 * yc, ln_g[i, 0], ln_b[i, 0])
            hc = modulate(xc, csh2, csc2).reshape(B * C, D)
            f_all = moe_ffn(jnp.concatenate([hc, h], axis=0), w_router, router_bias, w_gate[i], w_up[i], w_down[i])
            fc = f_all[:B * C].reshape(B, C, D)
            f = f_all[B * C:].reshape(B, L, D)
            xc = layer_norm(DEEPNORM_ALPHA * xc + cg2 * fc, ln_g[i, 1], ln_b[i, 1])
        else:
            f = moe_ffn(h, w_router, router_bias, w_gate[i], w_up[i], w_down[i]).reshape(B, L, D)
        x = layer_norm(DEEPNORM_ALPHA * x + g2 * f, ln_g[i, 1], ln_b[i, 1])
    return x
```

```cpp
#include <hip/hip_runtime.h>
#include <cstdio>
#include <cstdint>

#ifndef REP_MASK
#define REP_MASK 0
#endif
#ifndef MK_PER_PHASE
#define MK_PER_PHASE 0
#endif

constexpr int DM = 2048, NB = 2, SEQ = 8192, CTXL = 256;
constexpr int NCTX = NB * CTXL, NLAT = NB * SEQ, MT = NCTX + NLAT;
constexpr int NH = 16, NKV = 4, HD = 128, KVD = NKV * HD, QKVD = DM + 2 * KVD;
constexpr int SKV = CTXL + SEQ;
constexpr int NE = 32, DE = 1024;
constexpr int MAXT = 164, NSLOT = MAXT * 256;
constexpr float ALPHA = 1.41421356237309515f;
constexpr float LN_EPS = 1e-6f, RMS_EPS = 1e-6f;
constexpr int NPHASE = 18;

constexpr size_t MiB = 1u << 20;
constexpr size_t WS_CTL = 0, CTL_ZERO_BYTES = 1 * MiB;
constexpr size_t WS_MOD = 1 * MiB;
constexpr size_t WS_ROPE = WS_MOD + 512 * 1024;
constexpr size_t WS_WR = WS_MOD + 768 * 1024;
constexpr size_t WS_WQKV = 2 * MiB;
constexpr size_t WS_WO = 14 * MiB;
constexpr size_t WS_WPOOL = 22 * MiB;
constexpr size_t WS_WGU = 24 * MiB;
constexpr size_t WS_WD = 536 * MiB;
constexpr size_t WS_Y = 792 * MiB;
constexpr size_t WS_X1 = 924 * MiB;
constexpr size_t WS_X2 = 1056 * MiB;
constexpr size_t WS_H = 1188 * MiB;
constexpr size_t WS_LIST = 1254 * MiB;
constexpr size_t WS_SLOT = 1259 * MiB;
constexpr size_t WS_SH = 1260 * MiB;
constexpr size_t WS_U = WS_SH;
constexpr size_t WS_QKVR = WS_SH + 66 * MiB;
constexpr size_t WS_Q = WS_SH + 165 * MiB;
constexpr size_t WS_K = WS_SH + 231 * MiB;
constexpr size_t WS_V = WS_SH + 248 * MiB;
constexpr size_t WS_O = WS_SH + 265 * MiB;
constexpr size_t WS_HS = WS_SH;
constexpr size_t WS_ACT = WS_SH + 164 * MiB;
constexpr size_t WS_FB = WS_SH + 246 * MiB;
constexpr size_t WS_DP = WS_SH;
constexpr size_t WS_PQ = WS_SH + 510 * MiB;
constexpr size_t WS_PO = WS_PQ + 48 * MiB;
constexpr size_t WS_END = WS_PO + 32 * MiB;
static_assert((size_t)MT * DM * 4 <= 132 * MiB && (size_t)NSLOT * 2048 * 2 <= 164 * MiB && (size_t)2 * MT * DM * 4 <= 264 * MiB, "ws map");
static_assert((size_t)32 * MT * 8 <= 5 * MiB && (size_t)NSLOT * 8 <= 1 * MiB, "ws map 2");
constexpr int CW_CNT = 64;
constexpr int CW_Q = 3072;
constexpr int CW_MQ = 3136;
constexpr int CW_WQ = 3104;
constexpr int CW_DONE = 8192;
constexpr int CW_GUD = 16384;
constexpr int CW_YD = 40960;
constexpr int CW_P6Q = 3168;
constexpr int CW_BAR = 4096;

constexpr int RING_BYTES = 131072;
constexpr int MISC_OFF = RING_BYTES;
constexpr int TAB_OFF = MISC_OFF + 256;
constexpr int LDS_BYTES = 147456;

#define GAS __attribute__((address_space(1)))
#define LAS __attribute__((address_space(3)))
typedef unsigned short bf16_t;
typedef unsigned v4u __attribute__((ext_vector_type(4)));
typedef unsigned v2u __attribute__((ext_vector_type(2)));
typedef float f32x4 __attribute__((ext_vector_type(4)));
typedef float f32x2 __attribute__((ext_vector_type(2)));
typedef short bf16x8 __attribute__((ext_vector_type(8)));
typedef short s16x4 __attribute__((ext_vector_type(4)));
typedef float f32x16 __attribute__((ext_vector_type(16)));
typedef GAS unsigned gu32;
#define RLX_AGENT __ATOMIC_RELAXED, __HIP_MEMORY_SCOPE_AGENT
#define LDS_WAIT() asm volatile("s_waitcnt lgkmcnt(0)" ::: "memory")
#define VM_WAIT() asm volatile("s_waitcnt vmcnt(0)" ::: "memory")
__device__ __forceinline__ unsigned f2bf(float f) { unsigned u = __builtin_bit_cast(unsigned, f); return (u + 0x7fffu + ((u >> 16) & 1u)) >> 16; }
__device__ __forceinline__ unsigned pk2(float lo, float hi) { unsigned r; asm("v_cvt_pk_bf16_f32 %0, %1, %2" : "=v"(r) : "v"(lo), "v"(hi)); return r; }
__device__ __forceinline__ float bf2f(unsigned b) { return __builtin_bit_cast(float, b << 16); }
__device__ __forceinline__ unsigned cvt_pk_bf16(float lo, float hi) { unsigned r; asm volatile("v_cvt_pk_bf16_f32 %0, %1, %2" : "=v"(r) : "v"(lo), "v"(hi)); return r; }
__device__ __forceinline__ f32x4 bf4(v2u q) { return (f32x4){bf2f(q.x & 0xffffu), bf2f(q.x >> 16), bf2f(q.y & 0xffffu), bf2f(q.y >> 16)}; }
__device__ __forceinline__ float wave_sum(float v) {
#pragma unroll
    for (int o = 1; o < 64; o <<= 1) v += __shfl_xor(v, o);
    return v;
}
__device__ __forceinline__ float silu_f(float x) { return x / (1.0f + __expf(-x)); }
__device__ __forceinline__ int row_cond(int row) { return row < NCTX ? 2 : ((row - NCTX) >> 13); }
__device__ __forceinline__ int otid() { int t = threadIdx.x; asm volatile("" : "+v"(t)); return t; }
__device__ __forceinline__ int obid() { int t = blockIdx.x; asm volatile("" : "+s"(t)); return t; }
__device__ __forceinline__ int ogrid() { int t = gridDim.x; asm volatile("" : "+s"(t)); return t; }

#define XB_TMO      128
#define XB_XCNT(j)  (256  + 64 * (j))
#define XB_XSUB(j)  (1280 + 64 * (j))
#define XB_XGEN(j)  (2304 + 64 * (j))
#define XB_TOP      3328
#define XB_TOPGEN   3392
#define XCD_BAR_WORDS 3456
#define XB_SPIN_CAP (1u << 20)
__device__ __forceinline__ unsigned xb_ld(unsigned* p)              { return __hip_atomic_load(p, __ATOMIC_RELAXED, __HIP_MEMORY_SCOPE_AGENT); }
__device__ __forceinline__ unsigned xb_add(unsigned* p, unsigned v) { return __hip_atomic_fetch_add(p, v, __ATOMIC_RELAXED, __HIP_MEMORY_SCOPE_AGENT); }
__device__ __forceinline__ unsigned xb_xcc_id() { return (unsigned)__builtin_amdgcn_s_getreg((3 << 11) | 20) & 0xFu; }
#define XB_SPIN(cond, bar) do { unsigned _sp = 0; while (cond) { __builtin_amdgcn_s_sleep(1); \
    if ((++_sp & 255u) == 0u) { if (xb_ld(&(bar)[XB_TMO])) break; if (_sp > XB_SPIN_CAP) { atomicAdd(&(bar)[XB_TMO], 1u); break; } } } } while (0)
struct XcdBarrier { unsigned* bar; unsigned x; volatile LAS unsigned* st; };
__device__ __forceinline__ XcdBarrier xcd_barrier_post(unsigned* bar, volatile LAS unsigned* st) {
    XcdBarrier b; b.bar = bar; b.x = xb_xcc_id(); b.st = st;
    if (threadIdx.x == 0) (void)xb_add(&bar[XB_XCNT(b.x)], 1u);
    return b;
}
__device__ __forceinline__ void xcd_barrier_complete(unsigned* bar, unsigned x, unsigned& nloc, unsigned& nx) {
    const unsigned G = gridDim.x * gridDim.y * gridDim.z;
    unsigned sum, cnt, mine, sp = 0u;
    for (;;) {
        sum = 0u; cnt = 0u; mine = 0u;
#pragma unroll 1
        for (unsigned j = 0; j < 16; ++j) { const unsigned c = xb_ld(&bar[XB_XCNT(j)]); sum += c; cnt += (c > 0u) ? 1u : 0u; }
        if (sum == G) break;
        __builtin_amdgcn_s_sleep(1);
        if ((++sp & 255u) == 0u) { if (xb_ld(&bar[XB_TMO])) break; if (sp > XB_SPIN_CAP) { atomicAdd(&bar[XB_TMO], 1u); break; } }
    }
    mine = xb_ld(&bar[XB_XCNT(x)]);
    nloc = mine > 0u ? mine : 1u; nx = cnt > 0u ? cnt : 1u;
}
__device__ __forceinline__ void xcd_barrier(const XcdBarrier& b) {
    asm volatile("s_waitcnt vmcnt(0)" ::: "memory");
    __syncthreads();
    if (threadIdx.x == 0) {
        unsigned* bar = b.bar;
        __builtin_amdgcn_s_waitcnt(0);
        unsigned nloc = b.st[0], nx = b.st[1];
        if (nloc == 0u) { xcd_barrier_complete(bar, b.x, nloc, nx); b.st[0] = nloc; b.st[1] = nx; }
        const unsigned old = xb_add(&bar[XB_XSUB(b.x)], 1u);
        const unsigned gen = old / nloc;
        if (old + 1u == (gen + 1u) * nloc) {
            __builtin_amdgcn_fence(__ATOMIC_RELEASE, "agent");
            asm volatile("s_waitcnt vmcnt(0)" ::: "memory");
            const unsigned og = xb_add(&bar[XB_TOP], 1u);
            const unsigned tg = og / nx;
            if (og + 1u == (tg + 1u) * nx) xb_add(&bar[XB_TOPGEN], 1u);
            else XB_SPIN(xb_ld(&bar[XB_TOPGEN]) == tg, bar);
            __builtin_amdgcn_fence(__ATOMIC_ACQUIRE, "agent");
            xb_add(&bar[XB_XGEN(b.x)], 1u);
            asm volatile("s_waitcnt vmcnt(0)" ::: "memory");
        } else {
            XB_SPIN(xb_ld(&bar[XB_XGEN(b.x)]) == gen, bar);
            __builtin_amdgcn_fence(__ATOMIC_ACQUIRE, "agent");
            asm volatile("s_waitcnt vmcnt(0)" ::: "memory");
        }
    }
    __syncthreads();
}

namespace pg8 {
#define PG8_LAS __attribute__((address_space(3)))
constexpr int BM = 256, BK = 64, HALF = 128, HTB = HALF * BK * 2, STAGE_BYTES = 8 * HTB, NXCD = 8, WGM = 8;
__host__ __device__ __forceinline__ int lds_byte(int r, int c) { const int st = (r >> 4) * 2 + (c >> 5), rr = r & 15, cc = c & 31, ob = rr * 64 + cc * 2; return st * 1024 + (ob ^ (((ob >> 9) & 1) << 5)); }
__host__ __device__ __forceinline__ void stage_rc(int b, int& R, int& C) { const int st = b / 1024, sb = b % 1024, swz = sb ^ (((sb >> 9) & 1) << 5); R = (st >> 1) * 16 + swz / 64; C = (st & 1) * 32 + (swz % 64) / 2; }
__host__ __device__ __forceinline__ int perm32(int rho) { const int n = rho >> 4, i = rho & 15; return 8 * (i >> 2) + 4 * n + (i & 3); }

struct Unit { const char* A; const char* B; int pm, pn, aux, kt, rb, cn, ui; };
struct Gemm { int lda, ldb, K; };

struct TileOrder {
    int nM, nN, nwg, G, c, rot = 0;
    __device__ __forceinline__ void init(int nM_, int nN_, int G_, int c_) { nM = nM_; nN = nN_; nwg = nM * nN; G = G_; c = c_; }
    __device__ __forceinline__ bool get(int i, int& pm, int& pn) const { return map((long)i * G + c, pm, pn); }
    __device__ __forceinline__ bool map(long L, int& pm, int& pn) const {
        if (L >= nwg) return false;
        const int nig = WGM * nN;
        int wgid = (int)L; { const int q = nwg / NXCD, r = nwg % NXCD, xcd = wgid % NXCD; int off = wgid / NXCD; const int cs = (xcd < r ? xcd * (q + 1) : r * (q + 1) + (xcd - r) * q), len = q + (xcd < r ? 1 : 0);
            if (rot) { const int lead = (nig - cs % nig) % nig; if (lead < len) { off += lead; if (off >= len) off -= len; } }
            wgid = cs + off; }
        const int gid = wgid / nig, fm = gid * WGM, gsz = (nM - fm) < WGM ? (nM - fm) : WGM;
        pm = fm + ((wgid % nig) % gsz); pn = (wgid % nig) / gsz; return true;
    }
};

template <class Epi, class Sched, bool ALIGN_EPI, bool GATHER = false>
__device__ __forceinline__ void gemm_phase(PG8_LAS unsigned char* lds, const Gemm g, const Sched& S, const Epi& E) {
    const int tid = otid(), wid = __builtin_amdgcn_readfirstlane(tid >> 6), lane = tid & 63, wr = wid >> 2, wc = wid & 3, fr = lane & 15, fq = lane >> 4;
    unsigned vc[2][2], vn[2][2], voffB[2]; int Rr[2], Cc = 0;
#pragma unroll
    for (int i = 0; i < 2; ++i) { int R, C; stage_rc(tid * 16 + i * 8192, R, C); const int Rb = Epi::PERM ? ((R & ~31) + perm32(R & 31)) : R; Rr[i] = R; Cc = C;
        vc[0][i] = (unsigned)(R * g.lda + C) * 2u; vc[1][i] = vc[0][i] + (unsigned)(HALF * g.lda) * 2u; voffB[i] = (unsigned)(Rb * g.ldb + C) * 2u; }
#define PG8_ROWS(ui_, v) do { _Pragma("unroll") for (int _h = 0; _h < 2; ++_h) _Pragma("unroll") for (int _i = 0; _i < 2; ++_i) \
        v[_h][_i] = (unsigned)S.rowtok((ui_), Rr[_i] + HALF * _h) * (unsigned)(g.lda * 2) + (unsigned)Cc * 2u; } while (0)
    const size_t kstep = (size_t)(BK * 2);
    const size_t hsB = (size_t)HALF * g.ldb * 2;
    const unsigned ldsw = (unsigned)wid * 1024u;
    const int aoff = lds_byte(wr * 64 + fr, fq * 8), boff = lds_byte(wc * 32 + fr, fq * 8);
#define PG8_SA(b, h) (((b) * 2 + (h)) * HTB)
#define PG8_SB(b, h) ((4 + (b) * 2 + (h)) * HTB)
#define PG8_STAGE(bufoff, gbase, voff) do { _Pragma("unroll") for (int _i = 0; _i < 2; ++_i) \
        __builtin_amdgcn_global_load_lds((const unsigned*)((const char*)(gbase) + (voff)[_i]), (PG8_LAS unsigned*)(lds + (bufoff) + ldsw + _i * 8192), 16, 0, 0); } while (0)
#define PG8_LDA(dst, b, h) do { _Pragma("unroll") for (int m = 0; m < 4; ++m) _Pragma("unroll") for (int k = 0; k < 2; ++k) dst[m][k] = *(const PG8_LAS bf16x8*)(lds + PG8_SA(b, h) + aoff + m * 2048 + k * 1024); } while (0)
#define PG8_LDB(dst, b, h) do { _Pragma("unroll") for (int n = 0; n < 2; ++n) _Pragma("unroll") for (int k = 0; k < 2; ++k) dst[n][k] = *(const PG8_LAS bf16x8*)(lds + PG8_SB(b, h) + boff + n * 2048 + k * 1024); } while (0)
#define PG8_MMA(ai, bj, At, Bt) do { __builtin_amdgcn_s_setprio(1); _Pragma("unroll") for (int m = 0; m < 4; ++m) _Pragma("unroll") for (int n = 0; n < 2; ++n) _Pragma("unroll") for (int k = 0; k < 2; ++k) \
        acc[ai][bj][m][n] = __builtin_amdgcn_mfma_f32_16x16x32_bf16(Bt[n][k], At[m][k], acc[ai][bj][m][n], 0, 0, 0); __builtin_amdgcn_s_setprio(0); } while (0)
#define PG8_WAIT_V(n) asm volatile("s_waitcnt vmcnt(" #n ")" ::: "memory")
#define PG8_WAIT_L(n) asm volatile("s_waitcnt lgkmcnt(" #n ")" ::: "memory")
#define PG8_BAR __builtin_amdgcn_s_barrier()
#define PG8_SCHED __builtin_amdgcn_sched_barrier(0)
    Unit cur, nxt; int ui = 0; int pend = -1, pend2 = -1, wst = 0; unsigned pv = 8u; (void)pend; (void)pend2; (void)wst; (void)pv;
    if (!S.next(0, cur)) return;
    if constexpr (Sched::WAITS) S.wait_ready(cur);
    if constexpr (GATHER) PG8_ROWS(0, vc);
    f32x4 acc[2][2][4][2];
#pragma unroll
    for (int a = 0; a < 2; ++a)
#pragma unroll
        for (int b = 0; b < 2; ++b)
#pragma unroll
            for (int m = 0; m < 4; ++m)
#pragma unroll
                for (int n = 0; n < 2; ++n) acc[a][b][m][n] = (f32x4){0.f, 0.f, 0.f, 0.f};
    bf16x8 At[4][2], B0[2][2], B1[2][2];
    const char* cA = cur.A; const char* cB = cur.B;
    PG8_STAGE(PG8_SB(0, 0), cB, voffB); PG8_STAGE(PG8_SB(0, 1), cB + hsB, voffB); PG8_STAGE(PG8_SA(0, 0), cA, vc[0]); PG8_STAGE(PG8_SA(0, 1), cA, vc[1]);
    if (wr == 1) PG8_BAR;
    PG8_WAIT_V(2); PG8_BAR;
    PG8_STAGE(PG8_SB(1, 0), cB + kstep, voffB); PG8_STAGE(PG8_SA(1, 0), cA + kstep, vc[0]); PG8_STAGE(PG8_SB(1, 1), cB + hsB + kstep, voffB);
    PG8_WAIT_V(6); PG8_BAR;
    for (;;) {
        const bool has_next = S.next(ui + 1, nxt);
        if constexpr (Sched::WAITS) wst = has_next ? 1 : 0;
        const char* nA = has_next ? nxt.A : cA; const char* nB = has_next ? nxt.B : cB;
        if constexpr (GATHER) { if (has_next) PG8_ROWS(ui + 1, vn); else {
#pragma unroll
            for (int h = 0; h < 2; ++h) { vn[h][0] = vc[h][0]; vn[h][1] = vc[h][1]; } } }
        const int nt = cur.kt;
        for (int t = 0; t < nt; t += 2) {
            const bool last = (t == nt - 2);
            const char* a1 = cA + (size_t)(t + 1) * kstep;
            const char* a2 = last ? nA : cA + (size_t)(t + 2) * kstep; const char* b2 = last ? nB : cB + (size_t)(t + 2) * kstep;
            const char* a3 = a2 + kstep; const char* b3 = b2 + kstep;
            unsigned o0[2], o1[2];
#pragma unroll
            for (int i = 0; i < 2; ++i) { o0[i] = (GATHER && last) ? vn[0][i] : vc[0][i]; o1[i] = (GATHER && last) ? vn[1][i] : vc[1][i]; }
            PG8_LDB(B0, 0, 0); PG8_LDB(B1, 0, 1); PG8_SCHED; PG8_LDA(At, 0, 0); PG8_STAGE(PG8_SA(1, 1), a1, vc[1]);
            PG8_WAIT_V(8); PG8_WAIT_L(0); PG8_BAR; PG8_MMA(0, 0, At, B0); PG8_MMA(0, 1, At, B1); PG8_BAR; PG8_SCHED;
            PG8_LDA(At, 0, 1); PG8_STAGE(PG8_SB(0, 0), b2, voffB); PG8_STAGE(PG8_SB(0, 1), b2 + hsB, voffB); PG8_STAGE(PG8_SA(0, 0), a2, o0);
            PG8_WAIT_V(8); PG8_WAIT_L(0); PG8_BAR; PG8_MMA(1, 0, At, B0); PG8_MMA(1, 1, At, B1); PG8_BAR; PG8_SCHED;
            PG8_LDB(B0, 1, 0); PG8_LDB(B1, 1, 1); PG8_SCHED; PG8_LDA(At, 1, 0); PG8_STAGE(PG8_SA(0, 1), a2, o1);
            PG8_WAIT_V(8); PG8_WAIT_L(0); PG8_BAR; PG8_MMA(0, 0, At, B0); PG8_MMA(0, 1, At, B1); PG8_BAR; PG8_SCHED;
            PG8_LDA(At, 1, 1); PG8_STAGE(PG8_SB(1, 0), b3, voffB); PG8_STAGE(PG8_SB(1, 1), b3 + hsB, voffB); PG8_STAGE(PG8_SA(1, 0), a3, o0);
            PG8_WAIT_V(8); PG8_WAIT_L(0); PG8_BAR; PG8_MMA(1, 0, At, B0); PG8_MMA(1, 1, At, B1); PG8_BAR; PG8_SCHED;
            if constexpr (Sched::SIGNALS) { if (pend >= 0) { pend2 = pend; pend = -1; } else if (pend2 >= 0) { S.signal(pend2, lane, wid); pend2 = -1; } }
            if constexpr (Sched::WAITS) { if (wst == 1) { pv = S.poll(nxt); wst = 2; } else if (wst == 2) { wst = 0; if (pv < 8u) S.spin(nxt); } }
        }
        if constexpr (ALIGN_EPI) { if (wr == 0) PG8_BAR; }
        E(acc, cur, wr, wc, fr, fq);
        if constexpr (Sched::SIGNALS) pend = cur.pm;
        if (!has_next) break;
#pragma unroll
        for (int a = 0; a < 2; ++a)
#pragma unroll
            for (int b = 0; b < 2; ++b)
#pragma unroll
                for (int m = 0; m < 4; ++m)
#pragma unroll
                    for (int n = 0; n < 2; ++n) acc[a][b][m][n] = (f32x4){0.f, 0.f, 0.f, 0.f};
        cur = nxt; cA = nA; cB = nB; ++ui;
        if constexpr (GATHER) {
#pragma unroll
            for (int h = 0; h < 2; ++h) { vc[h][0] = vn[h][0]; vc[h][1] = vn[h][1]; } }
        if constexpr (ALIGN_EPI) { if (wr == 1) PG8_BAR; }
    }
    PG8_WAIT_V(0);
    if constexpr (!ALIGN_EPI) { if (wr == 0) PG8_BAR; }
    PG8_BAR;
    if constexpr (Sched::SIGNALS) { if (pend >= 0) S.signal(pend, lane, wid); }
#undef PG8_ROWS
#undef PG8_SA
#undef PG8_SB
#undef PG8_STAGE
#undef PG8_LDA
#undef PG8_LDB
#undef PG8_MMA
#undef PG8_WAIT_V
#undef PG8_WAIT_L
#undef PG8_BAR
#undef PG8_SCHED
}

template <unsigned AT, unsigned BT, int KT>
struct SchedDense {
    static constexpr bool SIGNALS = false, WAITS = false;
    TileOrder o; const char* A; const char* B; int pm0;
    __device__ __forceinline__ int rowtok(int, int) const { return 0; }
    __device__ __forceinline__ bool next(int i, Unit& u) const { int pm, pn; if (!o.get(i, pm, pn)) return false;
        u.rb = 0; u.cn = 0; u.pm = pm0 + pm; u.pn = pn; u.aux = 0; u.kt = KT; u.A = A + (size_t)((unsigned)u.pm * AT); u.B = B + (size_t)((unsigned)pn * BT); return true; }
};
template <unsigned AT, unsigned BT, int KT, int NN>
struct SchedSplit {
    static constexpr bool SIGNALS = false, WAITS = false;
    TileOrder o; const char* A; const char* B; int G, c; bool split;
    __device__ __forceinline__ int rowtok(int, int) const { return 0; }
    __device__ __forceinline__ void init(int G_, int c_) { G = G_; c = c_; split = ((64 * NN) % G_ == 0) && (2 * NN * 8 <= G_); if (split) o.init(64, NN, G_, c_); else o.init(66, NN, G_, c_); }
    __device__ __forceinline__ bool next(int i, Unit& u) const { u.rb = 0; u.cn = 0;
        if (!split) { int pm, pn; if (!o.get(i, pm, pn)) return false; u.pm = pm; u.pn = pn; u.aux = 0; u.kt = KT; u.A = A + (size_t)((unsigned)pm * AT); u.B = B + (size_t)((unsigned)pn * BT); return true; }
        const int fr = (64 * NN) / G;
        if (i < fr) { int pm, pn; o.get(i, pm, pn); u.pm = 2 + pm; u.pn = pn; u.aux = 0; u.kt = KT; u.A = A + (size_t)((unsigned)u.pm * AT); u.B = B + (size_t)((unsigned)pn * BT); return true; }
        if (i > fr || c >= 2 * NN * 8) return false;
        const int ks = c & 7, t = c >> 3; u.pm = t / NN; u.pn = t % NN; u.aux = ks + 1; u.kt = KT / 8;
        u.A = A + (size_t)((unsigned)u.pm * AT + (unsigned)ks * (KT / 8) * 128u); u.B = B + (size_t)((unsigned)u.pn * BT + (unsigned)ks * (KT / 8) * 128u); return true; }
};
struct SchedPool {
    static constexpr bool SIGNALS = false, WAITS = false;
    TileOrder o; const char* A; const char* B;
    __device__ __forceinline__ int rowtok(int, int) const { return 0; }
    __device__ __forceinline__ bool next(int i, Unit& u) const { int pm, pn; if (!o.get(i, pm, pn)) return false;
        u.rb = 0; u.cn = 0; u.pm = 2 + pm; u.pn = pn; u.aux = 0; u.kt = 8; const int g = pn >> 1;
        u.A = A + (size_t)((unsigned)u.pm * (256u * DM * 2u) + (unsigned)g * 1024u); u.B = B + (size_t)((unsigned)g * (512u * 512u * 2u) + (unsigned)(pn & 1) * (256u * 512u * 2u)); return true; }
};
struct SchedOne {
    static constexpr bool SIGNALS = false, WAITS = false;
    Unit u;
    __device__ __forceinline__ int rowtok(int, int) const { return 0; }
    __device__ __forceinline__ bool next(int i, Unit& o) const { if (i != 0) return false; o = u; return true; }
};
constexpr int RT_UNITS = 14;
template <unsigned AT, unsigned BT, unsigned BE, int KT, bool GATHER>
struct SchedMoe {
    static constexpr bool SIGNALS = GATHER, WAITS = !GATHER;
    unsigned* ctr;
    __device__ __forceinline__ void signal(int pm, int lane, int wid) const { if (wid == 0 && lane == 0) (void)xb_add(ctr + 32 * pm, 1u); }
    __device__ __forceinline__ void wait_ready(const Unit& u) const { while (xb_ld(ctr + 32 * u.pm) < 8u) __builtin_amdgcn_s_sleep(2); asm volatile("" ::: "memory"); }
    __device__ __forceinline__ unsigned poll(const Unit& u) const { return xb_ld(ctr + 32 * u.pm); }
    __device__ __forceinline__ void spin(const Unit& u) const { while (xb_ld(ctr + 32 * u.pm) < 8u) __builtin_amdgcn_s_sleep(2); }
    __device__ __forceinline__ void acquire_async() const { asm volatile("buffer_inv sc1" ::: "memory"); }
    TileOrder o; const char* A; const char* B; const PG8_LAS int* texp; const PG8_LAS int* tbase; const PG8_LAS int* tcnt; const PG8_LAS int* rt; const int* list;
    int rem = 0, nl = 0;
    __device__ __forceinline__ bool next(int i, Unit& u) const { int pm, pn;
        if (GATHER) { if (!o.get(i, pm, pn)) return false; }
        else { const bool light = o.c >= rem; const long L = (light && i < 2) ? (long)i * nl + (o.c - rem) : 2L * nl + (long)(light ? i - 2 : i) * o.G + o.c; if (!o.map(L, pm, pn)) return false; }
        const int e = __builtin_amdgcn_readfirstlane(texp[pm]);
        u.pm = pm; u.pn = pn; u.aux = e; u.kt = KT; u.ui = i; u.rb = (pm - __builtin_amdgcn_readfirstlane(tbase[e])) * 256; u.cn = __builtin_amdgcn_readfirstlane(tcnt[e]);
        u.A = GATHER ? A : A + (size_t)((unsigned)pm * AT); u.B = B + (size_t)((unsigned)e * BE + (unsigned)pn * BT); return true; }
    __device__ __forceinline__ int tok_of(const Unit& u, int row) const { const int pos = u.rb + row; return pos < u.cn ? (list[(size_t)u.aux * MT + pos] >> 1) : 0; }
    __device__ __forceinline__ int rowtok(int ui, int row) const { if (ui < RT_UNITS) return rt[ui * 256 + row]; Unit u; next(ui, u); return tok_of(u, row); }
    __device__ __forceinline__ void fill_dst(PG8_LAS int* rtw, const float* listg, int tid) const {
        int dv[RT_UNITS / 2]; float gv[RT_UNITS / 2]; bool ok[RT_UNITS / 2];
#pragma unroll
        for (int i = 0; i < RT_UNITS / 2; ++i) { Unit u; ok[i] = next(i, u); dv[i] = -1; gv[i] = 0.f;
            if (ok[i] && tid < 256) { const int pos = u.rb + tid; if (pos < u.cn) { const size_t li = (size_t)u.aux * MT + pos; dv[i] = list[li]; gv[i] = listg[li]; } } }
#pragma unroll
        for (int i = 0; i < RT_UNITS / 2; ++i) if (ok[i] && tid < 256) { rtw[i * 512 + tid] = dv[i]; rtw[i * 512 + 256 + tid] = (int)__float_as_uint(gv[i]); }
        __syncthreads(); }
    __device__ __forceinline__ void fill_rows(PG8_LAS int* rtw, int tid) const {
#pragma unroll
        for (int h = 0; h < 2; ++h) { int tk[RT_UNITS / 2]; bool ok[RT_UNITS / 2];
#pragma unroll
            for (int q = 0; q < RT_UNITS / 2; ++q) { Unit u; ok[q] = next(h * (RT_UNITS / 2) + q, u); tk[q] = 0; if (ok[q] && tid < 256) tk[q] = tok_of(u, tid); }
#pragma unroll
            for (int q = 0; q < RT_UNITS / 2; ++q) if (ok[q] && tid < 256) rtw[(h * (RT_UNITS / 2) + q) * 256 + tid] = tk[q]; }
        __syncthreads(); }
};

struct EpiBf16 {
    static constexpr bool PERM = true;
    bf16_t* O; int ldc; float* P;
    __device__ __forceinline__ void operator()(const f32x4 (&acc)[2][2][4][2], const Unit& u, int wr, int wc, int fr, int fq) const {
        const int row0 = u.pm * BM + wr * 64 + fr, col0 = u.pn * BM + wc * 32 + 8 * fq;
        if (u.aux == 0) {
#pragma unroll
            for (int ai = 0; ai < 2; ++ai)
#pragma unroll
                for (int m = 0; m < 4; ++m) { bf16_t* rowp = O + (size_t)(row0 + ai * HALF + m * 16) * ldc + col0;
#pragma unroll
                    for (int bj = 0; bj < 2; ++bj) { const f32x4 v0 = acc[ai][bj][m][0], v1 = acc[ai][bj][m][1];
                        v4u w; w.x = cvt_pk_bf16(v0[0], v0[1]); w.y = cvt_pk_bf16(v0[2], v0[3]); w.z = cvt_pk_bf16(v1[0], v1[1]); w.w = cvt_pk_bf16(v1[2], v1[3]);
                        *(v4u*)(rowp + bj * HALF) = w; } }
        } else {
            float* pb = P + (size_t)(u.aux - 1) * 512 * ldc;
#pragma unroll
            for (int ai = 0; ai < 2; ++ai)
#pragma unroll
                for (int m = 0; m < 4; ++m) { float* rowp = pb + (size_t)(row0 + ai * HALF + m * 16) * ldc + col0;
#pragma unroll
                    for (int bj = 0; bj < 2; ++bj) { *(f32x4*)(rowp + bj * HALF) = acc[ai][bj][m][0]; *(f32x4*)(rowp + bj * HALF + 4) = acc[ai][bj][m][1]; } }
        }
    }
};
struct EpiBf16W {
    static constexpr bool PERM = true;
    bf16_t* O; int ldc;
    __device__ __forceinline__ void operator()(const f32x4 (&acc)[2][2][4][2], const Unit& u, int wr, int wc, int fr, int fq) const {
        const int row0 = u.pm * BM + wr * 64 + fr, col0 = u.pn * BM + wc * 32 + 8 * fq;
#pragma unroll
        for (int ai = 0; ai < 2; ++ai)
#pragma unroll
            for (int m = 0; m < 4; ++m) { bf16_t* rowp = O + (size_t)(row0 + ai * HALF + m * 16) * ldc + col0;
#pragma unroll
                for (int bj = 0; bj < 2; ++bj) { const f32x4 v0 = acc[ai][bj][m][0], v1 = acc[ai][bj][m][1];
                    v4u w; w.x = cvt_pk_bf16(v0[0], v0[1]); w.y = cvt_pk_bf16(v0[2], v0[3]); w.z = cvt_pk_bf16(v1[0], v1[1]); w.w = cvt_pk_bf16(v1[2], v1[3]);
                    const bf16_t* gp = rowp + bj * HALF;
                    asm volatile("global_store_dwordx4 %0, %1, off sc1\n\ts_nop 1" :: "v"(gp), "v"(w) : "memory"); } }
    }
};
struct EpiQkv {
    static constexpr bool PERM = true;
    bf16_t* O; int ldc; float* P; bf16_t* V;
    __device__ __forceinline__ void operator()(const f32x4 (&acc)[2][2][4][2], const Unit& u, int wr, int wc, int fr, int fq) const {
        const int row0 = u.pm * BM + wr * 64 + fr, col0 = u.pn * BM + wc * 32 + 8 * fq;
        if (u.aux == 0) {
            const bool isV = u.pn >= (DM + KVD) / BM;
#pragma unroll
            for (int ai = 0; ai < 2; ++ai)
#pragma unroll
                for (int m = 0; m < 4; ++m) { const int row = row0 + ai * HALF + m * 16; bf16_t* rowp = O + (size_t)row * ldc + col0; size_t vstep = HALF;
                    if (isV) { const bool lat = row >= NCTX; const int lr = row - NCTX, b = lat ? (lr >> 13) : (row >> 8), kpos = lat ? (CTXL + (lr & 8191)) : (row & 255);
                        rowp = V + (((size_t)b * NKV + (size_t)(u.pn - (DM + KVD) / BM) * 2) * SKV + kpos) * HD + wc * 32 + 8 * fq; vstep = (size_t)SKV * HD; }
#pragma unroll
                    for (int bj = 0; bj < 2; ++bj) { const f32x4 v0 = acc[ai][bj][m][0], v1 = acc[ai][bj][m][1];
                        v4u w; w.x = cvt_pk_bf16(v0[0], v0[1]); w.y = cvt_pk_bf16(v0[2], v0[3]); w.z = cvt_pk_bf16(v1[0], v1[1]); w.w = cvt_pk_bf16(v1[2], v1[3]);
                        *(v4u*)(rowp + bj * vstep) = w; } }
        } else {
            float* pb = P + (size_t)(u.aux - 1) * 512 * ldc;
#pragma unroll
            for (int ai = 0; ai < 2; ++ai)
#pragma unroll
                for (int m = 0; m < 4; ++m) { float* rowp = pb + (size_t)(row0 + ai * HALF + m * 16) * ldc + col0;
#pragma unroll
                    for (int bj = 0; bj < 2; ++bj) { *(f32x4*)(rowp + bj * HALF) = acc[ai][bj][m][0]; *(f32x4*)(rowp + bj * HALF + 4) = acc[ai][bj][m][1]; } }
        }
    }
};
struct EpiGateUp {
    static constexpr bool PERM = true;
    bf16_t* ACT;
    __device__ __forceinline__ void operator()(const f32x4 (&acc)[2][2][4][2], const Unit& u, int wr, int wc, int fr, int fq) const {
        const int row0 = u.pm * BM + wr * 64 + fr, col0 = u.pn * HALF + wc * 32 + 8 * fq;
#pragma unroll
        for (int ai = 0; ai < 2; ++ai)
#pragma unroll
            for (int m = 0; m < 4; ++m) { bf16_t* rowp = ACT + (size_t)(row0 + ai * HALF + m * 16) * DE + col0;
                float v[8];
#pragma unroll
                for (int n = 0; n < 2; ++n)
#pragma unroll
                    for (int j = 0; j < 4; ++j) v[n * 4 + j] = silu_f(acc[ai][0][m][n][j]) * acc[ai][1][m][n][j];
                v4u w; w.x = cvt_pk_bf16(v[0], v[1]); w.y = cvt_pk_bf16(v[2], v[3]); w.z = cvt_pk_bf16(v[4], v[5]); w.w = cvt_pk_bf16(v[6], v[7]);
                asm volatile("global_store_dwordx4 %0, %1, off sc1\n\ts_nop 1" :: "v"(rowp), "v"(w) : "memory"); }
    }
};
struct EpiDown {
    static constexpr bool PERM = true;
    bf16_t* FB; const PG8_LAS int* rt;
    __device__ __forceinline__ void operator()(const f32x4 (&acc)[2][2][4][2], const Unit& u, int wr, int wc, int fr, int fq) const {
        const int r0 = wr * 64 + fr, col0 = u.pn * BM + wc * 32 + 8 * fq; const PG8_LAS int* tb = rt + u.ui * 512 + r0;
#pragma unroll
        for (int ai = 0; ai < 2; ++ai)
#pragma unroll
            for (int m = 0; m < 4; ++m) { const int d_ = tb[ai * HALF + m * 16]; const float g_ = __uint_as_float((unsigned)tb[256 + ai * HALF + m * 16]);
                if (d_ >= 0) { bf16_t* fr_ = FB + (size_t)d_ * DM + col0;
#pragma unroll
                    for (int bj = 0; bj < 2; ++bj) { const f32x4 v0 = acc[ai][bj][m][0] * g_, v1 = acc[ai][bj][m][1] * g_;
                        v4u w; w.x = cvt_pk_bf16(v0[0], v0[1]); w.y = cvt_pk_bf16(v0[2], v0[3]); w.z = cvt_pk_bf16(v1[0], v1[1]); w.w = cvt_pk_bf16(v1[2], v1[3]);
                        *(v4u*)(fr_ + bj * HALF) = w; } } }
    }
};
}

namespace att {
constexpr int D = 128, NW = 8, QBLK = 32, KVBLK = 64;
constexpr float SCALE = 0.088388347648318440f;
constexpr float THR = 8.f;
#ifndef ATT_SDEPTH
#define ATT_SDEPTH 1
#endif
constexpr int SDEPTH = ATT_SDEPTH;
constexpr int LDQ = DM, LDK = HD, LDO = DM;
constexpr size_t SHM_V = KVBLK * D * 2, SHM_K = KVBLK * D * 2, SHM_ATTN = 2 * SHM_V + 2 * SHM_K + NW * 64 * 4;
typedef unsigned u32x4 __attribute__((ext_vector_type(4)));
#define KSWZ(row, colB) ((row) * 256 + ((colB) ^ (((row) & 7) << 4)))
#define SBAR() __builtin_amdgcn_sched_barrier(0)
__device__ __forceinline__ int crow(int r, int hi) { return (r & 3) + 8 * (r >> 2) + 4 * hi; }
__device__ __forceinline__ unsigned cvtpk(float lo, float hi) { unsigned r; asm volatile("v_cvt_pk_bf16_f32 %0, %1, %2" : "=v"(r) : "v"(lo), "v"(hi)); return r; }
__device__ __forceinline__ bf16x8 ld8(const bf16_t* p) { return *reinterpret_cast<const bf16x8*>(p); }

__device__ __forceinline__ void partialSM(f32x16& p0, f32x16& p1, float& m_reg, float& mn, float& alpha) {
  constexpr float C = SCALE * 1.4426950408889634f;
  float pmax = p0[0]; for (int r = 1; r < 16; ++r) pmax = fmaxf(pmax, p0[r]); for (int r = 0; r < 16; ++r) pmax = fmaxf(pmax, p1[r]);
  { auto rr = __builtin_amdgcn_permlane32_swap(__float_as_uint(pmax), __float_as_uint(pmax), false, false);
    pmax = fmaxf(__uint_as_float(rr[0]), __uint_as_float(rr[1])); }
  if (__builtin_expect(__all(pmax - m_reg <= THR / SCALE), 1)) { mn = m_reg; alpha = 1.f; }
  else { mn = fmaxf(m_reg, pmax); alpha = __builtin_amdgcn_exp2f((m_reg - mn) * C); m_reg = mn; }
  float mnC = -mn * C;
  for (int r = 0; r < 16; ++r) p0[r] = fmaf(p0[r], C, mnC); for (int r = 0; r < 16; ++r) p1[r] = fmaf(p1[r], C, mnC);
  for (int r = 0; r < 16; ++r) p0[r] = __builtin_amdgcn_exp2f(p0[r]);
}
__device__ __forceinline__ void finishSM(f32x16& p0, f32x16& p1, float alpha, float& l_reg, bf16x8& pa0, bf16x8& pa1, bf16x8& pa2, bf16x8& pa3) {
  for (int r = 0; r < 16; ++r) p1[r] = __builtin_amdgcn_exp2f(p1[r]);
  float ps = 0; for (int r = 0; r < 16; ++r) ps += p0[r]; for (int r = 0; r < 16; ++r) ps += p1[r];
  { auto rr = __builtin_amdgcn_permlane32_swap(__float_as_uint(ps), __float_as_uint(ps), false, false);
    ps = __uint_as_float(rr[0]) + __uint_as_float(rr[1]); }
  l_reg = l_reg * alpha + ps;
#define PK4(P, BASE, OUT) do { unsigned a0 = cvtpk(P[BASE + 0], P[BASE + 1]), a1 = cvtpk(P[BASE + 2], P[BASE + 3]);   \
    unsigned b0 = cvtpk(P[BASE + 4], P[BASE + 5]), b1 = cvtpk(P[BASE + 6], P[BASE + 7]);                              \
    auto r0 = __builtin_amdgcn_permlane32_swap(a0, b0, false, false); auto r1 = __builtin_amdgcn_permlane32_swap(a1, b1, false, false); \
    u32x4 w = {r0[0], r1[0], r0[1], r1[1]}; OUT = *reinterpret_cast<bf16x8*>(&w); } while (0)
  PK4(p0, 0, pa0); PK4(p0, 8, pa1); PK4(p1, 0, pa2); PK4(p1, 8, pa3);
#undef PK4
}
__device__ __forceinline__ void qkt(f32x16& p0, f32x16& p1, const bf16_t* Ks, const bf16x8* qr, int r32, int hi) {
  p0 = f32x16{}; p1 = f32x16{};
  for (int d0 = 0; d0 < 8; ++d0) { int cb = (d0 * 16 + hi * 8) * 2;
    bf16x8 b0 = *reinterpret_cast<const bf16x8*>((const char*)Ks + KSWZ(r32, cb));
    bf16x8 b1 = *reinterpret_cast<const bf16x8*>((const char*)Ks + KSWZ(32 + r32, cb));
    p0 = __builtin_amdgcn_mfma_f32_32x32x16_bf16(b0, qr[d0], p0, 0, 0, 0);
    p1 = __builtin_amdgcn_mfma_f32_32x32x16_bf16(b1, qr[d0], p1, 0, 0, 0); }
}
__device__ __forceinline__ int v_st(int k, int c) { const int kk = (k & ~0xC) | ((k & 4) << 1) | ((k & 8) >> 1); return ((kk >> 3) * 4 + (c >> 5)) * 512 + ((kk & 7) * 32 + (c & 31)) * 2; }
__device__ __forceinline__ int v_rd_base(int lane) { return ((lane & 3) << 3) | (((lane >> 2) & 3) << 6) | (((lane >> 4) & 1) << 5) | (((lane >> 5) & 1) << 8); }
constexpr int v_rd_off(int d0, int ks, int half) { return d0 * 512 + ks * 4096 + half * 2048; }
template <int OFF> __device__ __forceinline__ s16x4 tr_read(int vb) {
  s16x4 r; asm volatile("ds_read_b64_tr_b16 %0, %1 offset:%2" : "=&v"(r) : "v"(vb), "i"(OFF) : "memory"); return r;
}
template <int D0> __device__ __forceinline__ void pv_one(f32x16& od, int vb, bf16x8 pa0, bf16x8 pa1, bf16x8 pa2, bf16x8 pa3) {
  const s16x4 l0 = tr_read<v_rd_off(D0, 0, 0)>(vb), h0 = tr_read<v_rd_off(D0, 0, 1)>(vb), l1 = tr_read<v_rd_off(D0, 1, 0)>(vb), h1 = tr_read<v_rd_off(D0, 1, 1)>(vb);
  const s16x4 l2 = tr_read<v_rd_off(D0, 2, 0)>(vb), h2 = tr_read<v_rd_off(D0, 2, 1)>(vb), l3 = tr_read<v_rd_off(D0, 3, 0)>(vb), h3 = tr_read<v_rd_off(D0, 3, 1)>(vb);
  asm volatile("s_waitcnt lgkmcnt(0)" ::: "memory"); SBAR();
#define PK(L, H) (bf16x8){L[0], L[1], L[2], L[3], H[0], H[1], H[2], H[3]}
  od = __builtin_amdgcn_mfma_f32_32x32x16_bf16(pa0, PK(l0, h0), od, 0, 0, 0);
  od = __builtin_amdgcn_mfma_f32_32x32x16_bf16(pa1, PK(l1, h1), od, 0, 0, 0);
  od = __builtin_amdgcn_mfma_f32_32x32x16_bf16(pa2, PK(l2, h2), od, 0, 0, 0);
  od = __builtin_amdgcn_mfma_f32_32x32x16_bf16(pa3, PK(l3, h3), od, 0, 0, 0);
#undef PK
}
__device__ __forceinline__ void pv_d0(f32x16* o, int vb, bf16x8 pa0, bf16x8 pa1, bf16x8 pa2, bf16x8 pa3) {
  pv_one<0>(o[0], vb, pa0, pa1, pa2, pa3); pv_one<1>(o[1], vb, pa0, pa1, pa2, pa3); pv_one<2>(o[2], vb, pa0, pa1, pa2, pa3); pv_one<3>(o[3], vb, pa0, pa1, pa2, pa3);
}
__device__ __forceinline__ void attn_dense_body(const bf16_t* __restrict__ Qb, const bf16_t* __restrict__ Kh, const bf16_t* __restrict__ Vh,
                                                bf16_t* __restrict__ Ob, int seq, char* lds) {
  const int tid = otid(), wid = tid >> 6, lane = tid & 63, r32 = lane & 31, hi = lane >> 5;
  bf16_t* V_lds = (bf16_t*)lds; bf16_t* K_lds = (bf16_t*)(lds + 2 * SHM_V);
  float* ws = (float*)(lds + 2 * SHM_V + 2 * SHM_K) + wid * 64; float* li_l = ws; float* al_l = ws + 32;
  float m_reg = -1e30f, l_reg = 0; f32x16 o[4] = {}; bf16x8 qr[8];
  const bf16_t* Qw = Qb + (long)(wid * QBLK + r32) * LDQ + hi * 8;
#pragma unroll
  for (int d0 = 0; d0 < 8; ++d0) qr[d0] = ld8(Qw + d0 * 16);
  const int sr = tid >> 4, sc = (tid & 15) * 8, vst0 = v_st(sr, sc), vst1 = v_st(32 + sr, sc);
  const int vb0 = (int)(uintptr_t)V_lds + v_rd_base(lane);
  struct { bf16x8 vs0, vs1, ks0, ks1; } sr_[SDEPTH];
#define SLOAD(i, k0) do { sr_[i].vs0 = ld8(&Vh[(long)((k0) + sr) * LDK + sc]); sr_[i].vs1 = ld8(&Vh[(long)((k0) + 32 + sr) * LDK + sc]); \
    sr_[i].ks0 = ld8(&Kh[(long)((k0) + sr) * LDK + sc]); sr_[i].ks1 = ld8(&Kh[(long)((k0) + 32 + sr) * LDK + sc]); } while (0)
#define SWRITE(b, i) do { *(bf16x8*)((char*)V_lds + (b) * SHM_V + vst0) = sr_[i].vs0;          \
    *(bf16x8*)((char*)V_lds + (b) * SHM_V + vst1) = sr_[i].vs1; int kc = sc * 2;               \
    *(bf16x8*)((char*)K_lds + (b) * SHM_K + KSWZ(sr, kc)) = sr_[i].ks0;                       \
    *(bf16x8*)((char*)K_lds + (b) * SHM_K + KSWZ(32 + sr, kc)) = sr_[i].ks1; } while (0)
#define SWAIT() do { if constexpr (SDEPTH == 2) asm volatile("s_waitcnt vmcnt(4)" ::: "memory"); else asm volatile("s_waitcnt vmcnt(0)" ::: "memory"); } while (0)
#define RESC(a) do { if (__any((a) < 1.f)) { if (hi == 0) al_l[r32] = (a); asm volatile("s_waitcnt lgkmcnt(0)" ::: "memory"); \
    for (int d = 0; d < 4; ++d) for (int r = 0; r < 16; ++r) o[d][r] *= al_l[crow(r, hi)]; } } while (0)
  f32x16 pA0, pA1, pB0, pB1; float mnA, mnB, alA, alB; bf16x8 pa0, pa1, pa2, pa3; const int NT = seq / KVBLK;
  constexpr int SE = 0, SO = SDEPTH - 1;
  SLOAD(SE, 0); asm volatile("s_waitcnt vmcnt(0)" ::: "memory"); SWRITE(0, SE); __syncthreads();
  qkt(pA0, pA1, K_lds, qr, r32, hi); partialSM(pA0, pA1, m_reg, mnA, alA);
  SLOAD(SO, KVBLK); if constexpr (SDEPTH == 2) { if (2 < NT) SLOAD(SE, 2 * KVBLK); }
  SWAIT(); SWRITE(1, SO); __syncthreads();
  for (int j = 1; j + 1 < NT; j += 2) {
    SBAR(); qkt(pB0, pB1, (bf16_t*)((char*)K_lds + SHM_K), qr, r32, hi);
    finishSM(pA0, pA1, alA, l_reg, pa0, pa1, pa2, pa3); SBAR();
    SLOAD(SO, (j + SDEPTH) * KVBLK); SBAR();
    pv_d0(o, vb0, pa0, pa1, pa2, pa3); partialSM(pB0, pB1, m_reg, mnB, alB);
    __syncthreads(); SWAIT(); SWRITE(0, SE);
    RESC(alB); __syncthreads();
    SBAR(); qkt(pA0, pA1, K_lds, qr, r32, hi);
    finishSM(pB0, pB1, alB, l_reg, pa0, pa1, pa2, pa3); SBAR();
    if (SDEPTH == 1 || j + 3 < NT) SLOAD(SE, (j + 1 + SDEPTH) * KVBLK); SBAR();
    pv_d0(o, vb0 + (int)SHM_V, pa0, pa1, pa2, pa3); partialSM(pA0, pA1, m_reg, mnA, alA);
    __syncthreads(); SWAIT(); SWRITE(1, SO);
    RESC(alA); __syncthreads();
  }
  SBAR(); qkt(pB0, pB1, (bf16_t*)((char*)K_lds + SHM_K), qr, r32, hi);
  finishSM(pA0, pA1, alA, l_reg, pa0, pa1, pa2, pa3); SBAR();
  pv_d0(o, vb0, pa0, pa1, pa2, pa3); partialSM(pB0, pB1, m_reg, mnB, alB);
  __syncthreads(); RESC(alB);
  finishSM(pB0, pB1, alB, l_reg, pa0, pa1, pa2, pa3); SBAR();
  pv_d0(o, vb0 + (int)SHM_V, pa0, pa1, pa2, pa3);
  if (hi == 0) li_l[r32] = l_reg; asm volatile("s_waitcnt lgkmcnt(0)" ::: "memory");
  float rli[16];
#pragma unroll
  for (int r = 0; r < 16; ++r) rli[r] = __builtin_amdgcn_rcpf(li_l[crow(r, hi)]);
  bf16_t* Ow = Ob + (long)(wid * QBLK) * LDO;
#pragma unroll
  for (int r = 0; r < 16; ++r) { int orow = crow(r, hi);
    for (int d0 = 0; d0 < 4; ++d0) Ow[(long)orow * LDO + d0 * 32 + r32] = (bf16_t)f2bf(o[d0][r] * rli[r]); }
  asm volatile("s_waitcnt vmcnt(0) lgkmcnt(0)" ::: "memory");
  __syncthreads();
#undef SLOAD
#undef SWRITE
#undef SWAIT
#undef RESC
}
constexpr size_t SHM_SLOT = 32768, SHM_DMA = 3 * SHM_SLOT + NW * 64 * 4;
#define ATT_WAIT_BAR() asm volatile("s_waitcnt vmcnt(0) lgkmcnt(0)\n\ts_barrier" ::: "memory")
__device__ __forceinline__ void attn_dma_body(const bf16_t* __restrict__ Qb, int ldq, int tpos0, const float* __restrict__ rope, const float* __restrict__ qgain,
                                              const bf16_t* __restrict__ Kh, const bf16_t* __restrict__ Vh, bf16_t* __restrict__ Ob, int seq, char* lds) {
  const int tid = otid(), wid = tid >> 6, lane = tid & 63, r32 = lane & 31, hi = lane >> 5;
  float* ws = (float*)(lds + 3 * SHM_SLOT) + wid * 64; float* li_l = ws; float* al_l = ws + 32;
  float m_reg = -1e30f, l_reg = 0; f32x16 o[4] = {}; bf16x8 qr[8];
  const bf16_t* Qw = Qb + (long)(wid * QBLK + r32) * ldq + hi * 8;
  unsigned koff[2], voff[2];
#pragma unroll
  for (int c = 0; c < 2; ++c) { const int g = c * 512 + tid;
    { const int row = g >> 4, ch = (g & 15) ^ (row & 7); koff[c] = (unsigned)(row * 128 + ch * 8) * 2u; }
    { const int sub = g >> 5, kk = (sub >> 2) * 8 + ((g >> 2) & 7), k = (kk & ~0xC) | ((kk & 4) << 1) | ((kk & 8) >> 1), col = (sub & 3) * 32 + (g & 3) * 8; voff[c] = (unsigned)(k * 128 + col) * 2u; } }
  const unsigned wbase = (unsigned)__builtin_amdgcn_readfirstlane(wid) * 1024u;
  typedef __attribute__((address_space(3))) unsigned lds_u32;
  lds_u32* ldsl = (lds_u32*)(__attribute__((address_space(3))) char*)lds;
#define ATT_DMA(t, slot) do { const char* kt_ = (const char*)Kh + (size_t)(t) * (KVBLK * D * 2); const char* vt_ = (const char*)Vh + (size_t)(t) * (KVBLK * D * 2); \
    _Pragma("unroll") for (int c_ = 0; c_ < 2; ++c_) { \
      __builtin_amdgcn_global_load_lds((const unsigned*)(kt_ + koff[c_]), (lds_u32*)((__attribute__((address_space(3))) char*)ldsl + (slot) * SHM_SLOT + c_ * 8192 + wbase), 16, 0, 0); \
      __builtin_amdgcn_global_load_lds((const unsigned*)(vt_ + voff[c_]), (lds_u32*)((__attribute__((address_space(3))) char*)ldsl + (slot) * SHM_SLOT + 16384 + c_ * 8192 + wbase), 16, 0, 0); } } while (0)
#define RESC(a) do { if (__any((a) < 1.f)) { if (hi == 0) al_l[r32] = (a); asm volatile("s_waitcnt lgkmcnt(0)" ::: "memory"); \
    for (int d = 0; d < 4; ++d) for (int r = 0; r < 16; ++r) o[d][r] *= al_l[crow(r, hi)]; } } while (0)
  const int NT = seq / KVBLK;
  ATT_DMA(0, 0); ATT_DMA(1, 1);
#pragma unroll
  for (int d0 = 0; d0 < 8; ++d0) qr[d0] = ld8(Qw + d0 * 16);
  if (tpos0 >= 0) {
    float ss = 0.f;
#pragma unroll
    for (int d0 = 0; d0 < 8; ++d0)
#pragma unroll
      for (int i = 0; i < 8; ++i) { const float x = bf2f((unsigned)(unsigned short)qr[d0][i]); ss += x * x; }
    { auto rr = __builtin_amdgcn_permlane32_swap(__float_as_uint(ss), __float_as_uint(ss), false, false); ss = __uint_as_float(rr[0]) + __uint_as_float(rr[1]); }
    const float rinv = 1.0f / sqrtf(ss * (1.0f / 128.0f) + RMS_EPS);
    const int t = tpos0 + wid * QBLK + r32;
#pragma unroll
    for (int ax = 0; ax < 2; ++ax) { const int pos = ax ? (t & 63) : (t >> 6);
#pragma unroll
      for (int q = 0; q < 2; ++q) { const int dl = 4 * ax + q, dh = dl + 2, p0 = q * 16 + 8 * hi;
        const float* cp_ = rope + pos * 32 + p0; const float* gl = qgain + dl * 16 + 8 * hi; const float* gh = qgain + dh * 16 + 8 * hi;
        float cs[8], sn[8], lo[8], hv[8];
#pragma unroll
        for (int i = 0; i < 8; ++i) { cs[i] = cp_[i]; sn[i] = cp_[4096 + i];
          lo[i] = bf2f((unsigned)(unsigned short)qr[dl][i]) * rinv * gl[i]; hv[i] = bf2f((unsigned)(unsigned short)qr[dh][i]) * rinv * gh[i]; }
        u32x4 wl, wh;
#pragma unroll
        for (int i = 0; i < 4; ++i) { const float l0 = lo[2 * i] * cs[2 * i] - hv[2 * i] * sn[2 * i], l1 = lo[2 * i + 1] * cs[2 * i + 1] - hv[2 * i + 1] * sn[2 * i + 1];
          const float h0 = hv[2 * i] * cs[2 * i] + lo[2 * i] * sn[2 * i], h1 = hv[2 * i + 1] * cs[2 * i + 1] + lo[2 * i + 1] * sn[2 * i + 1];
          wl[i] = pk2(l0, l1); wh[i] = pk2(h0, h1); }
        qr[dl] = *reinterpret_cast<bf16x8*>(&wl); qr[dh] = *reinterpret_cast<bf16x8*>(&wh); } } }
#pragma unroll
  for (int d0 = 0; d0 < 8; ++d0) asm volatile("" : "+v"(qr[d0]));
  ATT_WAIT_BAR();
  if (2 < NT) ATT_DMA(2, 2);
  const int vb0 = (int)(uintptr_t)lds + 16384 + v_rd_base(lane);
  f32x16 pA0, pA1, pB0, pB1; float mnA, mnB, alA, alB; bf16x8 pa0, pa1, pa2, pa3;
  qkt(pA0, pA1, (const bf16_t*)lds, qr, r32, hi); partialSM(pA0, pA1, m_reg, mnA, alA);
  int sj = 1;
  for (int j = 1; j + 1 < NT; j += 2) {
    { const int sp = sj == 0 ? 2 : sj - 1;
      SBAR(); qkt(pB0, pB1, (const bf16_t*)(lds + sj * SHM_SLOT), qr, r32, hi);
      finishSM(pA0, pA1, alA, l_reg, pa0, pa1, pa2, pa3); SBAR();
      pv_d0(o, vb0 + sp * (int)SHM_SLOT, pa0, pa1, pa2, pa3); partialSM(pB0, pB1, m_reg, mnB, alB);
      ATT_WAIT_BAR();
      if (j + 2 < NT) ATT_DMA(j + 2, sp);
      RESC(alB); }
    { const int s1 = sj == 2 ? 0 : sj + 1;
      SBAR(); qkt(pA0, pA1, (const bf16_t*)(lds + s1 * SHM_SLOT), qr, r32, hi);
      finishSM(pB0, pB1, alB, l_reg, pa0, pa1, pa2, pa3); SBAR();
      pv_d0(o, vb0 + sj * (int)SHM_SLOT, pa0, pa1, pa2, pa3); partialSM(pA0, pA1, m_reg, mnA, alA);
      ATT_WAIT_BAR();
      if (j + 3 < NT) ATT_DMA(j + 3, sj);
      RESC(alA);
      sj = s1 == 2 ? 0 : s1 + 1; }
  }
  { const int sp = sj == 0 ? 2 : sj - 1;
    SBAR(); qkt(pB0, pB1, (const bf16_t*)(lds + sj * SHM_SLOT), qr, r32, hi);
    finishSM(pA0, pA1, alA, l_reg, pa0, pa1, pa2, pa3); SBAR();
    pv_d0(o, vb0 + sp * (int)SHM_SLOT, pa0, pa1, pa2, pa3); partialSM(pB0, pB1, m_reg, mnB, alB);
    RESC(alB);
    finishSM(pB0, pB1, alB, l_reg, pa0, pa1, pa2, pa3); SBAR();
    pv_d0(o, vb0 + sj * (int)SHM_SLOT, pa0, pa1, pa2, pa3); }
  if (hi == 0) li_l[r32] = l_reg; asm volatile("s_waitcnt lgkmcnt(0)" ::: "memory");
  float rli[16];
#pragma unroll
  for (int r = 0; r < 16; ++r) rli[r] = __builtin_amdgcn_rcpf(li_l[crow(r, hi)]);
  bf16_t* Ow = Ob + (long)(wid * QBLK) * LDO;
  asm volatile("s_waitcnt lgkmcnt(0)\n\ts_barrier" ::: "memory");
  { char* st = lds + wid * 8704;
#pragma unroll
    for (int r = 0; r < 16; ++r) { const int orow = crow(r, hi);
#pragma unroll
      for (int d0 = 0; d0 < 4; ++d0) *(bf16_t*)(st + orow * 272 + (d0 * 32 + r32) * 2) = (bf16_t)f2bf(o[d0][r] * rli[r]); }
    asm volatile("s_waitcnt lgkmcnt(0)" ::: "memory");
#pragma unroll
    for (int i = 0; i < 8; ++i) { const int c = i * 64 + lane, row = c >> 4, cc = c & 15; const u32x4 v = *(const u32x4*)(st + row * 272 + cc * 16);
      const bf16_t* gp = Ow + (long)row * LDO + cc * 8;
      asm volatile("global_store_dwordx4 %0, %1, off sc1\n\ts_nop 1" :: "v"(gp), "v"(v) : "memory"); } }
  ATT_WAIT_BAR();
#undef ATT_DMA
#undef RESC
}
#undef KSWZ
}

struct Params {
    const float *x, *c, *ctx, *c_ctx, *w_mod, *b_mod, *ln_g, *ln_b, *w_qkv, *q_gain, *k_gain, *w_o, *w_pool, *pool_scale, *w_router, *router_bias, *w_gate, *w_up, *w_down;
    float* out; unsigned char* ws; int ph_lo, ph_hi;
};

struct TItem { const float* W; bf16_t* WT; int K, N, kind, k0, n0; };
__device__ __forceinline__ int t_drow(int kind, int n) { return kind == 0 ? n : ((n >> 7) * 256 + (kind == 2 ? 128 : 0) + (n & 127)); }
__device__ __forceinline__ void t_load(const TItem& d, float (&r)[32], int lane) {
    const float* p = d.W + (size_t)(d.k0 + (lane >> 5)) * d.N + d.n0 + (lane & 31);
#pragma unroll
    for (int i = 0; i < 32; ++i) r[i] = __builtin_nontemporal_load(p + (size_t)(2 * i) * d.N);
}
__device__ __forceinline__ void t_store(const TItem& d, const float (&r)[32], LAS float* scr, int lane) {
#pragma unroll
    for (int i = 0; i < 32; ++i) scr[(2 * i + (lane >> 5)) * 33 + (lane & 31)] = r[i];
    LDS_WAIT(); asm volatile("" ::: "memory");
    const int c = lane & 7;
#pragma unroll
    for (int j = 0; j < 4; ++j) { const int n = (lane >> 3) + 8 * j; const LAS float* s = scr + (8 * c) * 33 + n;
        v4u o; o.x = pk2(s[0 * 33], s[1 * 33]); o.y = pk2(s[2 * 33], s[3 * 33]); o.z = pk2(s[4 * 33], s[5 * 33]); o.w = pk2(s[6 * 33], s[7 * 33]);
        __builtin_nontemporal_store(o, (GAS v4u*)(d.WT + (size_t)t_drow(d.kind, d.n0 + n) * d.K + d.k0 + 8 * c)); }
    LDS_WAIT(); asm volatile("" ::: "memory");
}

__device__ __forceinline__ void mod_prepare(const float* cl, const float* cc, LAS float* sv, int tid) {
    for (int i = tid; i < 3 * DM; i += 512) { const int cd = i >> 11, k = i & 2047; const float v = (cd < 2) ? cl[cd * DM + k] : cc[k]; sv[i] = v / (1.0f + expf(-v)); }
    __syncthreads();
}
__device__ __forceinline__ void mod_item(int it, const float* wm, const float* bm, float* MOD, const LAS float* sv, LAS float* red, int tid, int lane, int wave) {
    const int c4 = lane & 7, kr = (lane >> 3) + 8 * wave;
    const int l = it / 384, nb = it % 384; const float* W = wm + (size_t)l * DM * 12288 + nb * 32 + c4 * 4;
    f32x4 a0 = {0, 0, 0, 0}, a1 = a0, a2 = a0;
#pragma unroll 16
    for (int s = 0; s < 32; ++s) { const int k = s * 64 + kr; const f32x4 w = *(const f32x4*)(W + (size_t)k * 12288);
        a0 += w * sv[k]; a1 += w * sv[DM + k]; a2 += w * sv[2 * DM + k]; }
    *(LAS f32x4*)(red + (kr * 3 + 0) * 32 + c4 * 4) = a0; *(LAS f32x4*)(red + (kr * 3 + 1) * 32 + c4 * 4) = a1; *(LAS f32x4*)(red + (kr * 3 + 2) * 32 + c4 * 4) = a2;
    __syncthreads();
    if (tid < 96) { const int cd = tid >> 5, n = tid & 31; float s = 0.f; for (int r = 0; r < 64; ++r) s += red[(r * 3 + cd) * 32 + n];
        MOD[((size_t)l * 3 + cd) * 12288 + nb * 32 + n] = s + bm[l * 12288 + nb * 32 + n]; }
    __syncthreads();
}

typedef const __attribute__((address_space(4))) Params CParams;
__device__ __forceinline__ CParams* kparams() { CParams* k = (CParams*)__builtin_amdgcn_kernarg_segment_ptr(); asm volatile("" : "+s"(k)); return k; }
#define WSP(T, off) ((T*)(kp->ws + (off)))


#define IN(k) (lo <= (k) && (k) < hi)
#define NREP(k) (1 + ((REP_MASK >> (k)) & 1))
#define SEAM(k) do { if (IN(k) && IN((k) + 1)) xcd_barrier(bar); } while (0)
#define TIDS const int tid = otid(), lane = tid & 63, wave = __builtin_amdgcn_readfirstlane(tid >> 6), G = ogrid(), bx = obid(), gw = bx * 8 + wave, NGW = G * 8; (void)lane; (void)gw; (void)NGW


template <int layer>
__device__ __forceinline__ void layer_half(const int lo, const int hi, const XcdBarrier& bar, LAS unsigned char* L, LAS int* tcnt, LAS int* tbase, LAS int* texp) {
        const int P6 = 6 + 7 * layer;
        if (IN(P6)) _Pragma("unroll 1") for (int rep_ = 0; rep_ < NREP(6); ++rep_) {
            CParams* kp = kparams(); TIDS;
            const int row_lo = layer == 0 ? 0 : NCTX;
            const float* modl = WSP(float, WS_MOD) + (size_t)layer * 3 * 12288;
            unsigned* cnt = WSP(unsigned, WS_CTL) + CW_CNT + layer * 1024;
            const bf16_t* Y = WSP(bf16_t, WS_Y); float* X1 = WSP(float, WS_X1); bf16_t* Hb = WSP(bf16_t, WS_H);
            const float* xlat = kp->x; const float* xctx = kp->ctx; const bf16_t* X2b = WSP(bf16_t, WS_X2);
            const float* pscale = kp->pool_scale;
            int* LIST = WSP(int, WS_LIST); float* LISTG = WSP(float, WS_LIST) + (size_t)32 * MT;
            const float* rbias = kp->router_bias;
            LAS bf16_t* hp = (LAS bf16_t*)L;
            LAS float* part = (LAS float*)(L + 65536);
            LAS int* lcnt = (LAS int*)(L + 65536 + 8192); LAS int* lbase = lcnt + 32;
            LAS int* asg = (LAS int*)(L + 65536 + 8192 + 256);
            LAS float* vG1 = (LAS float*)(L + 82176); LAS float* vLG = vG1 + DM; LAS float* vLB = vLG + DM; LAS float* vSC = vLB + DM; LAS float* vSH = vSC + DM;
            const float* lg = kp->ln_g + (size_t)(layer * 2 + 0) * DM; const float* lb = kp->ln_b + (size_t)(layer * 2 + 0) * DM;
            const int ngrp = (MT - row_lo) / 8;
            const bool agg = ((ngrp + G - 1) / G) * 16 <= 512;
            if (tid < 32) lcnt[tid] = 0;
            const int ti = lane & 31, hi = lane >> 5;
            const bf16_t* w1p = WSP(bf16_t, WS_WR) + ((size_t)(wave * 16) * 64 + lane) * 8; const bf16_t* w2p = w1p + 32 * DM;
            const LAS bf16_t* a1p = hp + (ti & 7) * DM + wave * 256 + 8 * hi; const LAS bf16_t* a2p = a1p + 8 * DM;
            f32x4 xv[8]; v2u xb[8], yv[8];
#define P6_LOAD(grp_) do { const int row_ = row_lo + (grp_) * 8 + wave; const float* xr_ = (row_ < NCTX) ? xctx + (size_t)row_ * DM : xlat + (size_t)(row_ - NCTX) * DM; const bf16_t* yr_ = Y + (size_t)row_ * DM; const bf16_t* xb_ = X2b + (size_t)row_ * DM; \
                _Pragma("unroll") for (int j = 0; j < 8; ++j) { if (layer == 0) xv[j] = *(const f32x4*)(xr_ + (j * 64 + lane) * 4); else xb[j] = *(const v2u*)(xb_ + (j * 64 + lane) * 4); yv[j] = *(const v2u*)(yr_ + (j * 64 + lane) * 4); } } while (0)
            LAS int* rdy = (LAS int*)(L + 124928); unsigned* yd = WSP(unsigned, WS_CTL) + CW_YD; volatile LAS unsigned* MISC = (volatile LAS unsigned*)(L + MISC_OFF);
            const bool dyn = (layer == 0) && (G % 2 == 0); const int pcls = bx & 1; unsigned* q6 = WSP(unsigned, WS_CTL) + CW_P6Q + 32 * pcls;
            auto gmap = [&](unsigned pos) -> int { return pos >= 1056u ? -1 : (pos < 32u ? pcls * 32 + (int)pos : 64 + pcls * 1024 + ((int)pos - 32)); };
            auto seq = [&](int k) -> int { const int g_ = bx + k * G; return g_ < ngrp ? g_ : -1; };
            auto ensure = [&](int g_) { if (layer == 0) { const int pm_ = g_ < 64 ? (g_ >> 5) : 2 + ((g_ - 64) >> 5); if (!rdy[pm_]) { while (xb_ld(yd + 32 * pm_) < 8u) __builtin_amdgcn_s_sleep(4); asm volatile("" ::: "memory"); } } };
            if (layer == 0) { if (tid < 66) rdy[tid] = xb_ld(yd + 32 * tid) >= 8u ? 1 : 0;
                if (tid == 0) { __builtin_amdgcn_fence(__ATOMIC_ACQUIRE, "agent"); asm volatile("s_waitcnt vmcnt(0)" ::: "memory");
                    if (dyn) { MISC[36] = xb_add(q6, 1u); MISC[37] = xb_add(q6, 1u); } }
                __syncthreads(); }
            int grp = dyn ? gmap(MISC[36]) : seq(0), nxt_ = dyn ? gmap(MISC[37]) : seq(1);
            if (grp >= 0) ensure(grp);
            P6_LOAD(grp >= 0 ? grp : 0);
            int it_ = 0, cur_cd = -1;
            for (; grp >= 0; ++it_) {
                unsigned tk2 = 0xffffffffu;
                if (dyn && tid == 0 && nxt_ >= 0 && it_ + 2 < 32) tk2 = xb_add(q6, 1u);
                const int row = row_lo + grp * 8 + wave; const int cd = row_cond(row_lo + grp * 8);
                if (cd != cur_cd) {
                    const float* g1 = modl + (size_t)cd * 12288 + 2 * DM;
                    float t0[4], t1[4], t2[4], t3[4], t4[4], t5[4];
                    __syncthreads();
#pragma unroll
                    for (int q = 0; q < 4; ++q) { const int i = tid + q * 512; t0[q] = g1[i]; t1[q] = (layer == 1) ? pscale[i] : 1.0f; t2[q] = lg[i]; t3[q] = lb[i]; t4[q] = g1[DM + i]; t5[q] = g1[2 * DM + i]; }
#pragma unroll
                    for (int q = 0; q < 4; ++q) { const int i = tid + q * 512; vG1[i] = t0[q] * t1[q]; vLG[i] = t2[q]; vLB[i] = t3[q]; vSH[i] = t4[q]; vSC[i] = t5[q] + 1.0f; }
                    cur_cd = cd; __syncthreads(); }
                f32x4 v[8]; float s = 0.f;
#pragma unroll
                for (int j = 0; j < 8; ++j) { const int c = (j * 64 + lane) * 4; const f32x4 gv = *(const LAS f32x4*)(vG1 + c);
                    const f32x4 yf = {bf2f(yv[j].x & 0xffffu), bf2f(yv[j].x >> 16), bf2f(yv[j].y & 0xffffu), bf2f(yv[j].y >> 16)};
                    const f32x4 xf = (layer == 0) ? xv[j] : bf4(xb[j]);
                    v[j] = xf * ALPHA + gv * yf; s += (v[j][0] + v[j][1]) + (v[j][2] + v[j][3]); }
                if (nxt_ >= 0) { ensure(nxt_); P6_LOAD(nxt_); }
                const float mean = wave_sum(s) * (1.0f / DM); float s2 = 0.f;
#pragma unroll
                for (int j = 0; j < 8; ++j) { v[j] = v[j] - mean; s2 += (v[j][0] * v[j][0] + v[j][1] * v[j][1]) + (v[j][2] * v[j][2] + v[j][3] * v[j][3]); }
                const float rstd = 1.0f / sqrtf(wave_sum(s2) * (1.0f / DM) + LN_EPS);
#pragma unroll
                for (int j = 0; j < 8; ++j) { const int c = (j * 64 + lane) * 4;
                    const f32x4 x1 = v[j] * rstd * *(const LAS f32x4*)(vLG + c) + *(const LAS f32x4*)(vLB + c);
                    { v2u xw; xw.x = pk2(x1[0], x1[1]); xw.y = pk2(x1[2], x1[3]); *(v2u*)((bf16_t*)X1 + (size_t)row * DM + c) = xw; }
                    const f32x4 hv = x1 * *(const LAS f32x4*)(vSC + c) + *(const LAS f32x4*)(vSH + c);
                    v2u w; w.x = pk2(hv[0], hv[1]); w.y = pk2(hv[2], hv[3]); *(v2u*)(Hb + (size_t)row * DM + c) = w;
                    v2u w2; w2.x = pk2(hv[0] - bf2f(w.x & 0xffffu), hv[1] - bf2f(w.x >> 16)); w2.y = pk2(hv[2] - bf2f(w.y & 0xffffu), hv[3] - bf2f(w.y >> 16));
                    *(LAS v2u*)(hp + wave * DM + c) = w; *(LAS v2u*)(hp + (8 + wave) * DM + c) = w2; }
                const bf16_t* w1q = w1p; asm volatile("" : "+v"(w1q));
                const bf16_t* w2q = w1q + 32 * DM;
                bf16x8 wA1[4], wA2[4], wB1[4], wB2[4];
#define P6_WLOAD(d1, d2, q0) do { _Pragma("unroll") for (int q_ = 0; q_ < 4; ++q_) { d1[q_] = *(const bf16x8*)(w1q + ((q0) + q_) * 512); d2[q_] = *(const bf16x8*)(w2q + ((q0) + q_) * 512); } } while (0)
#define P6_MMA(s1, s2, q0) do { _Pragma("unroll") for (int q_ = 0; q_ < 4; ++q_) { const bf16x8 a1 = *(const LAS bf16x8*)(a1p + ((q0) + q_) * 16), a2 = *(const LAS bf16x8*)(a2p + ((q0) + q_) * 16); \
                    acc = __builtin_amdgcn_mfma_f32_32x32x16_bf16(a1, s1[q_], acc, 0, 0, 0); acc = __builtin_amdgcn_mfma_f32_32x32x16_bf16(a1, s2[q_], acc, 0, 0, 0); acc = __builtin_amdgcn_mfma_f32_32x32x16_bf16(a2, s1[q_], acc, 0, 0, 0); } } while (0)
                P6_WLOAD(wA1, wA2, 0); P6_WLOAD(wB1, wB2, 4);
                __syncthreads();
                {
                    f32x16 acc = {};
                    __builtin_amdgcn_sched_barrier(0); P6_MMA(wA1, wA2, 0); __builtin_amdgcn_sched_barrier(0);
                    P6_WLOAD(wA1, wA2, 8); __builtin_amdgcn_sched_barrier(0); P6_MMA(wB1, wB2, 4); __builtin_amdgcn_sched_barrier(0);
                    P6_WLOAD(wB1, wB2, 12); __builtin_amdgcn_sched_barrier(0); P6_MMA(wA1, wA2, 8); __builtin_amdgcn_sched_barrier(0);
                    P6_MMA(wB1, wB2, 12);
#pragma unroll
                    for (int r = 0; r < 4; ++r) part[(wave * 8 + r + 4 * hi) * 32 + ti] = acc[r];
                }
                if (dyn && tid == 0) MISC[38] = tk2;
                __syncthreads();
                {
                    const int rr = row_lo + grp * 8 + wave, e = lane & 31; float lgt = 0.f;
#pragma unroll
                    for (int k = 0; k < 8; ++k) lgt += part[(k * 8 + wave) * 32 + e];
                    const float aff = 1.0f / (1.0f + expf(-lgt)); const float sel = aff + rbias[e];
                    const float o1 = __shfl_xor(sel, 1), mx1 = fmaxf(sel, o1), mn1 = fminf(sel, o1);
                    const float mx2 = __shfl_xor(mx1, 2), mn2 = __shfl_xor(mn1, 2);
                    float gs = fmaxf(mx1, mx2) + fmaxf(fminf(mx1, mx2), fmaxf(mn1, mn2)); int bg = e >> 2;
#pragma unroll
                    for (int o = 4; o < 32; o <<= 1) { const float og = __shfl_xor(gs, o); const int ob = __shfl_xor(bg, o); if (og > gs || (og == gs && ob < bg)) { gs = og; bg = ob; } }
                    float s4[4], a4[4];
#pragma unroll
                    for (int j = 0; j < 4; ++j) { s4[j] = __shfl(sel, bg * 4 + j); a4[j] = __shfl(aff, bg * 4 + j); }
                    int i0 = 0; float m0 = s4[0], g0 = a4[0];
#pragma unroll
                    for (int j = 1; j < 4; ++j) if (s4[j] > m0) { m0 = s4[j]; i0 = j; g0 = a4[j]; }
                    int i1 = -1; float m1 = -1e30f, g1_ = 0.f;
#pragma unroll
                    for (int j = 0; j < 4; ++j) if (j != i0 && s4[j] > m1) { m1 = s4[j]; i1 = j; g1_ = a4[j]; }
                    const int e0 = __builtin_amdgcn_readfirstlane(bg * 4 + i0), e1 = __builtin_amdgcn_readfirstlane(bg * 4 + i1);
                    const float inv = 1.0f / (g0 + g1_);
                    if (lane == 0 && rep_ == 0) {
                        if (agg) { const int q0 = __hip_atomic_fetch_add(&lcnt[e0], 1, __ATOMIC_RELAXED, __HIP_MEMORY_SCOPE_WORKGROUP), q1 = __hip_atomic_fetch_add(&lcnt[e1], 1, __ATOMIC_RELAXED, __HIP_MEMORY_SCOPE_WORKGROUP);
                            LAS int* ap = asg + (it_ * 8 + wave) * 8;
                            ap[0] = e0; ap[1] = q0; ap[2] = rr * 2; ap[3] = (int)__float_as_uint(g0 * inv); ap[4] = e1; ap[5] = q1; ap[6] = rr * 2 + 1; ap[7] = (int)__float_as_uint(g1_ * inv);
                        } else {
                            const unsigned p0 = __hip_atomic_fetch_add(&cnt[e0 * 32], 1u, RLX_AGENT), p1 = __hip_atomic_fetch_add(&cnt[e1 * 32], 1u, RLX_AGENT);
                            LIST[(size_t)e0 * MT + p0] = rr * 2; LISTG[(size_t)e0 * MT + p0] = g0 * inv;
                            LIST[(size_t)e1 * MT + p1] = rr * 2 + 1; LISTG[(size_t)e1 * MT + p1] = g1_ * inv; } }
                }
                grp = nxt_; nxt_ = dyn ? gmap(MISC[38]) : seq(it_ + 2);
            }
#undef P6_LOAD
#undef P6_WLOAD
#undef P6_MMA
            __syncthreads();
            if (agg && rep_ == 0) {
                if (tid < 32) lbase[tid] = (int)__hip_atomic_fetch_add(&cnt[tid * 32], (unsigned)lcnt[tid], RLX_AGENT);
                __syncthreads();
                for (int i = tid; i < it_ * 16; i += 512) { const int e = asg[i * 4], q = asg[i * 4 + 1], src = asg[i * 4 + 2]; const float gt = __uint_as_float((unsigned)asg[i * 4 + 3]);
                    const size_t o = (size_t)e * MT + (size_t)(lbase[e] + q); LIST[o] = src; LISTG[o] = gt; }
            }
            __syncthreads();
        }
        SEAM(P6);
        int NT = 0;
        if (IN(P6 + 1) || IN(P6 + 2) || IN(P6 + 3)) {
            CParams* kp = kparams(); unsigned* cnt = WSP(unsigned, WS_CTL) + CW_CNT + layer * 1024;
            const int ttid = otid();
            if (ttid < 64) { const int ln = ttid, e = ln & 31; const int c = (int)__hip_atomic_load(&cnt[e * 32], RLX_AGENT); const int nt_ = (c + 255) >> 8; int inc = nt_;
#pragma unroll
                for (int o = 1; o < 32; o <<= 1) { const int t_ = __shfl_up(inc, o); if ((ln & 31) >= o) inc += t_; }
                if (ln < 32) { tcnt[e] = c; tbase[e] = inc - nt_; if (e == 31) tbase[32] = inc; for (int t_ = inc - nt_; t_ < inc; ++t_) texp[t_] = e; } }
            __syncthreads();
            NT = __builtin_amdgcn_readfirstlane(tbase[32]);
        }
        if (IN(P6 + 2)) _Pragma("unroll 1") for (int rep_ = 0; rep_ < NREP(8); ++rep_) {
            CParams* kp = kparams();
            typedef pg8::SchedMoe<256u * DM * 2u, 256u * DM * 2u, 2048u * DM * 2u, DM / 64, true> Sch;
            LAS int* rt = (LAS int*)(L + TAB_OFF + 1024);
            pg8::Gemm g{DM, DM, DM}; Sch S; S.o.init(NT, 8, ogrid(), obid()); S.A = WSP(const char, WS_H); S.B = WSP(const char, WS_WGU) + (size_t)layer * 32 * 2048 * DM * 2;
            S.texp = texp; S.tbase = tbase; S.tcnt = tcnt; S.rt = rt; S.list = WSP(int, WS_LIST); S.ctr = WSP(unsigned, WS_CTL) + CW_GUD + layer * 8192;
            S.fill_rows(rt, otid());
            pg8::EpiGateUp E{WSP(bf16_t, WS_ACT)};
            pg8::gemm_phase<pg8::EpiGateUp, Sch, true, true>(L, g, S, E);
        }
        if (IN(P6 + 2)) _Pragma("unroll 1") for (int rep_ = 0; rep_ < NREP(9); ++rep_) {
            CParams* kp = kparams();
            typedef pg8::SchedMoe<256u * DE * 2u, 256u * DE * 2u, (unsigned)DM * DE * 2u, DE / 64, false> Sch;
            pg8::Gemm g{DE, DE, DE}; Sch S; S.o.init(NT, 8, ogrid(), obid()); S.o.rot = 1; S.rem = (NT * 8) % ogrid(); S.nl = ogrid() - S.rem; S.A = WSP(const char, WS_ACT); S.B = WSP(const char, WS_WD) + (size_t)layer * 32 * DM * DE * 2;
            LAS int* rt = (LAS int*)(L + TAB_OFF + 1024);
            S.texp = texp; S.tbase = tbase; S.tcnt = tcnt; S.rt = nullptr; S.list = WSP(int, WS_LIST); S.ctr = WSP(unsigned, WS_CTL) + CW_GUD + layer * 8192;
            if (otid() == 0) { __builtin_amdgcn_fence(__ATOMIC_ACQUIRE, "agent"); asm volatile("s_waitcnt vmcnt(0)" ::: "memory"); }
            S.fill_dst(rt, WSP(float, WS_LIST) + (size_t)32 * MT, otid());
            pg8::EpiDown E{WSP(bf16_t, WS_FB), rt};
            pg8::gemm_phase<pg8::EpiDown, Sch, true, false>(L, g, S, E);
        }
        SEAM(P6 + 3);
        if (IN(P6 + 4)) _Pragma("unroll 1") for (int rep_ = 0; rep_ < NREP(10); ++rep_) {
            CParams* kp = kparams(); TIDS;
            const int row_lo = layer == 0 ? 0 : NCTX;
            const float* modl = WSP(float, WS_MOD) + (size_t)layer * 3 * 12288; const float* X1 = WSP(float, WS_X1); const bf16_t* FB = WSP(bf16_t, WS_FB);
            float* dstb = kp->out - (size_t)NCTX * DM; bf16_t* X2b = WSP(bf16_t, WS_X2);
            LAS float* vG2 = (LAS float*)L; LAS float* vLG = vG2 + 3 * DM; LAS float* vLB = vLG + DM;
            { const float* lg = kp->ln_g + (size_t)(layer * 2 + 1) * DM; const float* lb = kp->ln_b + (size_t)(layer * 2 + 1) * DM;
              float t0[12], t1[4], t2[4];
#pragma unroll
              for (int q = 0; q < 12; ++q) { const int i = tid + q * 512; t0[q] = modl[(size_t)(i >> 11) * 12288 + 5 * DM + (i & 2047)]; }
#pragma unroll
              for (int q = 0; q < 4; ++q) { const int i = tid + q * 512; t1[q] = lg[i]; t2[q] = lb[i]; }
#pragma unroll
              for (int q = 0; q < 12; ++q) vG2[tid + q * 512] = t0[q];
#pragma unroll
              for (int q = 0; q < 4; ++q) { vLG[tid + q * 512] = t1[q]; vLB[tid + q * 512] = t2[q]; } }
            __syncthreads();
            f32x4 xa[8]; v2u fa[8], fb[8];
#define P10_LOAD(row_) do { const float* xr_ = X1 + (size_t)(row_) * DM; const bf16_t* xb_ = (const bf16_t*)X1 + (size_t)(row_) * DM; const bf16_t* f0_ = FB + (size_t)((row_) * 2) * DM; \
                _Pragma("unroll") for (int j = 0; j < 8; ++j) { const int c = (j * 64 + lane) * 4; \
                    { const v2u q_ = *(const v2u*)(xb_ + c); xa[j] = (f32x4){bf2f(q_.x & 0xffffu), bf2f(q_.x >> 16), bf2f(q_.y & 0xffffu), bf2f(q_.y >> 16)}; } \
                    fa[j] = *(const v2u*)(f0_ + c); fb[j] = *(const v2u*)(f0_ + DM + c); } } while (0)
            { const int r0 = row_lo + gw; P10_LOAD(r0 < MT ? r0 : row_lo); }
            for (int row = row_lo + gw; row < MT; row += NGW) { const int cd = row_cond(row);
                f32x4 v[8]; float s = 0.f;
#pragma unroll
                for (int j = 0; j < 8; ++j) { const int c = (j * 64 + lane) * 4;
                    const f32x4 fs = {bf2f(fa[j].x & 0xffffu) + bf2f(fb[j].x & 0xffffu), bf2f(fa[j].x >> 16) + bf2f(fb[j].x >> 16), bf2f(fa[j].y & 0xffffu) + bf2f(fb[j].y & 0xffffu), bf2f(fa[j].y >> 16) + bf2f(fb[j].y >> 16)};
                    v[j] = xa[j] * ALPHA + *(const LAS f32x4*)(vG2 + cd * DM + c) * fs; s += (v[j][0] + v[j][1]) + (v[j][2] + v[j][3]); }
                if (row + NGW < MT) P10_LOAD(row + NGW);
                const float mean = wave_sum(s) * (1.0f / DM); float s2 = 0.f;
#pragma unroll
                for (int j = 0; j < 8; ++j) { v[j] = v[j] - mean; s2 += (v[j][0] * v[j][0] + v[j][1] * v[j][1]) + (v[j][2] * v[j][2] + v[j][3] * v[j][3]); }
                const float rstd = 1.0f / sqrtf(wave_sum(s2) * (1.0f / DM) + LN_EPS);
                float* dst = dstb + (size_t)row * DM;
#pragma unroll
                for (int j = 0; j < 8; ++j) { const int c = (j * 64 + lane) * 4; const f32x4 r_ = v[j] * rstd * *(const LAS f32x4*)(vLG + c) + *(const LAS f32x4*)(vLB + c);
                    if (layer == 0) { v2u w; w.x = pk2(r_[0], r_[1]); w.y = pk2(r_[2], r_[3]); *(v2u*)(X2b + (size_t)row * DM + c) = w; } else *(f32x4*)(dst + c) = r_; } }
#undef P10_LOAD
            __syncthreads();
        }
        if constexpr (layer == 0) {
            SEAM(10);
            if (IN(11)) _Pragma("unroll 1") for (int rep_ = 0; rep_ < NREP(11); ++rep_) {
                CParams* kp = kparams(); TIDS;
                const bf16_t* X2 = WSP(bf16_t, WS_X2); bf16_t* DP = WSP(bf16_t, WS_DP);
                const float* sc1 = WSP(float, WS_MOD) + (size_t)3 * 12288 + DM;
                const int c = tid * 4, gch = c >> 9, hw = 1 << gch;
                for (int chunk = bx; chunk < NLAT / 64; chunk += G) { const int b = chunk >> 7, t0 = (chunk & 127) * 64;
                    const bf16_t* base = X2 + ((size_t)NCTX + (size_t)b * SEQ) * DM + c; bf16_t* dbase = DP + ((size_t)NCTX + (size_t)b * SEQ) * DM + c;
                    const f32x4 a1 = *(const f32x4*)(sc1 + (size_t)b * 12288 + c) + 1.0f;
                    f32x4 s = {0, 0, 0, 0};
                    { v2u wv[16];
#pragma unroll
                      for (int q = 0; q < 16; ++q) { const int p_ = t0 - 8 + q; wv[q] = *(const v2u*)(base + (size_t)(p_ < 0 ? 0 : p_) * DM); }
#pragma unroll
                      for (int q = 0; q < 16; ++q) { const int p_ = t0 - 8 + q; const bool in_ = p_ >= 0 && p_ >= t0 - hw && p_ < t0 + hw; s += bf4(wv[q]) * (in_ ? 1.0f : 0.0f); } }
#pragma unroll 8
                    for (int i = 0; i < 64; ++i) { const int t = t0 + i; const int tn = t + hw, to = t - hw;
                        const f32x4 xc = bf4(*(const v2u*)(base + (size_t)t * DM));
                        const f32x4 xn = bf4(*(const v2u*)(base + (size_t)(tn < SEQ ? tn : SEQ - 1) * DM)), xo = bf4(*(const v2u*)(base + (size_t)(to >= 0 ? to : 0) * DM));
                        const int lo_ = to < 0 ? 0 : to, hi_ = tn > SEQ ? SEQ : tn;
                        const f32x4 d = a1 * (s * (1.0f / (float)(hi_ - lo_)) - xc);
                        v2u w; w.x = pk2(d[0], d[1]); w.y = pk2(d[2], d[3]); *(v2u*)(dbase + (size_t)t * DM) = w;
                        s = s + xn * (tn < SEQ ? 1.0f : 0.0f) - xo * (to >= 0 ? 1.0f : 0.0f); }
                }
            }
            SEAM(11);
            if (IN(12)) _Pragma("unroll 1") for (int rep_ = 0; rep_ < NREP(12); ++rep_) {
                CParams* kp = kparams();
                pg8::Gemm g{DM, 512, 512}; pg8::SchedPool S; S.o.init(NLAT / 256, 8, ogrid(), obid()); S.A = WSP(const char, WS_DP); S.B = WSP(const char, WS_WPOOL);
                pg8::EpiBf16 E{WSP(bf16_t, WS_Y), DM, nullptr};
                pg8::gemm_phase<pg8::EpiBf16, pg8::SchedPool, true, false>(L, g, S, E);
            }
            SEAM(12);
        }
    }

__global__ void __launch_bounds__(512, 2) mk_fwd(Params p_unused) {
    extern __shared__ __attribute__((aligned(16))) unsigned char lds[];
    LAS unsigned char* L = (LAS unsigned char*)lds;
    volatile LAS unsigned* MISC = (volatile LAS unsigned*)(L + MISC_OFF);
    LAS int* tcnt = (LAS int*)(L + TAB_OFF); LAS int* tbase = tcnt + 32; LAS int* texp = tcnt + 80;
    if (threadIdx.x < 64) MISC[threadIdx.x] = 0u;
    __syncthreads();
    int lo, hi; XcdBarrier bar;
    { CParams* kp = kparams(); lo = kp->ph_lo; hi = kp->ph_hi; unsigned* bw = (unsigned*)(kp->ws + WS_CTL) + CW_BAR;
      bar.bar = bw; bar.x = 0; bar.st = nullptr; if (hi - lo > 1) bar = xcd_barrier_post(bw, MISC + 8); }
    if (IN(0)) _Pragma("unroll 1") for (int rep_ = 0; rep_ < NREP(0); ++rep_) {
        CParams* kp = kparams(); TIDS;
        float* MOD = WSP(float, WS_MOD); float* ROPE = WSP(float, WS_ROPE);
        for (int i = bx * 512 + tid; i < 4096; i += G * 512) { const int pos = i >> 5, pp = i & 31;
            const float inv = exp2f(-(float)pp * (13.287712379549449f / 32.0f)); const float ang = (float)pos * inv;
            float sn, cs; sincosf(ang, &sn, &cs); ROPE[i] = cs; ROPE[4096 + i] = sn; }
        { const float* wrt = kp->w_router; bf16_t* WR = WSP(bf16_t, WS_WR);
          for (int i = bx * 512 + tid; i < 32 * DM; i += G * 512) { const int ii = i & 7, ln = (i >> 3) & 63, kq = (i >> 9) & 15, w = i >> 13; const int e = ln & 31, k = w * 256 + kq * 16 + 8 * (ln >> 5) + ii;
              const float wv = wrt[k * 32 + e]; const unsigned h1 = f2bf(wv); const unsigned h2 = f2bf(wv - bf2f(h1)); WR[i] = (bf16_t)h1; WR[32 * DM + i] = (bf16_t)h2; } }
        {
            LAS float* sv = (LAS float*)L;
            LAS float* red = (LAS float*)(L + 32768);
            mod_prepare(kp->c, kp->c_ctx, sv, tid);
            for (int it = bx; it < 384; it += G) mod_item(it, kp->w_mod, kp->b_mod, MOD, sv, red, tid, lane, wave);
        }
        {
            LAS float* scr = (LAS float*)(L + wave * 16384);
            constexpr int I_QKV = (DM / 64) * (QKVD / 32), I_O = (DM / 64) * (DM / 32), I_P = (512 / 64) * (512 / 32), I_G = (DM / 64) * (DE / 32), I_D = (DE / 64) * (DM / 32);
            constexpr int NITEMS = I_QKV + I_O + 4 * I_P;
            (void)I_G; (void)I_D;
            auto decode = [&](int it) { TItem d; int r = it;
                if (r < I_QKV) { d.W = kp->w_qkv; d.WT = WSP(bf16_t, WS_WQKV); d.K = DM; d.N = QKVD; d.kind = 0; }
                else if ((r -= I_QKV) < I_O) { d.W = kp->w_o; d.WT = WSP(bf16_t, WS_WO); d.K = DM; d.N = DM; d.kind = 0; }
                else { r -= I_O; const int g = r / I_P; r -= g * I_P; d.W = kp->w_pool + (size_t)g * 512 * 512; d.WT = WSP(bf16_t, WS_WPOOL) + (size_t)g * 512 * 512; d.K = 512; d.N = 512; d.kind = 0; }
                const int nblk = d.N / 32; d.k0 = 64 * (r / nblk); d.n0 = 32 * (r % nblk); return d; };
            for (int it = gw; it < NITEMS; it += 2 * NGW) {
                const TItem d0 = decode(it); float ra[32], rb[32]; t_load(d0, ra, lane);
                const bool two = it + NGW < NITEMS; TItem d1 = d0; if (two) { d1 = decode(it + NGW); t_load(d1, rb, lane); }
                t_store(d0, ra, scr, lane); if (two) t_store(d1, rb, scr, lane);
            }
        }
        __syncthreads();
    }
    SEAM(0);

    if (IN(1)) _Pragma("unroll 1") for (int rep_ = 0; rep_ < NREP(1); ++rep_) {
        CParams* kp = kparams(); TIDS;
        const float* MOD = WSP(float, WS_MOD); bf16_t* U = WSP(bf16_t, WS_U); const float* xl = kp->x; const float* xc = kp->ctx;
        const int R = (MT + NGW - 1) / NGW, r0 = gw * R, r1 = (r0 + R) < MT ? (r0 + R) : MT;
        f32x4 sa[8], sb[8], xv[8]; int cur = -1;
#define P1_LOAD(row_) do { const float* xr_ = ((row_) < NCTX) ? xc + (size_t)(row_) * DM : xl + (size_t)((row_) - NCTX) * DM; _Pragma("unroll") for (int j = 0; j < 8; ++j) xv[j] = *(const f32x4*)(xr_ + (j * 64 + lane) * 4); } while (0)
        if (r0 < r1) P1_LOAD(r0); else P1_LOAD(0);
        for (int row = r0; row < r1; ++row) { const int cd = row_cond(row);
            if (cd != cur) { const float* sh = MOD + (size_t)cd * 12288; const float* sc = sh + DM;
#pragma unroll
                for (int j = 0; j < 8; ++j) { const int c = (j * 64 + lane) * 4; sa[j] = *(const f32x4*)(sc + c) + 1.0f; sb[j] = *(const f32x4*)(sh + c); }
                cur = cd; }
            f32x4 o[8];
#pragma unroll
            for (int j = 0; j < 8; ++j) o[j] = xv[j] * sa[j] + sb[j];
            if (row + 1 < r1) P1_LOAD(row + 1);
#pragma unroll
            for (int j = 0; j < 8; ++j) { const int c = (j * 64 + lane) * 4; v2u w; w.x = pk2(o[j][0], o[j][1]); w.y = pk2(o[j][2], o[j][3]); *(v2u*)(U + (size_t)row * DM + c) = w; } }
#undef P1_LOAD
    }
    SEAM(1);

    if (IN(2)) _Pragma("unroll 1") for (int rep_ = 0; rep_ < NREP(2); ++rep_) {
        CParams* kp = kparams();
        typedef pg8::SchedSplit<256u * DM * 2u, 256u * DM * 2u, DM / 64, QKVD / 256> Sch;
        pg8::Gemm g{DM, DM, DM}; Sch S; S.init(ogrid(), obid()); S.A = WSP(const char, WS_U); S.B = WSP(const char, WS_WQKV);
        pg8::EpiQkv E{WSP(bf16_t, WS_QKVR), QKVD, WSP(float, WS_PQ), WSP(bf16_t, WS_V)};
        pg8::gemm_phase<pg8::EpiQkv, Sch, true, false>(L, g, S, E);
    }
    SEAM(2);

    if (IN(3)) _Pragma("unroll 1") for (int rep_ = 0; rep_ < NREP(3); ++rep_) {
        CParams* kp = kparams(); TIDS;
        const float* ROPE = WSP(float, WS_ROPE); const bf16_t* QKVR = WSP(bf16_t, WS_QKVR); bf16_t* Qb = WSP(bf16_t, WS_Q); bf16_t* Kb = WSP(bf16_t, WS_K); bf16_t* Vb = WSP(bf16_t, WS_V);
        const int sub = lane >> 4, l16 = lane & 15, d0 = l16 * 8, ax = l16 >> 3, hh = (l16 >> 2) & 1, p0 = (l16 & 3) * 8;
        const bool split3 = ((64 * (QKVD / 256)) % G == 0) && (2 * (QKVD / 256) * 8 <= G);
        const float* PQ = WSP(float, WS_PQ);
        float qg[8], kg[8];
        { const float* qgn = kp->q_gain; const float* kgn = kp->k_gain;
#pragma unroll
          for (int i = 0; i < 8; ++i) { qg[i] = qgn[d0 + i]; kg[i] = kgn[d0 + i]; } }
        v4u rw[6];
#define P3_LOAD(row_) do { const bf16_t* s_ = QKVR + (size_t)(row_) * QKVD + sub * 128 + d0; const bool all_ = (row_) < NCTX; _Pragma("unroll") for (int it = 0; it < 6; ++it) if (it == 4 || all_) rw[it] = *(const v4u*)(s_ + it * 512); } while (0)
        for (int r4 = NCTX + gw * 4; r4 < MT; r4 += NGW * 4) {
            v4u kr[4]; f32x4 c0[4], c1[4], s0[4], s1[4];
#pragma unroll
            for (int q = 0; q < 4; ++q) { const int row = r4 + q, t = (row - NCTX) & 8191; kr[q] = *(const v4u*)(QKVR + (size_t)row * QKVD + 2048 + sub * 128 + d0);
                const int pos = ax ? (t & 63) : (t >> 6); const float* cp_ = ROPE + pos * 32 + p0; c0[q] = *(const f32x4*)cp_; c1[q] = *(const f32x4*)(cp_ + 4); s0[q] = *(const f32x4*)(cp_ + 4096); s1[q] = *(const f32x4*)(cp_ + 4100); }
#pragma unroll
            for (int q = 0; q < 4; ++q) { const int row = r4 + q, lr = row - NCTX, b = lr >> 13, kpos = CTXL + (lr & 8191); const v4u raw = kr[q];
                float f[8], cs[8], sn[8];
#pragma unroll
                for (int i = 0; i < 4; ++i) { f[2 * i] = bf2f(raw[i] & 0xffffu); f[2 * i + 1] = bf2f(raw[i] >> 16); cs[i] = c0[q][i]; cs[4 + i] = c1[q][i]; sn[i] = hh ? s0[q][i] : -s0[q][i]; sn[4 + i] = hh ? s1[q][i] : -s1[q][i]; }
                float ss = 0.f;
#pragma unroll
                for (int i = 0; i < 8; ++i) ss += f[i] * f[i];
                ss += __shfl_xor(ss, 1); ss += __shfl_xor(ss, 2); ss += __shfl_xor(ss, 4); ss += __shfl_xor(ss, 8);
                const float r = 1.0f / sqrtf(ss * (1.0f / 128.0f) + RMS_EPS);
                float o[8];
#pragma unroll
                for (int i = 0; i < 8; ++i) { const float y = f[i] * r * kg[i]; const float pr = __shfl_xor(y, 4); o[i] = y * cs[i] + pr * sn[i]; }
                v4u w; w.x = pk2(o[0], o[1]); w.y = pk2(o[2], o[3]); w.z = pk2(o[4], o[5]); w.w = pk2(o[6], o[7]);
                *(v4u*)(Kb + (((size_t)b * NKV + sub) * SKV + kpos) * HD + d0) = w; }
        }
        P3_LOAD(gw < NCTX ? gw : 0);
        for (int row = gw; row < NCTX; row += NGW) {
            const bool lat = row >= NCTX; const int lr = row - NCTX; const int b = lat ? (lr >> 13) : (row >> 8); const int t = lat ? (lr & 8191) : 0;
            const int kpos = lat ? (CTXL + t) : (row & 255);
            v4u cur[6];
#pragma unroll
            for (int it = 0; it < 6; ++it) cur[it] = rw[it];
            if (row + NGW < NCTX) P3_LOAD(row + NGW);
            float cs[8], sn[8];
#pragma unroll
            for (int i = 0; i < 8; ++i) { cs[i] = 1.f; sn[i] = 0.f; }
            if (lat) { const int pos = ax ? (t & 63) : (t >> 6); const float* cp_ = ROPE + pos * 32 + p0;
                const f32x4 c0 = *(const f32x4*)cp_, c1 = *(const f32x4*)(cp_ + 4), s0 = *(const f32x4*)(cp_ + 4096), s1 = *(const f32x4*)(cp_ + 4100);
#pragma unroll
                for (int i = 0; i < 4; ++i) { cs[i] = c0[i]; cs[4 + i] = c1[i]; sn[i] = hh ? s0[i] : -s0[i]; sn[4 + i] = hh ? s1[i] : -s1[i]; } }
#pragma unroll
            for (int it = 0; it < 6; ++it) { const int h = it * 4 + sub;
                if (lat && it != 4) continue;
                if (it == 5 && !split3) continue;
                float f[8]; v4u raw;
                if (!lat && split3) {
                    f32x4 q0[8]; const float* pp_ = PQ + (size_t)row * QKVD + h * 128 + d0;
#pragma unroll
                    for (int ks = 0; ks < 8; ++ks) q0[ks] = *(const f32x4*)(pp_ + (size_t)ks * 512 * QKVD);
                    f32x4 a0 = q0[0];
#pragma unroll
                    for (int ks = 1; ks < 8; ++ks) a0 += q0[ks];
#pragma unroll
                    for (int ks = 0; ks < 8; ++ks) q0[ks] = *(const f32x4*)(pp_ + (size_t)ks * 512 * QKVD + 4);
                    f32x4 a1 = q0[0];
#pragma unroll
                    for (int ks = 1; ks < 8; ++ks) a1 += q0[ks];
#pragma unroll
                    for (int i = 0; i < 4; ++i) { f[i] = a0[i]; f[4 + i] = a1[i]; }
                    raw.x = pk2(f[0], f[1]); raw.y = pk2(f[2], f[3]); raw.z = pk2(f[4], f[5]); raw.w = pk2(f[6], f[7]);
#pragma unroll
                    for (int i = 0; i < 4; ++i) { f[2 * i] = bf2f(raw[i] & 0xffffu); f[2 * i + 1] = bf2f(raw[i] >> 16); }
                } else { raw = cur[it];
#pragma unroll
                    for (int i = 0; i < 4; ++i) { f[2 * i] = bf2f(raw[i] & 0xffffu); f[2 * i + 1] = bf2f(raw[i] >> 16); } }
                if (it == 5) { *(v4u*)(Vb + (((size_t)b * NKV + (h - 20)) * SKV + kpos) * HD + d0) = raw; continue; }
                float ss = 0.f;
#pragma unroll
                for (int i = 0; i < 8; ++i) ss += f[i] * f[i];
                ss += __shfl_xor(ss, 1); ss += __shfl_xor(ss, 2); ss += __shfl_xor(ss, 4); ss += __shfl_xor(ss, 8);
                const float r = 1.0f / sqrtf(ss * (1.0f / 128.0f) + RMS_EPS);
                float o[8];
#pragma unroll
                for (int i = 0; i < 8; ++i) { const float y = f[i] * r * (it < 4 ? qg[i] : kg[i]); const float pr = __shfl_xor(y, 4); o[i] = y * cs[i] + pr * sn[i]; }
                v4u w; w.x = pk2(o[0], o[1]); w.y = pk2(o[2], o[3]); w.z = pk2(o[4], o[5]); w.w = pk2(o[6], o[7]);
                bf16_t* d = (it < 4) ? Qb + (size_t)row * DM + h * 128 + d0 : Kb + (((size_t)b * NKV + (h - 16)) * SKV + kpos) * HD + d0;
                *(v4u*)d = w; }
        }
#undef P3_LOAD
    }
    SEAM(3);

    if (IN(4)) _Pragma("unroll 1") for (int rep_ = 0; rep_ < NREP(4); ++rep_) {
        CParams* kp = kparams();
        const bf16_t* Qb = WSP(bf16_t, WS_Q); const bf16_t* Kb = WSP(bf16_t, WS_K); const bf16_t* Vb = WSP(bf16_t, WS_V); bf16_t* Ob = WSP(bf16_t, WS_O);
        const bf16_t* QKVR = WSP(bf16_t, WS_QKVR); const float* ROPE = WSP(float, WS_ROPE); const float* qgn = kp->q_gain;
        const int G = ogrid(), bx = obid(); const bool fast = (G % 8) == 0;
        const int NR = fast ? (G >> 3) : G, rank = fast ? (bx >> 3) : bx, tot = fast ? 132 : 1056;
        const bool split = fast && NR == 32; const int NA = split ? 26 : NR;
        if (rank < NA) for (int i = 0;; ++i) {
            int w = rank + NA * i;
            if (split && i == 5) w = rank >= 24 ? rank + 106 : tot;
            if (w >= tot) break;
            const int combo = fast ? (bx & 7) : (w / 132), ww = fast ? w : (w % 132), b = combo >> 2, kvh = combo & 3;
            const bool isl = ww < 128; const int rbk = ww >> 2; const int h = kvh * 4 + (isl ? (ww & 3) : (ww - 128));
            const size_t row0 = isl ? ((size_t)NCTX + (size_t)b * SEQ + (size_t)rbk * 256) : ((size_t)b * CTXL);
            if (isl) att::attn_dma_body(QKVR + row0 * QKVD + h * HD, QKVD, rbk * 256, ROPE, qgn, Kb + (size_t)combo * SKV * HD, Vb + (size_t)combo * SKV * HD, Ob + row0 * DM + h * HD, SKV, (char*)lds);
            else att::attn_dma_body(Qb + row0 * DM + h * HD, DM, -1, ROPE, qgn, Kb + (size_t)combo * SKV * HD, Vb + (size_t)combo * SKV * HD, Ob + row0 * DM + h * HD, CTXL, (char*)lds);
            if (otid() == 0) { asm volatile("s_waitcnt vmcnt(0)" ::: "memory");
                (void)xb_add(WSP(unsigned, WS_CTL) + CW_DONE + 32 * (isl ? (b * 32 + rbk) : (64 + b)), 1u); }
        }
        {
            const int tid = otid(), lane = tid & 63, wave = __builtin_amdgcn_readfirstlane(tid >> 6);
            unsigned* mq = WSP(unsigned, WS_CTL) + CW_MQ; bool prepared = false;
            for (;;) {
                if (tid == 0) MISC[34] = xb_add(mq, 1u);
                __syncthreads();
                const unsigned t = MISC[34];
                __syncthreads();
                if (t >= 384u) break;
                if (!prepared) { mod_prepare(kp->c, kp->c_ctx, (LAS float*)L, tid); prepared = true; }
                mod_item(384 + (int)t, kp->w_mod, kp->b_mod, WSP(float, WS_MOD), (const LAS float*)L, (LAS float*)(L + 32768), tid, lane, wave);
            }
        }
        {
            const int tid = otid(), lane = tid & 63, wave = __builtin_amdgcn_readfirstlane(tid >> 6);
            LAS float* scr = (LAS float*)(L + wave * 16384);
            unsigned* qc = WSP(unsigned, WS_CTL) + CW_Q;
            constexpr int I_G = (DM / 64) * (DE / 32), I_D = (DE / 64) * (DM / 32), PER = 2 * I_G + I_D; constexpr unsigned NTICK = 64u * PER / 2u;
            auto decode = [&](int it) { TItem d; const int le = it / PER; int r = it - le * PER;
                if (r < I_G) { d.W = kp->w_gate + (size_t)le * DM * DE; d.WT = WSP(bf16_t, WS_WGU) + (size_t)le * 2048 * DM; d.K = DM; d.N = DE; d.kind = 1; }
                else if ((r -= I_G) < I_G) { d.W = kp->w_up + (size_t)le * DM * DE; d.WT = WSP(bf16_t, WS_WGU) + (size_t)le * 2048 * DM; d.K = DM; d.N = DE; d.kind = 2; }
                else { r -= I_G; d.W = kp->w_down + (size_t)le * DE * DM; d.WT = WSP(bf16_t, WS_WD) + (size_t)le * DM * DE; d.K = DE; d.N = DM; d.kind = 0; }
                const int nblk = d.N / 32; d.k0 = 64 * (r / nblk); d.n0 = 32 * (r % nblk); return d; };
            auto grab = [&]() { unsigned t = 0; if (lane == 0) t = __hip_atomic_fetch_add(qc, 1u, __ATOMIC_RELAXED, __HIP_MEMORY_SCOPE_AGENT); return (unsigned)__builtin_amdgcn_readfirstlane((int)t); };
            unsigned tk = grab();
            while (tk < NTICK) {
                const unsigned nx = grab();
                const TItem d0 = decode((int)(2u * tk)); TItem d1 = d0; d1.n0 += 32;
                float ra[32], rb[32]; t_load(d0, ra, lane); t_load(d1, rb, lane);
                t_store(d0, ra, scr, lane); t_store(d1, rb, scr, lane);
                tk = nx;
            }
        }
        __syncthreads();
        {
            unsigned* wq = WSP(unsigned, WS_CTL) + CW_WQ; unsigned* done = WSP(unsigned, WS_CTL) + CW_DONE; unsigned* yd = WSP(unsigned, WS_CTL) + CW_YD; unsigned* bw = WSP(unsigned, WS_CTL) + CW_BAR;
            const char* Oc = WSP(const char, WS_O); const char* Wc = WSP(const char, WS_WO);
            pg8::Gemm g{DM, DM, DM}; pg8::EpiBf16W E{WSP(bf16_t, WS_Y), DM};
            int tail = obid(); bool queue = true;
            for (;;) {
                if (otid() == 0) { int pm = -1, pn = 0, fl = 0;
                    if (queue) { const unsigned t = xb_add(wq, 1u);
                        if (t < 416u) { const int rbk = (int)t >> 4, b = ((int)t >> 3) & 1; pn = (int)t & 7; pm = 2 + b * 32 + rbk; fl = b * 32 + rbk; }
                        else if (t < 432u) { const int c = (int)t - 416; pm = c >> 3; pn = c & 7; fl = 64 + pm; } }
                    else if (tail < 96) { const int rbk = 26 + (tail >> 4), b = (tail >> 3) & 1; pn = tail & 7; pm = 2 + b * 32 + rbk; fl = b * 32 + rbk; }
                    if (pm >= 0) { XB_SPIN(xb_ld(&done[32 * fl]) < 16u, bw);
                        __builtin_amdgcn_fence(__ATOMIC_ACQUIRE, "agent"); asm volatile("s_waitcnt vmcnt(0)" ::: "memory"); }
                    MISC[32] = (unsigned)pm; MISC[33] = (unsigned)pn; }
                __syncthreads();
                const int pm = (int)MISC[32], pn = (int)MISC[33];
                __syncthreads();
                if (pm < 0) { if (!queue) break; queue = false; continue; }
                pg8::SchedOne S; S.u.A = Oc + (size_t)((unsigned)pm * (256u * DM * 2u)); S.u.B = Wc + (size_t)((unsigned)pn * (256u * DM * 2u)); S.u.pm = pm; S.u.pn = pn; S.u.aux = 0; S.u.kt = DM / 64; S.u.rb = 0; S.u.cn = 0; S.u.ui = 0;
                pg8::gemm_phase<pg8::EpiBf16W, pg8::SchedOne, true, false>(L, g, S, E);
                if (otid() == 0) (void)xb_add(&yd[32 * pm], 1u);
                if (!queue) tail += ogrid();
            }
        }
    }


    layer_half<0>(lo, hi, bar, L, tcnt, tbase, texp);
    layer_half<1>(lo, hi, bar, L, tcnt, tbase, texp);
#undef IN
#undef SEAM
#undef TIDS
}

extern "C" void kernel_launch(void* const* d_in, const int* in_sizes, int n_in, void* d_out, int out_size, void* d_ws, size_t ws_size, hipStream_t stream) {
    static int grid = 0;
    if (grid == 0) {
        if (n_in != 19 || in_sizes[0] != NLAT * DM || out_size != NLAT * DM || ws_size < WS_END) {
            fprintf(stderr, "kernel_launch: shape mismatch: n_in %d in0 %d out %d ws %zu (need %zu); nothing launched\n", n_in, n_in > 0 ? in_sizes[0] : -1, out_size, ws_size, (size_t)WS_END); grid = -1; return; }
        int dev = 0, cus = 0, per_cu = 0;
        if (hipGetDevice(&dev) != hipSuccess || hipDeviceGetAttribute(&cus, hipDeviceAttributeMultiprocessorCount, dev) != hipSuccess) { fprintf(stderr, "kernel_launch: device query failed\n"); grid = -1; return; }
        if (hipFuncSetAttribute((const void*)mk_fwd, hipFuncAttributeMaxDynamicSharedMemorySize, LDS_BYTES) != hipSuccess) { fprintf(stderr, "kernel_launch: hipFuncSetAttribute failed\n"); grid = -1; return; }
        if (hipOccupancyMaxActiveBlocksPerMultiprocessor(&per_cu, (const void*)mk_fwd, 512, LDS_BYTES) != hipSuccess || per_cu < 1)
            fprintf(stderr, "kernel_launch: note: occupancy query reports %d workgroups per CU\n", per_cu);
        (void)hipGetLastError();
        if (cus * (pg8::RT_UNITS / 2) < MAXT * 8) { fprintf(stderr, "kernel_launch: %d CUs: the MoE phases' per-workgroup LDS row tables are sized for >= %d workgroups; nothing launched\n", cus, (MAXT * 8 + pg8::RT_UNITS / 2 - 1) / (pg8::RT_UNITS / 2)); grid = -1; return; }
        grid = cus;
    }
    if (grid < 0) return;
    if (hipMemsetAsync((char*)d_ws + WS_CTL, 0, CTL_ZERO_BYTES, stream) != hipSuccess) { fprintf(stderr, "kernel_launch: memset failed\n"); return; }
    Params p{};
    p.x = (const float*)d_in[0]; p.c = (const float*)d_in[1]; p.ctx = (const float*)d_in[2]; p.c_ctx = (const float*)d_in[3]; p.w_mod = (const float*)d_in[4]; p.b_mod = (const float*)d_in[5];
    p.ln_g = (const float*)d_in[6]; p.ln_b = (const float*)d_in[7]; p.w_qkv = (const float*)d_in[8]; p.q_gain = (const float*)d_in[9]; p.k_gain = (const float*)d_in[10]; p.w_o = (const float*)d_in[11];
    p.w_pool = (const float*)d_in[12]; p.pool_scale = (const float*)d_in[13]; p.w_router = (const float*)d_in[14]; p.router_bias = (const float*)d_in[15];
    p.w_gate = (const float*)d_in[16]; p.w_up = (const float*)d_in[17]; p.w_down = (const float*)d_in[18];
    p.out = (float*)d_out; p.ws = (unsigned char*)d_ws;
#if MK_PER_PHASE
    for (int k = 0; k < NPHASE; ++k) { p.ph_lo = k; p.ph_hi = k + 1;
        hipLaunchKernelGGL(mk_fwd, dim3(grid), dim3(512), LDS_BYTES, stream, p);
        const hipError_t le = hipPeekAtLastError(); if (le != hipSuccess) { fprintf(stderr, "kernel_launch: launch %d failed: %s\n", k, hipGetErrorName(le)); break; } }
#else
    p.ph_lo = 0; p.ph_hi = NPHASE;
    hipLaunchKernelGGL(mk_fwd, dim3(grid), dim3(512), LDS_BYTES, stream, p);
    const hipError_t le = hipPeekAtLastError(); if (le != hipSuccess) fprintf(stderr, "kernel_launch: launch failed: %s\n", hipGetErrorName(le));
#endif
}
```

```cpp
#include <hip/hip_runtime.h>
#include <cstdio>
#include <cstdint>

#ifndef REP_MASK
#define REP_MASK 0
#endif
#ifndef MK_PER_PHASE
#define MK_PER_PHASE 0
#endif

constexpr int DM = 2048, NB = 2, SEQ = 8192, CTXL = 256;
constexpr int NCTX = NB * CTXL, NLAT = NB * SEQ, MT = NCTX + NLAT;
constexpr int NH = 16, NKV = 4, HD = 128, KVD = NKV * HD, QKVD = DM + 2 * KVD;
constexpr int SKV = CTXL + SEQ;
constexpr int NE = 32, DE = 1024;
constexpr int MAXT = 164, NSLOT = MAXT * 256;
constexpr float ALPHA = 1.41421356237309515f;
constexpr float LN_EPS = 1e-6f, RMS_EPS = 1e-6f;
constexpr int NPHASE = 18;

constexpr size_t MiB = 1u << 20;
constexpr size_t WS_CTL = 0, CTL_ZERO_BYTES = 1 * MiB;
constexpr size_t WS_MOD = 1 * MiB;
constexpr size_t WS_ROPE = WS_MOD + 512 * 1024;
constexpr size_t WS_WR = WS_MOD + 768 * 1024;
constexpr size_t WS_WQKV = 2 * MiB;
constexpr size_t WS_WO = 14 * MiB;
constexpr size_t WS_WPOOL = 22 * MiB;
constexpr size_t WS_WGU = 24 * MiB;
constexpr size_t WS_WD = 536 * MiB;
constexpr size_t WS_Y = 792 * MiB;
constexpr size_t WS_X1 = 924 * MiB;
constexpr size_t WS_X2 = 1056 * MiB;
constexpr size_t WS_H = 1188 * MiB;
constexpr size_t WS_LIST = 1254 * MiB;
constexpr size_t WS_SLOT = 1259 * MiB;
constexpr size_t WS_SH = 1260 * MiB;
constexpr size_t WS_U = WS_SH;
constexpr size_t WS_QKVR = WS_SH + 66 * MiB;
constexpr size_t WS_Q = WS_SH + 165 * MiB;
constexpr size_t WS_K = WS_SH + 231 * MiB;
constexpr size_t WS_V = WS_SH + 248 * MiB;
constexpr size_t WS_O = WS_SH + 265 * MiB;
constexpr size_t WS_HS = WS_SH;
constexpr size_t WS_ACT = WS_SH + 164 * MiB;
constexpr size_t WS_FB = WS_SH + 246 * MiB;
constexpr size_t WS_DP = WS_SH;
constexpr size_t WS_PQ = WS_SH + 510 * MiB;
constexpr size_t WS_PO = WS_PQ + 48 * MiB;
constexpr size_t WS_END = WS_PO + 32 * MiB;
static_assert((size_t)MT * DM * 4 <= 132 * MiB && (size_t)NSLOT * 2048 * 2 <= 164 * MiB && (size_t)2 * MT * DM * 4 <= 264 * MiB, "ws map");
static_assert((size_t)32 * MT * 8 <= 5 * MiB && (size_t)NSLOT * 8 <= 1 * MiB, "ws map 2");
constexpr int CW_CNT = 64;
constexpr int CW_Q = 3072;
constexpr int CW_MQ = 3136;
constexpr int CW_WQ = 3104;
constexpr int CW_DONE = 8192;
constexpr int CW_GUD = 16384;
constexpr int CW_YD = 40960;
constexpr int CW_P6Q = 3168;
constexpr int CW_BAR = 4096;

constexpr int RING_BYTES = 131072;
constexpr int MISC_OFF = RING_BYTES;
constexpr int TAB_OFF = MISC_OFF + 256;
constexpr int LDS_BYTES = 147456;

#define GAS __attribute__((address_space(1)))
#define LAS __attribute__((address_space(3)))
typedef unsigned short bf16_t;
typedef unsigned v4u __attribute__((ext_vector_type(4)));
typedef unsigned v2u __attribute__((ext_vector_type(2)));
typedef float f32x4 __attribute__((ext_vector_type(4)));
typedef float f32x2 __attribute__((ext_vector_type(2)));
typedef short bf16x8 __attribute__((ext_vector_type(8)));
typedef short s16x4 __attribute__((ext_vector_type(4)));
typedef float f32x16 __attribute__((ext_vector_type(16)));
typedef GAS unsigned gu32;
#define RLX_AGENT __ATOMIC_RELAXED, __HIP_MEMORY_SCOPE_AGENT
#define LDS_WAIT() asm volatile("s_waitcnt lgkmcnt(0)" ::: "memory")
#define VM_WAIT() asm volatile("s_waitcnt vmcnt(0)" ::: "memory")
__device__ __forceinline__ unsigned f2bf(float f) { unsigned u = __builtin_bit_cast(unsigned, f); return (u + 0x7fffu + ((u >> 16) & 1u)) >> 16; }
__device__ __forceinline__ unsigned pk2(float lo, float hi) { unsigned r; asm("v_cvt_pk_bf16_f32 %0, %1, %2" : "=v"(r) : "v"(lo), "v"(hi)); return r; }
__device__ __forceinline__ float bf2f(unsigned b) { return __builtin_bit_cast(float, b << 16); }
__device__ __forceinline__ unsigned cvt_pk_bf16(float lo, float hi) { unsigned r; asm volatile("v_cvt_pk_bf16_f32 %0, %1, %2" : "=v"(r) : "v"(lo), "v"(hi)); return r; }
__device__ __forceinline__ f32x4 bf4(v2u q) { return (f32x4){bf2f(q.x & 0xffffu), bf2f(q.x >> 16), bf2f(q.y & 0xffffu), bf2f(q.y >> 16)}; }
template <int CTRL> __device__ __forceinline__ float dppf(float v) { return __builtin_bit_cast(float, __builtin_amdgcn_update_dpp(0, __builtin_bit_cast(int, v), CTRL, 0xF, 0xF, true)); }
template <int CTRL> __device__ __forceinline__ int dppi(int v) { return __builtin_amdgcn_update_dpp(0, v, CTRL, 0xF, 0xF, true); }
__device__ __forceinline__ float wave_sum(float v) {
    v += dppf<0xB1>(v); v += dppf<0x4E>(v); v += dppf<0x141>(v); v += dppf<0x140>(v);
    { const auto r = __builtin_amdgcn_permlane16_swap(__float_as_uint(v), __float_as_uint(v), false, false); v = __uint_as_float(r[0]) + __uint_as_float(r[1]); }
    { const auto r = __builtin_amdgcn_permlane32_swap(__float_as_uint(v), __float_as_uint(v), false, false); v = __uint_as_float(r[0]) + __uint_as_float(r[1]); }
    return v;
}
__device__ __forceinline__ float silu_f(float x) { return x / (1.0f + __expf(-x)); }
__device__ __forceinline__ int row_cond(int row) { return row < NCTX ? 2 : ((row - NCTX) >> 13); }
__device__ __forceinline__ int otid() { int t = threadIdx.x; asm volatile("" : "+v"(t)); return t; }
__device__ __forceinline__ int obid() { int t = blockIdx.x; asm volatile("" : "+s"(t)); return t; }
__device__ __forceinline__ int ogrid() { int t = gridDim.x; asm volatile("" : "+s"(t)); return t; }

#define XB_TMO      128
#define XB_XCNT(j)  (256  + 64 * (j))
#define XB_XSUB(j)  (1280 + 64 * (j))
#define XB_XGEN(j)  (2304 + 64 * (j))
#define XB_TOP      3328
#define XB_TOPGEN   3392
#define XCD_BAR_WORDS 3456
#define XB_SPIN_CAP (1u << 20)
__device__ __forceinline__ unsigned xb_ld(unsigned* p)              { return __hip_atomic_load(p, __ATOMIC_RELAXED, __HIP_MEMORY_SCOPE_AGENT); }
__device__ __forceinline__ unsigned xb_add(unsigned* p, unsigned v) { return __hip_atomic_fetch_add(p, v, __ATOMIC_RELAXED, __HIP_MEMORY_SCOPE_AGENT); }
__device__ __forceinline__ unsigned xb_xcc_id() { return (unsigned)__builtin_amdgcn_s_getreg((3 << 11) | 20) & 0xFu; }
#define XB_SPIN(cond, bar) do { unsigned _sp = 0; while (cond) { __builtin_amdgcn_s_sleep(1); \
    if ((++_sp & 255u) == 0u) { if (xb_ld(&(bar)[XB_TMO])) break; if (_sp > XB_SPIN_CAP) { atomicAdd(&(bar)[XB_TMO], 1u); break; } } } } while (0)
struct XcdBarrier { unsigned* bar; unsigned x; volatile LAS unsigned* st; };
__device__ __forceinline__ XcdBarrier xcd_barrier_post(unsigned* bar, volatile LAS unsigned* st) {
    XcdBarrier b; b.bar = bar; b.x = xb_xcc_id(); b.st = st;
    if (threadIdx.x == 0) (void)xb_add(&bar[XB_XCNT(b.x)], 1u);
    return b;
}
__device__ __forceinline__ void xcd_barrier_complete(unsigned* bar, unsigned x, unsigned& nloc, unsigned& nx) {
    const unsigned G = gridDim.x * gridDim.y * gridDim.z;
    unsigned sum, cnt, mine, sp = 0u;
    for (;;) {
        sum = 0u; cnt = 0u; mine = 0u;
#pragma unroll 1
        for (unsigned j = 0; j < 16; ++j) { const unsigned c = xb_ld(&bar[XB_XCNT(j)]); sum += c; cnt += (c > 0u) ? 1u : 0u; }
        if (sum == G) break;
        __builtin_amdgcn_s_sleep(1);
        if ((++sp & 255u) == 0u) { if (xb_ld(&bar[XB_TMO])) break; if (sp > XB_SPIN_CAP) { atomicAdd(&bar[XB_TMO], 1u); break; } }
    }
    mine = xb_ld(&bar[XB_XCNT(x)]);
    nloc = mine > 0u ? mine : 1u; nx = cnt > 0u ? cnt : 1u;
}
__device__ __forceinline__ void xcd_barrier(const XcdBarrier& b) {
    asm volatile("s_waitcnt vmcnt(0)" ::: "memory");
    __syncthreads();
    if (threadIdx.x == 0) {
        unsigned* bar = b.bar;
        __builtin_amdgcn_s_waitcnt(0);
        unsigned nloc = b.st[0], nx = b.st[1];
        if (nloc == 0u) { xcd_barrier_complete(bar, b.x, nloc, nx); b.st[0] = nloc; b.st[1] = nx; }
        const unsigned old = xb_add(&bar[XB_XSUB(b.x)], 1u);
        const unsigned gen = old / nloc;
        if (old + 1u == (gen + 1u) * nloc) {
            __builtin_amdgcn_fence(__ATOMIC_RELEASE, "agent");
            asm volatile("s_waitcnt vmcnt(0)" ::: "memory");
            const unsigned og = xb_add(&bar[XB_TOP], 1u);
            const unsigned tg = og / nx;
            if (og + 1u == (tg + 1u) * nx) xb_add(&bar[XB_TOPGEN], 1u);
            else XB_SPIN(xb_ld(&bar[XB_TOPGEN]) == tg, bar);
            __builtin_amdgcn_fence(__ATOMIC_ACQUIRE, "agent");
            xb_add(&bar[XB_XGEN(b.x)], 1u);
            asm volatile("s_waitcnt vmcnt(0)" ::: "memory");
        } else {
            XB_SPIN(xb_ld(&bar[XB_XGEN(b.x)]) == gen, bar);
            __builtin_amdgcn_fence(__ATOMIC_ACQUIRE, "agent");
            asm volatile("s_waitcnt vmcnt(0)" ::: "memory");
        }
    }
    __syncthreads();
}

namespace pg8 {
#define PG8_LAS __attribute__((address_space(3)))
constexpr int BM = 256, BK = 64, HALF = 128, HTB = HALF * BK * 2, STAGE_BYTES = 8 * HTB, NXCD = 8, WGM = 8;
__host__ __device__ __forceinline__ int lds_byte(int r, int c) { const int st = (r >> 4) * 2 + (c >> 5), rr = r & 15, cc = c & 31, ob = rr * 64 + cc * 2; return st * 1024 + (ob ^ (((ob >> 9) & 1) << 5)); }
__host__ __device__ __forceinline__ void stage_rc(int b, int& R, int& C) { const int st = b / 1024, sb = b % 1024, swz = sb ^ (((sb >> 9) & 1) << 5); R = (st >> 1) * 16 + swz / 64; C = (st & 1) * 32 + (swz % 64) / 2; }
__host__ __device__ __forceinline__ int perm32(int rho) { const int n = rho >> 4, i = rho & 15; return 8 * (i >> 2) + 4 * n + (i & 3); }

struct Unit { const char* A; const char* B; int pm, pn, aux, kt, rb, cn, ui; };
struct Gemm { int lda, ldb, K; };

struct TileOrder {
    int nM, nN, nwg, G, c, rot = 0;
    __device__ __forceinline__ void init(int nM_, int nN_, int G_, int c_) { nM = nM_; nN = nN_; nwg = nM * nN; G = G_; c = c_; }
    __device__ __forceinline__ bool get(int i, int& pm, int& pn) const { return map((long)i * G + c, pm, pn); }
    __device__ __forceinline__ bool map(long L, int& pm, int& pn) const {
        if (L >= nwg) return false;
        const int nig = WGM * nN;
        int wgid = (int)L; { const int q = nwg / NXCD, r = nwg % NXCD, xcd = wgid % NXCD; int off = wgid / NXCD; const int cs = (xcd < r ? xcd * (q + 1) : r * (q + 1) + (xcd - r) * q), len = q + (xcd < r ? 1 : 0);
            if (rot) { const int lead = (nig - cs % nig) % nig; if (lead < len) { off += lead; if (off >= len) off -= len; } }
            wgid = cs + off; }
        const int gid = wgid / nig, fm = gid * WGM, gsz = (nM - fm) < WGM ? (nM - fm) : WGM;
        pm = fm + ((wgid % nig) % gsz); pn = (wgid % nig) / gsz; return true;
    }
};

template <class Epi, class Sched, bool ALIGN_EPI, bool GATHER = false>
__device__ __forceinline__ void gemm_phase(PG8_LAS unsigned char* lds, const Gemm g, const Sched& S, const Epi& E) {
    const int tid = otid(), wid = __builtin_amdgcn_readfirstlane(tid >> 6), lane = tid & 63, wr = wid >> 2, wc = wid & 3, fr = lane & 15, fq = lane >> 4;
    unsigned vc[2][2], vn[2][2], voffB[2]; int Rr[2], Cc = 0;
#pragma unroll
    for (int i = 0; i < 2; ++i) { int R, C; stage_rc(tid * 16 + i * 8192, R, C); const int Rb = Epi::PERM ? ((R & ~31) + perm32(R & 31)) : R; Rr[i] = R; Cc = C;
        vc[0][i] = (unsigned)(R * g.lda + C) * 2u; vc[1][i] = vc[0][i] + (unsigned)(HALF * g.lda) * 2u; voffB[i] = (unsigned)(Rb * g.ldb + C) * 2u; }
#define PG8_ROWS(ui_, v) do { _Pragma("unroll") for (int _h = 0; _h < 2; ++_h) _Pragma("unroll") for (int _i = 0; _i < 2; ++_i) \
        v[_h][_i] = (unsigned)S.rowtok((ui_), Rr[_i] + HALF * _h) * (unsigned)(g.lda * 2) + (unsigned)Cc * 2u; } while (0)
    const size_t kstep = (size_t)(BK * 2);
    const size_t hsB = (size_t)HALF * g.ldb * 2;
    const unsigned ldsw = (unsigned)wid * 1024u;
    const int aoff = lds_byte(wr * 64 + fr, fq * 8), boff = lds_byte(wc * 32 + fr, fq * 8);
#define PG8_SA(b, h) (((b) * 2 + (h)) * HTB)
#define PG8_SB(b, h) ((4 + (b) * 2 + (h)) * HTB)
#define PG8_STAGE(bufoff, gbase, voff) do { _Pragma("unroll") for (int _i = 0; _i < 2; ++_i) \
        __builtin_amdgcn_global_load_lds((const unsigned*)((const char*)(gbase) + (voff)[_i]), (PG8_LAS unsigned*)(lds + (bufoff) + ldsw + _i * 8192), 16, 0, 0); } while (0)
#define PG8_LDA(dst, b, h) do { _Pragma("unroll") for (int m = 0; m < 4; ++m) _Pragma("unroll") for (int k = 0; k < 2; ++k) dst[m][k] = *(const PG8_LAS bf16x8*)(lds + PG8_SA(b, h) + aoff + m * 2048 + k * 1024); } while (0)
#define PG8_LDB(dst, b, h) do { _Pragma("unroll") for (int n = 0; n < 2; ++n) _Pragma("unroll") for (int k = 0; k < 2; ++k) dst[n][k] = *(const PG8_LAS bf16x8*)(lds + PG8_SB(b, h) + boff + n * 2048 + k * 1024); } while (0)
#define PG8_MMA(ai, bj, At, Bt) do { __builtin_amdgcn_s_setprio(1); _Pragma("unroll") for (int m = 0; m < 4; ++m) _Pragma("unroll") for (int n = 0; n < 2; ++n) _Pragma("unroll") for (int k = 0; k < 2; ++k) \
        acc[ai][bj][m][n] = __builtin_amdgcn_mfma_f32_16x16x32_bf16(Bt[n][k], At[m][k], acc[ai][bj][m][n], 0, 0, 0); __builtin_amdgcn_s_setprio(0); } while (0)
#define PG8_WAIT_V(n) asm volatile("s_waitcnt vmcnt(" #n ")" ::: "memory")
#define PG8_WAIT_L(n) asm volatile("s_waitcnt lgkmcnt(" #n ")" ::: "memory")
#define PG8_BAR __builtin_amdgcn_s_barrier()
#define PG8_SCHED __builtin_amdgcn_sched_barrier(0)
    Unit cur, nxt; int ui = 0; int pend = -1, pend2 = -1, wst = 0; unsigned pv = 8u; (void)pend; (void)pend2; (void)wst; (void)pv;
    if (!S.next(0, cur)) return;
    if constexpr (Sched::WAITS) S.wait_ready(cur);
    if constexpr (GATHER) PG8_ROWS(0, vc);
    f32x4 acc[2][2][4][2];
#pragma unroll
    for (int a = 0; a < 2; ++a)
#pragma unroll
        for (int b = 0; b < 2; ++b)
#pragma unroll
            for (int m = 0; m < 4; ++m)
#pragma unroll
                for (int n = 0; n < 2; ++n) acc[a][b][m][n] = (f32x4){0.f, 0.f, 0.f, 0.f};
    bf16x8 At[4][2], B0[2][2], B1[2][2];
    const char* cA = cur.A; const char* cB = cur.B;
    PG8_STAGE(PG8_SB(0, 0), cB, voffB); PG8_STAGE(PG8_SB(0, 1), cB + hsB, voffB); PG8_STAGE(PG8_SA(0, 0), cA, vc[0]); PG8_STAGE(PG8_SA(0, 1), cA, vc[1]);
    if (wr == 1) PG8_BAR;
    PG8_WAIT_V(2); PG8_BAR;
    PG8_STAGE(PG8_SB(1, 0), cB + kstep, voffB); PG8_STAGE(PG8_SA(1, 0), cA + kstep, vc[0]); PG8_STAGE(PG8_SB(1, 1), cB + hsB + kstep, voffB);
    PG8_WAIT_V(6); PG8_BAR;
    for (;;) {
        const bool has_next = S.next(ui + 1, nxt);
        if constexpr (Sched::WAITS) wst = has_next ? 1 : 0;
        const char* nA = has_next ? nxt.A : cA; const char* nB = has_next ? nxt.B : cB;
        if constexpr (GATHER) { if (has_next) PG8_ROWS(ui + 1, vn); else {
#pragma unroll
            for (int h = 0; h < 2; ++h) { vn[h][0] = vc[h][0]; vn[h][1] = vc[h][1]; } } }
        const int nt = cur.kt;
        for (int t = 0; t < nt; t += 2) {
            const bool last = (t == nt - 2);
            const char* a1 = cA + (size_t)(t + 1) * kstep;
            const char* a2 = last ? nA : cA + (size_t)(t + 2) * kstep; const char* b2 = last ? nB : cB + (size_t)(t + 2) * kstep;
            const char* a3 = a2 + kstep; const char* b3 = b2 + kstep;
            unsigned o0[2], o1[2];
#pragma unroll
            for (int i = 0; i < 2; ++i) { o0[i] = (GATHER && last) ? vn[0][i] : vc[0][i]; o1[i] = (GATHER && last) ? vn[1][i] : vc[1][i]; }
            PG8_LDB(B0, 0, 0); PG8_LDB(B1, 0, 1); PG8_SCHED; PG8_LDA(At, 0, 0); PG8_STAGE(PG8_SA(1, 1), a1, vc[1]);
            PG8_WAIT_V(8); PG8_WAIT_L(0); PG8_BAR; PG8_MMA(0, 0, At, B0); PG8_MMA(0, 1, At, B1); PG8_BAR; PG8_SCHED;
            PG8_LDA(At, 0, 1); PG8_STAGE(PG8_SB(0, 0), b2, voffB); PG8_STAGE(PG8_SB(0, 1), b2 + hsB, voffB); PG8_STAGE(PG8_SA(0, 0), a2, o0);
            PG8_WAIT_V(8); PG8_WAIT_L(0); PG8_BAR; PG8_MMA(1, 0, At, B0); PG8_MMA(1, 1, At, B1); PG8_BAR; PG8_SCHED;
            PG8_LDB(B0, 1, 0); PG8_LDB(B1, 1, 1); PG8_SCHED; PG8_LDA(At, 1, 0); PG8_STAGE(PG8_SA(0, 1), a2, o1);
            PG8_WAIT_V(8); PG8_WAIT_L(0); PG8_BAR; PG8_MMA(0, 0, At, B0); PG8_MMA(0, 1, At, B1); PG8_BAR; PG8_SCHED;
            PG8_LDA(At, 1, 1); PG8_STAGE(PG8_SB(1, 0), b3, voffB); PG8_STAGE(PG8_SB(1, 1), b3 + hsB, voffB); PG8_STAGE(PG8_SA(1, 0), a3, o0);
            PG8_WAIT_V(8); PG8_WAIT_L(0); PG8_BAR; PG8_MMA(1, 0, At, B0); PG8_MMA(1, 1, At, B1); PG8_BAR; PG8_SCHED;
            if constexpr (Sched::SIGNALS) { if (pend >= 0) { pend2 = pend; pend = -1; } else if (pend2 >= 0) { S.signal(pend2, lane, wid); pend2 = -1; } }
            if constexpr (Sched::WAITS) { if (wst == 1) { pv = S.poll(nxt); wst = 2; } else if (wst == 2) { wst = 0; if (pv < 8u) S.spin(nxt); } }
        }
        if constexpr (ALIGN_EPI) { if (wr == 0) PG8_BAR; }
        E(acc, cur, wr, wc, fr, fq);
        if constexpr (Sched::SIGNALS) pend = cur.pm;
        if (!has_next) break;
#pragma unroll
        for (int a = 0; a < 2; ++a)
#pragma unroll
            for (int b = 0; b < 2; ++b)
#pragma unroll
                for (int m = 0; m < 4; ++m)
#pragma unroll
                    for (int n = 0; n < 2; ++n) acc[a][b][m][n] = (f32x4){0.f, 0.f, 0.f, 0.f};
        cur = nxt; cA = nA; cB = nB; ++ui;
        if constexpr (GATHER) {
#pragma unroll
            for (int h = 0; h < 2; ++h) { vc[h][0] = vn[h][0]; vc[h][1] = vn[h][1]; } }
        if constexpr (ALIGN_EPI) { if (wr == 1) PG8_BAR; }
    }
    PG8_WAIT_V(0);
    if constexpr (!ALIGN_EPI) { if (wr == 0) PG8_BAR; }
    PG8_BAR;
    if constexpr (Sched::SIGNALS) { if (pend >= 0) S.signal(pend, lane, wid); }
#undef PG8_ROWS
#undef PG8_SA
#undef PG8_SB
#undef PG8_STAGE
#undef PG8_LDA
#undef PG8_LDB
#undef PG8_MMA
#undef PG8_WAIT_V
#undef PG8_WAIT_L
#undef PG8_BAR
#undef PG8_SCHED
}

template <unsigned AT, unsigned BT, int KT>
struct SchedDense {
    static constexpr bool SIGNALS = false, WAITS = false;
    TileOrder o; const char* A; const char* B; int pm0;
    __device__ __forceinline__ int rowtok(int, int) const { return 0; }
    __device__ __forceinline__ bool next(int i, Unit& u) const { int pm, pn; if (!o.get(i, pm, pn)) return false;
        u.rb = 0; u.cn = 0; u.pm = pm0 + pm; u.pn = pn; u.aux = 0; u.kt = KT; u.A = A + (size_t)((unsigned)u.pm * AT); u.B = B + (size_t)((unsigned)pn * BT); return true; }
};
template <unsigned AT, unsigned BT, int KT, int NN>
struct SchedSplit {
    static constexpr bool SIGNALS = false, WAITS = false;
    TileOrder o; const char* A; const char* B; int G, c; bool split;
    __device__ __forceinline__ int rowtok(int, int) const { return 0; }
    __device__ __forceinline__ void init(int G_, int c_) { G = G_; c = c_; split = ((64 * NN) % G_ == 0) && (2 * NN * 8 <= G_); if (split) o.init(64, NN, G_, c_); else o.init(66, NN, G_, c_); }
    __device__ __forceinline__ bool next(int i, Unit& u) const { u.rb = 0; u.cn = 0;
        if (!split) { int pm, pn; if (!o.get(i, pm, pn)) return false; u.pm = pm; u.pn = pn; u.aux = 0; u.kt = KT; u.A = A + (size_t)((unsigned)pm * AT); u.B = B + (size_t)((unsigned)pn * BT); return true; }
        const int fr = (64 * NN) / G;
        if (i < fr) { int pm, pn; o.get(i, pm, pn); u.pm = 2 + pm; u.pn = pn; u.aux = 0; u.kt = KT; u.A = A + (size_t)((unsigned)u.pm * AT); u.B = B + (size_t)((unsigned)pn * BT); return true; }
        if (i > fr || c >= 2 * NN * 8) return false;
        const int ks = c & 7, t = c >> 3; u.pm = t / NN; u.pn = t % NN; u.aux = ks + 1; u.kt = KT / 8;
        u.A = A + (size_t)((unsigned)u.pm * AT + (unsigned)ks * (KT / 8) * 128u); u.B = B + (size_t)((unsigned)u.pn * BT + (unsigned)ks * (KT / 8) * 128u); return true; }
};
struct SchedPool {
    static constexpr bool SIGNALS = false, WAITS = false;
    TileOrder o; const char* A; const char* B;
    __device__ __forceinline__ int rowtok(int, int) const { return 0; }
    __device__ __forceinline__ bool next(int i, Unit& u) const { int pm, pn; if (!o.get(i, pm, pn)) return false;
        u.rb = 0; u.cn = 0; u.pm = 2 + pm; u.pn = pn; u.aux = 0; u.kt = 8; const int g = pn >> 1;
        u.A = A + (size_t)((unsigned)u.pm * (256u * DM * 2u) + (unsigned)g * 1024u); u.B = B + (size_t)((unsigned)g * (512u * 512u * 2u) + (unsigned)(pn & 1) * (256u * 512u * 2u)); return true; }
};
struct SchedOne {
    static constexpr bool SIGNALS = false, WAITS = false;
    Unit u;
    __device__ __forceinline__ int rowtok(int, int) const { return 0; }
    __device__ __forceinline__ bool next(int i, Unit& o) const { if (i != 0) return false; o = u; return true; }
};
constexpr int RT_UNITS = 14;
template <unsigned AT, unsigned BT, unsigned BE, int KT, bool GATHER>
struct SchedMoe {
    static constexpr bool SIGNALS = GATHER, WAITS = !GATHER;
    unsigned* ctr;
    __device__ __forceinline__ void signal(int pm, int lane, int wid) const { if (wid == 0 && lane == 0) (void)xb_add(ctr + 32 * pm, 1u); }
    __device__ __forceinline__ void wait_ready(const Unit& u) const { while (xb_ld(ctr + 32 * u.pm) < 8u) __builtin_amdgcn_s_sleep(2); asm volatile("" ::: "memory"); }
    __device__ __forceinline__ unsigned poll(const Unit& u) const { return xb_ld(ctr + 32 * u.pm); }
    __device__ __forceinline__ void spin(const Unit& u) const { while (xb_ld(ctr + 32 * u.pm) < 8u) __builtin_amdgcn_s_sleep(2); }
    __device__ __forceinline__ void acquire_async() const { asm volatile("buffer_inv sc1" ::: "memory"); }
    TileOrder o; const char* A; const char* B; const PG8_LAS int* texp; const PG8_LAS int* tbase; const PG8_LAS int* tcnt; const PG8_LAS int* rt; const int* list;
    int rem = 0, nl = 0;
    __device__ __forceinline__ bool next(int i, Unit& u) const { int pm, pn;
        if (GATHER) { if (!o.get(i, pm, pn)) return false; }
        else { const bool light = o.c >= rem; const long L = (light && i < 2) ? (long)i * nl + (o.c - rem) : 2L * nl + (long)(light ? i - 2 : i) * o.G + o.c; if (!o.map(L, pm, pn)) return false; }
        const int e = __builtin_amdgcn_readfirstlane(texp[pm]);
        u.pm = pm; u.pn = pn; u.aux = e; u.kt = KT; u.ui = i; u.rb = (pm - __builtin_amdgcn_readfirstlane(tbase[e])) * 256; u.cn = __builtin_amdgcn_readfirstlane(tcnt[e]);
        u.A = GATHER ? A : A + (size_t)((unsigned)pm * AT); u.B = B + (size_t)((unsigned)e * BE + (unsigned)pn * BT); return true; }
    __device__ __forceinline__ int tok_of(const Unit& u, int row) const { const int pos = u.rb + row; return pos < u.cn ? (list[(size_t)u.aux * MT + pos] >> 1) : 0; }
    __device__ __forceinline__ int rowtok(int ui, int row) const { if (ui < RT_UNITS) return rt[ui * 256 + row]; Unit u; next(ui, u); return tok_of(u, row); }
    __device__ __forceinline__ void fill_dst(PG8_LAS int* rtw, const float* listg, int tid) const {
        int dv[RT_UNITS / 2]; float gv[RT_UNITS / 2]; bool ok[RT_UNITS / 2];
#pragma unroll
        for (int i = 0; i < RT_UNITS / 2; ++i) { Unit u; ok[i] = next(i, u); dv[i] = -1; gv[i] = 0.f;
            if (ok[i] && tid < 256) { const int pos = u.rb + tid; if (pos < u.cn) { const size_t li = (size_t)u.aux * MT + pos; dv[i] = list[li]; gv[i] = listg[li]; } } }
#pragma unroll
        for (int i = 0; i < RT_UNITS / 2; ++i) if (ok[i] && tid < 256) { rtw[i * 512 + tid] = dv[i]; rtw[i * 512 + 256 + tid] = (int)__float_as_uint(gv[i]); }
        __syncthreads(); }
    __device__ __forceinline__ void fill_rows(PG8_LAS int* rtw, int tid) const {
#pragma unroll
        for (int h = 0; h < 2; ++h) { int tk[RT_UNITS / 2]; bool ok[RT_UNITS / 2];
#pragma unroll
            for (int q = 0; q < RT_UNITS / 2; ++q) { Unit u; ok[q] = next(h * (RT_UNITS / 2) + q, u); tk[q] = 0; if (ok[q] && tid < 256) tk[q] = tok_of(u, tid); }
#pragma unroll
            for (int q = 0; q < RT_UNITS / 2; ++q) if (ok[q] && tid < 256) rtw[(h * (RT_UNITS / 2) + q) * 256 + tid] = tk[q]; }
        __syncthreads(); }
};

struct EpiBf16 {
    static constexpr bool PERM = true;
    bf16_t* O; int ldc; float* P;
    __device__ __forceinline__ void operator()(const f32x4 (&acc)[2][2][4][2], const Unit& u, int wr, int wc, int fr, int fq) const {
        const int row0 = u.pm * BM + wr * 64 + fr, col0 = u.pn * BM + wc * 32 + 8 * fq;
        if (u.aux == 0) {
#pragma unroll
            for (int ai = 0; ai < 2; ++ai)
#pragma unroll
                for (int m = 0; m < 4; ++m) { bf16_t* rowp = O + (size_t)(row0 + ai * HALF + m * 16) * ldc + col0;
#pragma unroll
                    for (int bj = 0; bj < 2; ++bj) { const f32x4 v0 = acc[ai][bj][m][0], v1 = acc[ai][bj][m][1];
                        v4u w; w.x = cvt_pk_bf16(v0[0], v0[1]); w.y = cvt_pk_bf16(v0[2], v0[3]); w.z = cvt_pk_bf16(v1[0], v1[1]); w.w = cvt_pk_bf16(v1[2], v1[3]);
                        *(v4u*)(rowp + bj * HALF) = w; } }
        } else {
            float* pb = P + (size_t)(u.aux - 1) * 512 * ldc;
#pragma unroll
            for (int ai = 0; ai < 2; ++ai)
#pragma unroll
                for (int m = 0; m < 4; ++m) { float* rowp = pb + (size_t)(row0 + ai * HALF + m * 16) * ldc + col0;
#pragma unroll
                    for (int bj = 0; bj < 2; ++bj) { *(f32x4*)(rowp + bj * HALF) = acc[ai][bj][m][0]; *(f32x4*)(rowp + bj * HALF + 4) = acc[ai][bj][m][1]; } }
        }
    }
};
struct EpiBf16W {
    static constexpr bool PERM = true;
    bf16_t* O; int ldc;
    __device__ __forceinline__ void operator()(const f32x4 (&acc)[2][2][4][2], const Unit& u, int wr, int wc, int fr, int fq) const {
        const int row0 = u.pm * BM + wr * 64 + fr, col0 = u.pn * BM + wc * 32 + 8 * fq;
#pragma unroll
        for (int ai = 0; ai < 2; ++ai)
#pragma unroll
            for (int m = 0; m < 4; ++m) { bf16_t* rowp = O + (size_t)(row0 + ai * HALF + m * 16) * ldc + col0;
#pragma unroll
                for (int bj = 0; bj < 2; ++bj) { const f32x4 v0 = acc[ai][bj][m][0], v1 = acc[ai][bj][m][1];
                    v4u w; w.x = cvt_pk_bf16(v0[0], v0[1]); w.y = cvt_pk_bf16(v0[2], v0[3]); w.z = cvt_pk_bf16(v1[0], v1[1]); w.w = cvt_pk_bf16(v1[2], v1[3]);
                    const bf16_t* gp = rowp + bj * HALF;
                    asm volatile("global_store_dwordx4 %0, %1, off sc1\n\ts_nop 1" :: "v"(gp), "v"(w) : "memory"); } }
    }
};
struct EpiQkv {
    static constexpr bool PERM = true;
    bf16_t* O; int ldc; float* P; bf16_t* V;
    __device__ __forceinline__ void operator()(const f32x4 (&acc)[2][2][4][2], const Unit& u, int wr, int wc, int fr, int fq) const {
        const int row0 = u.pm * BM + wr * 64 + fr, col0 = u.pn * BM + wc * 32 + 8 * fq;
        if (u.aux == 0) {
            const bool isV = u.pn >= (DM + KVD) / BM;
#pragma unroll
            for (int ai = 0; ai < 2; ++ai)
#pragma unroll
                for (int m = 0; m < 4; ++m) { const int row = row0 + ai * HALF + m * 16; bf16_t* rowp = O + (size_t)row * ldc + col0; size_t vstep = HALF;
                    if (isV) { const bool lat = row >= NCTX; const int lr = row - NCTX, b = lat ? (lr >> 13) : (row >> 8), kpos = lat ? (CTXL + (lr & 8191)) : (row & 255);
                        rowp = V + (((size_t)b * NKV + (size_t)(u.pn - (DM + KVD) / BM) * 2) * SKV + kpos) * HD + wc * 32 + 8 * fq; vstep = (size_t)SKV * HD; }
#pragma unroll
                    for (int bj = 0; bj < 2; ++bj) { const f32x4 v0 = acc[ai][bj][m][0], v1 = acc[ai][bj][m][1];
                        v4u w; w.x = cvt_pk_bf16(v0[0], v0[1]); w.y = cvt_pk_bf16(v0[2], v0[3]); w.z = cvt_pk_bf16(v1[0], v1[1]); w.w = cvt_pk_bf16(v1[2], v1[3]);
                        *(v4u*)(rowp + bj * vstep) = w; } }
        } else {
            float* pb = P + (size_t)(u.aux - 1) * 512 * ldc;
#pragma unroll
            for (int ai = 0; ai < 2; ++ai)
#pragma unroll
                for (int m = 0; m < 4; ++m) { float* rowp = pb + (size_t)(row0 + ai * HALF + m * 16) * ldc + col0;
#pragma unroll
                    for (int bj = 0; bj < 2; ++bj) { *(f32x4*)(rowp + bj * HALF) = acc[ai][bj][m][0]; *(f32x4*)(rowp + bj * HALF + 4) = acc[ai][bj][m][1]; } }
        }
    }
};
struct EpiGateUp {
    static constexpr bool PERM = true;
    bf16_t* ACT;
    __device__ __forceinline__ void operator()(const f32x4 (&acc)[2][2][4][2], const Unit& u, int wr, int wc, int fr, int fq) const {
        const int row0 = u.pm * BM + wr * 64 + fr, col0 = u.pn * HALF + wc * 32 + 8 * fq;
#pragma unroll
        for (int ai = 0; ai < 2; ++ai)
#pragma unroll
            for (int m = 0; m < 4; ++m) { bf16_t* rowp = ACT + (size_t)(row0 + ai * HALF + m * 16) * DE + col0;
                float v[8];
#pragma unroll
                for (int n = 0; n < 2; ++n)
#pragma unroll
                    for (int j = 0; j < 4; ++j) v[n * 4 + j] = silu_f(acc[ai][0][m][n][j]) * acc[ai][1][m][n][j];
                v4u w; w.x = cvt_pk_bf16(v[0], v[1]); w.y = cvt_pk_bf16(v[2], v[3]); w.z = cvt_pk_bf16(v[4], v[5]); w.w = cvt_pk_bf16(v[6], v[7]);
                asm volatile("global_store_dwordx4 %0, %1, off sc1\n\ts_nop 1" :: "v"(rowp), "v"(w) : "memory"); }
    }
};
struct EpiDown {
    static constexpr bool PERM = true;
    bf16_t* FB; const PG8_LAS int* rt;
    __device__ __forceinline__ void operator()(const f32x4 (&acc)[2][2][4][2], const Unit& u, int wr, int wc, int fr, int fq) const {
        const int r0 = wr * 64 + fr, col0 = u.pn * BM + wc * 32 + 8 * fq; const PG8_LAS int* tb = rt + u.ui * 512 + r0;
#pragma unroll
        for (int ai = 0; ai < 2; ++ai)
#pragma unroll
            for (int m = 0; m < 4; ++m) { const int d_ = tb[ai * HALF + m * 16]; const float g_ = __uint_as_float((unsigned)tb[256 + ai * HALF + m * 16]);
                if (d_ >= 0) { bf16_t* fr_ = FB + (size_t)d_ * DM + col0;
#pragma unroll
                    for (int bj = 0; bj < 2; ++bj) { const f32x4 v0 = acc[ai][bj][m][0] * g_, v1 = acc[ai][bj][m][1] * g_;
                        v4u w; w.x = cvt_pk_bf16(v0[0], v0[1]); w.y = cvt_pk_bf16(v0[2], v0[3]); w.z = cvt_pk_bf16(v1[0], v1[1]); w.w = cvt_pk_bf16(v1[2], v1[3]);
                        *(v4u*)(fr_ + bj * HALF) = w; } } }
    }
};
}

namespace att {
constexpr int D = 128, NW = 8, QBLK = 32, KVBLK = 64;
constexpr float SCALE = 0.088388347648318440f;
constexpr float THR = 8.f;
#ifndef ATT_SDEPTH
#define ATT_SDEPTH 1
#endif
constexpr int SDEPTH = ATT_SDEPTH;
constexpr int LDQ = DM, LDK = HD, LDO = DM;
constexpr size_t SHM_V = KVBLK * D * 2, SHM_K = KVBLK * D * 2, SHM_ATTN = 2 * SHM_V + 2 * SHM_K + NW * 64 * 4;
typedef unsigned u32x4 __attribute__((ext_vector_type(4)));
#define KSWZ(row, colB) ((row) * 256 + ((colB) ^ (((row) & 7) << 4)))
#define SBAR() __builtin_amdgcn_sched_barrier(0)
__device__ __forceinline__ int crow(int r, int hi) { return (r & 3) + 8 * (r >> 2) + 4 * hi; }
__device__ __forceinline__ unsigned cvtpk(float lo, float hi) { unsigned r; asm volatile("v_cvt_pk_bf16_f32 %0, %1, %2" : "=v"(r) : "v"(lo), "v"(hi)); return r; }
__device__ __forceinline__ bf16x8 ld8(const bf16_t* p) { return *reinterpret_cast<const bf16x8*>(p); }

__device__ __forceinline__ void partialSM(f32x16& p0, f32x16& p1, float& m_reg, float& mn, float& alpha) {
  constexpr float C = SCALE * 1.4426950408889634f;
  float pmax = p0[0]; for (int r = 1; r < 16; ++r) pmax = fmaxf(pmax, p0[r]); for (int r = 0; r < 16; ++r) pmax = fmaxf(pmax, p1[r]);
  { auto rr = __builtin_amdgcn_permlane32_swap(__float_as_uint(pmax), __float_as_uint(pmax), false, false);
    pmax = fmaxf(__uint_as_float(rr[0]), __uint_as_float(rr[1])); }
  if (__builtin_expect(__all(pmax - m_reg <= THR / SCALE), 1)) { mn = m_reg; alpha = 1.f; }
  else { mn = fmaxf(m_reg, pmax); alpha = __builtin_amdgcn_exp2f((m_reg - mn) * C); m_reg = mn; }
  float mnC = -mn * C;
  for (int r = 0; r < 16; ++r) p0[r] = fmaf(p0[r], C, mnC); for (int r = 0; r < 16; ++r) p1[r] = fmaf(p1[r], C, mnC);
  for (int r = 0; r < 16; ++r) p0[r] = __builtin_amdgcn_exp2f(p0[r]);
}
__device__ __forceinline__ void finishSM(f32x16& p0, f32x16& p1, float alpha, float& l_reg, bf16x8& pa0, bf16x8& pa1, bf16x8& pa2, bf16x8& pa3) {
  for (int r = 0; r < 16; ++r) p1[r] = __builtin_amdgcn_exp2f(p1[r]);
  float ps = 0; for (int r = 0; r < 16; ++r) ps += p0[r]; for (int r = 0; r < 16; ++r) ps += p1[r];
  { auto rr = __builtin_amdgcn_permlane32_swap(__float_as_uint(ps), __float_as_uint(ps), false, false);
    ps = __uint_as_float(rr[0]) + __uint_as_float(rr[1]); }
  l_reg = l_reg * alpha + ps;
#define PK4(P, BASE, OUT) do { unsigned a0 = cvtpk(P[BASE + 0], P[BASE + 1]), a1 = cvtpk(P[BASE + 2], P[BASE + 3]);   \
    unsigned b0 = cvtpk(P[BASE + 4], P[BASE + 5]), b1 = cvtpk(P[BASE + 6], P[BASE + 7]);                              \
    auto r0 = __builtin_amdgcn_permlane32_swap(a0, b0, false, false); auto r1 = __builtin_amdgcn_permlane32_swap(a1, b1, false, false); \
    u32x4 w = {r0[0], r1[0], r0[1], r1[1]}; OUT = *reinterpret_cast<bf16x8*>(&w); } while (0)
  PK4(p0, 0, pa0); PK4(p0, 8, pa1); PK4(p1, 0, pa2); PK4(p1, 8, pa3);
#undef PK4
}
__device__ __forceinline__ void qkt(f32x16& p0, f32x16& p1, const bf16_t* Ks, const bf16x8* qr, int r32, int hi) {
  p0 = f32x16{}; p1 = f32x16{};
  for (int d0 = 0; d0 < 8; ++d0) { int cb = (d0 * 16 + hi * 8) * 2;
    bf16x8 b0 = *reinterpret_cast<const bf16x8*>((const char*)Ks + KSWZ(r32, cb));
    bf16x8 b1 = *reinterpret_cast<const bf16x8*>((const char*)Ks + KSWZ(32 + r32, cb));
    p0 = __builtin_amdgcn_mfma_f32_32x32x16_bf16(b0, qr[d0], p0, 0, 0, 0);
    p1 = __builtin_amdgcn_mfma_f32_32x32x16_bf16(b1, qr[d0], p1, 0, 0, 0); }
}
__device__ __forceinline__ int v_st(int k, int c) { const int kk = (k & ~0xC) | ((k & 4) << 1) | ((k & 8) >> 1); return ((kk >> 3) * 4 + (c >> 5)) * 512 + ((kk & 7) * 32 + (c & 31)) * 2; }
__device__ __forceinline__ int v_rd_base(int lane) { return ((lane & 3) << 3) | (((lane >> 2) & 3) << 6) | (((lane >> 4) & 1) << 5) | (((lane >> 5) & 1) << 8); }
constexpr int v_rd_off(int d0, int ks, int half) { return d0 * 512 + ks * 4096 + half * 2048; }
template <int OFF> __device__ __forceinline__ s16x4 tr_read(int vb) {
  s16x4 r; asm volatile("ds_read_b64_tr_b16 %0, %1 offset:%2" : "=&v"(r) : "v"(vb), "i"(OFF) : "memory"); return r;
}
template <int D0> __device__ __forceinline__ void pv_one(f32x16& od, int vb, bf16x8 pa0, bf16x8 pa1, bf16x8 pa2, bf16x8 pa3) {
  const s16x4 l0 = tr_read<v_rd_off(D0, 0, 0)>(vb), h0 = tr_read<v_rd_off(D0, 0, 1)>(vb), l1 = tr_read<v_rd_off(D0, 1, 0)>(vb), h1 = tr_read<v_rd_off(D0, 1, 1)>(vb);
  const s16x4 l2 = tr_read<v_rd_off(D0, 2, 0)>(vb), h2 = tr_read<v_rd_off(D0, 2, 1)>(vb), l3 = tr_read<v_rd_off(D0, 3, 0)>(vb), h3 = tr_read<v_rd_off(D0, 3, 1)>(vb);
  asm volatile("s_waitcnt lgkmcnt(0)" ::: "memory"); SBAR();
#define PK(L, H) (bf16x8){L[0], L[1], L[2], L[3], H[0], H[1], H[2], H[3]}
  od = __builtin_amdgcn_mfma_f32_32x32x16_bf16(pa0, PK(l0, h0), od, 0, 0, 0);
  od = __builtin_amdgcn_mfma_f32_32x32x16_bf16(pa1, PK(l1, h1), od, 0, 0, 0);
  od = __builtin_amdgcn_mfma_f32_32x32x16_bf16(pa2, PK(l2, h2), od, 0, 0, 0);
  od = __builtin_amdgcn_mfma_f32_32x32x16_bf16(pa3, PK(l3, h3), od, 0, 0, 0);
#undef PK
}
__device__ __forceinline__ void pv_d0(f32x16* o, int vb, bf16x8 pa0, bf16x8 pa1, bf16x8 pa2, bf16x8 pa3) {
  pv_one<0>(o[0], vb, pa0, pa1, pa2, pa3); pv_one<1>(o[1], vb, pa0, pa1, pa2, pa3); pv_one<2>(o[2], vb, pa0, pa1, pa2, pa3); pv_one<3>(o[3], vb, pa0, pa1, pa2, pa3);
}
__device__ __forceinline__ void attn_dense_body(const bf16_t* __restrict__ Qb, const bf16_t* __restrict__ Kh, const bf16_t* __restrict__ Vh,
                                                bf16_t* __restrict__ Ob, int seq, char* lds) {
  const int tid = otid(), wid = tid >> 6, lane = tid & 63, r32 = lane & 31, hi = lane >> 5;
  bf16_t* V_lds = (bf16_t*)lds; bf16_t* K_lds = (bf16_t*)(lds + 2 * SHM_V);
  float* ws = (float*)(lds + 2 * SHM_V + 2 * SHM_K) + wid * 64; float* li_l = ws; float* al_l = ws + 32;
  float m_reg = -1e30f, l_reg = 0; f32x16 o[4] = {}; bf16x8 qr[8];
  const bf16_t* Qw = Qb + (long)(wid * QBLK + r32) * LDQ + hi * 8;
#pragma unroll
  for (int d0 = 0; d0 < 8; ++d0) qr[d0] = ld8(Qw + d0 * 16);
  const int sr = tid >> 4, sc = (tid & 15) * 8, vst0 = v_st(sr, sc), vst1 = v_st(32 + sr, sc);
  const int vb0 = (int)(uintptr_t)V_lds + v_rd_base(lane);
  struct { bf16x8 vs0, vs1, ks0, ks1; } sr_[SDEPTH];
#define SLOAD(i, k0) do { sr_[i].vs0 = ld8(&Vh[(long)((k0) + sr) * LDK + sc]); sr_[i].vs1 = ld8(&Vh[(long)((k0) + 32 + sr) * LDK + sc]); \
    sr_[i].ks0 = ld8(&Kh[(long)((k0) + sr) * LDK + sc]); sr_[i].ks1 = ld8(&Kh[(long)((k0) + 32 + sr) * LDK + sc]); } while (0)
#define SWRITE(b, i) do { *(bf16x8*)((char*)V_lds + (b) * SHM_V + vst0) = sr_[i].vs0;          \
    *(bf16x8*)((char*)V_lds + (b) * SHM_V + vst1) = sr_[i].vs1; int kc = sc * 2;               \
    *(bf16x8*)((char*)K_lds + (b) * SHM_K + KSWZ(sr, kc)) = sr_[i].ks0;                       \
    *(bf16x8*)((char*)K_lds + (b) * SHM_K + KSWZ(32 + sr, kc)) = sr_[i].ks1; } while (0)
#define SWAIT() do { if constexpr (SDEPTH == 2) asm volatile("s_waitcnt vmcnt(4)" ::: "memory"); else asm volatile("s_waitcnt vmcnt(0)" ::: "memory"); } while (0)
#define RESC(a) do { if (__any((a) < 1.f)) { if (hi == 0) al_l[r32] = (a); asm volatile("s_waitcnt lgkmcnt(0)" ::: "memory"); \
    for (int d = 0; d < 4; ++d) for (int r = 0; r < 16; ++r) o[d][r] *= al_l[crow(r, hi)]; } } while (0)
  f32x16 pA0, pA1, pB0, pB1; float mnA, mnB, alA, alB; bf16x8 pa0, pa1, pa2, pa3; const int NT = seq / KVBLK;
  constexpr int SE = 0, SO = SDEPTH - 1;
  SLOAD(SE, 0); asm volatile("s_waitcnt vmcnt(0)" ::: "memory"); SWRITE(0, SE); __syncthreads();
  qkt(pA0, pA1, K_lds, qr, r32, hi); partialSM(pA0, pA1, m_reg, mnA, alA);
  SLOAD(SO, KVBLK); if constexpr (SDEPTH == 2) { if (2 < NT) SLOAD(SE, 2 * KVBLK); }
  SWAIT(); SWRITE(1, SO); __syncthreads();
  for (int j = 1; j + 1 < NT; j += 2) {
    SBAR(); qkt(pB0, pB1, (bf16_t*)((char*)K_lds + SHM_K), qr, r32, hi);
    finishSM(pA0, pA1, alA, l_reg, pa0, pa1, pa2, pa3); SBAR();
    SLOAD(SO, (j + SDEPTH) * KVBLK); SBAR();
    pv_d0(o, vb0, pa0, pa1, pa2, pa3); partialSM(pB0, pB1, m_reg, mnB, alB);
    __syncthreads(); SWAIT(); SWRITE(0, SE);
    RESC(alB); __syncthreads();
    SBAR(); qkt(pA0, pA1, K_lds, qr, r32, hi);
    finishSM(pB0, pB1, alB, l_reg, pa0, pa1, pa2, pa3); SBAR();
    if (SDEPTH == 1 || j + 3 < NT) SLOAD(SE, (j + 1 + SDEPTH) * KVBLK); SBAR();
    pv_d0(o, vb0 + (int)SHM_V, pa0, pa1, pa2, pa3); partialSM(pA0, pA1, m_reg, mnA, alA);
    __syncthreads(); SWAIT(); SWRITE(1, SO);
    RESC(alA); __syncthreads();
  }
  SBAR(); qkt(pB0, pB1, (bf16_t*)((char*)K_lds + SHM_K), qr, r32, hi);
  finishSM(pA0, pA1, alA, l_reg, pa0, pa1, pa2, pa3); SBAR();
  pv_d0(o, vb0, pa0, pa1, pa2, pa3); partialSM(pB0, pB1, m_reg, mnB, alB);
  __syncthreads(); RESC(alB);
  finishSM(pB0, pB1, alB, l_reg, pa0, pa1, pa2, pa3); SBAR();
  pv_d0(o, vb0 + (int)SHM_V, pa0, pa1, pa2, pa3);
  if (hi == 0) li_l[r32] = l_reg; asm volatile("s_waitcnt lgkmcnt(0)" ::: "memory");
  float rli[16];
#pragma unroll
  for (int r = 0; r < 16; ++r) rli[r] = __builtin_amdgcn_rcpf(li_l[crow(r, hi)]);
  bf16_t* Ow = Ob + (long)(wid * QBLK) * LDO;
#pragma unroll
  for (int r = 0; r < 16; ++r) { int orow = crow(r, hi);
    for (int d0 = 0; d0 < 4; ++d0) Ow[(long)orow * LDO + d0 * 32 + r32] = (bf16_t)f2bf(o[d0][r] * rli[r]); }
  asm volatile("s_waitcnt vmcnt(0) lgkmcnt(0)" ::: "memory");
  __syncthreads();
#undef SLOAD
#undef SWRITE
#undef SWAIT
#undef RESC
}
constexpr size_t SHM_SLOT = 32768, SHM_DMA = 3 * SHM_SLOT + NW * 64 * 4;
#define ATT_WAIT_BAR() asm volatile("s_waitcnt vmcnt(0) lgkmcnt(0)\n\ts_barrier" ::: "memory")
__device__ __forceinline__ void attn_dma_body(const bf16_t* __restrict__ Qb, int ldq, int tpos0, const float* __restrict__ rope, const float* __restrict__ qgain,
                                              const bf16_t* __restrict__ Kh, const bf16_t* __restrict__ Vh, bf16_t* __restrict__ Ob, int seq, char* lds) {
  const int tid = otid(), wid = tid >> 6, lane = tid & 63, r32 = lane & 31, hi = lane >> 5;
  float* ws = (float*)(lds + 3 * SHM_SLOT) + wid * 64; float* li_l = ws; float* al_l = ws + 32;
  float m_reg = -1e30f, l_reg = 0; f32x16 o[4] = {}; bf16x8 qr[8];
  const bf16_t* Qw = Qb + (long)(wid * QBLK + r32) * ldq + hi * 8;
  unsigned koff[2], voff[2];
#pragma unroll
  for (int c = 0; c < 2; ++c) { const int g = c * 512 + tid;
    { const int row = g >> 4, ch = (g & 15) ^ (row & 7); koff[c] = (unsigned)(row * 128 + ch * 8) * 2u; }
    { const int sub = g >> 5, kk = (sub >> 2) * 8 + ((g >> 2) & 7), k = (kk & ~0xC) | ((kk & 4) << 1) | ((kk & 8) >> 1), col = (sub & 3) * 32 + (g & 3) * 8; voff[c] = (unsigned)(k * 128 + col) * 2u; } }
  const unsigned wbase = (unsigned)__builtin_amdgcn_readfirstlane(wid) * 1024u;
  typedef __attribute__((address_space(3))) unsigned lds_u32;
  lds_u32* ldsl = (lds_u32*)(__attribute__((address_space(3))) char*)lds;
#define ATT_DMA(t, slot) do { const char* kt_ = (const char*)Kh + (size_t)(t) * (KVBLK * D * 2); const char* vt_ = (const char*)Vh + (size_t)(t) * (KVBLK * D * 2); \
    _Pragma("unroll") for (int c_ = 0; c_ < 2; ++c_) { \
      __builtin_amdgcn_global_load_lds((const unsigned*)(kt_ + koff[c_]), (lds_u32*)((__attribute__((address_space(3))) char*)ldsl + (slot) * SHM_SLOT + c_ * 8192 + wbase), 16, 0, 0); \
      __builtin_amdgcn_global_load_lds((const unsigned*)(vt_ + voff[c_]), (lds_u32*)((__attribute__((address_space(3))) char*)ldsl + (slot) * SHM_SLOT + 16384 + c_ * 8192 + wbase), 16, 0, 0); } } while (0)
#define RESC(a) do { if (__any((a) < 1.f)) { if (hi == 0) al_l[r32] = (a); asm volatile("s_waitcnt lgkmcnt(0)" ::: "memory"); \
    for (int d = 0; d < 4; ++d) for (int r = 0; r < 16; ++r) o[d][r] *= al_l[crow(r, hi)]; } } while (0)
  const int NT = seq / KVBLK;
  ATT_DMA(0, 0); ATT_DMA(1, 1);
#pragma unroll
  for (int d0 = 0; d0 < 8; ++d0) qr[d0] = ld8(Qw + d0 * 16);
  if (tpos0 >= 0) {
    float ss = 0.f;
#pragma unroll
    for (int d0 = 0; d0 < 8; ++d0)
#pragma unroll
      for (int i = 0; i < 8; ++i) { const float x = bf2f((unsigned)(unsigned short)qr[d0][i]); ss += x * x; }
    { auto rr = __builtin_amdgcn_permlane32_swap(__float_as_uint(ss), __float_as_uint(ss), false, false); ss = __uint_as_float(rr[0]) + __uint_as_float(rr[1]); }
    const float rinv = 1.0f / sqrtf(ss * (1.0f / 128.0f) + RMS_EPS);
    const int t = tpos0 + wid * QBLK + r32;
#pragma unroll
    for (int ax = 0; ax < 2; ++ax) { const int pos = ax ? (t & 63) : (t >> 6);
#pragma unroll
      for (int q = 0; q < 2; ++q) { const int dl = 4 * ax + q, dh = dl + 2, p0 = q * 16 + 8 * hi;
        const float* cp_ = rope + pos * 32 + p0; const float* gl = qgain + dl * 16 + 8 * hi; const float* gh = qgain + dh * 16 + 8 * hi;
        float cs[8], sn[8], lo[8], hv[8];
#pragma unroll
        for (int i = 0; i < 8; ++i) { cs[i] = cp_[i]; sn[i] = cp_[4096 + i];
          lo[i] = bf2f((unsigned)(unsigned short)qr[dl][i]) * rinv * gl[i]; hv[i] = bf2f((unsigned)(unsigned short)qr[dh][i]) * rinv * gh[i]; }
        u32x4 wl, wh;
#pragma unroll
        for (int i = 0; i < 4; ++i) { const float l0 = lo[2 * i] * cs[2 * i] - hv[2 * i] * sn[2 * i], l1 = lo[2 * i + 1] * cs[2 * i + 1] - hv[2 * i + 1] * sn[2 * i + 1];
          const float h0 = hv[2 * i] * cs[2 * i] + lo[2 * i] * sn[2 * i], h1 = hv[2 * i + 1] * cs[2 * i + 1] + lo[2 * i + 1] * sn[2 * i + 1];
          wl[i] = pk2(l0, l1); wh[i] = pk2(h0, h1); }
        qr[dl] = *reinterpret_cast<bf16x8*>(&wl); qr[dh] = *reinterpret_cast<bf16x8*>(&wh); } } }
#pragma unroll
  for (int d0 = 0; d0 < 8; ++d0) asm volatile("" : "+v"(qr[d0]));
  ATT_WAIT_BAR();
  if (2 < NT) ATT_DMA(2, 2);
  const int vb0 = (int)(uintptr_t)lds + 16384 + v_rd_base(lane);
  f32x16 pA0, pA1, pB0, pB1; float mnA, mnB, alA, alB; bf16x8 pa0, pa1, pa2, pa3;
  qkt(pA0, pA1, (const bf16_t*)lds, qr, r32, hi); partialSM(pA0, pA1, m_reg, mnA, alA);
  int sj = 1;
  for (int j = 1; j + 1 < NT; j += 2) {
    { const int sp = sj == 0 ? 2 : sj - 1;
      SBAR(); qkt(pB0, pB1, (const bf16_t*)(lds + sj * SHM_SLOT), qr, r32, hi);
      finishSM(pA0, pA1, alA, l_reg, pa0, pa1, pa2, pa3); SBAR();
      pv_d0(o, vb0 + sp * (int)SHM_SLOT, pa0, pa1, pa2, pa3); partialSM(pB0, pB1, m_reg, mnB, alB);
      ATT_WAIT_BAR();
      if (j + 2 < NT) ATT_DMA(j + 2, sp);
      RESC(alB); }
    { const int s1 = sj == 2 ? 0 : sj + 1;
      SBAR(); qkt(pA0, pA1, (const bf16_t*)(lds + s1 * SHM_SLOT), qr, r32, hi);
      finishSM(pB0, pB1, alB, l_reg, pa0, pa1, pa2, pa3); SBAR();
      pv_d0(o, vb0 + sj * (int)SHM_SLOT, pa0, pa1, pa2, pa3); partialSM(pA0, pA1, m_reg, mnA, alA);
      ATT_WAIT_BAR();
      if (j + 3 < NT) ATT_DMA(j + 3, sj);
      RESC(alA);
      sj = s1 == 2 ? 0 : s1 + 1; }
  }
  { const int sp = sj == 0 ? 2 : sj - 1;
    SBAR(); qkt(pB0, pB1, (const bf16_t*)(lds + sj * SHM_SLOT), qr, r32, hi);
    finishSM(pA0, pA1, alA, l_reg, pa0, pa1, pa2, pa3); SBAR();
    pv_d0(o, vb0 + sp * (int)SHM_SLOT, pa0, pa1, pa2, pa3); partialSM(pB0, pB1, m_reg, mnB, alB);
    RESC(alB);
    finishSM(pB0, pB1, alB, l_reg, pa0, pa1, pa2, pa3); SBAR();
    pv_d0(o, vb0 + sj * (int)SHM_SLOT, pa0, pa1, pa2, pa3); }
  if (hi == 0) li_l[r32] = l_reg; asm volatile("s_waitcnt lgkmcnt(0)" ::: "memory");
  float rli[16];
#pragma unroll
  for (int r = 0; r < 16; ++r) rli[r] = __builtin_amdgcn_rcpf(li_l[crow(r, hi)]);
  bf16_t* Ow = Ob + (long)(wid * QBLK) * LDO;
  asm volatile("s_waitcnt lgkmcnt(0)\n\ts_barrier" ::: "memory");
  { char* st = lds + wid * 8704;
#pragma unroll
    for (int r = 0; r < 16; ++r) { const int orow = crow(r, hi);
#pragma unroll
      for (int d0 = 0; d0 < 4; ++d0) *(bf16_t*)(st + orow * 272 + (d0 * 32 + r32) * 2) = (bf16_t)f2bf(o[d0][r] * rli[r]); }
    asm volatile("s_waitcnt lgkmcnt(0)" ::: "memory");
#pragma unroll
    for (int i = 0; i < 8; ++i) { const int c = i * 64 + lane, row = c >> 4, cc = c & 15; const u32x4 v = *(const u32x4*)(st + row * 272 + cc * 16);
      const bf16_t* gp = Ow + (long)row * LDO + cc * 8;
      asm volatile("global_store_dwordx4 %0, %1, off sc1\n\ts_nop 1" :: "v"(gp), "v"(v) : "memory"); } }
  ATT_WAIT_BAR();
#undef ATT_DMA
#undef RESC
}
#undef KSWZ
}

struct Params {
    const float *x, *c, *ctx, *c_ctx, *w_mod, *b_mod, *ln_g, *ln_b, *w_qkv, *q_gain, *k_gain, *w_o, *w_pool, *pool_scale, *w_router, *router_bias, *w_gate, *w_up, *w_down;
    float* out; unsigned char* ws; int ph_lo, ph_hi;
};

struct TItem { const float* W; bf16_t* WT; int K, N, kind, k0, n0; };
__device__ __forceinline__ int t_drow(int kind, int n) { return kind == 0 ? n : ((n >> 7) * 256 + (kind == 2 ? 128 : 0) + (n & 127)); }
__device__ __forceinline__ void t_load(const TItem& d, float (&r)[32], int lane) {
    const float* p = d.W + (size_t)(d.k0 + (lane >> 5)) * d.N + d.n0 + (lane & 31);
#pragma unroll
    for (int i = 0; i < 32; ++i) r[i] = __builtin_nontemporal_load(p + (size_t)(2 * i) * d.N);
}
__device__ __forceinline__ void t_store(const TItem& d, const float (&r)[32], LAS float* scr, int lane) {
#pragma unroll
    for (int i = 0; i < 32; ++i) scr[(2 * i + (lane >> 5)) * 33 + (lane & 31)] = r[i];
    LDS_WAIT(); asm volatile("" ::: "memory");
    const int c = lane & 7;
#pragma unroll
    for (int j = 0; j < 4; ++j) { const int n = (lane >> 3) + 8 * j; const LAS float* s = scr + (8 * c) * 33 + n;
        v4u o; o.x = pk2(s[0 * 33], s[1 * 33]); o.y = pk2(s[2 * 33], s[3 * 33]); o.z = pk2(s[4 * 33], s[5 * 33]); o.w = pk2(s[6 * 33], s[7 * 33]);
        __builtin_nontemporal_store(o, (GAS v4u*)(d.WT + (size_t)t_drow(d.kind, d.n0 + n) * d.K + d.k0 + 8 * c)); }
    LDS_WAIT(); asm volatile("" ::: "memory");
}

__device__ __forceinline__ void mod_prepare(const float* cl, const float* cc, LAS float* sv, int tid) {
    for (int i = tid; i < 3 * DM; i += 512) { const int cd = i >> 11, k = i & 2047; const float v = (cd < 2) ? cl[cd * DM + k] : cc[k]; sv[i] = v / (1.0f + expf(-v)); }
    __syncthreads();
}
__device__ __forceinline__ void mod_item(int it, const float* wm, const float* bm, float* MOD, const LAS float* sv, LAS float* red, int tid, int lane, int wave) {
    const int c4 = lane & 7, kr = (lane >> 3) + 8 * wave;
    const int l = it / 384, nb = it % 384; const float* W = wm + (size_t)l * DM * 12288 + nb * 32 + c4 * 4;
    f32x4 a0 = {0, 0, 0, 0}, a1 = a0, a2 = a0;
#pragma unroll 16
    for (int s = 0; s < 32; ++s) { const int k = s * 64 + kr; const f32x4 w = *(const f32x4*)(W + (size_t)k * 12288);
        a0 += w * sv[k]; a1 += w * sv[DM + k]; a2 += w * sv[2 * DM + k]; }
    *(LAS f32x4*)(red + (kr * 3 + 0) * 32 + c4 * 4) = a0; *(LAS f32x4*)(red + (kr * 3 + 1) * 32 + c4 * 4) = a1; *(LAS f32x4*)(red + (kr * 3 + 2) * 32 + c4 * 4) = a2;
    __syncthreads();
    if (tid < 96) { const int cd = tid >> 5, n = tid & 31; float s = 0.f; for (int r = 0; r < 64; ++r) s += red[(r * 3 + cd) * 32 + n];
        MOD[((size_t)l * 3 + cd) * 12288 + nb * 32 + n] = s + bm[l * 12288 + nb * 32 + n]; }
    __syncthreads();
}

typedef const __attribute__((address_space(4))) Params CParams;
__device__ __forceinline__ CParams* kparams() { CParams* k = (CParams*)__builtin_amdgcn_kernarg_segment_ptr(); asm volatile("" : "+s"(k)); return k; }
#define WSP(T, off) ((T*)(kp->ws + (off)))


#define IN(k) (lo <= (k) && (k) < hi)
#define NREP(k) (1 + ((REP_MASK >> (k)) & 1))
#define SEAM(k) do { if (IN(k) && IN((k) + 1)) xcd_barrier(bar); } while (0)
#define TIDS const int tid = otid(), lane = tid & 63, wave = __builtin_amdgcn_readfirstlane(tid >> 6), G = ogrid(), bx = obid(), gw = bx * 8 + wave, NGW = G * 8; (void)lane; (void)gw; (void)NGW


template <int layer>
__device__ __forceinline__ void layer_half(const int lo, const int hi, const XcdBarrier& bar, LAS unsigned char* L, LAS int* tcnt, LAS int* tbase, LAS int* texp) {
        const int P6 = 6 + 7 * layer;
        if (IN(P6)) _Pragma("unroll 1") for (int rep_ = 0; rep_ < NREP(6); ++rep_) {
            CParams* kp = kparams(); TIDS;
            const int row_lo = layer == 0 ? 0 : NCTX;
            const float* modl = WSP(float, WS_MOD) + (size_t)layer * 3 * 12288;
            unsigned* cnt = WSP(unsigned, WS_CTL) + CW_CNT + layer * 1024;
            const bf16_t* Y = WSP(bf16_t, WS_Y); float* X1 = WSP(float, WS_X1); bf16_t* Hb = WSP(bf16_t, WS_H);
            const float* xlat = kp->x; const float* xctx = kp->ctx; const bf16_t* X2b = WSP(bf16_t, WS_X2);
            const float* pscale = kp->pool_scale;
            int* LIST = WSP(int, WS_LIST); float* LISTG = WSP(float, WS_LIST) + (size_t)32 * MT;
            const float* rbias = kp->router_bias;
            LAS bf16_t* hp = (LAS bf16_t*)L;
            LAS float* part = (LAS float*)(L + 65536);
            LAS int* lcnt = (LAS int*)(L + 65536 + 8192); LAS int* lbase = lcnt + 32;
            LAS int* asg = (LAS int*)(L + 65536 + 8192 + 256);
            LAS float* vG1 = (LAS float*)(L + 82176); LAS float* vLG = vG1 + DM; LAS float* vLB = vLG + DM; LAS float* vSC = vLB + DM; LAS float* vSH = vSC + DM;
            const float* lg = kp->ln_g + (size_t)(layer * 2 + 0) * DM; const float* lb = kp->ln_b + (size_t)(layer * 2 + 0) * DM;
            const int ngrp = (MT - row_lo) / 8;
            const bool agg = ((ngrp + G - 1) / G) * 16 <= 512;
            if (tid < 32) lcnt[tid] = 0;
            const int ti = lane & 31, hi = lane >> 5;
            const bf16_t* w1p = WSP(bf16_t, WS_WR) + ((size_t)(wave * 16) * 64 + lane) * 8; const bf16_t* w2p = w1p + 32 * DM;
            const LAS bf16_t* a1p = hp + (ti & 7) * DM + wave * 256 + 8 * hi; const LAS bf16_t* a2p = a1p + 8 * DM;
            f32x4 xv[8]; v2u xb[8], yv[8];
#define P6_LOAD(grp_) do { const int row_ = row_lo + (grp_) * 8 + wave; const float* xr_ = (row_ < NCTX) ? xctx + (size_t)row_ * DM : xlat + (size_t)(row_ - NCTX) * DM; const bf16_t* yr_ = Y + (size_t)row_ * DM; const bf16_t* xb_ = X2b + (size_t)row_ * DM; \
                _Pragma("unroll") for (int j = 0; j < 8; ++j) { if (layer == 0) xv[j] = *(const f32x4*)(xr_ + (j * 64 + lane) * 4); else xb[j] = *(const v2u*)(xb_ + (j * 64 + lane) * 4); yv[j] = *(const v2u*)(yr_ + (j * 64 + lane) * 4); } } while (0)
            LAS int* rdy = (LAS int*)(L + 124928); unsigned* yd = WSP(unsigned, WS_CTL) + CW_YD; volatile LAS unsigned* MISC = (volatile LAS unsigned*)(L + MISC_OFF);
            const bool dyn = (layer == 0) && (G % 2 == 0); const int pcls = bx & 1; unsigned* q6 = WSP(unsigned, WS_CTL) + CW_P6Q + 32 * pcls;
            auto gmap = [&](unsigned pos) -> int { return pos >= 1056u ? -1 : (pos < 32u ? pcls * 32 + (int)pos : 64 + pcls * 1024 + ((int)pos - 32)); };
            auto seq = [&](int k) -> int { const int g_ = bx + k * G; return g_ < ngrp ? g_ : -1; };
            auto ensure = [&](int g_) { if (layer == 0) { const int pm_ = g_ < 64 ? (g_ >> 5) : 2 + ((g_ - 64) >> 5); if (!rdy[pm_]) { while (xb_ld(yd + 32 * pm_) < 8u) __builtin_amdgcn_s_sleep(4); asm volatile("" ::: "memory"); } } };
            if (layer == 0) { if (tid < 66) rdy[tid] = xb_ld(yd + 32 * tid) >= 8u ? 1 : 0;
                if (tid == 0) { __builtin_amdgcn_fence(__ATOMIC_ACQUIRE, "agent"); asm volatile("s_waitcnt vmcnt(0)" ::: "memory");
                    if (dyn) { MISC[36] = xb_add(q6, 1u); MISC[37] = xb_add(q6, 1u); } }
                __syncthreads(); }
            int grp = dyn ? gmap(MISC[36]) : seq(0), nxt_ = dyn ? gmap(MISC[37]) : seq(1);
            if (grp >= 0) ensure(grp);
            P6_LOAD(grp >= 0 ? grp : 0);
            int it_ = 0, cur_cd = -1;
            for (; grp >= 0; ++it_) {
                unsigned tk2 = 0xffffffffu;
                if (dyn && tid == 0 && nxt_ >= 0 && it_ + 2 < 32) tk2 = xb_add(q6, 1u);
                const int row = row_lo + grp * 8 + wave; const int cd = row_cond(row_lo + grp * 8);
                if (cd != cur_cd) {
                    const float* g1 = modl + (size_t)cd * 12288 + 2 * DM;
                    float t0[4], t1[4], t2[4], t3[4], t4[4], t5[4];
                    __syncthreads();
#pragma unroll
                    for (int q = 0; q < 4; ++q) { const int i = tid + q * 512; t0[q] = g1[i]; t1[q] = (layer == 1) ? pscale[i] : 1.0f; t2[q] = lg[i]; t3[q] = lb[i]; t4[q] = g1[DM + i]; t5[q] = g1[2 * DM + i]; }
#pragma unroll
                    for (int q = 0; q < 4; ++q) { const int i = tid + q * 512; vG1[i] = t0[q] * t1[q]; vLG[i] = t2[q]; vLB[i] = t3[q]; vSH[i] = t4[q]; vSC[i] = t5[q] + 1.0f; }
                    cur_cd = cd; __syncthreads(); }
                f32x4 v[8]; float s = 0.f;
#pragma unroll
                for (int j = 0; j < 8; ++j) { const int c = (j * 64 + lane) * 4; const f32x4 gv = *(const LAS f32x4*)(vG1 + c);
                    const f32x4 yf = {bf2f(yv[j].x & 0xffffu), bf2f(yv[j].x >> 16), bf2f(yv[j].y & 0xffffu), bf2f(yv[j].y >> 16)};
                    const f32x4 xf = (layer == 0) ? xv[j] : bf4(xb[j]);
                    v[j] = xf * ALPHA + gv * yf; s += (v[j][0] + v[j][1]) + (v[j][2] + v[j][3]); }
                if (nxt_ >= 0) { ensure(nxt_); P6_LOAD(nxt_); }
                const float mean = wave_sum(s) * (1.0f / DM); float s2 = 0.f;
#pragma unroll
                for (int j = 0; j < 8; ++j) { v[j] = v[j] - mean; s2 += (v[j][0] * v[j][0] + v[j][1] * v[j][1]) + (v[j][2] * v[j][2] + v[j][3] * v[j][3]); }
                const float rstd = 1.0f / sqrtf(wave_sum(s2) * (1.0f / DM) + LN_EPS);
#pragma unroll
                for (int j = 0; j < 8; ++j) { const int c = (j * 64 + lane) * 4;
                    const f32x4 x1 = v[j] * rstd * *(const LAS f32x4*)(vLG + c) + *(const LAS f32x4*)(vLB + c);
                    { v2u xw; xw.x = pk2(x1[0], x1[1]); xw.y = pk2(x1[2], x1[3]); *(v2u*)((bf16_t*)X1 + (size_t)row * DM + c) = xw; }
                    const f32x4 hv = x1 * *(const LAS f32x4*)(vSC + c) + *(const LAS f32x4*)(vSH + c);
                    v2u w; w.x = pk2(hv[0], hv[1]); w.y = pk2(hv[2], hv[3]); *(v2u*)(Hb + (size_t)row * DM + c) = w;
                    v2u w2; w2.x = pk2(hv[0] - bf2f(w.x & 0xffffu), hv[1] - bf2f(w.x >> 16)); w2.y = pk2(hv[2] - bf2f(w.y & 0xffffu), hv[3] - bf2f(w.y >> 16));
                    *(LAS v2u*)(hp + wave * DM + c) = w; *(LAS v2u*)(hp + (8 + wave) * DM + c) = w2; }
                const bf16_t* w1q = w1p; asm volatile("" : "+v"(w1q));
                const bf16_t* w2q = w1q + 32 * DM;
                bf16x8 wA1[4], wA2[4], wB1[4], wB2[4];
#define P6_WLOAD(d1, d2, q0) do { _Pragma("unroll") for (int q_ = 0; q_ < 4; ++q_) { d1[q_] = *(const bf16x8*)(w1q + ((q0) + q_) * 512); d2[q_] = *(const bf16x8*)(w2q + ((q0) + q_) * 512); } } while (0)
#define P6_MMA(s1, s2, q0) do { _Pragma("unroll") for (int q_ = 0; q_ < 4; ++q_) { const bf16x8 a1 = *(const LAS bf16x8*)(a1p + ((q0) + q_) * 16), a2 = *(const LAS bf16x8*)(a2p + ((q0) + q_) * 16); \
                    acc = __builtin_amdgcn_mfma_f32_32x32x16_bf16(a1, s1[q_], acc, 0, 0, 0); acc = __builtin_amdgcn_mfma_f32_32x32x16_bf16(a1, s2[q_], acc, 0, 0, 0); acc = __builtin_amdgcn_mfma_f32_32x32x16_bf16(a2, s1[q_], acc, 0, 0, 0); } } while (0)
                P6_WLOAD(wA1, wA2, 0); P6_WLOAD(wB1, wB2, 4);
                __syncthreads();
                {
                    f32x16 acc = {};
                    __builtin_amdgcn_sched_barrier(0); P6_MMA(wA1, wA2, 0); __builtin_amdgcn_sched_barrier(0);
                    P6_WLOAD(wA1, wA2, 8); __builtin_amdgcn_sched_barrier(0); P6_MMA(wB1, wB2, 4); __builtin_amdgcn_sched_barrier(0);
                    P6_WLOAD(wB1, wB2, 12); __builtin_amdgcn_sched_barrier(0); P6_MMA(wA1, wA2, 8); __builtin_amdgcn_sched_barrier(0);
                    P6_MMA(wB1, wB2, 12);
#pragma unroll
                    for (int r = 0; r < 4; ++r) part[(wave * 8 + r + 4 * hi) * 32 + ti] = acc[r];
                }
                if (dyn && tid == 0) MISC[38] = tk2;
                __syncthreads();
                {
                    const int rr = row_lo + grp * 8 + wave, e = lane & 31; float lgt = 0.f;
#pragma unroll
                    for (int k = 0; k < 8; ++k) lgt += part[(k * 8 + wave) * 32 + e];
                    const float aff = 1.0f / (1.0f + expf(-lgt)); const float sel = aff + rbias[e];
                    const float o1 = dppf<0xB1>(sel), mx1 = fmaxf(sel, o1), mn1 = fminf(sel, o1);
                    const float mx2 = dppf<0x4E>(mx1), mn2 = dppf<0x4E>(mn1);
                    float gs = fmaxf(mx1, mx2) + fmaxf(fminf(mx1, mx2), fmaxf(mn1, mn2)); int bg = e >> 2;
                    { const float og = dppf<0x141>(gs); const int ob = dppi<0x141>(bg); if (og > gs || (og == gs && ob < bg)) { gs = og; bg = ob; } }
                    { const float og = dppf<0x140>(gs); const int ob = dppi<0x140>(bg); if (og > gs || (og == gs && ob < bg)) { gs = og; bg = ob; } }
                    { const auto rg = __builtin_amdgcn_permlane16_swap(__float_as_uint(gs), __float_as_uint(gs), false, false); const auto rb = __builtin_amdgcn_permlane16_swap((unsigned)bg, (unsigned)bg, false, false);
                      const bool odd = (lane & 16) != 0; const float og = __uint_as_float(odd ? rg[0] : rg[1]); const int ob = (int)(odd ? rb[0] : rb[1]); if (og > gs || (og == gs && ob < bg)) { gs = og; bg = ob; } }
                    const int bgs = __builtin_amdgcn_readfirstlane(bg);
                    float s4[4], a4[4];
#pragma unroll
                    for (int j = 0; j < 4; ++j) { s4[j] = __uint_as_float((unsigned)__builtin_amdgcn_readlane((int)__float_as_uint(sel), bgs * 4 + j)); a4[j] = __uint_as_float((unsigned)__builtin_amdgcn_readlane((int)__float_as_uint(aff), bgs * 4 + j)); }
                    int i0 = 0; float m0 = s4[0], g0 = a4[0];
#pragma unroll
                    for (int j = 1; j < 4; ++j) if (s4[j] > m0) { m0 = s4[j]; i0 = j; g0 = a4[j]; }
                    int i1 = -1; float m1 = -1e30f, g1_ = 0.f;
#pragma unroll
                    for (int j = 0; j < 4; ++j) if (j != i0 && s4[j] > m1) { m1 = s4[j]; i1 = j; g1_ = a4[j]; }
                    const int e0 = __builtin_amdgcn_readfirstlane(bg * 4 + i0), e1 = __builtin_amdgcn_readfirstlane(bg * 4 + i1);
                    const float inv = 1.0f / (g0 + g1_);
                    if (lane == 0 && rep_ == 0) {
                        if (agg) { const int q0 = __hip_atomic_fetch_add(&lcnt[e0], 1, __ATOMIC_RELAXED, __HIP_MEMORY_SCOPE_WORKGROUP), q1 = __hip_atomic_fetch_add(&lcnt[e1], 1, __ATOMIC_RELAXED, __HIP_MEMORY_SCOPE_WORKGROUP);
                            LAS int* ap = asg + (it_ * 8 + wave) * 8;
                            ap[0] = e0; ap[1] = q0; ap[2] = rr * 2; ap[3] = (int)__float_as_uint(g0 * inv); ap[4] = e1; ap[5] = q1; ap[6] = rr * 2 + 1; ap[7] = (int)__float_as_uint(g1_ * inv);
                        } else {
                            const unsigned p0 = __hip_atomic_fetch_add(&cnt[e0 * 32], 1u, RLX_AGENT), p1 = __hip_atomic_fetch_add(&cnt[e1 * 32], 1u, RLX_AGENT);
                            LIST[(size_t)e0 * MT + p0] = rr * 2; LISTG[(size_t)e0 * MT + p0] = g0 * inv;
                            LIST[(size_t)e1 * MT + p1] = rr * 2 + 1; LISTG[(size_t)e1 * MT + p1] = g1_ * inv; } }
                }
                grp = nxt_; nxt_ = dyn ? gmap(MISC[38]) : seq(it_ + 2);
            }
#undef P6_LOAD
#undef P6_WLOAD
#undef P6_MMA
            __syncthreads();
            if (agg && rep_ == 0) {
                if (tid < 32) lbase[tid] = (int)__hip_atomic_fetch_add(&cnt[tid * 32], (unsigned)lcnt[tid], RLX_AGENT);
                __syncthreads();
                for (int i = tid; i < it_ * 16; i += 512) { const int e = asg[i * 4], q = asg[i * 4 + 1], src = asg[i * 4 + 2]; const float gt = __uint_as_float((unsigned)asg[i * 4 + 3]);
                    const size_t o = (size_t)e * MT + (size_t)(lbase[e] + q); LIST[o] = src; LISTG[o] = gt; }
            }
            __syncthreads();
        }
        SEAM(P6);
        int NT = 0;
        if (IN(P6 + 1) || IN(P6 + 2) || IN(P6 + 3)) {
            CParams* kp = kparams(); unsigned* cnt = WSP(unsigned, WS_CTL) + CW_CNT + layer * 1024;
            const int ttid = otid();
            if (ttid < 64) { const int ln = ttid, e = ln & 31; const int c = (int)__hip_atomic_load(&cnt[e * 32], RLX_AGENT); const int nt_ = (c + 255) >> 8; int inc = nt_;
#pragma unroll
                for (int o = 1; o < 32; o <<= 1) { const int t_ = __shfl_up(inc, o); if ((ln & 31) >= o) inc += t_; }
                if (ln < 32) { tcnt[e] = c; tbase[e] = inc - nt_; if (e == 31) tbase[32] = inc; for (int t_ = inc - nt_; t_ < inc; ++t_) texp[t_] = e; } }
            __syncthreads();
            NT = __builtin_amdgcn_readfirstlane(tbase[32]);
        }
        if (IN(P6 + 2)) _Pragma("unroll 1") for (int rep_ = 0; rep_ < NREP(8); ++rep_) {
            CParams* kp = kparams();
            typedef pg8::SchedMoe<256u * DM * 2u, 256u * DM * 2u, 2048u * DM * 2u, DM / 64, true> Sch;
            LAS int* rt = (LAS int*)(L + TAB_OFF + 1024);
            pg8::Gemm g{DM, DM, DM}; Sch S; S.o.init(NT, 8, ogrid(), obid()); S.A = WSP(const char, WS_H); S.B = WSP(const char, WS_WGU) + (size_t)layer * 32 * 2048 * DM * 2;
            S.texp = texp; S.tbase = tbase; S.tcnt = tcnt; S.rt = rt; S.list = WSP(int, WS_LIST); S.ctr = WSP(unsigned, WS_CTL) + CW_GUD + layer * 8192;
            S.fill_rows(rt, otid());
            pg8::EpiGateUp E{WSP(bf16_t, WS_ACT)};
            pg8::gemm_phase<pg8::EpiGateUp, Sch, true, true>(L, g, S, E);
        }
        if (IN(P6 + 2)) _Pragma("unroll 1") for (int rep_ = 0; rep_ < NREP(9); ++rep_) {
            CParams* kp = kparams();
            typedef pg8::SchedMoe<256u * DE * 2u, 256u * DE * 2u, (unsigned)DM * DE * 2u, DE / 64, false> Sch;
            pg8::Gemm g{DE, DE, DE}; Sch S; S.o.init(NT, 8, ogrid(), obid()); S.o.rot = 1; S.rem = (NT * 8) % ogrid(); S.nl = ogrid() - S.rem; S.A = WSP(const char, WS_ACT); S.B = WSP(const char, WS_WD) + (size_t)layer * 32 * DM * DE * 2;
            LAS int* rt = (LAS int*)(L + TAB_OFF + 1024);
            S.texp = texp; S.tbase = tbase; S.tcnt = tcnt; S.rt = nullptr; S.list = WSP(int, WS_LIST); S.ctr = WSP(unsigned, WS_CTL) + CW_GUD + layer * 8192;
            if (otid() == 0) { __builtin_amdgcn_fence(__ATOMIC_ACQUIRE, "agent"); asm volatile("s_waitcnt vmcnt(0)" ::: "memory"); }
            S.fill_dst(rt, WSP(float, WS_LIST) + (size_t)32 * MT, otid());
            pg8::EpiDown E{WSP(bf16_t, WS_FB), rt};
            pg8::gemm_phase<pg8::EpiDown, Sch, true, false>(L, g, S, E);
        }
        SEAM(P6 + 3);
        if (IN(P6 + 4)) _Pragma("unroll 1") for (int rep_ = 0; rep_ < NREP(10); ++rep_) {
            CParams* kp = kparams(); TIDS;
            const int row_lo = layer == 0 ? 0 : NCTX;
            const float* modl = WSP(float, WS_MOD) + (size_t)layer * 3 * 12288; const float* X1 = WSP(float, WS_X1); const bf16_t* FB = WSP(bf16_t, WS_FB);
            float* dstb = kp->out - (size_t)NCTX * DM; bf16_t* X2b = WSP(bf16_t, WS_X2);
            LAS float* vG2 = (LAS float*)L; LAS float* vLG = vG2 + 3 * DM; LAS float* vLB = vLG + DM;
            { const float* lg = kp->ln_g + (size_t)(layer * 2 + 1) * DM; const float* lb = kp->ln_b + (size_t)(layer * 2 + 1) * DM;
              float t0[12], t1[4], t2[4];
#pragma unroll
              for (int q = 0; q < 12; ++q) { const int i = tid + q * 512; t0[q] = modl[(size_t)(i >> 11) * 12288 + 5 * DM + (i & 2047)]; }
#pragma unroll
              for (int q = 0; q < 4; ++q) { const int i = tid + q * 512; t1[q] = lg[i]; t2[q] = lb[i]; }
#pragma unroll
              for (int q = 0; q < 12; ++q) vG2[tid + q * 512] = t0[q];
#pragma unroll
              for (int q = 0; q < 4; ++q) { vLG[tid + q * 512] = t1[q]; vLB[tid + q * 512] = t2[q]; } }
            __syncthreads();
            f32x4 xa[8]; v2u fa[8], fb[8];
#define P10_LOAD(row_) do { const float* xr_ = X1 + (size_t)(row_) * DM; const bf16_t* xb_ = (const bf16_t*)X1 + (size_t)(row_) * DM; const bf16_t* f0_ = FB + (size_t)((row_) * 2) * DM; \
                _Pragma("unroll") for (int j = 0; j < 8; ++j) { const int c = (j * 64 + lane) * 4; \
                    { const v2u q_ = *(const v2u*)(xb_ + c); xa[j] = (f32x4){bf2f(q_.x & 0xffffu), bf2f(q_.x >> 16), bf2f(q_.y & 0xffffu), bf2f(q_.y >> 16)}; } \
                    fa[j] = *(const v2u*)(f0_ + c); fb[j] = *(const v2u*)(f0_ + DM + c); } } while (0)
            { const int r0 = row_lo + gw; P10_LOAD(r0 < MT ? r0 : row_lo); }
            for (int row = row_lo + gw; row < MT; row += NGW) { const int cd = row_cond(row);
                f32x4 v[8]; float s = 0.f;
#pragma unroll
                for (int j = 0; j < 8; ++j) { const int c = (j * 64 + lane) * 4;
                    const f32x4 fs = {bf2f(fa[j].x & 0xffffu) + bf2f(fb[j].x & 0xffffu), bf2f(fa[j].x >> 16) + bf2f(fb[j].x >> 16), bf2f(fa[j].y & 0xffffu) + bf2f(fb[j].y & 0xffffu), bf2f(fa[j].y >> 16) + bf2f(fb[j].y >> 16)};
                    v[j] = xa[j] * ALPHA + *(const LAS f32x4*)(vG2 + cd * DM + c) * fs; s += (v[j][0] + v[j][1]) + (v[j][2] + v[j][3]); }
                if (row + NGW < MT) P10_LOAD(row + NGW);
                const float mean = wave_sum(s) * (1.0f / DM); float s2 = 0.f;
#pragma unroll
                for (int j = 0; j < 8; ++j) { v[j] = v[j] - mean; s2 += (v[j][0] * v[j][0] + v[j][1] * v[j][1]) + (v[j][2] * v[j][2] + v[j][3] * v[j][3]); }
                const float rstd = 1.0f / sqrtf(wave_sum(s2) * (1.0f / DM) + LN_EPS);
                float* dst = dstb + (size_t)row * DM;
#pragma unroll
                for (int j = 0; j < 8; ++j) { const int c = (j * 64 + lane) * 4; const f32x4 r_ = v[j] * rstd * *(const LAS f32x4*)(vLG + c) + *(const LAS f32x4*)(vLB + c);
                    if (layer == 0) { v2u w; w.x = pk2(r_[0], r_[1]); w.y = pk2(r_[2], r_[3]); *(v2u*)(X2b + (size_t)row * DM + c) = w; } else *(f32x4*)(dst + c) = r_; } }
#undef P10_LOAD
            __syncthreads();
        }
        if constexpr (layer == 0) {
            SEAM(10);
            if (IN(11)) _Pragma("unroll 1") for (int rep_ = 0; rep_ < NREP(11); ++rep_) {
                CParams* kp = kparams(); TIDS;
                const bf16_t* X2 = WSP(bf16_t, WS_X2); bf16_t* DP = WSP(bf16_t, WS_DP);
                const float* sc1 = WSP(float, WS_MOD) + (size_t)3 * 12288 + DM;
                const int c = tid * 4, gch = c >> 9, hw = 1 << gch;
                for (int chunk = bx; chunk < NLAT / 64; chunk += G) { const int b = chunk >> 7, t0 = (chunk & 127) * 64;
                    const bf16_t* base = X2 + ((size_t)NCTX + (size_t)b * SEQ) * DM + c; bf16_t* dbase = DP + ((size_t)NCTX + (size_t)b * SEQ) * DM + c;
                    const f32x4 a1 = *(const f32x4*)(sc1 + (size_t)b * 12288 + c) + 1.0f;
                    f32x4 s = {0, 0, 0, 0};
                    { v2u wv[16];
#pragma unroll
                      for (int q = 0; q < 16; ++q) { const int p_ = t0 - 8 + q; wv[q] = *(const v2u*)(base + (size_t)(p_ < 0 ? 0 : p_) * DM); }
#pragma unroll
                      for (int q = 0; q < 16; ++q) { const int p_ = t0 - 8 + q; const bool in_ = p_ >= 0 && p_ >= t0 - hw && p_ < t0 + hw; s += bf4(wv[q]) * (in_ ? 1.0f : 0.0f); } }
#pragma unroll 8
                    for (int i = 0; i < 64; ++i) { const int t = t0 + i; const int tn = t + hw, to = t - hw;
                        const f32x4 xc = bf4(*(const v2u*)(base + (size_t)t * DM));
                        const f32x4 xn = bf4(*(const v2u*)(base + (size_t)(tn < SEQ ? tn : SEQ - 1) * DM)), xo = bf4(*(const v2u*)(base + (size_t)(to >= 0 ? to : 0) * DM));
                        const int lo_ = to < 0 ? 0 : to, hi_ = tn > SEQ ? SEQ : tn;
                        const f32x4 d = a1 * (s * (1.0f / (float)(hi_ - lo_)) - xc);
                        v2u w; w.x = pk2(d[0], d[1]); w.y = pk2(d[2], d[3]); *(v2u*)(dbase + (size_t)t * DM) = w;
                        s = s + xn * (tn < SEQ ? 1.0f : 0.0f) - xo * (to >= 0 ? 1.0f : 0.0f); }
                }
            }
            SEAM(11);
            if (IN(12)) _Pragma("unroll 1") for (int rep_ = 0; rep_ < NREP(12); ++rep_) {
                CParams* kp = kparams();
                pg8::Gemm g{DM, 512, 512}; pg8::SchedPool S; S.o.init(NLAT / 256, 8, ogrid(), obid()); S.A = WSP(const char, WS_DP); S.B = WSP(const char, WS_WPOOL);
                pg8::EpiBf16 E{WSP(bf16_t, WS_Y), DM, nullptr};
                pg8::gemm_phase<pg8::EpiBf16, pg8::SchedPool, true, false>(L, g, S, E);
            }
            SEAM(12);
        }
    }

__global__ void __launch_bounds__(512, 2) mk_fwd(Params p_unused) {
    extern __shared__ __attribute__((aligned(16))) unsigned char lds[];
    LAS unsigned char* L = (LAS unsigned char*)lds;
    volatile LAS unsigned* MISC = (volatile LAS unsigned*)(L + MISC_OFF);
    LAS int* tcnt = (LAS int*)(L + TAB_OFF); LAS int* tbase = tcnt + 32; LAS int* texp = tcnt + 80;
    if (threadIdx.x < 64) MISC[threadIdx.x] = 0u;
    __syncthreads();
    int lo, hi; XcdBarrier bar;
    { CParams* kp = kparams(); lo = kp->ph_lo; hi = kp->ph_hi; unsigned* bw = (unsigned*)(kp->ws + WS_CTL) + CW_BAR;
      bar.bar = bw; bar.x = 0; bar.st = nullptr; if (hi - lo > 1) bar = xcd_barrier_post(bw, MISC + 8); }
    if (IN(0)) _Pragma("unroll 1") for (int rep_ = 0; rep_ < NREP(0); ++rep_) {
        CParams* kp = kparams(); TIDS;
        float* MOD = WSP(float, WS_MOD); float* ROPE = WSP(float, WS_ROPE);
        for (int i = bx * 512 + tid; i < 4096; i += G * 512) { const int pos = i >> 5, pp = i & 31;
            const float inv = exp2f(-(float)pp * (13.287712379549449f / 32.0f)); const float ang = (float)pos * inv;
            float sn, cs; sincosf(ang, &sn, &cs); ROPE[i] = cs; ROPE[4096 + i] = sn; }
        { const float* wrt = kp->w_router; bf16_t* WR = WSP(bf16_t, WS_WR);
          for (int i = bx * 512 + tid; i < 32 * DM; i += G * 512) { const int ii = i & 7, ln = (i >> 3) & 63, kq = (i >> 9) & 15, w = i >> 13; const int e = ln & 31, k = w * 256 + kq * 16 + 8 * (ln >> 5) + ii;
              const float wv = wrt[k * 32 + e]; const unsigned h1 = f2bf(wv); const unsigned h2 = f2bf(wv - bf2f(h1)); WR[i] = (bf16_t)h1; WR[32 * DM + i] = (bf16_t)h2; } }
        {
            LAS float* sv = (LAS float*)L;
            LAS float* red = (LAS float*)(L + 32768);
            mod_prepare(kp->c, kp->c_ctx, sv, tid);
            for (int it = bx; it < 384; it += G) mod_item(it, kp->w_mod, kp->b_mod, MOD, sv, red, tid, lane, wave);
        }
        {
            LAS float* scr = (LAS float*)(L + wave * 16384);
            constexpr int I_QKV = (DM / 64) * (QKVD / 32), I_O = (DM / 64) * (DM / 32), I_P = (512 / 64) * (512 / 32), I_G = (DM / 64) * (DE / 32), I_D = (DE / 64) * (DM / 32);
            constexpr int NITEMS = I_QKV + I_O + 4 * I_P;
            (void)I_G; (void)I_D;
            auto decode = [&](int it) { TItem d; int r = it;
                if (r < I_QKV) { d.W = kp->w_qkv; d.WT = WSP(bf16_t, WS_WQKV); d.K = DM; d.N = QKVD; d.kind = 0; }
                else if ((r -= I_QKV) < I_O) { d.W = kp->w_o; d.WT = WSP(bf16_t, WS_WO); d.K = DM; d.N = DM; d.kind = 0; }
                else { r -= I_O; const int g = r / I_P; r -= g * I_P; d.W = kp->w_pool + (size_t)g * 512 * 512; d.WT = WSP(bf16_t, WS_WPOOL) + (size_t)g * 512 * 512; d.K = 512; d.N = 512; d.kind = 0; }
                const int nblk = d.N / 32; d.k0 = 64 * (r / nblk); d.n0 = 32 * (r % nblk); return d; };
            for (int it = gw; it < NITEMS; it += 2 * NGW) {
                const TItem d0 = decode(it); float ra[32], rb[32]; t_load(d0, ra, lane);
                const bool two = it + NGW < NITEMS; TItem d1 = d0; if (two) { d1 = decode(it + NGW); t_load(d1, rb, lane); }
                t_store(d0, ra, scr, lane); if (two) t_store(d1, rb, scr, lane);
            }
        }
        __syncthreads();
    }
    SEAM(0);

    if (IN(1)) _Pragma("unroll 1") for (int rep_ = 0; rep_ < NREP(1); ++rep_) {
        CParams* kp = kparams(); TIDS;
        const float* MOD = WSP(float, WS_MOD); bf16_t* U = WSP(bf16_t, WS_U); const float* xl = kp->x; const float* xc = kp->ctx;
        const int R = (MT + NGW - 1) / NGW, r0 = gw * R, r1 = (r0 + R) < MT ? (r0 + R) : MT;
        f32x4 sa[8], sb[8], xv[8]; int cur = -1;
#define P1_LOAD(row_) do { const float* xr_ = ((row_) < NCTX) ? xc + (size_t)(row_) * DM : xl + (size_t)((row_) - NCTX) * DM; _Pragma("unroll") for (int j = 0; j < 8; ++j) xv[j] = *(const f32x4*)(xr_ + (j * 64 + lane) * 4); } while (0)
        if (r0 < r1) P1_LOAD(r0); else P1_LOAD(0);
        for (int row = r0; row < r1; ++row) { const int cd = row_cond(row);
            if (cd != cur) { const float* sh = MOD + (size_t)cd * 12288; const float* sc = sh + DM;
#pragma unroll
                for (int j = 0; j < 8; ++j) { const int c = (j * 64 + lane) * 4; sa[j] = *(const f32x4*)(sc + c) + 1.0f; sb[j] = *(const f32x4*)(sh + c); }
                cur = cd; }
            f32x4 o[8];
#pragma unroll
            for (int j = 0; j < 8; ++j) o[j] = xv[j] * sa[j] + sb[j];
            if (row + 1 < r1) P1_LOAD(row + 1);
#pragma unroll
            for (int j = 0; j < 8; ++j) { const int c = (j * 64 + lane) * 4; v2u w; w.x = pk2(o[j][0], o[j][1]); w.y = pk2(o[j][2], o[j][3]); *(v2u*)(U + (size_t)row * DM + c) = w; } }
#undef P1_LOAD
    }
    SEAM(1);

    if (IN(2)) _Pragma("unroll 1") for (int rep_ = 0; rep_ < NREP(2); ++rep_) {
        CParams* kp = kparams();
        typedef pg8::SchedSplit<256u * DM * 2u, 256u * DM * 2u, DM / 64, QKVD / 256> Sch;
        pg8::Gemm g{DM, DM, DM}; Sch S; S.init(ogrid(), obid()); S.A = WSP(const char, WS_U); S.B = WSP(const char, WS_WQKV);
        pg8::EpiQkv E{WSP(bf16_t, WS_QKVR), QKVD, WSP(float, WS_PQ), WSP(bf16_t, WS_V)};
        pg8::gemm_phase<pg8::EpiQkv, Sch, true, false>(L, g, S, E);
    }
    SEAM(2);

    if (IN(3)) _Pragma("unroll 1") for (int rep_ = 0; rep_ < NREP(3); ++rep_) {
        CParams* kp = kparams(); TIDS;
        const float* ROPE = WSP(float, WS_ROPE); const bf16_t* QKVR = WSP(bf16_t, WS_QKVR); bf16_t* Qb = WSP(bf16_t, WS_Q); bf16_t* Kb = WSP(bf16_t, WS_K); bf16_t* Vb = WSP(bf16_t, WS_V);
        const int sub = lane >> 4, l16 = lane & 15, d0 = l16 * 8, ax = l16 >> 3, hh = (l16 >> 2) & 1, p0 = (l16 & 3) * 8;
        const bool split3 = ((64 * (QKVD / 256)) % G == 0) && (2 * (QKVD / 256) * 8 <= G);
        const float* PQ = WSP(float, WS_PQ);
        float qg[8], kg[8];
        { const float* qgn = kp->q_gain; const float* kgn = kp->k_gain;
#pragma unroll
          for (int i = 0; i < 8; ++i) { qg[i] = qgn[d0 + i]; kg[i] = kgn[d0 + i]; } }
        v4u rw[6];
#define P3_LOAD(row_) do { const bf16_t* s_ = QKVR + (size_t)(row_) * QKVD + sub * 128 + d0; const bool all_ = (row_) < NCTX; _Pragma("unroll") for (int it = 0; it < 6; ++it) if (it == 4 || all_) rw[it] = *(const v4u*)(s_ + it * 512); } while (0)
        for (int r4 = NCTX + gw * 4; r4 < MT; r4 += NGW * 4) {
            v4u kr[4]; f32x4 c0[4], c1[4], s0[4], s1[4];
#pragma unroll
            for (int q = 0; q < 4; ++q) { const int row = r4 + q, t = (row - NCTX) & 8191; kr[q] = *(const v4u*)(QKVR + (size_t)row * QKVD + 2048 + sub * 128 + d0);
                const int pos = ax ? (t & 63) : (t >> 6); const float* cp_ = ROPE + pos * 32 + p0; c0[q] = *(const f32x4*)cp_; c1[q] = *(const f32x4*)(cp_ + 4); s0[q] = *(const f32x4*)(cp_ + 4096); s1[q] = *(const f32x4*)(cp_ + 4100); }
#pragma unroll
            for (int q = 0; q < 4; ++q) { const int row = r4 + q, lr = row - NCTX, b = lr >> 13, kpos = CTXL + (lr & 8191); const v4u raw = kr[q];
                float f[8], cs[8], sn[8];
#pragma unroll
                for (int i = 0; i < 4; ++i) { f[2 * i] = bf2f(raw[i] & 0xffffu); f[2 * i + 1] = bf2f(raw[i] >> 16); cs[i] = c0[q][i]; cs[4 + i] = c1[q][i]; sn[i] = hh ? s0[q][i] : -s0[q][i]; sn[4 + i] = hh ? s1[q][i] : -s1[q][i]; }
                float ss = 0.f;
#pragma unroll
                for (int i = 0; i < 8; ++i) ss += f[i] * f[i];
                ss += __shfl_xor(ss, 1); ss += __shfl_xor(ss, 2); ss += __shfl_xor(ss, 4); ss += __shfl_xor(ss, 8);
                const float r = 1.0f / sqrtf(ss * (1.0f / 128.0f) + RMS_EPS);
                float o[8];
#pragma unroll
                for (int i = 0; i < 8; ++i) { const float y = f[i] * r * kg[i]; const float pr = __shfl_xor(y, 4); o[i] = y * cs[i] + pr * sn[i]; }
                v4u w; w.x = pk2(o[0], o[1]); w.y = pk2(o[2], o[3]); w.z = pk2(o[4], o[5]); w.w = pk2(o[6], o[7]);
                *(v4u*)(Kb + (((size_t)b * NKV + sub) * SKV + kpos) * HD + d0) = w; }
        }
        P3_LOAD(gw < NCTX ? gw : 0);
        for (int row = gw; row < NCTX; row += NGW) {
            const bool lat = row >= NCTX; const int lr = row - NCTX; const int b = lat ? (lr >> 13) : (row >> 8); const int t = lat ? (lr & 8191) : 0;
            const int kpos = lat ? (CTXL + t) : (row & 255);
            v4u cur[6];
#pragma unroll
            for (int it = 0; it < 6; ++it) cur[it] = rw[it];
            if (row + NGW < NCTX) P3_LOAD(row + NGW);
            float cs[8], sn[8];
#pragma unroll
            for (int i = 0; i < 8; ++i) { cs[i] = 1.f; sn[i] = 0.f; }
            if (lat) { const int pos = ax ? (t & 63) : (t >> 6); const float* cp_ = ROPE + pos * 32 + p0;
                const f32x4 c0 = *(const f32x4*)cp_, c1 = *(const f32x4*)(cp_ + 4), s0 = *(const f32x4*)(cp_ + 4096), s1 = *(const f32x4*)(cp_ + 4100);
#pragma unroll
                for (int i = 0; i < 4; ++i) { cs[i] = c0[i]; cs[4 + i] = c1[i]; sn[i] = hh ? s0[i] : -s0[i]; sn[4 + i] = hh ? s1[i] : -s1[i]; } }
#pragma unroll
            for (int it = 0; it < 6; ++it) { const int h = it * 4 + sub;
                if (lat && it != 4) continue;
                if (it == 5 && !split3) continue;
                float f[8]; v4u raw;
                if (!lat && split3) {
                    f32x4 q0[8]; const float* pp_ = PQ + (size_t)row * QKVD + h * 128 + d0;
#pragma unroll
                    for (int ks = 0; ks < 8; ++ks) q0[ks] = *(const f32x4*)(pp_ + (size_t)ks * 512 * QKVD);
                    f32x4 a0 = q0[0];
#pragma unroll
                    for (int ks = 1; ks < 8; ++ks) a0 += q0[ks];
#pragma unroll
                    for (int ks = 0; ks < 8; ++ks) q0[ks] = *(const f32x4*)(pp_ + (size_t)ks * 512 * QKVD + 4);
                    f32x4 a1 = q0[0];
#pragma unroll
                    for (int ks = 1; ks < 8; ++ks) a1 += q0[ks];
#pragma unroll
                    for (int i = 0; i < 4; ++i) { f[i] = a0[i]; f[4 + i] = a1[i]; }
                    raw.x = pk2(f[0], f[1]); raw.y = pk2(f[2], f[3]); raw.z = pk2(f[4], f[5]); raw.w = pk2(f[6], f[7]);
#pragma unroll
                    for (int i = 0; i < 4; ++i) { f[2 * i] = bf2f(raw[i] & 0xffffu); f[2 * i + 1] = bf2f(raw[i] >> 16); }
                } else { raw = cur[it];
#pragma unroll
                    for (int i = 0; i < 4; ++i) { f[2 * i] = bf2f(raw[i] & 0xffffu); f[2 * i + 1] = bf2f(raw[i] >> 16); } }
                if (it == 5) { *(v4u*)(Vb + (((size_t)b * NKV + (h - 20)) * SKV + kpos) * HD + d0) = raw; continue; }
                float ss = 0.f;
#pragma unroll
                for (int i = 0; i < 8; ++i) ss += f[i] * f[i];
                ss += __shfl_xor(ss, 1); ss += __shfl_xor(ss, 2); ss += __shfl_xor(ss, 4); ss += __shfl_xor(ss, 8);
                const float r = 1.0f / sqrtf(ss * (1.0f / 128.0f) + RMS_EPS);
                float o[8];
#pragma unroll
                for (int i = 0; i < 8; ++i) { const float y = f[i] * r * (it < 4 ? qg[i] : kg[i]); const float pr = __shfl_xor(y, 4); o[i] = y * cs[i] + pr * sn[i]; }
                v4u w; w.x = pk2(o[0], o[1]); w.y = pk2(o[2], o[3]); w.z = pk2(o[4], o[5]); w.w = pk2(o[6], o[7]);
                bf16_t* d = (it < 4) ? Qb + (size_t)row * DM + h * 128 + d0 : Kb + (((size_t)b * NKV + (h - 16)) * SKV + kpos) * HD + d0;
                *(v4u*)d = w; }
        }
#undef P3_LOAD
    }
    SEAM(3);

    if (IN(4)) _Pragma("unroll 1") for (int rep_ = 0; rep_ < NREP(4); ++rep_) {
        CParams* kp = kparams();
        const bf16_t* Qb = WSP(bf16_t, WS_Q); const bf16_t* Kb = WSP(bf16_t, WS_K); const bf16_t* Vb = WSP(bf16_t, WS_V); bf16_t* Ob = WSP(bf16_t, WS_O);
        const bf16_t* QKVR = WSP(bf16_t, WS_QKVR); const float* ROPE = WSP(float, WS_ROPE); const float* qgn = kp->q_gain;
        const int G = ogrid(), bx = obid(); const bool fast = (G % 8) == 0;
        const int NR = fast ? (G >> 3) : G, rank = fast ? (bx >> 3) : bx, tot = fast ? 132 : 1056;
        const bool split = fast && NR == 32; const int NA = split ? 26 : NR;
        if (rank < NA) for (int i = 0;; ++i) {
            int w = rank + NA * i;
            if (split && i == 5) w = rank >= 24 ? rank + 106 : tot;
            if (w >= tot) break;
            const int combo = fast ? (bx & 7) : (w / 132), ww = fast ? w : (w % 132), b = combo >> 2, kvh = combo & 3;
            const bool isl = ww < 128; const int rbk = ww >> 2; const int h = kvh * 4 + (isl ? (ww & 3) : (ww - 128));
            const size_t row0 = isl ? ((size_t)NCTX + (size_t)b * SEQ + (size_t)rbk * 256) : ((size_t)b * CTXL);
            if (isl) att::attn_dma_body(QKVR + row0 * QKVD + h * HD, QKVD, rbk * 256, ROPE, qgn, Kb + (size_t)combo * SKV * HD, Vb + (size_t)combo * SKV * HD, Ob + row0 * DM + h * HD, SKV, (char*)lds);
            else att::attn_dma_body(Qb + row0 * DM + h * HD, DM, -1, ROPE, qgn, Kb + (size_t)combo * SKV * HD, Vb + (size_t)combo * SKV * HD, Ob + row0 * DM + h * HD, CTXL, (char*)lds);
            if (otid() == 0) { asm volatile("s_waitcnt vmcnt(0)" ::: "memory");
                (void)xb_add(WSP(unsigned, WS_CTL) + CW_DONE + 32 * (isl ? (b * 32 + rbk) : (64 + b)), 1u); }
        }
        {
            const int tid = otid(), lane = tid & 63, wave = __builtin_amdgcn_readfirstlane(tid >> 6);
            unsigned* mq = WSP(unsigned, WS_CTL) + CW_MQ; bool prepared = false;
            for (;;) {
                if (tid == 0) MISC[34] = xb_add(mq, 1u);
                __syncthreads();
                const unsigned t = MISC[34];
                __syncthreads();
                if (t >= 384u) break;
                if (!prepared) { mod_prepare(kp->c, kp->c_ctx, (LAS float*)L, tid); prepared = true; }
                mod_item(384 + (int)t, kp->w_mod, kp->b_mod, WSP(float, WS_MOD), (const LAS float*)L, (LAS float*)(L + 32768), tid, lane, wave);
            }
        }
        {
            const int tid = otid(), lane = tid & 63, wave = __builtin_amdgcn_readfirstlane(tid >> 6);
            LAS float* scr = (LAS float*)(L + wave * 16384);
            unsigned* qc = WSP(unsigned, WS_CTL) + CW_Q;
            constexpr int I_G = (DM / 64) * (DE / 32), I_D = (DE / 64) * (DM / 32), PER = 2 * I_G + I_D; constexpr unsigned NTICK = 64u * PER / 2u;
            auto decode = [&](int it) { TItem d; const int le = it / PER; int r = it - le * PER;
                if (r < I_G) { d.W = kp->w_gate + (size_t)le * DM * DE; d.WT = WSP(bf16_t, WS_WGU) + (size_t)le * 2048 * DM; d.K = DM; d.N = DE; d.kind = 1; }
                else if ((r -= I_G) < I_G) { d.W = kp->w_up + (size_t)le * DM * DE; d.WT = WSP(bf16_t, WS_WGU) + (size_t)le * 2048 * DM; d.K = DM; d.N = DE; d.kind = 2; }
                else { r -= I_G; d.W = kp->w_down + (size_t)le * DE * DM; d.WT = WSP(bf16_t, WS_WD) + (size_t)le * DM * DE; d.K = DE; d.N = DM; d.kind = 0; }
                const int nblk = d.N / 32; d.k0 = 64 * (r / nblk); d.n0 = 32 * (r % nblk); return d; };
            auto grab = [&]() { unsigned t = 0; if (lane == 0) t = __hip_atomic_fetch_add(qc, 1u, __ATOMIC_RELAXED, __HIP_MEMORY_SCOPE_AGENT); return (unsigned)__builtin_amdgcn_readfirstlane((int)t); };
            unsigned tk = grab();
            while (tk < NTICK) {
                const unsigned nx = grab();
                const TItem d0 = decode((int)(2u * tk)); TItem d1 = d0; d1.n0 += 32;
                float ra[32], rb[32]; t_load(d0, ra, lane); t_load(d1, rb, lane);
                t_store(d0, ra, scr, lane); t_store(d1, rb, scr, lane);
                tk = nx;
            }
        }
        __syncthreads();
        {
            unsigned* wq = WSP(unsigned, WS_CTL) + CW_WQ; unsigned* done = WSP(unsigned, WS_CTL) + CW_DONE; unsigned* yd = WSP(unsigned, WS_CTL) + CW_YD; unsigned* bw = WSP(unsigned, WS_CTL) + CW_BAR;
            const char* Oc = WSP(const char, WS_O); const char* Wc = WSP(const char, WS_WO);
            pg8::Gemm g{DM, DM, DM}; pg8::EpiBf16W E{WSP(bf16_t, WS_Y), DM};
            int tail = obid(); bool queue = true;
            for (;;) {
                if (otid() == 0) { int pm = -1, pn = 0, fl = 0;
                    if (queue) { const unsigned t = xb_add(wq, 1u);
                        if (t < 416u) { const int rbk = (int)t >> 4, b = ((int)t >> 3) & 1; pn = (int)t & 7; pm = 2 + b * 32 + rbk; fl = b * 32 + rbk; }
                        else if (t < 432u) { const int c = (int)t - 416; pm = c >> 3; pn = c & 7; fl = 64 + pm; } }
                    else if (tail < 96) { const int rbk = 26 + (tail >> 4), b = (tail >> 3) & 1; pn = tail & 7; pm = 2 + b * 32 + rbk; fl = b * 32 + rbk; }
                    if (pm >= 0) { XB_SPIN(xb_ld(&done[32 * fl]) < 16u, bw);
                        __builtin_amdgcn_fence(__ATOMIC_ACQUIRE, "agent"); asm volatile("s_waitcnt vmcnt(0)" ::: "memory"); }
                    MISC[32] = (unsigned)pm; MISC[33] = (unsigned)pn; }
                __syncthreads();
                const int pm = (int)MISC[32], pn = (int)MISC[33];
                __syncthreads();
                if (pm < 0) { if (!queue) break; queue = false; continue; }
                pg8::SchedOne S; S.u.A = Oc + (size_t)((unsigned)pm * (256u * DM * 2u)); S.u.B = Wc + (size_t)((unsigned)pn * (256u * DM * 2u)); S.u.pm = pm; S.u.pn = pn; S.u.aux = 0; S.u.kt = DM / 64; S.u.rb = 0; S.u.cn = 0; S.u.ui = 0;
                pg8::gemm_phase<pg8::EpiBf16W, pg8::SchedOne, true, false>(L, g, S, E);
                if (otid() == 0) (void)xb_add(&yd[32 * pm], 1u);
                if (!queue) tail += ogrid();
            }
        }
    }


    layer_half<0>(lo, hi, bar, L, tcnt, tbase, texp);
    layer_half<1>(lo, hi, bar, L, tcnt, tbase, texp);
#undef IN
#undef SEAM
#undef TIDS
}

extern "C" void kernel_launch(void* const* d_in, const int* in_sizes, int n_in, void* d_out, int out_size, void* d_ws, size_t ws_size, hipStream_t stream) {
    static int grid = 0;
    if (grid == 0) {
        if (n_in != 19 || in_sizes[0] != NLAT * DM || out_size != NLAT * DM || ws_size < WS_END) {
            fprintf(stderr, "kernel_launch: shape mismatch: n_in %d in0 %d out %d ws %zu (need %zu); nothing launched\n", n_in, n_in > 0 ? in_sizes[0] : -1, out_size, ws_size, (size_t)WS_END); grid = -1; return; }
        int dev = 0, cus = 0, per_cu = 0;
        if (hipGetDevice(&dev) != hipSuccess || hipDeviceGetAttribute(&cus, hipDeviceAttributeMultiprocessorCount, dev) != hipSuccess) { fprintf(stderr, "kernel_launch: device query failed\n"); grid = -1; return; }
        if (hipFuncSetAttribute((const void*)mk_fwd, hipFuncAttributeMaxDynamicSharedMemorySize, LDS_BYTES) != hipSuccess) { fprintf(stderr, "kernel_launch: hipFuncSetAttribute failed\n"); grid = -1; return; }
        if (hipOccupancyMaxActiveBlocksPerMultiprocessor(&per_cu, (const void*)mk_fwd, 512, LDS_BYTES) != hipSuccess || per_cu < 1)
            fprintf(stderr, "kernel_launch: note: occupancy query reports %d workgroups per CU\n", per_cu);
        (void)hipGetLastError();
        if (cus * (pg8::RT_UNITS / 2) < MAXT * 8) { fprintf(stderr, "kernel_launch: %d CUs: the MoE phases' per-workgroup LDS row tables are sized for >= %d workgroups; nothing launched\n", cus, (MAXT * 8 + pg8::RT_UNITS / 2 - 1) / (pg8::RT_UNITS / 2)); grid = -1; return; }
        grid = cus;
    }
    if (grid < 0) return;
    if (hipMemsetAsync((char*)d_ws + WS_CTL, 0, CTL_ZERO_BYTES, stream) != hipSuccess) { fprintf(stderr, "kernel_launch: memset failed\n"); return; }
    Params p{};
    p.x = (const float*)d_in[0]; p.c = (const float*)d_in[1]; p.ctx = (const float*)d_in[2]; p.c_ctx = (const float*)d_in[3]; p.w_mod = (const float*)d_in[4]; p.b_mod = (const float*)d_in[5];
    p.ln_g = (const float*)d_in[6]; p.ln_b = (const float*)d_in[7]; p.w_qkv = (const float*)d_in[8]; p.q_gain = (const float*)d_in[9]; p.k_gain = (const float*)d_in[10]; p.w_o = (const float*)d_in[11];
    p.w_pool = (const float*)d_in[12]; p.pool_scale = (const float*)d_in[13]; p.w_router = (const float*)d_in[14]; p.router_bias = (const float*)d_in[15];
    p.w_gate = (const float*)d_in[16]; p.w_up = (const float*)d_in[17]; p.w_down = (const float*)d_in[18];
    p.out = (float*)d_out; p.ws = (unsigned char*)d_ws;
#if MK_PER_PHASE
    for (int k = 0; k < NPHASE; ++k) { p.ph_lo = k; p.ph_hi = k + 1;
        hipLaunchKernelGGL(mk_fwd, dim3(grid), dim3(512), LDS_BYTES, stream, p);
        const hipError_t le = hipPeekAtLastError(); if (le != hipSuccess) { fprintf(stderr, "kernel_launch: launch %d failed: %s\n", k, hipGetErrorName(le)); break; } }
#else
    p.ph_lo = 0; p.ph_hi = NPHASE;
    hipLaunchKernelGGL(mk_fwd, dim3(grid), dim3(512), LDS_BYTES, stream, p);
    const hipError_t le = hipPeekAtLastError(); if (le != hipSuccess) fprintf(stderr, "kernel_launch: launch failed: %s\n", hipGetErrorName(le));
#endif
}
```

```cpp
#include <hip/hip_runtime.h>
#include <cstdio>
#include <cstdint>

#ifndef REP_MASK
#define REP_MASK 0
#endif
#ifndef MK_PER_PHASE
#define MK_PER_PHASE 0
#endif

constexpr int DM = 2048, NB = 2, SEQ = 8192, CTXL = 256;
constexpr int NCTX = NB * CTXL, NLAT = NB * SEQ, MT = NCTX + NLAT;
constexpr int NH = 16, NKV = 4, HD = 128, KVD = NKV * HD, QKVD = DM + 2 * KVD;
constexpr int SKV = CTXL + SEQ;
constexpr int NE = 32, DE = 1024;
constexpr int MAXT = 164, NSLOT = MAXT * 256;
constexpr float ALPHA = 1.41421356237309515f;
constexpr float LN_EPS = 1e-6f, RMS_EPS = 1e-6f;
constexpr int NPHASE = 18;

constexpr size_t MiB = 1u << 20;
constexpr size_t WS_CTL = 0, CTL_ZERO_BYTES = 1 * MiB;
constexpr size_t WS_MOD = 1 * MiB;
constexpr size_t WS_ROPE = WS_MOD + 512 * 1024;
constexpr size_t WS_WR = WS_MOD + 768 * 1024;
constexpr size_t WS_WQKV = 2 * MiB;
constexpr size_t WS_WO = 14 * MiB;
constexpr size_t WS_WPOOL = 22 * MiB;
constexpr size_t WS_WGU = 24 * MiB;
constexpr size_t WS_WD = 536 * MiB;
constexpr size_t WS_Y = 792 * MiB;
constexpr size_t WS_X1 = 924 * MiB;
constexpr size_t WS_X2 = 1056 * MiB;
constexpr size_t WS_H = 1188 * MiB;
constexpr size_t WS_LIST = 1254 * MiB;
constexpr size_t WS_SLOT = 1259 * MiB;
constexpr size_t WS_SH = 1260 * MiB;
constexpr size_t WS_U = WS_SH;
constexpr size_t WS_QKVR = WS_SH + 66 * MiB;
constexpr size_t WS_Q = WS_SH + 165 * MiB;
constexpr size_t WS_K = WS_SH + 231 * MiB;
constexpr size_t WS_V = WS_SH + 248 * MiB;
constexpr size_t WS_O = WS_SH + 265 * MiB;
constexpr size_t WS_HS = WS_SH;
constexpr size_t WS_ACT = WS_SH + 164 * MiB;
constexpr size_t WS_FB = WS_SH + 246 * MiB;
constexpr size_t WS_DP = WS_SH;
constexpr size_t WS_PQ = WS_SH + 510 * MiB;
constexpr size_t WS_PO = WS_PQ + 48 * MiB;
constexpr size_t WS_END = WS_PO + 32 * MiB;
static_assert((size_t)MT * DM * 4 <= 132 * MiB && (size_t)NSLOT * 2048 * 2 <= 164 * MiB && (size_t)2 * MT * DM * 4 <= 264 * MiB, "ws map");
static_assert((size_t)32 * MT * 8 <= 5 * MiB && (size_t)NSLOT * 8 <= 1 * MiB, "ws map 2");
constexpr int CW_CNT = 64;
constexpr int CW_Q = 3072;
constexpr int CW_MQ = 3136;
constexpr int CW_WQ = 3104;
constexpr int CW_DONE = 8192;
constexpr int CW_GUD = 16384;
constexpr int CW_YD = 40960;
constexpr int CW_P6Q = 3168;
constexpr int CW_BAR = 4096;

constexpr int RING_BYTES = 131072;
constexpr int MISC_OFF = RING_BYTES;
constexpr int TAB_OFF = MISC_OFF + 256;
constexpr int LDS_BYTES = 147456;

#define GAS __attribute__((address_space(1)))
#define LAS __attribute__((address_space(3)))
typedef unsigned short bf16_t;
typedef unsigned v4u __attribute__((ext_vector_type(4)));
typedef unsigned v2u __attribute__((ext_vector_type(2)));
typedef float f32x4 __attribute__((ext_vector_type(4)));
typedef float f32x2 __attribute__((ext_vector_type(2)));
typedef short bf16x8 __attribute__((ext_vector_type(8)));
typedef short s16x4 __attribute__((ext_vector_type(4)));
typedef float f32x16 __attribute__((ext_vector_type(16)));
typedef GAS unsigned gu32;
#define RLX_AGENT __ATOMIC_RELAXED, __HIP_MEMORY_SCOPE_AGENT
#define LDS_WAIT() asm volatile("s_waitcnt lgkmcnt(0)" ::: "memory")
#define VM_WAIT() asm volatile("s_waitcnt vmcnt(0)" ::: "memory")
__device__ __forceinline__ unsigned f2bf(float f) { unsigned u = __builtin_bit_cast(unsigned, f); return (u + 0x7fffu + ((u >> 16) & 1u)) >> 16; }
__device__ __forceinline__ unsigned pk2(float lo, float hi) { unsigned r; asm("v_cvt_pk_bf16_f32 %0, %1, %2" : "=v"(r) : "v"(lo), "v"(hi)); return r; }
__device__ __forceinline__ float bf2f(unsigned b) { return __builtin_bit_cast(float, b << 16); }
__device__ __forceinline__ unsigned cvt_pk_bf16(float lo, float hi) { unsigned r; asm volatile("v_cvt_pk_bf16_f32 %0, %1, %2" : "=v"(r) : "v"(lo), "v"(hi)); return r; }
__device__ __forceinline__ f32x4 bf4(v2u q) { return (f32x4){bf2f(q.x & 0xffffu), bf2f(q.x >> 16), bf2f(q.y & 0xffffu), bf2f(q.y >> 16)}; }
template <int CTRL> __device__ __forceinline__ float dppf(float v) { return __builtin_bit_cast(float, __builtin_amdgcn_update_dpp(0, __builtin_bit_cast(int, v), CTRL, 0xF, 0xF, true)); }
template <int CTRL> __device__ __forceinline__ int dppi(int v) { return __builtin_amdgcn_update_dpp(0, v, CTRL, 0xF, 0xF, true); }
__device__ __forceinline__ float wave_sum(float v) {
    v += dppf<0xB1>(v); v += dppf<0x4E>(v); v += dppf<0x141>(v); v += dppf<0x140>(v);
    { const auto r = __builtin_amdgcn_permlane16_swap(__float_as_uint(v), __float_as_uint(v), false, false); v = __uint_as_float(r[0]) + __uint_as_float(r[1]); }
    { const auto r = __builtin_amdgcn_permlane32_swap(__float_as_uint(v), __float_as_uint(v), false, false); v = __uint_as_float(r[0]) + __uint_as_float(r[1]); }
    return v;
}
__device__ __forceinline__ float silu_f(float x) { return x / (1.0f + __expf(-x)); }
__device__ __forceinline__ int row_cond(int row) { return row < NCTX ? 2 : ((row - NCTX) >> 13); }
__device__ __forceinline__ int otid() { int t = threadIdx.x; asm volatile("" : "+v"(t)); return t; }
__device__ __forceinline__ int obid() { int t = blockIdx.x; asm volatile("" : "+s"(t)); return t; }
__device__ __forceinline__ int ogrid() { int t = gridDim.x; asm volatile("" : "+s"(t)); return t; }

#define XB_TMO      128
#define XB_XCNT(j)  (256  + 64 * (j))
#define XB_XSUB(j)  (1280 + 64 * (j))
#define XB_XGEN(j)  (2304 + 64 * (j))
#define XB_TOP      3328
#define XB_TOPGEN   3392
#define XCD_BAR_WORDS 3456
#define XB_SPIN_CAP (1u << 20)
__device__ __forceinline__ unsigned xb_ld(unsigned* p)              { return __hip_atomic_load(p, __ATOMIC_RELAXED, __HIP_MEMORY_SCOPE_AGENT); }
__device__ __forceinline__ unsigned xb_add(unsigned* p, unsigned v) { return __hip_atomic_fetch_add(p, v, __ATOMIC_RELAXED, __HIP_MEMORY_SCOPE_AGENT); }
__device__ __forceinline__ unsigned xb_xcc_id() { return (unsigned)__builtin_amdgcn_s_getreg((3 << 11) | 20) & 0xFu; }
#define XB_SPIN(cond, bar) do { unsigned _sp = 0; while (cond) { __builtin_amdgcn_s_sleep(1); \
    if ((++_sp & 255u) == 0u) { if (xb_ld(&(bar)[XB_TMO])) break; if (_sp > XB_SPIN_CAP) { atomicAdd(&(bar)[XB_TMO], 1u); break; } } } } while (0)
struct XcdBarrier { unsigned* bar; unsigned x; volatile LAS unsigned* st; };
__device__ __forceinline__ XcdBarrier xcd_barrier_post(unsigned* bar, volatile LAS unsigned* st) {
    XcdBarrier b; b.bar = bar; b.x = xb_xcc_id(); b.st = st;
    if (threadIdx.x == 0) (void)xb_add(&bar[XB_XCNT(b.x)], 1u);
    return b;
}
__device__ __forceinline__ void xcd_barrier_complete(unsigned* bar, unsigned x, unsigned& nloc, unsigned& nx) {
    const unsigned G = gridDim.x * gridDim.y * gridDim.z;
    unsigned sum, cnt, mine, sp = 0u;
    for (;;) {
        sum = 0u; cnt = 0u; mine = 0u;
#pragma unroll 1
        for (unsigned j = 0; j < 16; ++j) { const unsigned c = xb_ld(&bar[XB_XCNT(j)]); sum += c; cnt += (c > 0u) ? 1u : 0u; }
        if (sum == G) break;
        __builtin_amdgcn_s_sleep(1);
        if ((++sp & 255u) == 0u) { if (xb_ld(&bar[XB_TMO])) break; if (sp > XB_SPIN_CAP) { atomicAdd(&bar[XB_TMO], 1u); break; } }
    }
    mine = xb_ld(&bar[XB_XCNT(x)]);
    nloc = mine > 0u ? mine : 1u; nx = cnt > 0u ? cnt : 1u;
}
__device__ __forceinline__ void xcd_barrier(const XcdBarrier& b) {
    asm volatile("s_waitcnt vmcnt(0)" ::: "memory");
    __syncthreads();
    if (threadIdx.x == 0) {
        unsigned* bar = b.bar;
        __builtin_amdgcn_s_waitcnt(0);
        unsigned nloc = b.st[0], nx = b.st[1];
        if (nloc == 0u) { xcd_barrier_complete(bar, b.x, nloc, nx); b.st[0] = nloc; b.st[1] = nx; }
        const unsigned old = xb_add(&bar[XB_XSUB(b.x)], 1u);
        const unsigned gen = old / nloc;
        if (old + 1u == (gen + 1u) * nloc) {
            __builtin_amdgcn_fence(__ATOMIC_RELEASE, "agent");
            asm volatile("s_waitcnt vmcnt(0)" ::: "memory");
            const unsigned og = xb_add(&bar[XB_TOP], 1u);
            const unsigned tg = og / nx;
            if (og + 1u == (tg + 1u) * nx) xb_add(&bar[XB_TOPGEN], 1u);
            else XB_SPIN(xb_ld(&bar[XB_TOPGEN]) == tg, bar);
            __builtin_amdgcn_fence(__ATOMIC_ACQUIRE, "agent");
            xb_add(&bar[XB_XGEN(b.x)], 1u);
            asm volatile("s_waitcnt vmcnt(0)" ::: "memory");
        } else {
            XB_SPIN(xb_ld(&bar[XB_XGEN(b.x)]) == gen, bar);
            __builtin_amdgcn_fence(__ATOMIC_ACQUIRE, "agent");
            asm volatile("s_waitcnt vmcnt(0)" ::: "memory");
        }
    }
    __syncthreads();
}

namespace pg8 {
#define PG8_LAS __attribute__((address_space(3)))
constexpr int BM = 256, BK = 64, HALF = 128, HTB = HALF * BK * 2, STAGE_BYTES = 8 * HTB, NXCD = 8, WGM = 8;
__host__ __device__ __forceinline__ int lds_byte(int r, int c) { const int st = (r >> 4) * 2 + (c >> 5), rr = r & 15, cc = c & 31, ob = rr * 64 + cc * 2; return st * 1024 + (ob ^ (((ob >> 9) & 1) << 5)); }
__host__ __device__ __forceinline__ void stage_rc(int b, int& R, int& C) { const int st = b / 1024, sb = b % 1024, swz = sb ^ (((sb >> 9) & 1) << 5); R = (st >> 1) * 16 + swz / 64; C = (st & 1) * 32 + (swz % 64) / 2; }
__host__ __device__ __forceinline__ int perm32(int rho) { const int n = rho >> 4, i = rho & 15; return 8 * (i >> 2) + 4 * n + (i & 3); }

struct Unit { const char* A; const char* B; int pm, pn, aux, kt, rb, cn, ui; };
struct Gemm { int lda, ldb, K; };

struct TileOrder {
    int nM, nN, nwg, G, c, rot = 0;
    __device__ __forceinline__ void init(int nM_, int nN_, int G_, int c_) { nM = nM_; nN = nN_; nwg = nM * nN; G = G_; c = c_; }
    __device__ __forceinline__ bool get(int i, int& pm, int& pn) const { return map((long)i * G + c, pm, pn); }
    __device__ __forceinline__ bool map(long L, int& pm, int& pn) const {
        if (L >= nwg) return false;
        const int nig = WGM * nN;
        int wgid = (int)L; { const int q = nwg / NXCD, r = nwg % NXCD, xcd = wgid % NXCD; int off = wgid / NXCD; const int cs = (xcd < r ? xcd * (q + 1) : r * (q + 1) + (xcd - r) * q), len = q + (xcd < r ? 1 : 0);
            if (rot) { const int lead = (nig - cs % nig) % nig; if (lead < len) { off += lead; if (off >= len) off -= len; } }
            wgid = cs + off; }
        const int gid = wgid / nig, fm = gid * WGM, gsz = (nM - fm) < WGM ? (nM - fm) : WGM;
        pm = fm + ((wgid % nig) % gsz); pn = (wgid % nig) / gsz; return true;
    }
};

template <class Epi, class Sched, bool ALIGN_EPI, bool GATHER = false>
__device__ __forceinline__ void gemm_phase(PG8_LAS unsigned char* lds, const Gemm g, const Sched& S, const Epi& E) {
    const int tid = otid(), wid = __builtin_amdgcn_readfirstlane(tid >> 6), lane = tid & 63, wr = wid >> 2, wc = wid & 3, fr = lane & 15, fq = lane >> 4;
    unsigned vc[2][2], vn[2][2], voffB[2]; int Rr[2], Cc = 0;
#pragma unroll
    for (int i = 0; i < 2; ++i) { int R, C; stage_rc(tid * 16 + i * 8192, R, C); const int Rb = Epi::PERM ? ((R & ~31) + perm32(R & 31)) : R; Rr[i] = R; Cc = C;
        vc[0][i] = (unsigned)(R * g.lda + C) * 2u; vc[1][i] = vc[0][i] + (unsigned)(HALF * g.lda) * 2u; voffB[i] = (unsigned)(Rb * g.ldb + C) * 2u; }
#define PG8_ROWS(ui_, v) do { _Pragma("unroll") for (int _h = 0; _h < 2; ++_h) _Pragma("unroll") for (int _i = 0; _i < 2; ++_i) \
        v[_h][_i] = (unsigned)S.rowtok((ui_), Rr[_i] + HALF * _h) * (unsigned)(g.lda * 2) + (unsigned)Cc * 2u; } while (0)
    const size_t kstep = (size_t)(BK * 2);
    const size_t hsB = (size_t)HALF * g.ldb * 2;
    const unsigned ldsw = (unsigned)wid * 1024u;
    const int aoff = lds_byte(wr * 64 + fr, fq * 8), boff = lds_byte(wc * 32 + fr, fq * 8);
#define PG8_SA(b, h) (((b) * 2 + (h)) * HTB)
#define PG8_SB(b, h) ((4 + (b) * 2 + (h)) * HTB)
#define PG8_STAGE(bufoff, gbase, voff) do { _Pragma("unroll") for (int _i = 0; _i < 2; ++_i) \
        __builtin_amdgcn_global_load_lds((const unsigned*)((const char*)(gbase) + (voff)[_i]), (PG8_LAS unsigned*)(lds + (bufoff) + ldsw + _i * 8192), 16, 0, 0); } while (0)
#define PG8_LDA(dst, b, h) do { _Pragma("unroll") for (int m = 0; m < 4; ++m) _Pragma("unroll") for (int k = 0; k < 2; ++k) dst[m][k] = *(const PG8_LAS bf16x8*)(lds + PG8_SA(b, h) + aoff + m * 2048 + k * 1024); } while (0)
#define PG8_LDB(dst, b, h) do { _Pragma("unroll") for (int n = 0; n < 2; ++n) _Pragma("unroll") for (int k = 0; k < 2; ++k) dst[n][k] = *(const PG8_LAS bf16x8*)(lds + PG8_SB(b, h) + boff + n * 2048 + k * 1024); } while (0)
#define PG8_MMA(ai, bj, At, Bt) do { __builtin_amdgcn_s_setprio(1); _Pragma("unroll") for (int m = 0; m < 4; ++m) _Pragma("unroll") for (int n = 0; n < 2; ++n) _Pragma("unroll") for (int k = 0; k < 2; ++k) \
        acc[ai][bj][m][n] = __builtin_amdgcn_mfma_f32_16x16x32_bf16(Bt[n][k], At[m][k], acc[ai][bj][m][n], 0, 0, 0); __builtin_amdgcn_s_setprio(0); } while (0)
#define PG8_WAIT_V(n) asm volatile("s_waitcnt vmcnt(" #n ")" ::: "memory")
#define PG8_WAIT_L(n) asm volatile("s_waitcnt lgkmcnt(" #n ")" ::: "memory")
#define PG8_BAR __builtin_amdgcn_s_barrier()
#define PG8_SCHED __builtin_amdgcn_sched_barrier(0)
    Unit cur, nxt; int ui = 0; int pend = -1, pend2 = -1, wst = 0; unsigned pv = 8u; (void)pend; (void)pend2; (void)wst; (void)pv;
    if (!S.next(0, cur)) return;
    if constexpr (Sched::WAITS) S.wait_ready(cur);
    if constexpr (GATHER) PG8_ROWS(0, vc);
    f32x4 acc[2][2][4][2];
#pragma unroll
    for (int a = 0; a < 2; ++a)
#pragma unroll
        for (int b = 0; b < 2; ++b)
#pragma unroll
            for (int m = 0; m < 4; ++m)
#pragma unroll
                for (int n = 0; n < 2; ++n) acc[a][b][m][n] = (f32x4){0.f, 0.f, 0.f, 0.f};
    bf16x8 At[4][2], B0[2][2], B1[2][2];
    const char* cA = cur.A; const char* cB = cur.B;
    PG8_STAGE(PG8_SB(0, 0), cB, voffB); PG8_STAGE(PG8_SB(0, 1), cB + hsB, voffB); PG8_STAGE(PG8_SA(0, 0), cA, vc[0]); PG8_STAGE(PG8_SA(0, 1), cA, vc[1]);
    if (wr == 1) PG8_BAR;
    PG8_WAIT_V(2); PG8_BAR;
    PG8_STAGE(PG8_SB(1, 0), cB + kstep, voffB); PG8_STAGE(PG8_SA(1, 0), cA + kstep, vc[0]); PG8_STAGE(PG8_SB(1, 1), cB + hsB + kstep, voffB);
    PG8_WAIT_V(6); PG8_BAR;
    for (;;) {
        const bool has_next = S.next(ui + 1, nxt);
        if constexpr (Sched::WAITS) wst = has_next ? 1 : 0;
        const char* nA = has_next ? nxt.A : cA; const char* nB = has_next ? nxt.B : cB;
        if constexpr (GATHER) { if (has_next) PG8_ROWS(ui + 1, vn); else {
#pragma unroll
            for (int h = 0; h < 2; ++h) { vn[h][0] = vc[h][0]; vn[h][1] = vc[h][1]; } } }
        const int nt = cur.kt;
        for (int t = 0; t < nt; t += 2) {
            const bool last = (t == nt - 2);
            const char* a1 = cA + (size_t)(t + 1) * kstep;
            const char* a2 = last ? nA : cA + (size_t)(t + 2) * kstep; const char* b2 = last ? nB : cB + (size_t)(t + 2) * kstep;
            const char* a3 = a2 + kstep; const char* b3 = b2 + kstep;
            unsigned o0[2], o1[2];
#pragma unroll
            for (int i = 0; i < 2; ++i) { o0[i] = (GATHER && last) ? vn[0][i] : vc[0][i]; o1[i] = (GATHER && last) ? vn[1][i] : vc[1][i]; }
            PG8_LDB(B0, 0, 0); PG8_LDB(B1, 0, 1); PG8_SCHED; PG8_LDA(At, 0, 0); PG8_STAGE(PG8_SA(1, 1), a1, vc[1]);
            PG8_WAIT_V(8); PG8_WAIT_L(0); PG8_BAR; PG8_MMA(0, 0, At, B0); PG8_MMA(0, 1, At, B1); PG8_BAR; PG8_SCHED;
            PG8_LDA(At, 0, 1); PG8_STAGE(PG8_SB(0, 0), b2, voffB); PG8_STAGE(PG8_SB(0, 1), b2 + hsB, voffB); PG8_STAGE(PG8_SA(0, 0), a2, o0);
            PG8_WAIT_V(8); PG8_WAIT_L(0); PG8_BAR; PG8_MMA(1, 0, At, B0); PG8_MMA(1, 1, At, B1); PG8_BAR; PG8_SCHED;
            PG8_LDB(B0, 1, 0); PG8_LDB(B1, 1, 1); PG8_SCHED; PG8_LDA(At, 1, 0); PG8_STAGE(PG8_SA(0, 1), a2, o1);
            PG8_WAIT_V(8); PG8_WAIT_L(0); PG8_BAR; PG8_MMA(0, 0, At, B0); PG8_MMA(0, 1, At, B1); PG8_BAR; PG8_SCHED;
            PG8_LDA(At, 1, 1); PG8_STAGE(PG8_SB(1, 0), b3, voffB); PG8_STAGE(PG8_SB(1, 1), b3 + hsB, voffB); PG8_STAGE(PG8_SA(1, 0), a3, o0);
            PG8_WAIT_V(8); PG8_WAIT_L(0); PG8_BAR; PG8_MMA(1, 0, At, B0); PG8_MMA(1, 1, At, B1); PG8_BAR; PG8_SCHED;
            if constexpr (Sched::SIGNALS) { if (pend >= 0) { pend2 = pend; pend = -1; } else if (pend2 >= 0) { S.signal(pend2, lane, wid); pend2 = -1; } }
            if constexpr (Sched::WAITS) { if (wst == 1) { pv = S.poll(nxt); wst = 2; } else if (wst == 2) { wst = 0; if (pv < 8u) S.spin(nxt); } }
        }
        if constexpr (ALIGN_EPI) { if (wr == 0) PG8_BAR; }
        E(acc, cur, wr, wc, fr, fq);
        if constexpr (Sched::SIGNALS) pend = cur.pm;
        if (!has_next) break;
#pragma unroll
        for (int a = 0; a < 2; ++a)
#pragma unroll
            for (int b = 0; b < 2; ++b)
#pragma unroll
                for (int m = 0; m < 4; ++m)
#pragma unroll
                    for (int n = 0; n < 2; ++n) acc[a][b][m][n] = (f32x4){0.f, 0.f, 0.f, 0.f};
        cur = nxt; cA = nA; cB = nB; ++ui;
        if constexpr (GATHER) {
#pragma unroll
            for (int h = 0; h < 2; ++h) { vc[h][0] = vn[h][0]; vc[h][1] = vn[h][1]; } }
        if constexpr (ALIGN_EPI) { if (wr == 1) PG8_BAR; }
    }
    PG8_WAIT_V(0);
    if constexpr (!ALIGN_EPI) { if (wr == 0) PG8_BAR; }
    PG8_BAR;
    if constexpr (Sched::SIGNALS) { if (pend >= 0) S.signal(pend, lane, wid); }
#undef PG8_ROWS
#undef PG8_SA
#undef PG8_SB
#undef PG8_STAGE
#undef PG8_LDA
#undef PG8_LDB
#undef PG8_MMA
#undef PG8_WAIT_V
#undef PG8_WAIT_L
#undef PG8_BAR
#undef PG8_SCHED
}

template <unsigned AT, unsigned BT, int KT>
struct SchedDense {
    static constexpr bool SIGNALS = false, WAITS = false;
    TileOrder o; const char* A; const char* B; int pm0;
    __device__ __forceinline__ int rowtok(int, int) const { return 0; }
    __device__ __forceinline__ bool next(int i, Unit& u) const { int pm, pn; if (!o.get(i, pm, pn)) return false;
        u.rb = 0; u.cn = 0; u.pm = pm0 + pm; u.pn = pn; u.aux = 0; u.kt = KT; u.A = A + (size_t)((unsigned)u.pm * AT); u.B = B + (size_t)((unsigned)pn * BT); return true; }
};
template <unsigned AT, unsigned BT, int KT, int NN>
struct SchedSplit {
    static constexpr bool SIGNALS = false, WAITS = false;
    TileOrder o; const char* A; const char* B; int G, c; bool split;
    __device__ __forceinline__ int rowtok(int, int) const { return 0; }
    __device__ __forceinline__ void init(int G_, int c_) { G = G_; c = c_; split = ((64 * NN) % G_ == 0) && (2 * NN * 8 <= G_); if (split) o.init(64, NN, G_, c_); else o.init(66, NN, G_, c_); }
    __device__ __forceinline__ bool next(int i, Unit& u) const { u.rb = 0; u.cn = 0;
        if (!split) { int pm, pn; if (!o.get(i, pm, pn)) return false; u.pm = pm; u.pn = pn; u.aux = 0; u.kt = KT; u.A = A + (size_t)((unsigned)pm * AT); u.B = B + (size_t)((unsigned)pn * BT); return true; }
        const int fr = (64 * NN) / G;
        if (i < fr) { int pm, pn; o.get(i, pm, pn); u.pm = 2 + pm; u.pn = pn; u.aux = 0; u.kt = KT; u.A = A + (size_t)((unsigned)u.pm * AT); u.B = B + (size_t)((unsigned)pn * BT); return true; }
        if (i > fr || c >= 2 * NN * 8) return false;
        const int ks = c & 7, t = c >> 3; u.pm = t / NN; u.pn = t % NN; u.aux = ks + 1; u.kt = KT / 8;
        u.A = A + (size_t)((unsigned)u.pm * AT + (unsigned)ks * (KT / 8) * 128u); u.B = B + (size_t)((unsigned)u.pn * BT + (unsigned)ks * (KT / 8) * 128u); return true; }
};
struct SchedPool {
    static constexpr bool SIGNALS = false, WAITS = false;
    TileOrder o; const char* A; const char* B;
    __device__ __forceinline__ int rowtok(int, int) const { return 0; }
    __device__ __forceinline__ bool next(int i, Unit& u) const { int pm, pn; if (!o.get(i, pm, pn)) return false;
        u.rb = 0; u.cn = 0; u.pm = 2 + pm; u.pn = pn; u.aux = 0; u.kt = 8; const int g = pn >> 1;
        u.A = A + (size_t)((unsigned)u.pm * (256u * DM * 2u) + (unsigned)g * 1024u); u.B = B + (size_t)((unsigned)g * (512u * 512u * 2u) + (unsigned)(pn & 1) * (256u * 512u * 2u)); return true; }
};
struct SchedOne {
    static constexpr bool SIGNALS = false, WAITS = false;
    Unit u;
    __device__ __forceinline__ int rowtok(int, int) const { return 0; }
    __device__ __forceinline__ bool next(int i, Unit& o) const { if (i != 0) return false; o = u; return true; }
};
constexpr int RT_UNITS = 14;
template <unsigned AT, unsigned BT, unsigned BE, int KT, bool GATHER>
struct SchedMoe {
    static constexpr bool SIGNALS = GATHER, WAITS = !GATHER;
    unsigned* ctr;
    __device__ __forceinline__ void signal(int pm, int lane, int wid) const { if (wid == 0 && lane == 0) (void)xb_add(ctr + 32 * pm, 1u); }
    __device__ __forceinline__ void wait_ready(const Unit& u) const { while (xb_ld(ctr + 32 * u.pm) < 8u) __builtin_amdgcn_s_sleep(2); asm volatile("" ::: "memory"); }
    __device__ __forceinline__ unsigned poll(const Unit& u) const { return xb_ld(ctr + 32 * u.pm); }
    __device__ __forceinline__ void spin(const Unit& u) const { while (xb_ld(ctr + 32 * u.pm) < 8u) __builtin_amdgcn_s_sleep(2); }
    __device__ __forceinline__ void acquire_async() const { asm volatile("buffer_inv sc1" ::: "memory"); }
    TileOrder o; const char* A; const char* B; const PG8_LAS int* texp; const PG8_LAS int* tbase; const PG8_LAS int* tcnt; const PG8_LAS int* rt; const int* list;
    int rem = 0, nl = 0;
    __device__ __forceinline__ bool next(int i, Unit& u) const { int pm, pn;
        if (GATHER) { if (!o.get(i, pm, pn)) return false; }
        else { const bool light = o.c >= rem; const long L = (light && i < 2) ? (long)i * nl + (o.c - rem) : 2L * nl + (long)(light ? i - 2 : i) * o.G + o.c; if (!o.map(L, pm, pn)) return false; }
        const int e = __builtin_amdgcn_readfirstlane(texp[pm]);
        u.pm = pm; u.pn = pn; u.aux = e; u.kt = KT; u.ui = i; u.rb = (pm - __builtin_amdgcn_readfirstlane(tbase[e])) * 256; u.cn = __builtin_amdgcn_readfirstlane(tcnt[e]);
        u.A = GATHER ? A : A + (size_t)((unsigned)pm * AT); u.B = B + (size_t)((unsigned)e * BE + (unsigned)pn * BT); return true; }
    __device__ __forceinline__ int tok_of(const Unit& u, int row) const { const int pos = u.rb + row; return pos < u.cn ? (list[(size_t)u.aux * MT + pos] >> 1) : 0; }
    __device__ __forceinline__ int rowtok(int ui, int row) const { if (ui < RT_UNITS) return rt[ui * 256 + row]; Unit u; next(ui, u); return tok_of(u, row); }
    __device__ __forceinline__ void fill_dst(PG8_LAS int* rtw, const float* listg, int tid) const {
        int dv[RT_UNITS / 2]; float gv[RT_UNITS / 2]; bool ok[RT_UNITS / 2];
#pragma unroll
        for (int i = 0; i < RT_UNITS / 2; ++i) { Unit u; ok[i] = next(i, u); dv[i] = -1; gv[i] = 0.f;
            if (ok[i] && tid < 256) { const int pos = u.rb + tid; if (pos < u.cn) { const size_t li = (size_t)u.aux * MT + pos; dv[i] = list[li]; gv[i] = listg[li]; } } }
#pragma unroll
        for (int i = 0; i < RT_UNITS / 2; ++i) if (ok[i] && tid < 256) { rtw[i * 512 + tid] = dv[i]; rtw[i * 512 + 256 + tid] = (int)__float_as_uint(gv[i]); }
        __syncthreads(); }
    __device__ __forceinline__ void fill_rows(PG8_LAS int* rtw, int tid) const {
#pragma unroll
        for (int h = 0; h < 2; ++h) { int tk[RT_UNITS / 2]; bool ok[RT_UNITS / 2];
#pragma unroll
            for (int q = 0; q < RT_UNITS / 2; ++q) { Unit u; ok[q] = next(h * (RT_UNITS / 2) + q, u); tk[q] = 0; if (ok[q] && tid < 256) tk[q] = tok_of(u, tid); }
#pragma unroll
            for (int q = 0; q < RT_UNITS / 2; ++q) if (ok[q] && tid < 256) rtw[(h * (RT_UNITS / 2) + q) * 256 + tid] = tk[q]; }
        __syncthreads(); }
};

struct EpiBf16 {
    static constexpr bool PERM = true;
    bf16_t* O; int ldc; float* P;
    __device__ __forceinline__ void operator()(const f32x4 (&acc)[2][2][4][2], const Unit& u, int wr, int wc, int fr, int fq) const {
        const int row0 = u.pm * BM + wr * 64 + fr, col0 = u.pn * BM + wc * 32 + 8 * fq;
        if (u.aux == 0) {
#pragma unroll
            for (int ai = 0; ai < 2; ++ai)
#pragma unroll
                for (int m = 0; m < 4; ++m) { bf16_t* rowp = O + (size_t)(row0 + ai * HALF + m * 16) * ldc + col0;
#pragma unroll
                    for (int bj = 0; bj < 2; ++bj) { const f32x4 v0 = acc[ai][bj][m][0], v1 = acc[ai][bj][m][1];
                        v4u w; w.x = cvt_pk_bf16(v0[0], v0[1]); w.y = cvt_pk_bf16(v0[2], v0[3]); w.z = cvt_pk_bf16(v1[0], v1[1]); w.w = cvt_pk_bf16(v1[2], v1[3]);
                        *(v4u*)(rowp + bj * HALF) = w; } }
        } else {
            float* pb = P + (size_t)(u.aux - 1) * 512 * ldc;
#pragma unroll
            for (int ai = 0; ai < 2; ++ai)
#pragma unroll
                for (int m = 0; m < 4; ++m) { float* rowp = pb + (size_t)(row0 + ai * HALF + m * 16) * ldc + col0;
#pragma unroll
                    for (int bj = 0; bj < 2; ++bj) { *(f32x4*)(rowp + bj * HALF) = acc[ai][bj][m][0]; *(f32x4*)(rowp + bj * HALF + 4) = acc[ai][bj][m][1]; } }
        }
    }
};
struct EpiBf16W {
    static constexpr bool PERM = true;
    bf16_t* O; int ldc;
    __device__ __forceinline__ void operator()(const f32x4 (&acc)[2][2][4][2], const Unit& u, int wr, int wc, int fr, int fq) const {
        const int row0 = u.pm * BM + wr * 64 + fr, col0 = u.pn * BM + wc * 32 + 8 * fq;
#pragma unroll
        for (int ai = 0; ai < 2; ++ai)
#pragma unroll
            for (int m = 0; m < 4; ++m) { bf16_t* rowp = O + (size_t)(row0 + ai * HALF + m * 16) * ldc + col0;
#pragma unroll
                for (int bj = 0; bj < 2; ++bj) { const f32x4 v0 = acc[ai][bj][m][0], v1 = acc[ai][bj][m][1];
                    v4u w; w.x = cvt_pk_bf16(v0[0], v0[1]); w.y = cvt_pk_bf16(v0[2], v0[3]); w.z = cvt_pk_bf16(v1[0], v1[1]); w.w = cvt_pk_bf16(v1[2], v1[3]);
                    const bf16_t* gp = rowp + bj * HALF;
                    asm volatile("global_store_dwordx4 %0, %1, off sc1\n\ts_nop 1" :: "v"(gp), "v"(w) : "memory"); } }
    }
};
struct EpiQkv {
    static constexpr bool PERM = true;
    bf16_t* O; int ldc; float* P; bf16_t* V;
    __device__ __forceinline__ void operator()(const f32x4 (&acc)[2][2][4][2], const Unit& u, int wr, int wc, int fr, int fq) const {
        const int row0 = u.pm * BM + wr * 64 + fr, col0 = u.pn * BM + wc * 32 + 8 * fq;
        if (u.aux == 0) {
            const bool isV = u.pn >= (DM + KVD) / BM;
#pragma unroll
            for (int ai = 0; ai < 2; ++ai)
#pragma unroll
                for (int m = 0; m < 4; ++m) { const int row = row0 + ai * HALF + m * 16; bf16_t* rowp = O + (size_t)row * ldc + col0; size_t vstep = HALF;
                    if (isV) { const bool lat = row >= NCTX; const int lr = row - NCTX, b = lat ? (lr >> 13) : (row >> 8), kpos = lat ? (CTXL + (lr & 8191)) : (row & 255);
                        rowp = V + (((size_t)b * NKV + (size_t)(u.pn - (DM + KVD) / BM) * 2) * SKV + kpos) * HD + wc * 32 + 8 * fq; vstep = (size_t)SKV * HD; }
#pragma unroll
                    for (int bj = 0; bj < 2; ++bj) { const f32x4 v0 = acc[ai][bj][m][0], v1 = acc[ai][bj][m][1];
                        v4u w; w.x = cvt_pk_bf16(v0[0], v0[1]); w.y = cvt_pk_bf16(v0[2], v0[3]); w.z = cvt_pk_bf16(v1[0], v1[1]); w.w = cvt_pk_bf16(v1[2], v1[3]);
                        *(v4u*)(rowp + bj * vstep) = w; } }
        } else {
            float* pb = P + (size_t)(u.aux - 1) * 512 * ldc;
#pragma unroll
            for (int ai = 0; ai < 2; ++ai)
#pragma unroll
                for (int m = 0; m < 4; ++m) { float* rowp = pb + (size_t)(row0 + ai * HALF + m * 16) * ldc + col0;
#pragma unroll
                    for (int bj = 0; bj < 2; ++bj) { *(f32x4*)(rowp + bj * HALF) = acc[ai][bj][m][0]; *(f32x4*)(rowp + bj * HALF + 4) = acc[ai][bj][m][1]; } }
        }
    }
};
struct EpiGateUp {
    static constexpr bool PERM = true;
    bf16_t* ACT;
    __device__ __forceinline__ void operator()(const f32x4 (&acc)[2][2][4][2], const Unit& u, int wr, int wc, int fr, int fq) const {
        const int row0 = u.pm * BM + wr * 64 + fr, col0 = u.pn * HALF + wc * 32 + 8 * fq;
#pragma unroll
        for (int ai = 0; ai < 2; ++ai)
#pragma unroll
            for (int m = 0; m < 4; ++m) { bf16_t* rowp = ACT + (size_t)(row0 + ai * HALF + m * 16) * DE + col0;
                float v[8];
#pragma unroll
                for (int n = 0; n < 2; ++n)
#pragma unroll
                    for (int j = 0; j < 4; ++j) v[n * 4 + j] = silu_f(acc[ai][0][m][n][j]) * acc[ai][1][m][n][j];
                v4u w; w.x = cvt_pk_bf16(v[0], v[1]); w.y = cvt_pk_bf16(v[2], v[3]); w.z = cvt_pk_bf16(v[4], v[5]); w.w = cvt_pk_bf16(v[6], v[7]);
                asm volatile("global_store_dwordx4 %0, %1, off sc1\n\ts_nop 1" :: "v"(rowp), "v"(w) : "memory"); }
    }
};
struct EpiDown {
    static constexpr bool PERM = true;
    bf16_t* FB; const PG8_LAS int* rt;
    __device__ __forceinline__ void operator()(const f32x4 (&acc)[2][2][4][2], const Unit& u, int wr, int wc, int fr, int fq) const {
        const int r0 = wr * 64 + fr, col0 = u.pn * BM + wc * 32 + 8 * fq; const PG8_LAS int* tb = rt + u.ui * 512 + r0;
#pragma unroll
        for (int ai = 0; ai < 2; ++ai)
#pragma unroll
            for (int m = 0; m < 4; ++m) { const int d_ = tb[ai * HALF + m * 16]; const float g_ = __uint_as_float((unsigned)tb[256 + ai * HALF + m * 16]);
                if (d_ >= 0) { bf16_t* fr_ = FB + (size_t)d_ * DM + col0;
#pragma unroll
                    for (int bj = 0; bj < 2; ++bj) { const f32x4 v0 = acc[ai][bj][m][0] * g_, v1 = acc[ai][bj][m][1] * g_;
                        v4u w; w.x = cvt_pk_bf16(v0[0], v0[1]); w.y = cvt_pk_bf16(v0[2], v0[3]); w.z = cvt_pk_bf16(v1[0], v1[1]); w.w = cvt_pk_bf16(v1[2], v1[3]);
                        *(v4u*)(fr_ + bj * HALF) = w; } } }
    }
};
}

namespace att {
constexpr int D = 128, NW = 8, QBLK = 32, KVBLK = 64;
constexpr float SCALE = 0.088388347648318440f;
constexpr float THR = 8.f;
#ifndef ATT_SDEPTH
#define ATT_SDEPTH 1
#endif
constexpr int SDEPTH = ATT_SDEPTH;
constexpr int LDQ = DM, LDK = HD, LDO = DM;
constexpr size_t SHM_V = KVBLK * D * 2, SHM_K = KVBLK * D * 2, SHM_ATTN = 2 * SHM_V + 2 * SHM_K + NW * 64 * 4;
typedef unsigned u32x4 __attribute__((ext_vector_type(4)));
#define KSWZ(row, colB) ((row) * 256 + ((colB) ^ (((row) & 7) << 4)))
#define SBAR() __builtin_amdgcn_sched_barrier(0)
__device__ __forceinline__ int crow(int r, int hi) { return (r & 3) + 8 * (r >> 2) + 4 * hi; }
__device__ __forceinline__ unsigned cvtpk(float lo, float hi) { unsigned r; asm volatile("v_cvt_pk_bf16_f32 %0, %1, %2" : "=v"(r) : "v"(lo), "v"(hi)); return r; }
__device__ __forceinline__ bf16x8 ld8(const bf16_t* p) { return *reinterpret_cast<const bf16x8*>(p); }

__device__ __forceinline__ void partialSM(f32x16& p0, f32x16& p1, float& m_reg, float& mn, float& alpha) {
  constexpr float C = SCALE * 1.4426950408889634f;
  float pmax = p0[0]; for (int r = 1; r < 16; ++r) pmax = fmaxf(pmax, p0[r]); for (int r = 0; r < 16; ++r) pmax = fmaxf(pmax, p1[r]);
  { auto rr = __builtin_amdgcn_permlane32_swap(__float_as_uint(pmax), __float_as_uint(pmax), false, false);
    pmax = fmaxf(__uint_as_float(rr[0]), __uint_as_float(rr[1])); }
  if (__builtin_expect(__all(pmax - m_reg <= THR / SCALE), 1)) { mn = m_reg; alpha = 1.f; }
  else { mn = fmaxf(m_reg, pmax); alpha = __builtin_amdgcn_exp2f((m_reg - mn) * C); m_reg = mn; }
  float mnC = -mn * C;
  for (int r = 0; r < 16; ++r) p0[r] = fmaf(p0[r], C, mnC); for (int r = 0; r < 16; ++r) p1[r] = fmaf(p1[r], C, mnC);
  for (int r = 0; r < 16; ++r) p0[r] = __builtin_amdgcn_exp2f(p0[r]);
}
__device__ __forceinline__ void finishSM(f32x16& p0, f32x16& p1, float alpha, float& l_reg, bf16x8& pa0, bf16x8& pa1, bf16x8& pa2, bf16x8& pa3) {
  for (int r = 0; r < 16; ++r) p1[r] = __builtin_amdgcn_exp2f(p1[r]);
  float ps = 0; for (int r = 0; r < 16; ++r) ps += p0[r]; for (int r = 0; r < 16; ++r) ps += p1[r];
  { auto rr = __builtin_amdgcn_permlane32_swap(__float_as_uint(ps), __float_as_uint(ps), false, false);
    ps = __uint_as_float(rr[0]) + __uint_as_float(rr[1]); }
  l_reg = l_reg * alpha + ps;
#define PK4(P, BASE, OUT) do { unsigned a0 = cvtpk(P[BASE + 0], P[BASE + 1]), a1 = cvtpk(P[BASE + 2], P[BASE + 3]);   \
    unsigned b0 = cvtpk(P[BASE + 4], P[BASE + 5]), b1 = cvtpk(P[BASE + 6], P[BASE + 7]);                              \
    auto r0 = __builtin_amdgcn_permlane32_swap(a0, b0, false, false); auto r1 = __builtin_amdgcn_permlane32_swap(a1, b1, false, false); \
    u32x4 w = {r0[0], r1[0], r0[1], r1[1]}; OUT = *reinterpret_cast<bf16x8*>(&w); } while (0)
  PK4(p0, 0, pa0); PK4(p0, 8, pa1); PK4(p1, 0, pa2); PK4(p1, 8, pa3);
#undef PK4
}
__device__ __forceinline__ void qkt(f32x16& p0, f32x16& p1, const bf16_t* Ks, const bf16x8* qr, int r32, int hi) {
  p0 = f32x16{}; p1 = f32x16{};
  for (int d0 = 0; d0 < 8; ++d0) { int cb = (d0 * 16 + hi * 8) * 2;
    bf16x8 b0 = *reinterpret_cast<const bf16x8*>((const char*)Ks + KSWZ(r32, cb));
    bf16x8 b1 = *reinterpret_cast<const bf16x8*>((const char*)Ks + KSWZ(32 + r32, cb));
    p0 = __builtin_amdgcn_mfma_f32_32x32x16_bf16(b0, qr[d0], p0, 0, 0, 0);
    p1 = __builtin_amdgcn_mfma_f32_32x32x16_bf16(b1, qr[d0], p1, 0, 0, 0); }
}
__device__ __forceinline__ int v_st(int k, int c) { const int kk = (k & ~0xC) | ((k & 4) << 1) | ((k & 8) >> 1); return ((kk >> 3) * 4 + (c >> 5)) * 512 + ((kk & 7) * 32 + (c & 31)) * 2; }
__device__ __forceinline__ int v_rd_base(int lane) { return ((lane & 3) << 3) | (((lane >> 2) & 3) << 6) | (((lane >> 4) & 1) << 5) | (((lane >> 5) & 1) << 8); }
constexpr int v_rd_off(int d0, int ks, int half) { return d0 * 512 + ks * 4096 + half * 2048; }
template <int OFF> __device__ __forceinline__ s16x4 tr_read(int vb) {
  s16x4 r; asm volatile("ds_read_b64_tr_b16 %0, %1 offset:%2" : "=&v"(r) : "v"(vb), "i"(OFF) : "memory"); return r;
}
template <int D0> __device__ __forceinline__ void pv_one(f32x16& od, int vb, bf16x8 pa0, bf16x8 pa1, bf16x8 pa2, bf16x8 pa3) {
  const s16x4 l0 = tr_read<v_rd_off(D0, 0, 0)>(vb), h0 = tr_read<v_rd_off(D0, 0, 1)>(vb), l1 = tr_read<v_rd_off(D0, 1, 0)>(vb), h1 = tr_read<v_rd_off(D0, 1, 1)>(vb);
  const s16x4 l2 = tr_read<v_rd_off(D0, 2, 0)>(vb), h2 = tr_read<v_rd_off(D0, 2, 1)>(vb), l3 = tr_read<v_rd_off(D0, 3, 0)>(vb), h3 = tr_read<v_rd_off(D0, 3, 1)>(vb);
  asm volatile("s_waitcnt lgkmcnt(0)" ::: "memory"); SBAR();
#define PK(L, H) (bf16x8){L[0], L[1], L[2], L[3], H[0], H[1], H[2], H[3]}
  od = __builtin_amdgcn_mfma_f32_32x32x16_bf16(pa0, PK(l0, h0), od, 0, 0, 0);
  od = __builtin_amdgcn_mfma_f32_32x32x16_bf16(pa1, PK(l1, h1), od, 0, 0, 0);
  od = __builtin_amdgcn_mfma_f32_32x32x16_bf16(pa2, PK(l2, h2), od, 0, 0, 0);
  od = __builtin_amdgcn_mfma_f32_32x32x16_bf16(pa3, PK(l3, h3), od, 0, 0, 0);
#undef PK
}
__device__ __forceinline__ void pv_d0(f32x16* o, int vb, bf16x8 pa0, bf16x8 pa1, bf16x8 pa2, bf16x8 pa3) {
  pv_one<0>(o[0], vb, pa0, pa1, pa2, pa3); pv_one<1>(o[1], vb, pa0, pa1, pa2, pa3); pv_one<2>(o[2], vb, pa0, pa1, pa2, pa3); pv_one<3>(o[3], vb, pa0, pa1, pa2, pa3);
}
__device__ __forceinline__ void attn_dense_body(const bf16_t* __restrict__ Qb, const bf16_t* __restrict__ Kh, const bf16_t* __restrict__ Vh,
                                                bf16_t* __restrict__ Ob, int seq, char* lds) {
  const int tid = otid(), wid = tid >> 6, lane = tid & 63, r32 = lane & 31, hi = lane >> 5;
  bf16_t* V_lds = (bf16_t*)lds; bf16_t* K_lds = (bf16_t*)(lds + 2 * SHM_V);
  float* ws = (float*)(lds + 2 * SHM_V + 2 * SHM_K) + wid * 64; float* li_l = ws; float* al_l = ws + 32;
  float m_reg = -1e30f, l_reg = 0; f32x16 o[4] = {}; bf16x8 qr[8];
  const bf16_t* Qw = Qb + (long)(wid * QBLK + r32) * LDQ + hi * 8;
#pragma unroll
  for (int d0 = 0; d0 < 8; ++d0) qr[d0] = ld8(Qw + d0 * 16);
  const int sr = tid >> 4, sc = (tid & 15) * 8, vst0 = v_st(sr, sc), vst1 = v_st(32 + sr, sc);
  const int vb0 = (int)(uintptr_t)V_lds + v_rd_base(lane);
  struct { bf16x8 vs0, vs1, ks0, ks1; } sr_[SDEPTH];
#define SLOAD(i, k0) do { sr_[i].vs0 = ld8(&Vh[(long)((k0) + sr) * LDK + sc]); sr_[i].vs1 = ld8(&Vh[(long)((k0) + 32 + sr) * LDK + sc]); \
    sr_[i].ks0 = ld8(&Kh[(long)((k0) + sr) * LDK + sc]); sr_[i].ks1 = ld8(&Kh[(long)((k0) + 32 + sr) * LDK + sc]); } while (0)
#define SWRITE(b, i) do { *(bf16x8*)((char*)V_lds + (b) * SHM_V + vst0) = sr_[i].vs0;          \
    *(bf16x8*)((char*)V_lds + (b) * SHM_V + vst1) = sr_[i].vs1; int kc = sc * 2;               \
    *(bf16x8*)((char*)K_lds + (b) * SHM_K + KSWZ(sr, kc)) = sr_[i].ks0;                       \
    *(bf16x8*)((char*)K_lds + (b) * SHM_K + KSWZ(32 + sr, kc)) = sr_[i].ks1; } while (0)
#define SWAIT() do { if constexpr (SDEPTH == 2) asm volatile("s_waitcnt vmcnt(4)" ::: "memory"); else asm volatile("s_waitcnt vmcnt(0)" ::: "memory"); } while (0)
#define RESC(a) do { if (__any((a) < 1.f)) { if (hi == 0) al_l[r32] = (a); asm volatile("s_waitcnt lgkmcnt(0)" ::: "memory"); \
    for (int d = 0; d < 4; ++d) for (int r = 0; r < 16; ++r) o[d][r] *= al_l[crow(r, hi)]; } } while (0)
  f32x16 pA0, pA1, pB0, pB1; float mnA, mnB, alA, alB; bf16x8 pa0, pa1, pa2, pa3; const int NT = seq / KVBLK;
  constexpr int SE = 0, SO = SDEPTH - 1;
  SLOAD(SE, 0); asm volatile("s_waitcnt vmcnt(0)" ::: "memory"); SWRITE(0, SE); __syncthreads();
  qkt(pA0, pA1, K_lds, qr, r32, hi); partialSM(pA0, pA1, m_reg, mnA, alA);
  SLOAD(SO, KVBLK); if constexpr (SDEPTH == 2) { if (2 < NT) SLOAD(SE, 2 * KVBLK); }
  SWAIT(); SWRITE(1, SO); __syncthreads();
  for (int j = 1; j + 1 < NT; j += 2) {
    SBAR(); qkt(pB0, pB1, (bf16_t*)((char*)K_lds + SHM_K), qr, r32, hi);
    finishSM(pA0, pA1, alA, l_reg, pa0, pa1, pa2, pa3); SBAR();
    SLOAD(SO, (j + SDEPTH) * KVBLK); SBAR();
    pv_d0(o, vb0, pa0, pa1, pa2, pa3); partialSM(pB0, pB1, m_reg, mnB, alB);
    __syncthreads(); SWAIT(); SWRITE(0, SE);
    RESC(alB); __syncthreads();
    SBAR(); qkt(pA0, pA1, K_lds, qr, r32, hi);
    finishSM(pB0, pB1, alB, l_reg, pa0, pa1, pa2, pa3); SBAR();
    if (SDEPTH == 1 || j + 3 < NT) SLOAD(SE, (j + 1 + SDEPTH) * KVBLK); SBAR();
    pv_d0(o, vb0 + (int)SHM_V, pa0, pa1, pa2, pa3); partialSM(pA0, pA1, m_reg, mnA, alA);
    __syncthreads(); SWAIT(); SWRITE(1, SO);
    RESC(alA); __syncthreads();
  }
  SBAR(); qkt(pB0, pB1, (bf16_t*)((char*)K_lds + SHM_K), qr, r32, hi);
  finishSM(pA0, pA1, alA, l_reg, pa0, pa1, pa2, pa3); SBAR();
  pv_d0(o, vb0, pa0, pa1, pa2, pa3); partialSM(pB0, pB1, m_reg, mnB, alB);
  __syncthreads(); RESC(alB);
  finishSM(pB0, pB1, alB, l_reg, pa0, pa1, pa2, pa3); SBAR();
  pv_d0(o, vb0 + (int)SHM_V, pa0, pa1, pa2, pa3);
  if (hi == 0) li_l[r32] = l_reg; asm volatile("s_waitcnt lgkmcnt(0)" ::: "memory");
  float rli[16];
#pragma unroll
  for (int r = 0; r < 16; ++r) rli[r] = __builtin_amdgcn_rcpf(li_l[crow(r, hi)]);
  bf16_t* Ow = Ob + (long)(wid * QBLK) * LDO;
#pragma unroll
  for (int r = 0; r < 16; ++r) { int orow = crow(r, hi);
    for (int d0 = 0; d0 < 4; ++d0) Ow[(long)orow * LDO + d0 * 32 + r32] = (bf16_t)f2bf(o[d0][r] * rli[r]); }
  asm volatile("s_waitcnt vmcnt(0) lgkmcnt(0)" ::: "memory");
  __syncthreads();
#undef SLOAD
#undef SWRITE
#undef SWAIT
#undef RESC
}
constexpr size_t SHM_SLOT = 32768, SHM_DMA = 3 * SHM_SLOT + NW * 64 * 4;
#define ATT_WAIT_BAR() asm volatile("s_waitcnt vmcnt(0) lgkmcnt(0)\n\ts_barrier" ::: "memory")
__device__ __forceinline__ void attn_dma_body(const bf16_t* __restrict__ Qb, int ldq, int tpos0, const float* __restrict__ rope, const float* __restrict__ qgain,
                                              const bf16_t* __restrict__ Kh, const bf16_t* __restrict__ Vh, bf16_t* __restrict__ Ob, int seq, char* lds) {
  const int tid = otid(), wid = tid >> 6, lane = tid & 63, r32 = lane & 31, hi = lane >> 5;
  float* ws = (float*)(lds + 3 * SHM_SLOT) + wid * 64; float* li_l = ws; float* al_l = ws + 32;
  float m_reg = -1e30f, l_reg = 0; f32x16 o[4] = {}; bf16x8 qr[8];
  const bf16_t* Qw = Qb + (long)(wid * QBLK + r32) * ldq + hi * 8;
  unsigned koff[2], voff[2];
#pragma unroll
  for (int c = 0; c < 2; ++c) { const int g = c * 512 + tid;
    { const int row = g >> 4, ch = (g & 15) ^ (row & 7); koff[c] = (unsigned)(row * 128 + ch * 8) * 2u; }
    { const int sub = g >> 5, kk = (sub >> 2) * 8 + ((g >> 2) & 7), k = (kk & ~0xC) | ((kk & 4) << 1) | ((kk & 8) >> 1), col = (sub & 3) * 32 + (g & 3) * 8; voff[c] = (unsigned)(k * 128 + col) * 2u; } }
  const unsigned wbase = (unsigned)__builtin_amdgcn_readfirstlane(wid) * 1024u;
  typedef __attribute__((address_space(3))) unsigned lds_u32;
  lds_u32* ldsl = (lds_u32*)(__attribute__((address_space(3))) char*)lds;
#define ATT_DMA(t, slot) do { const char* kt_ = (const char*)Kh + (size_t)(t) * (KVBLK * D * 2); const char* vt_ = (const char*)Vh + (size_t)(t) * (KVBLK * D * 2); \
    _Pragma("unroll") for (int c_ = 0; c_ < 2; ++c_) { \
      __builtin_amdgcn_global_load_lds((const unsigned*)(kt_ + koff[c_]), (lds_u32*)((__attribute__((address_space(3))) char*)ldsl + (slot) * SHM_SLOT + c_ * 8192 + wbase), 16, 0, 0); \
      __builtin_amdgcn_global_load_lds((const unsigned*)(vt_ + voff[c_]), (lds_u32*)((__attribute__((address_space(3))) char*)ldsl + (slot) * SHM_SLOT + 16384 + c_ * 8192 + wbase), 16, 0, 0); } } while (0)
#define RESC(a) do { if (__any((a) < 1.f)) { if (hi == 0) al_l[r32] = (a); asm volatile("s_waitcnt lgkmcnt(0)" ::: "memory"); \
    for (int d = 0; d < 4; ++d) for (int r = 0; r < 16; ++r) o[d][r] *= al_l[crow(r, hi)]; } } while (0)
  const int NT = seq / KVBLK;
  ATT_DMA(0, 0); ATT_DMA(1, 1);
#pragma unroll
  for (int d0 = 0; d0 < 8; ++d0) qr[d0] = ld8(Qw + d0 * 16);
  if (tpos0 >= 0) {
    float ss = 0.f;
#pragma unroll
    for (int d0 = 0; d0 < 8; ++d0)
#pragma unroll
      for (int i = 0; i < 8; ++i) { const float x = bf2f((unsigned)(unsigned short)qr[d0][i]); ss += x * x; }
    { auto rr = __builtin_amdgcn_permlane32_swap(__float_as_uint(ss), __float_as_uint(ss), false, false); ss = __uint_as_float(rr[0]) + __uint_as_float(rr[1]); }
    const float rinv = 1.0f / sqrtf(ss * (1.0f / 128.0f) + RMS_EPS);
    const int t = tpos0 + wid * QBLK + r32;
#pragma unroll
    for (int ax = 0; ax < 2; ++ax) { const int pos = ax ? (t & 63) : (t >> 6);
#pragma unroll
      for (int q = 0; q < 2; ++q) { const int dl = 4 * ax + q, dh = dl + 2, p0 = q * 16 + 8 * hi;
        const float* cp_ = rope + pos * 32 + p0; const float* gl = qgain + dl * 16 + 8 * hi; const float* gh = qgain + dh * 16 + 8 * hi;
        float cs[8], sn[8], lo[8], hv[8];
#pragma unroll
        for (int i = 0; i < 8; ++i) { cs[i] = cp_[i]; sn[i] = cp_[4096 + i];
          lo[i] = bf2f((unsigned)(unsigned short)qr[dl][i]) * rinv * gl[i]; hv[i] = bf2f((unsigned)(unsigned short)qr[dh][i]) * rinv * gh[i]; }
        u32x4 wl, wh;
#pragma unroll
        for (int i = 0; i < 4; ++i) { const float l0 = lo[2 * i] * cs[2 * i] - hv[2 * i] * sn[2 * i], l1 = lo[2 * i + 1] * cs[2 * i + 1] - hv[2 * i + 1] * sn[2 * i + 1];
          const float h0 = hv[2 * i] * cs[2 * i] + lo[2 * i] * sn[2 * i], h1 = hv[2 * i + 1] * cs[2 * i + 1] + lo[2 * i + 1] * sn[2 * i + 1];
          wl[i] = pk2(l0, l1); wh[i] = pk2(h0, h1); }
        qr[dl] = *reinterpret_cast<bf16x8*>(&wl); qr[dh] = *reinterpret_cast<bf16x8*>(&wh); } } }
#pragma unroll
  for (int d0 = 0; d0 < 8; ++d0) asm volatile("" : "+v"(qr[d0]));
  ATT_WAIT_BAR();
  if (2 < NT) ATT_DMA(2, 2);
  const int vb0 = (int)(uintptr_t)lds + 16384 + v_rd_base(lane);
  f32x16 pA0, pA1, pB0, pB1; float mnA, mnB, alA, alB; bf16x8 pa0, pa1, pa2, pa3;
  qkt(pA0, pA1, (const bf16_t*)lds, qr, r32, hi); partialSM(pA0, pA1, m_reg, mnA, alA);
  int sj = 1;
  for (int j = 1; j + 1 < NT; j += 2) {
    { const int sp = sj == 0 ? 2 : sj - 1;
      SBAR(); qkt(pB0, pB1, (const bf16_t*)(lds + sj * SHM_SLOT), qr, r32, hi);
      finishSM(pA0, pA1, alA, l_reg, pa0, pa1, pa2, pa3); SBAR();
      pv_d0(o, vb0 + sp * (int)SHM_SLOT, pa0, pa1, pa2, pa3); partialSM(pB0, pB1, m_reg, mnB, alB);
      ATT_WAIT_BAR();
      if (j + 2 < NT) ATT_DMA(j + 2, sp);
      RESC(alB); }
    { const int s1 = sj == 2 ? 0 : sj + 1;
      SBAR(); qkt(pA0, pA1, (const bf16_t*)(lds + s1 * SHM_SLOT), qr, r32, hi);
      finishSM(pB0, pB1, alB, l_reg, pa0, pa1, pa2, pa3); SBAR();
      pv_d0(o, vb0 + sj * (int)SHM_SLOT, pa0, pa1, pa2, pa3); partialSM(pA0, pA1, m_reg, mnA, alA);
      ATT_WAIT_BAR();
      if (j + 3 < NT) ATT_DMA(j + 3, sj);
      RESC(alA);
      sj = s1 == 2 ? 0 : s1 + 1; }
  }
  { const int sp = sj == 0 ? 2 : sj - 1;
    SBAR(); qkt(pB0, pB1, (const bf16_t*)(lds + sj * SHM_SLOT), qr, r32, hi);
    finishSM(pA0, pA1, alA, l_reg, pa0, pa1, pa2, pa3); SBAR();
    pv_d0(o, vb0 + sp * (int)SHM_SLOT, pa0, pa1, pa2, pa3); partialSM(pB0, pB1, m_reg, mnB, alB);
    RESC(alB);
    finishSM(pB0, pB1, alB, l_reg, pa0, pa1, pa2, pa3); SBAR();
    pv_d0(o, vb0 + sj * (int)SHM_SLOT, pa0, pa1, pa2, pa3); }
  if (hi == 0) li_l[r32] = l_reg; asm volatile("s_waitcnt lgkmcnt(0)" ::: "memory");
  float rli[16];
#pragma unroll
  for (int r = 0; r < 16; ++r) rli[r] = __builtin_amdgcn_rcpf(li_l[crow(r, hi)]);
  bf16_t* Ow = Ob + (long)(wid * QBLK) * LDO;
  asm volatile("s_waitcnt lgkmcnt(0)\n\ts_barrier" ::: "memory");
  { char* st = lds + wid * 8704;
#pragma unroll
    for (int r = 0; r < 16; ++r) { const int orow = crow(r, hi);
#pragma unroll
      for (int d0 = 0; d0 < 4; ++d0) *(bf16_t*)(st + orow * 272 + (d0 * 32 + r32) * 2) = (bf16_t)f2bf(o[d0][r] * rli[r]); }
    asm volatile("s_waitcnt lgkmcnt(0)" ::: "memory");
#pragma unroll
    for (int i = 0; i < 8; ++i) { const int c = i * 64 + lane, row = c >> 4, cc = c & 15; const u32x4 v = *(const u32x4*)(st + row * 272 + cc * 16);
      const bf16_t* gp = Ow + (long)row * LDO + cc * 8;
      asm volatile("global_store_dwordx4 %0, %1, off sc1\n\ts_nop 1" :: "v"(gp), "v"(v) : "memory"); } }
  ATT_WAIT_BAR();
#undef ATT_DMA
#undef RESC
}
#undef KSWZ
}

struct Params {
    const float *x, *c, *ctx, *c_ctx, *w_mod, *b_mod, *ln_g, *ln_b, *w_qkv, *q_gain, *k_gain, *w_o, *w_pool, *pool_scale, *w_router, *router_bias, *w_gate, *w_up, *w_down;
    float* out; unsigned char* ws; int ph_lo, ph_hi;
};

struct TItem { const float* W; bf16_t* WT; int K, N, kind, k0, n0; };
__device__ __forceinline__ int t_drow(int kind, int n) { return kind == 0 ? n : ((n >> 7) * 256 + (kind == 2 ? 128 : 0) + (n & 127)); }
__device__ __forceinline__ void t_load(const TItem& d, f32x4 (&r)[8], int lane) {
    const float* p = d.W + (size_t)(d.k0 + (lane >> 3)) * d.N + d.n0 + (lane & 7) * 4;
#pragma unroll
    for (int i = 0; i < 8; ++i) r[i] = __builtin_nontemporal_load((const f32x4*)(p + (size_t)(8 * i) * d.N));
}
__device__ __forceinline__ void t_store(const TItem& d, const f32x4 (&r)[8], LAS float* scr, int lane) {
#pragma unroll
    for (int i = 0; i < 8; ++i) *(LAS f32x4*)(scr + (8 * i + (lane >> 3)) * 32 + (((lane & 7) * 4 + 8 * i) & 31)) = r[i];
    LDS_WAIT(); asm volatile("" ::: "memory");
    const int c = lane >> 3, nl = lane & 7;
#pragma unroll
    for (int j = 0; j < 4; ++j) { const int n = nl + 8 * j; const LAS float* s = scr + (8 * c) * 32 + ((n + 8 * c) & 31);
        v4u o; o.x = pk2(s[0 * 32], s[1 * 32]); o.y = pk2(s[2 * 32], s[3 * 32]); o.z = pk2(s[4 * 32], s[5 * 32]); o.w = pk2(s[6 * 32], s[7 * 32]);
        __builtin_nontemporal_store(o, (GAS v4u*)(d.WT + (size_t)t_drow(d.kind, d.n0 + n) * d.K + d.k0 + 8 * c)); }
    LDS_WAIT(); asm volatile("" ::: "memory");
}

__device__ __forceinline__ void mod_prepare(const float* cl, const float* cc, LAS float* sv, int tid) {
    for (int i = tid; i < 3 * DM; i += 512) { const int cd = i >> 11, k = i & 2047; const float v = (cd < 2) ? cl[cd * DM + k] : cc[k]; sv[i] = v / (1.0f + expf(-v)); }
    __syncthreads();
}
__device__ __forceinline__ void mod_item(int it, const float* wm, const float* bm, float* MOD, const LAS float* sv, LAS float* red, int tid, int lane, int wave) {
    const int c4 = lane & 7, kr = (lane >> 3) + 8 * wave;
    const int l = it / 384, nb = it % 384; const float* W = wm + (size_t)l * DM * 12288 + nb * 32 + c4 * 4;
    f32x4 a0 = {0, 0, 0, 0}, a1 = a0, a2 = a0;
#pragma unroll 16
    for (int s = 0; s < 32; ++s) { const int k = s * 64 + kr; const f32x4 w = *(const f32x4*)(W + (size_t)k * 12288);
        a0 += w * sv[k]; a1 += w * sv[DM + k]; a2 += w * sv[2 * DM + k]; }
    *(LAS f32x4*)(red + (kr * 3 + 0) * 32 + c4 * 4) = a0; *(LAS f32x4*)(red + (kr * 3 + 1) * 32 + c4 * 4) = a1; *(LAS f32x4*)(red + (kr * 3 + 2) * 32 + c4 * 4) = a2;
    __syncthreads();
    if (tid < 96) { const int cd = tid >> 5, n = tid & 31; float s = 0.f; for (int r = 0; r < 64; ++r) s += red[(r * 3 + cd) * 32 + n];
        MOD[((size_t)l * 3 + cd) * 12288 + nb * 32 + n] = s + bm[l * 12288 + nb * 32 + n]; }
    __syncthreads();
}

typedef const __attribute__((address_space(4))) Params CParams;
__device__ __forceinline__ CParams* kparams() { CParams* k = (CParams*)__builtin_amdgcn_kernarg_segment_ptr(); asm volatile("" : "+s"(k)); return k; }
#define WSP(T, off) ((T*)(kp->ws + (off)))


#define IN(k) (lo <= (k) && (k) < hi)
#define NREP(k) (1 + ((REP_MASK >> (k)) & 1))
#define SEAM(k) do { if (IN(k) && IN((k) + 1)) xcd_barrier(bar); } while (0)
#define TIDS const int tid = otid(), lane = tid & 63, wave = __builtin_amdgcn_readfirstlane(tid >> 6), G = ogrid(), bx = obid(), gw = bx * 8 + wave, NGW = G * 8; (void)lane; (void)gw; (void)NGW


template <int layer>
__device__ __forceinline__ void layer_half(const int lo, const int hi, const XcdBarrier& bar, LAS unsigned char* L, LAS int* tcnt, LAS int* tbase, LAS int* texp) {
        const int P6 = 6 + 7 * layer;
        if (IN(P6)) _Pragma("unroll 1") for (int rep_ = 0; rep_ < NREP(6); ++rep_) {
            CParams* kp = kparams(); TIDS;
            const int row_lo = layer == 0 ? 0 : NCTX;
            const float* modl = WSP(float, WS_MOD) + (size_t)layer * 3 * 12288;
            unsigned* cnt = WSP(unsigned, WS_CTL) + CW_CNT + layer * 1024;
            const bf16_t* Y = WSP(bf16_t, WS_Y); float* X1 = WSP(float, WS_X1); bf16_t* Hb = WSP(bf16_t, WS_H);
            const float* xlat = kp->x; const float* xctx = kp->ctx; const bf16_t* X2b = WSP(bf16_t, WS_X2);
            const float* pscale = kp->pool_scale;
            int* LIST = WSP(int, WS_LIST); float* LISTG = WSP(float, WS_LIST) + (size_t)32 * MT;
            const float* rbias = kp->router_bias;
            LAS bf16_t* hp = (LAS bf16_t*)L;
            LAS float* part = (LAS float*)(L + 65536);
            LAS int* lcnt = (LAS int*)(L + 65536 + 8192); LAS int* lbase = lcnt + 32;
            LAS int* asg = (LAS int*)(L + 65536 + 8192 + 256);
            LAS float* vG1 = (LAS float*)(L + 82176); LAS float* vLG = vG1 + DM; LAS float* vLB = vLG + DM; LAS float* vSC = vLB + DM; LAS float* vSH = vSC + DM;
            const float* lg = kp->ln_g + (size_t)(layer * 2 + 0) * DM; const float* lb = kp->ln_b + (size_t)(layer * 2 + 0) * DM;
            const int ngrp = (MT - row_lo) / 8;
            const bool agg = ((ngrp + G - 1) / G) * 16 <= 512;
            if (tid < 32) lcnt[tid] = 0;
            const int ti = lane & 31, hi = lane >> 5;
            const bf16_t* w1p = WSP(bf16_t, WS_WR) + ((size_t)(wave * 16) * 64 + lane) * 8; const bf16_t* w2p = w1p + 32 * DM;
            const LAS bf16_t* a1p = hp + (ti & 7) * DM + wave * 256 + 8 * hi; const LAS bf16_t* a2p = a1p + 8 * DM;
            f32x4 xv[8]; v2u xb[8], yv[8];
#define P6_LOAD(grp_) do { const int row_ = row_lo + (grp_) * 8 + wave; const float* xr_ = (row_ < NCTX) ? xctx + (size_t)row_ * DM : xlat + (size_t)(row_ - NCTX) * DM; const bf16_t* yr_ = Y + (size_t)row_ * DM; const bf16_t* xb_ = X2b + (size_t)row_ * DM; \
                _Pragma("unroll") for (int j = 0; j < 8; ++j) { if (layer == 0) xv[j] = *(const f32x4*)(xr_ + (j * 64 + lane) * 4); else xb[j] = *(const v2u*)(xb_ + (j * 64 + lane) * 4); yv[j] = *(const v2u*)(yr_ + (j * 64 + lane) * 4); } } while (0)
            LAS int* rdy = (LAS int*)(L + 124928); unsigned* yd = WSP(unsigned, WS_CTL) + CW_YD; volatile LAS unsigned* MISC = (volatile LAS unsigned*)(L + MISC_OFF);
            const bool dyn = (layer == 0) && (G % 2 == 0); const int pcls = bx & 1; unsigned* q6 = WSP(unsigned, WS_CTL) + CW_P6Q + 32 * pcls;
            auto gmap = [&](unsigned pos) -> int { return pos >= 1056u ? -1 : (pos < 32u ? pcls * 32 + (int)pos : 64 + pcls * 1024 + ((int)pos - 32)); };
            auto seq = [&](int k) -> int { const int g_ = bx + k * G; return g_ < ngrp ? g_ : -1; };
            auto ensure = [&](int g_) { if (layer == 0) { const int pm_ = g_ < 64 ? (g_ >> 5) : 2 + ((g_ - 64) >> 5); if (!rdy[pm_]) { while (xb_ld(yd + 32 * pm_) < 8u) __builtin_amdgcn_s_sleep(4); asm volatile("" ::: "memory"); } } };
            if (layer == 0) { if (tid < 66) rdy[tid] = xb_ld(yd + 32 * tid) >= 8u ? 1 : 0;
                if (tid == 0) { __builtin_amdgcn_fence(__ATOMIC_ACQUIRE, "agent"); asm volatile("s_waitcnt vmcnt(0)" ::: "memory");
                    if (dyn) { MISC[36] = xb_add(q6, 1u); MISC[37] = xb_add(q6, 1u); } }
                __syncthreads(); }
            int grp = dyn ? gmap(MISC[36]) : seq(0), nxt_ = dyn ? gmap(MISC[37]) : seq(1);
            if (grp >= 0) ensure(grp);
            P6_LOAD(grp >= 0 ? grp : 0);
            int it_ = 0, cur_cd = -1;
            for (; grp >= 0; ++it_) {
                unsigned tk2 = 0xffffffffu;
                if (dyn && tid == 0 && nxt_ >= 0 && it_ + 2 < 32) tk2 = xb_add(q6, 1u);
                const int row = row_lo + grp * 8 + wave; const int cd = row_cond(row_lo + grp * 8);
                if (cd != cur_cd) {
                    const float* g1 = modl + (size_t)cd * 12288 + 2 * DM;
                    float t0[4], t1[4], t2[4], t3[4], t4[4], t5[4];
                    __syncthreads();
#pragma unroll
                    for (int q = 0; q < 4; ++q) { const int i = tid + q * 512; t0[q] = g1[i]; t1[q] = (layer == 1) ? pscale[i] : 1.0f; t2[q] = lg[i]; t3[q] = lb[i]; t4[q] = g1[DM + i]; t5[q] = g1[2 * DM + i]; }
#pragma unroll
                    for (int q = 0; q < 4; ++q) { const int i = tid + q * 512; vG1[i] = t0[q] * t1[q]; vLG[i] = t2[q]; vLB[i] = t3[q]; vSH[i] = t4[q]; vSC[i] = t5[q] + 1.0f; }
                    cur_cd = cd; __syncthreads(); }
                f32x4 v[8]; float s = 0.f;
#pragma unroll
                for (int j = 0; j < 8; ++j) { const int c = (j * 64 + lane) * 4; const f32x4 gv = *(const LAS f32x4*)(vG1 + c);
                    const f32x4 yf = {bf2f(yv[j].x & 0xffffu), bf2f(yv[j].x >> 16), bf2f(yv[j].y & 0xffffu), bf2f(yv[j].y >> 16)};
                    const f32x4 xf = (layer == 0) ? xv[j] : bf4(xb[j]);
                    v[j] = xf * ALPHA + gv * yf; s += (v[j][0] + v[j][1]) + (v[j][2] + v[j][3]); }
                if (nxt_ >= 0) { ensure(nxt_); P6_LOAD(nxt_); }
                const float mean = wave_sum(s) * (1.0f / DM); float s2 = 0.f;
#pragma unroll
                for (int j = 0; j < 8; ++j) { v[j] = v[j] - mean; s2 += (v[j][0] * v[j][0] + v[j][1] * v[j][1]) + (v[j][2] * v[j][2] + v[j][3] * v[j][3]); }
                const float rstd = 1.0f / sqrtf(wave_sum(s2) * (1.0f / DM) + LN_EPS);
#pragma unroll
                for (int j = 0; j < 8; ++j) { const int c = (j * 64 + lane) * 4;
                    const f32x4 x1 = v[j] * rstd * *(const LAS f32x4*)(vLG + c) + *(const LAS f32x4*)(vLB + c);
                    { v2u xw; xw.x = pk2(x1[0], x1[1]); xw.y = pk2(x1[2], x1[3]); *(v2u*)((bf16_t*)X1 + (size_t)row * DM + c) = xw; }
                    const f32x4 hv = x1 * *(const LAS f32x4*)(vSC + c) + *(const LAS f32x4*)(vSH + c);
                    v2u w; w.x = pk2(hv[0], hv[1]); w.y = pk2(hv[2], hv[3]); *(v2u*)(Hb + (size_t)row * DM + c) = w;
                    v2u w2; w2.x = pk2(hv[0] - bf2f(w.x & 0xffffu), hv[1] - bf2f(w.x >> 16)); w2.y = pk2(hv[2] - bf2f(w.y & 0xffffu), hv[3] - bf2f(w.y >> 16));
                    *(LAS v2u*)(hp + wave * DM + c) = w; *(LAS v2u*)(hp + (8 + wave) * DM + c) = w2; }
                const bf16_t* w1q = w1p; asm volatile("" : "+v"(w1q));
                const bf16_t* w2q = w1q + 32 * DM;
                bf16x8 wA1[4], wA2[4], wB1[4], wB2[4];
#define P6_WLOAD(d1, d2, q0) do { _Pragma("unroll") for (int q_ = 0; q_ < 4; ++q_) { d1[q_] = *(const bf16x8*)(w1q + ((q0) + q_) * 512); d2[q_] = *(const bf16x8*)(w2q + ((q0) + q_) * 512); } } while (0)
#define P6_MMA(s1, s2, q0) do { _Pragma("unroll") for (int q_ = 0; q_ < 4; ++q_) { const bf16x8 a1 = *(const LAS bf16x8*)(a1p + ((q0) + q_) * 16), a2 = *(const LAS bf16x8*)(a2p + ((q0) + q_) * 16); \
                    acc = __builtin_amdgcn_mfma_f32_32x32x16_bf16(a1, s1[q_], acc, 0, 0, 0); acc = __builtin_amdgcn_mfma_f32_32x32x16_bf16(a1, s2[q_], acc, 0, 0, 0); acc = __builtin_amdgcn_mfma_f32_32x32x16_bf16(a2, s1[q_], acc, 0, 0, 0); } } while (0)
                P6_WLOAD(wA1, wA2, 0); P6_WLOAD(wB1, wB2, 4);
                __syncthreads();
                {
                    f32x16 acc = {};
                    __builtin_amdgcn_sched_barrier(0); P6_MMA(wA1, wA2, 0); __builtin_amdgcn_sched_barrier(0);
                    P6_WLOAD(wA1, wA2, 8); __builtin_amdgcn_sched_barrier(0); P6_MMA(wB1, wB2, 4); __builtin_amdgcn_sched_barrier(0);
                    P6_WLOAD(wB1, wB2, 12); __builtin_amdgcn_sched_barrier(0); P6_MMA(wA1, wA2, 8); __builtin_amdgcn_sched_barrier(0);
                    P6_MMA(wB1, wB2, 12);
#pragma unroll
                    for (int r = 0; r < 4; ++r) part[(wave * 8 + r + 4 * hi) * 32 + ti] = acc[r];
                }
                if (dyn && tid == 0) MISC[38] = tk2;
                __syncthreads();
                {
                    const int rr = row_lo + grp * 8 + wave, e = lane & 31; float lgt = 0.f;
#pragma unroll
                    for (int k = 0; k < 8; ++k) lgt += part[(k * 8 + wave) * 32 + e];
                    const float aff = 1.0f / (1.0f + expf(-lgt)); const float sel = aff + rbias[e];
                    const float o1 = dppf<0xB1>(sel), mx1 = fmaxf(sel, o1), mn1 = fminf(sel, o1);
                    const float mx2 = dppf<0x4E>(mx1), mn2 = dppf<0x4E>(mn1);
                    float gs = fmaxf(mx1, mx2) + fmaxf(fminf(mx1, mx2), fmaxf(mn1, mn2)); int bg = e >> 2;
                    { const float og = dppf<0x141>(gs); const int ob = dppi<0x141>(bg); if (og > gs || (og == gs && ob < bg)) { gs = og; bg = ob; } }
                    { const float og = dppf<0x140>(gs); const int ob = dppi<0x140>(bg); if (og > gs || (og == gs && ob < bg)) { gs = og; bg = ob; } }
                    { const auto rg = __builtin_amdgcn_permlane16_swap(__float_as_uint(gs), __float_as_uint(gs), false, false); const auto rb = __builtin_amdgcn_permlane16_swap((unsigned)bg, (unsigned)bg, false, false);
                      const bool odd = (lane & 16) != 0; const float og = __uint_as_float(odd ? rg[0] : rg[1]); const int ob = (int)(odd ? rb[0] : rb[1]); if (og > gs || (og == gs && ob < bg)) { gs = og; bg = ob; } }
                    const int bgs = __builtin_amdgcn_readfirstlane(bg);
                    float s4[4], a4[4];
#pragma unroll
                    for (int j = 0; j < 4; ++j) { s4[j] = __uint_as_float((unsigned)__builtin_amdgcn_readlane((int)__float_as_uint(sel), bgs * 4 + j)); a4[j] = __uint_as_float((unsigned)__builtin_amdgcn_readlane((int)__float_as_uint(aff), bgs * 4 + j)); }
                    int i0 = 0; float m0 = s4[0], g0 = a4[0];
#pragma unroll
                    for (int j = 1; j < 4; ++j) if (s4[j] > m0) { m0 = s4[j]; i0 = j; g0 = a4[j]; }
                    int i1 = -1; float m1 = -1e30f, g1_ = 0.f;
#pragma unroll
                    for (int j = 0; j < 4; ++j) if (j != i0 && s4[j] > m1) { m1 = s4[j]; i1 = j; g1_ = a4[j]; }
                    const int e0 = __builtin_amdgcn_readfirstlane(bg * 4 + i0), e1 = __builtin_amdgcn_readfirstlane(bg * 4 + i1);
                    const float inv = 1.0f / (g0 + g1_);
                    if (lane == 0 && rep_ == 0) {
                        if (agg) { const int q0 = __hip_atomic_fetch_add(&lcnt[e0], 1, __ATOMIC_RELAXED, __HIP_MEMORY_SCOPE_WORKGROUP), q1 = __hip_atomic_fetch_add(&lcnt[e1], 1, __ATOMIC_RELAXED, __HIP_MEMORY_SCOPE_WORKGROUP);
                            LAS int* ap = asg + (it_ * 8 + wave) * 8;
                            ap[0] = e0; ap[1] = q0; ap[2] = rr * 2; ap[3] = (int)__float_as_uint(g0 * inv); ap[4] = e1; ap[5] = q1; ap[6] = rr * 2 + 1; ap[7] = (int)__float_as_uint(g1_ * inv);
                        } else {
                            const unsigned p0 = __hip_atomic_fetch_add(&cnt[e0 * 32], 1u, RLX_AGENT), p1 = __hip_atomic_fetch_add(&cnt[e1 * 32], 1u, RLX_AGENT);
                            LIST[(size_t)e0 * MT + p0] = rr * 2; LISTG[(size_t)e0 * MT + p0] = g0 * inv;
                            LIST[(size_t)e1 * MT + p1] = rr * 2 + 1; LISTG[(size_t)e1 * MT + p1] = g1_ * inv; } }
                }
                grp = nxt_; nxt_ = dyn ? gmap(MISC[38]) : seq(it_ + 2);
            }
#undef P6_LOAD
#undef P6_WLOAD
#undef P6_MMA
            __syncthreads();
            if (agg && rep_ == 0) {
                if (tid < 32) lbase[tid] = (int)__hip_atomic_fetch_add(&cnt[tid * 32], (unsigned)lcnt[tid], RLX_AGENT);
                __syncthreads();
                for (int i = tid; i < it_ * 16; i += 512) { const int e = asg[i * 4], q = asg[i * 4 + 1], src = asg[i * 4 + 2]; const float gt = __uint_as_float((unsigned)asg[i * 4 + 3]);
                    const size_t o = (size_t)e * MT + (size_t)(lbase[e] + q); LIST[o] = src; LISTG[o] = gt; }
            }
            __syncthreads();
        }
        SEAM(P6);
        int NT = 0;
        if (IN(P6 + 1) || IN(P6 + 2) || IN(P6 + 3)) {
            CParams* kp = kparams(); unsigned* cnt = WSP(unsigned, WS_CTL) + CW_CNT + layer * 1024;
            const int ttid = otid();
            if (ttid < 64) { const int ln = ttid, e = ln & 31; const int c = (int)__hip_atomic_load(&cnt[e * 32], RLX_AGENT); const int nt_ = (c + 255) >> 8; int inc = nt_;
#pragma unroll
                for (int o = 1; o < 32; o <<= 1) { const int t_ = __shfl_up(inc, o); if ((ln & 31) >= o) inc += t_; }
                if (ln < 32) { tcnt[e] = c; tbase[e] = inc - nt_; if (e == 31) tbase[32] = inc; for (int t_ = inc - nt_; t_ < inc; ++t_) texp[t_] = e; } }
            __syncthreads();
            NT = __builtin_amdgcn_readfirstlane(tbase[32]);
        }
        if (IN(P6 + 2)) _Pragma("unroll 1") for (int rep_ = 0; rep_ < NREP(8); ++rep_) {
            CParams* kp = kparams();
            typedef pg8::SchedMoe<256u * DM * 2u, 256u * DM * 2u, 2048u * DM * 2u, DM / 64, true> Sch;
            LAS int* rt = (LAS int*)(L + TAB_OFF + 1024);
            pg8::Gemm g{DM, DM, DM}; Sch S; S.o.init(NT, 8, ogrid(), obid()); S.A = WSP(const char, WS_H); S.B = WSP(const char, WS_WGU) + (size_t)layer * 32 * 2048 * DM * 2;
            S.texp = texp; S.tbase = tbase; S.tcnt = tcnt; S.rt = rt; S.list = WSP(int, WS_LIST); S.ctr = WSP(unsigned, WS_CTL) + CW_GUD + layer * 8192;
            S.fill_rows(rt, otid());
            pg8::EpiGateUp E{WSP(bf16_t, WS_ACT)};
            pg8::gemm_phase<pg8::EpiGateUp, Sch, true, true>(L, g, S, E);
        }
        if (IN(P6 + 2)) _Pragma("unroll 1") for (int rep_ = 0; rep_ < NREP(9); ++rep_) {
            CParams* kp = kparams();
            typedef pg8::SchedMoe<256u * DE * 2u, 256u * DE * 2u, (unsigned)DM * DE * 2u, DE / 64, false> Sch;
            pg8::Gemm g{DE, DE, DE}; Sch S; S.o.init(NT, 8, ogrid(), obid()); S.o.rot = 1; S.rem = (NT * 8) % ogrid(); S.nl = ogrid() - S.rem; S.A = WSP(const char, WS_ACT); S.B = WSP(const char, WS_WD) + (size_t)layer * 32 * DM * DE * 2;
            LAS int* rt = (LAS int*)(L + TAB_OFF + 1024);
            S.texp = texp; S.tbase = tbase; S.tcnt = tcnt; S.rt = nullptr; S.list = WSP(int, WS_LIST); S.ctr = WSP(unsigned, WS_CTL) + CW_GUD + layer * 8192;
            if (otid() == 0) { __builtin_amdgcn_fence(__ATOMIC_ACQUIRE, "agent"); asm volatile("s_waitcnt vmcnt(0)" ::: "memory"); }
            S.fill_dst(rt, WSP(float, WS_LIST) + (size_t)32 * MT, otid());
            pg8::EpiDown E{WSP(bf16_t, WS_FB), rt};
            pg8::gemm_phase<pg8::EpiDown, Sch, true, false>(L, g, S, E);
        }
        SEAM(P6 + 3);
        if (IN(P6 + 4)) _Pragma("unroll 1") for (int rep_ = 0; rep_ < NREP(10); ++rep_) {
            CParams* kp = kparams(); TIDS;
            const int row_lo = layer == 0 ? 0 : NCTX;
            const float* modl = WSP(float, WS_MOD) + (size_t)layer * 3 * 12288; const float* X1 = WSP(float, WS_X1); const bf16_t* FB = WSP(bf16_t, WS_FB);
            float* dstb = kp->out - (size_t)NCTX * DM; bf16_t* X2b = WSP(bf16_t, WS_X2);
            LAS float* vG2 = (LAS float*)L; LAS float* vLG = vG2 + 3 * DM; LAS float* vLB = vLG + DM;
            { const float* lg = kp->ln_g + (size_t)(layer * 2 + 1) * DM; const float* lb = kp->ln_b + (size_t)(layer * 2 + 1) * DM;
              float t0[12], t1[4], t2[4];
#pragma unroll
              for (int q = 0; q < 12; ++q) { const int i = tid + q * 512; t0[q] = modl[(size_t)(i >> 11) * 12288 + 5 * DM + (i & 2047)]; }
#pragma unroll
              for (int q = 0; q < 4; ++q) { const int i = tid + q * 512; t1[q] = lg[i]; t2[q] = lb[i]; }
#pragma unroll
              for (int q = 0; q < 12; ++q) vG2[tid + q * 512] = t0[q];
#pragma unroll
              for (int q = 0; q < 4; ++q) { vLG[tid + q * 512] = t1[q]; vLB[tid + q * 512] = t2[q]; } }
            __syncthreads();
            f32x4 xa[8]; v2u fa[8], fb[8];
#define P10_LOAD(row_) do { const float* xr_ = X1 + (size_t)(row_) * DM; const bf16_t* xb_ = (const bf16_t*)X1 + (size_t)(row_) * DM; const bf16_t* f0_ = FB + (size_t)((row_) * 2) * DM; \
                _Pragma("unroll") for (int j = 0; j < 8; ++j) { const int c = (j * 64 + lane) * 4; \
                    { const v2u q_ = *(const v2u*)(xb_ + c); xa[j] = (f32x4){bf2f(q_.x & 0xffffu), bf2f(q_.x >> 16), bf2f(q_.y & 0xffffu), bf2f(q_.y >> 16)}; } \
                    fa[j] = *(const v2u*)(f0_ + c); fb[j] = *(const v2u*)(f0_ + DM + c); } } while (0)
            { const int r0 = row_lo + gw; P10_LOAD(r0 < MT ? r0 : row_lo); }
            for (int row = row_lo + gw; row < MT; row += NGW) { const int cd = row_cond(row);
                f32x4 v[8]; float s = 0.f;
#pragma unroll
                for (int j = 0; j < 8; ++j) { const int c = (j * 64 + lane) * 4;
                    const f32x4 fs = {bf2f(fa[j].x & 0xffffu) + bf2f(fb[j].x & 0xffffu), bf2f(fa[j].x >> 16) + bf2f(fb[j].x >> 16), bf2f(fa[j].y & 0xffffu) + bf2f(fb[j].y & 0xffffu), bf2f(fa[j].y >> 16) + bf2f(fb[j].y >> 16)};
                    v[j] = xa[j] * ALPHA + *(const LAS f32x4*)(vG2 + cd * DM + c) * fs; s += (v[j][0] + v[j][1]) + (v[j][2] + v[j][3]); }
                if (row + NGW < MT) P10_LOAD(row + NGW);
                const float mean = wave_sum(s) * (1.0f / DM); float s2 = 0.f;
#pragma unroll
                for (int j = 0; j < 8; ++j) { v[j] = v[j] - mean; s2 += (v[j][0] * v[j][0] + v[j][1] * v[j][1]) + (v[j][2] * v[j][2] + v[j][3] * v[j][3]); }
                const float rstd = 1.0f / sqrtf(wave_sum(s2) * (1.0f / DM) + LN_EPS);
                float* dst = dstb + (size_t)row * DM;
#pragma unroll
                for (int j = 0; j < 8; ++j) { const int c = (j * 64 + lane) * 4; const f32x4 r_ = v[j] * rstd * *(const LAS f32x4*)(vLG + c) + *(const LAS f32x4*)(vLB + c);
                    if (layer == 0) { v2u w; w.x = pk2(r_[0], r_[1]); w.y = pk2(r_[2], r_[3]); *(v2u*)(X2b + (size_t)row * DM + c) = w; } else *(f32x4*)(dst + c) = r_; } }
#undef P10_LOAD
            __syncthreads();
        }
        if constexpr (layer == 0) {
            SEAM(10);
            if (IN(11)) _Pragma("unroll 1") for (int rep_ = 0; rep_ < NREP(11); ++rep_) {
                CParams* kp = kparams(); TIDS;
                const bf16_t* X2 = WSP(bf16_t, WS_X2); bf16_t* DP = WSP(bf16_t, WS_DP);
                const float* sc1 = WSP(float, WS_MOD) + (size_t)3 * 12288 + DM;
                const int c = tid * 4, gch = c >> 9, hw = 1 << gch;
                for (int chunk = bx; chunk < NLAT / 64; chunk += G) { const int b = chunk >> 7, t0 = (chunk & 127) * 64;
                    const bf16_t* base = X2 + ((size_t)NCTX + (size_t)b * SEQ) * DM + c; bf16_t* dbase = DP + ((size_t)NCTX + (size_t)b * SEQ) * DM + c;
                    const f32x4 a1 = *(const f32x4*)(sc1 + (size_t)b * 12288 + c) + 1.0f;
                    f32x4 s = {0, 0, 0, 0};
                    { v2u wv[16];
#pragma unroll
                      for (int q = 0; q < 16; ++q) { const int p_ = t0 - 8 + q; wv[q] = *(const v2u*)(base + (size_t)(p_ < 0 ? 0 : p_) * DM); }
#pragma unroll
                      for (int q = 0; q < 16; ++q) { const int p_ = t0 - 8 + q; const bool in_ = p_ >= 0 && p_ >= t0 - hw && p_ < t0 + hw; s += bf4(wv[q]) * (in_ ? 1.0f : 0.0f); } }
#pragma unroll 8
                    for (int i = 0; i < 64; ++i) { const int t = t0 + i; const int tn = t + hw, to = t - hw;
                        const f32x4 xc = bf4(*(const v2u*)(base + (size_t)t * DM));
                        const f32x4 xn = bf4(*(const v2u*)(base + (size_t)(tn < SEQ ? tn : SEQ - 1) * DM)), xo = bf4(*(const v2u*)(base + (size_t)(to >= 0 ? to : 0) * DM));
                        const int lo_ = to < 0 ? 0 : to, hi_ = tn > SEQ ? SEQ : tn;
                        const f32x4 d = a1 * (s * (1.0f / (float)(hi_ - lo_)) - xc);
                        v2u w; w.x = pk2(d[0], d[1]); w.y = pk2(d[2], d[3]); *(v2u*)(dbase + (size_t)t * DM) = w;
                        s = s + xn * (tn < SEQ ? 1.0f : 0.0f) - xo * (to >= 0 ? 1.0f : 0.0f); }
                }
            }
            SEAM(11);
            if (IN(12)) _Pragma("unroll 1") for (int rep_ = 0; rep_ < NREP(12); ++rep_) {
                CParams* kp = kparams();
                pg8::Gemm g{DM, 512, 512}; pg8::SchedPool S; S.o.init(NLAT / 256, 8, ogrid(), obid()); S.A = WSP(const char, WS_DP); S.B = WSP(const char, WS_WPOOL);
                pg8::EpiBf16 E{WSP(bf16_t, WS_Y), DM, nullptr};
                pg8::gemm_phase<pg8::EpiBf16, pg8::SchedPool, true, false>(L, g, S, E);
            }
            SEAM(12);
        }
    }

__global__ void __launch_bounds__(512, 2) mk_fwd(Params p_unused) {
    extern __shared__ __attribute__((aligned(16))) unsigned char lds[];
    LAS unsigned char* L = (LAS unsigned char*)lds;
    volatile LAS unsigned* MISC = (volatile LAS unsigned*)(L + MISC_OFF);
    LAS int* tcnt = (LAS int*)(L + TAB_OFF); LAS int* tbase = tcnt + 32; LAS int* texp = tcnt + 80;
    if (threadIdx.x < 64) MISC[threadIdx.x] = 0u;
    __syncthreads();
    int lo, hi; XcdBarrier bar;
    { CParams* kp = kparams(); lo = kp->ph_lo; hi = kp->ph_hi; unsigned* bw = (unsigned*)(kp->ws + WS_CTL) + CW_BAR;
      bar.bar = bw; bar.x = 0; bar.st = nullptr; if (hi - lo > 1) bar = xcd_barrier_post(bw, MISC + 8); }
    if (IN(0)) _Pragma("unroll 1") for (int rep_ = 0; rep_ < NREP(0); ++rep_) {
        CParams* kp = kparams(); TIDS;
        float* MOD = WSP(float, WS_MOD); float* ROPE = WSP(float, WS_ROPE);
        for (int i = bx * 512 + tid; i < 4096; i += G * 512) { const int pos = i >> 5, pp = i & 31;
            const float inv = exp2f(-(float)pp * (13.287712379549449f / 32.0f)); const float ang = (float)pos * inv;
            float sn, cs; sincosf(ang, &sn, &cs); ROPE[i] = cs; ROPE[4096 + i] = sn; }
        { const float* wrt = kp->w_router; bf16_t* WR = WSP(bf16_t, WS_WR);
          for (int i = bx * 512 + tid; i < 32 * DM; i += G * 512) { const int ii = i & 7, ln = (i >> 3) & 63, kq = (i >> 9) & 15, w = i >> 13; const int e = ln & 31, k = w * 256 + kq * 16 + 8 * (ln >> 5) + ii;
              const float wv = wrt[k * 32 + e]; const unsigned h1 = f2bf(wv); const unsigned h2 = f2bf(wv - bf2f(h1)); WR[i] = (bf16_t)h1; WR[32 * DM + i] = (bf16_t)h2; } }
        {
            LAS float* sv = (LAS float*)L;
            LAS float* red = (LAS float*)(L + 32768);
            mod_prepare(kp->c, kp->c_ctx, sv, tid);
            for (int it = bx; it < 384; it += G) mod_item(it, kp->w_mod, kp->b_mod, MOD, sv, red, tid, lane, wave);
        }
        {
            LAS float* scr = (LAS float*)(L + wave * 16384);
            constexpr int I_QKV = (DM / 64) * (QKVD / 32), I_O = (DM / 64) * (DM / 32), I_P = (512 / 64) * (512 / 32), I_G = (DM / 64) * (DE / 32), I_D = (DE / 64) * (DM / 32);
            constexpr int NITEMS = I_QKV + I_O + 4 * I_P;
            (void)I_G; (void)I_D;
            auto decode = [&](int it) { TItem d; int r = it;
                if (r < I_QKV) { d.W = kp->w_qkv; d.WT = WSP(bf16_t, WS_WQKV); d.K = DM; d.N = QKVD; d.kind = 0; }
                else if ((r -= I_QKV) < I_O) { d.W = kp->w_o; d.WT = WSP(bf16_t, WS_WO); d.K = DM; d.N = DM; d.kind = 0; }
                else { r -= I_O; const int g = r / I_P; r -= g * I_P; d.W = kp->w_pool + (size_t)g * 512 * 512; d.WT = WSP(bf16_t, WS_WPOOL) + (size_t)g * 512 * 512; d.K = 512; d.N = 512; d.kind = 0; }
                const int nblk = d.N / 32; d.k0 = 64 * (r / nblk); d.n0 = 32 * (r % nblk); return d; };
            for (int it = gw; it < NITEMS; it += 2 * NGW) {
                const TItem d0 = decode(it); f32x4 ra[8], rb[8]; t_load(d0, ra, lane);
                const bool two = it + NGW < NITEMS; TItem d1 = d0; if (two) { d1 = decode(it + NGW); t_load(d1, rb, lane); }
                t_store(d0, ra, scr, lane); if (two) t_store(d1, rb, scr, lane);
            }
        }
        __syncthreads();
    }
    SEAM(0);

    if (IN(1)) _Pragma("unroll 1") for (int rep_ = 0; rep_ < NREP(1); ++rep_) {
        CParams* kp = kparams(); TIDS;
        const float* MOD = WSP(float, WS_MOD); bf16_t* U = WSP(bf16_t, WS_U); const float* xl = kp->x; const float* xc = kp->ctx;
        const int R = (MT + NGW - 1) / NGW, r0 = gw * R, r1 = (r0 + R) < MT ? (r0 + R) : MT;
        f32x4 sa[8], sb[8], xv[8]; int cur = -1;
#define P1_LOAD(row_) do { const float* xr_ = ((row_) < NCTX) ? xc + (size_t)(row_) * DM : xl + (size_t)((row_) - NCTX) * DM; _Pragma("unroll") for (int j = 0; j < 8; ++j) xv[j] = *(const f32x4*)(xr_ + (j * 64 + lane) * 4); } while (0)
        if (r0 < r1) P1_LOAD(r0); else P1_LOAD(0);
        for (int row = r0; row < r1; ++row) { const int cd = row_cond(row);
            if (cd != cur) { const float* sh = MOD + (size_t)cd * 12288; const float* sc = sh + DM;
#pragma unroll
                for (int j = 0; j < 8; ++j) { const int c = (j * 64 + lane) * 4; sa[j] = *(const f32x4*)(sc + c) + 1.0f; sb[j] = *(const f32x4*)(sh + c); }
                cur = cd; }
            f32x4 o[8];
#pragma unroll
            for (int j = 0; j < 8; ++j) o[j] = xv[j] * sa[j] + sb[j];
            if (row + 1 < r1) P1_LOAD(row + 1);
#pragma unroll
            for (int j = 0; j < 8; ++j) { const int c = (j * 64 + lane) * 4; v2u w; w.x = pk2(o[j][0], o[j][1]); w.y = pk2(o[j][2], o[j][3]); *(v2u*)(U + (size_t)row * DM + c) = w; } }
#undef P1_LOAD
    }
    SEAM(1);

    if (IN(2)) _Pragma("unroll 1") for (int rep_ = 0; rep_ < NREP(2); ++rep_) {
        CParams* kp = kparams();
        typedef pg8::SchedSplit<256u * DM * 2u, 256u * DM * 2u, DM / 64, QKVD / 256> Sch;
        pg8::Gemm g{DM, DM, DM}; Sch S; S.init(ogrid(), obid()); S.A = WSP(const char, WS_U); S.B = WSP(const char, WS_WQKV);
        pg8::EpiQkv E{WSP(bf16_t, WS_QKVR), QKVD, WSP(float, WS_PQ), WSP(bf16_t, WS_V)};
        pg8::gemm_phase<pg8::EpiQkv, Sch, true, false>(L, g, S, E);
    }
    SEAM(2);

    if (IN(3)) _Pragma("unroll 1") for (int rep_ = 0; rep_ < NREP(3); ++rep_) {
        CParams* kp = kparams(); TIDS;
        const float* ROPE = WSP(float, WS_ROPE); const bf16_t* QKVR = WSP(bf16_t, WS_QKVR); bf16_t* Qb = WSP(bf16_t, WS_Q); bf16_t* Kb = WSP(bf16_t, WS_K); bf16_t* Vb = WSP(bf16_t, WS_V);
        const int sub = lane >> 4, l16 = lane & 15, d0 = l16 * 8, ax = l16 >> 3, hh = (l16 >> 2) & 1, p0 = (l16 & 3) * 8;
        const bool split3 = ((64 * (QKVD / 256)) % G == 0) && (2 * (QKVD / 256) * 8 <= G);
        const float* PQ = WSP(float, WS_PQ);
        float qg[8], kg[8];
        { const float* qgn = kp->q_gain; const float* kgn = kp->k_gain;
#pragma unroll
          for (int i = 0; i < 8; ++i) { qg[i] = qgn[d0 + i]; kg[i] = kgn[d0 + i]; } }
        v4u rw[6];
#define P3_LOAD(row_) do { const bf16_t* s_ = QKVR + (size_t)(row_) * QKVD + sub * 128 + d0; const bool all_ = (row_) < NCTX; _Pragma("unroll") for (int it = 0; it < 6; ++it) if (it == 4 || all_) rw[it] = *(const v4u*)(s_ + it * 512); } while (0)
        for (int r4 = NCTX + gw * 4; r4 < MT; r4 += NGW * 4) {
            v4u kr[4]; f32x4 c0[4], c1[4], s0[4], s1[4];
#pragma unroll
            for (int q = 0; q < 4; ++q) { const int row = r4 + q, t = (row - NCTX) & 8191; kr[q] = *(const v4u*)(QKVR + (size_t)row * QKVD + 2048 + sub * 128 + d0);
                const int pos = ax ? (t & 63) : (t >> 6); const float* cp_ = ROPE + pos * 32 + p0; c0[q] = *(const f32x4*)cp_; c1[q] = *(const f32x4*)(cp_ + 4); s0[q] = *(const f32x4*)(cp_ + 4096); s1[q] = *(const f32x4*)(cp_ + 4100); }
#pragma unroll
            for (int q = 0; q < 4; ++q) { const int row = r4 + q, lr = row - NCTX, b = lr >> 13, kpos = CTXL + (lr & 8191); const v4u raw = kr[q];
                float f[8], cs[8], sn[8];
#pragma unroll
                for (int i = 0; i < 4; ++i) { f[2 * i] = bf2f(raw[i] & 0xffffu); f[2 * i + 1] = bf2f(raw[i] >> 16); cs[i] = c0[q][i]; cs[4 + i] = c1[q][i]; sn[i] = hh ? s0[q][i] : -s0[q][i]; sn[4 + i] = hh ? s1[q][i] : -s1[q][i]; }
                float ss = 0.f;
#pragma unroll
                for (int i = 0; i < 8; ++i) ss += f[i] * f[i];
                ss += __shfl_xor(ss, 1); ss += __shfl_xor(ss, 2); ss += __shfl_xor(ss, 4); ss += __shfl_xor(ss, 8);
                const float r = 1.0f / sqrtf(ss * (1.0f / 128.0f) + RMS_EPS);
                float o[8];
#pragma unroll
                for (int i = 0; i < 8; ++i) { const float y = f[i] * r * kg[i]; const float pr = __shfl_xor(y, 4); o[i] = y * cs[i] + pr * sn[i]; }
                v4u w; w.x = pk2(o[0], o[1]); w.y = pk2(o[2], o[3]); w.z = pk2(o[4], o[5]); w.w = pk2(o[6], o[7]);
                *(v4u*)(Kb + (((size_t)b * NKV + sub) * SKV + kpos) * HD + d0) = w; }
        }
        P3_LOAD(gw < NCTX ? gw : 0);
        for (int row = gw; row < NCTX; row += NGW) {
            const bool lat = row >= NCTX; const int lr = row - NCTX; const int b = lat ? (lr >> 13) : (row >> 8); const int t = lat ? (lr & 8191) : 0;
            const int kpos = lat ? (CTXL + t) : (row & 255);
            v4u cur[6];
#pragma unroll
            for (int it = 0; it < 6; ++it) cur[it] = rw[it];
            if (row + NGW < NCTX) P3_LOAD(row + NGW);
            float cs[8], sn[8];
#pragma unroll
            for (int i = 0; i < 8; ++i) { cs[i] = 1.f; sn[i] = 0.f; }
            if (lat) { const int pos = ax ? (t & 63) : (t >> 6); const float* cp_ = ROPE + pos * 32 + p0;
                const f32x4 c0 = *(const f32x4*)cp_, c1 = *(const f32x4*)(cp_ + 4), s0 = *(const f32x4*)(cp_ + 4096), s1 = *(const f32x4*)(cp_ + 4100);
#pragma unroll
                for (int i = 0; i < 4; ++i) { cs[i] = c0[i]; cs[4 + i] = c1[i]; sn[i] = hh ? s0[i] : -s0[i]; sn[4 + i] = hh ? s1[i] : -s1[i]; } }
#pragma unroll
            for (int it = 0; it < 6; ++it) { const int h = it * 4 + sub;
                if (lat && it != 4) continue;
                if (it == 5 && !split3) continue;
                float f[8]; v4u raw;
                if (!lat && split3) {
                    f32x4 q0[8]; const float* pp_ = PQ + (size_t)row * QKVD + h * 128 + d0;
#pragma unroll
                    for (int ks = 0; ks < 8; ++ks) q0[ks] = *(const f32x4*)(pp_ + (size_t)ks * 512 * QKVD);
                    f32x4 a0 = q0[0];
#pragma unroll
                    for (int ks = 1; ks < 8; ++ks) a0 += q0[ks];
#pragma unroll
                    for (int ks = 0; ks < 8; ++ks) q0[ks] = *(const f32x4*)(pp_ + (size_t)ks * 512 * QKVD + 4);
                    f32x4 a1 = q0[0];
#pragma unroll
                    for (int ks = 1; ks < 8; ++ks) a1 += q0[ks];
#pragma unroll
                    for (int i = 0; i < 4; ++i) { f[i] = a0[i]; f[4 + i] = a1[i]; }
                    raw.x = pk2(f[0], f[1]); raw.y = pk2(f[2], f[3]); raw.z = pk2(f[4], f[5]); raw.w = pk2(f[6], f[7]);
#pragma unroll
                    for (int i = 0; i < 4; ++i) { f[2 * i] = bf2f(raw[i] & 0xffffu); f[2 * i + 1] = bf2f(raw[i] >> 16); }
                } else { raw = cur[it];
#pragma unroll
                    for (int i = 0; i < 4; ++i) { f[2 * i] = bf2f(raw[i] & 0xffffu); f[2 * i + 1] = bf2f(raw[i] >> 16); } }
                if (it == 5) { *(v4u*)(Vb + (((size_t)b * NKV + (h - 20)) * SKV + kpos) * HD + d0) = raw; continue; }
                float ss = 0.f;
#pragma unroll
                for (int i = 0; i < 8; ++i) ss += f[i] * f[i];
                ss += __shfl_xor(ss, 1); ss += __shfl_xor(ss, 2); ss += __shfl_xor(ss, 4); ss += __shfl_xor(ss, 8);
                const float r = 1.0f / sqrtf(ss * (1.0f / 128.0f) + RMS_EPS);
                float o[8];
#pragma unroll
                for (int i = 0; i < 8; ++i) { const float y = f[i] * r * (it < 4 ? qg[i] : kg[i]); const float pr = __shfl_xor(y, 4); o[i] = y * cs[i] + pr * sn[i]; }
                v4u w; w.x = pk2(o[0], o[1]); w.y = pk2(o[2], o[3]); w.z = pk2(o[4], o[5]); w.w = pk2(o[6], o[7]);
                bf16_t* d = (it < 4) ? Qb + (size_t)row * DM + h * 128 + d0 : Kb + (((size_t)b * NKV + (h - 16)) * SKV + kpos) * HD + d0;
                *(v4u*)d = w; }
        }
#undef P3_LOAD
    }
    SEAM(3);

    if (IN(4)) _Pragma("unroll 1") for (int rep_ = 0; rep_ < NREP(4); ++rep_) {
        CParams* kp = kparams();
        const bf16_t* Qb = WSP(bf16_t, WS_Q); const bf16_t* Kb = WSP(bf16_t, WS_K); const bf16_t* Vb = WSP(bf16_t, WS_V); bf16_t* Ob = WSP(bf16_t, WS_O);
        const bf16_t* QKVR = WSP(bf16_t, WS_QKVR); const float* ROPE = WSP(float, WS_ROPE); const float* qgn = kp->q_gain;
        const int G = ogrid(), bx = obid(); const bool fast = (G % 8) == 0;
        const int NR = fast ? (G >> 3) : G, rank = fast ? (bx >> 3) : bx, tot = fast ? 132 : 1056;
        const bool split = fast && NR == 32; const int NA = split ? 26 : NR;
        if (rank < NA) for (int i = 0;; ++i) {
            int w = rank + NA * i;
            if (split && i == 5) w = rank >= 24 ? rank + 106 : tot;
            if (w >= tot) break;
            const int combo = fast ? (bx & 7) : (w / 132), ww = fast ? w : (w % 132), b = combo >> 2, kvh = combo & 3;
            const bool isl = ww < 128; const int rbk = ww >> 2; const int h = kvh * 4 + (isl ? (ww & 3) : (ww - 128));
            const size_t row0 = isl ? ((size_t)NCTX + (size_t)b * SEQ + (size_t)rbk * 256) : ((size_t)b * CTXL);
            if (isl) att::attn_dma_body(QKVR + row0 * QKVD + h * HD, QKVD, rbk * 256, ROPE, qgn, Kb + (size_t)combo * SKV * HD, Vb + (size_t)combo * SKV * HD, Ob + row0 * DM + h * HD, SKV, (char*)lds);
            else att::attn_dma_body(Qb + row0 * DM + h * HD, DM, -1, ROPE, qgn, Kb + (size_t)combo * SKV * HD, Vb + (size_t)combo * SKV * HD, Ob + row0 * DM + h * HD, CTXL, (char*)lds);
            if (otid() == 0) { asm volatile("s_waitcnt vmcnt(0)" ::: "memory");
                (void)xb_add(WSP(unsigned, WS_CTL) + CW_DONE + 32 * (isl ? (b * 32 + rbk) : (64 + b)), 1u); }
        }
        {
            const int tid = otid(), lane = tid & 63, wave = __builtin_amdgcn_readfirstlane(tid >> 6);
            unsigned* mq = WSP(unsigned, WS_CTL) + CW_MQ; bool prepared = false;
            for (;;) {
                if (tid == 0) MISC[34] = xb_add(mq, 1u);
                __syncthreads();
                const unsigned t = MISC[34];
                __syncthreads();
                if (t >= 384u) break;
                if (!prepared) { mod_prepare(kp->c, kp->c_ctx, (LAS float*)L, tid); prepared = true; }
                mod_item(384 + (int)t, kp->w_mod, kp->b_mod, WSP(float, WS_MOD), (const LAS float*)L, (LAS float*)(L + 32768), tid, lane, wave);
            }
        }
        {
            const int tid = otid(), lane = tid & 63, wave = __builtin_amdgcn_readfirstlane(tid >> 6);
            LAS float* scr = (LAS float*)(L + wave * 16384);
            unsigned* qc = WSP(unsigned, WS_CTL) + CW_Q;
            constexpr int I_G = (DM / 64) * (DE / 32), I_D = (DE / 64) * (DM / 32), PER = 2 * I_G + I_D; constexpr unsigned NTICK = 64u * PER / 2u;
            auto decode = [&](int it) { TItem d; const int le = it / PER; int r = it - le * PER;
                if (r < I_G) { d.W = kp->w_gate + (size_t)le * DM * DE; d.WT = WSP(bf16_t, WS_WGU) + (size_t)le * 2048 * DM; d.K = DM; d.N = DE; d.kind = 1; }
                else if ((r -= I_G) < I_G) { d.W = kp->w_up + (size_t)le * DM * DE; d.WT = WSP(bf16_t, WS_WGU) + (size_t)le * 2048 * DM; d.K = DM; d.N = DE; d.kind = 2; }
                else { r -= I_G; d.W = kp->w_down + (size_t)le * DE * DM; d.WT = WSP(bf16_t, WS_WD) + (size_t)le * DM * DE; d.K = DE; d.N = DM; d.kind = 0; }
                const int nblk = d.N / 32; d.k0 = 64 * (r / nblk); d.n0 = 32 * (r % nblk); return d; };
            auto grab = [&]() { unsigned t = 0; if (lane == 0) t = __hip_atomic_fetch_add(qc, 1u, __ATOMIC_RELAXED, __HIP_MEMORY_SCOPE_AGENT); return (unsigned)__builtin_amdgcn_readfirstlane((int)t); };
            unsigned tk = grab();
            while (tk < NTICK) {
                const unsigned nx = grab();
                const TItem d0 = decode((int)(2u * tk)); TItem d1 = d0; d1.n0 += 32;
                f32x4 ra[8], rb[8]; t_load(d0, ra, lane); t_load(d1, rb, lane);
                t_store(d0, ra, scr, lane); t_store(d1, rb, scr, lane);
                tk = nx;
            }
        }
        __syncthreads();
        {
            unsigned* wq = WSP(unsigned, WS_CTL) + CW_WQ; unsigned* done = WSP(unsigned, WS_CTL) + CW_DONE; unsigned* yd = WSP(unsigned, WS_CTL) + CW_YD; unsigned* bw = WSP(unsigned, WS_CTL) + CW_BAR;
            const char* Oc = WSP(const char, WS_O); const char* Wc = WSP(const char, WS_WO);
            pg8::Gemm g{DM, DM, DM}; pg8::EpiBf16W E{WSP(bf16_t, WS_Y), DM};
            int tail = obid(); bool queue = true;
            for (;;) {
                if (otid() == 0) { int pm = -1, pn = 0, fl = 0;
                    if (queue) { const unsigned t = xb_add(wq, 1u);
                        if (t < 416u) { const int rbk = (int)t >> 4, b = ((int)t >> 3) & 1; pn = (int)t & 7; pm = 2 + b * 32 + rbk; fl = b * 32 + rbk; }
                        else if (t < 432u) { const int c = (int)t - 416; pm = c >> 3; pn = c & 7; fl = 64 + pm; } }
                    else if (tail < 96) { const int rbk = 26 + (tail >> 4), b = (tail >> 3) & 1; pn = tail & 7; pm = 2 + b * 32 + rbk; fl = b * 32 + rbk; }
                    if (pm >= 0) { XB_SPIN(xb_ld(&done[32 * fl]) < 16u, bw);
                        __builtin_amdgcn_fence(__ATOMIC_ACQUIRE, "agent"); asm volatile("s_waitcnt vmcnt(0)" ::: "memory"); }
                    MISC[32] = (unsigned)pm; MISC[33] = (unsigned)pn; }
                __syncthreads();
                const int pm = (int)MISC[32], pn = (int)MISC[33];
                __syncthreads();
                if (pm < 0) { if (!queue) break; queue = false; continue; }
                pg8::SchedOne S; S.u.A = Oc + (size_t)((unsigned)pm * (256u * DM * 2u)); S.u.B = Wc + (size_t)((unsigned)pn * (256u * DM * 2u)); S.u.pm = pm; S.u.pn = pn; S.u.aux = 0; S.u.kt = DM / 64; S.u.rb = 0; S.u.cn = 0; S.u.ui = 0;
                pg8::gemm_phase<pg8::EpiBf16W, pg8::SchedOne, true, false>(L, g, S, E);
                if (otid() == 0) (void)xb_add(&yd[32 * pm], 1u);
                if (!queue) tail += ogrid();
            }
        }
    }


    layer_half<0>(lo, hi, bar, L, tcnt, tbase, texp);
    layer_half<1>(lo, hi, bar, L, tcnt, tbase, texp);
#undef IN
#undef SEAM
#undef TIDS
}

extern "C" void kernel_launch(void* const* d_in, const int* in_sizes, int n_in, void* d_out, int out_size, void* d_ws, size_t ws_size, hipStream_t stream) {
    static int grid = 0;
    if (grid == 0) {
        if (n_in != 19 || in_sizes[0] != NLAT * DM || out_size != NLAT * DM || ws_size < WS_END) {
            fprintf(stderr, "kernel_launch: shape mismatch: n_in %d in0 %d out %d ws %zu (need %zu); nothing launched\n", n_in, n_in > 0 ? in_sizes[0] : -1, out_size, ws_size, (size_t)WS_END); grid = -1; return; }
        int dev = 0, cus = 0, per_cu = 0;
        if (hipGetDevice(&dev) != hipSuccess || hipDeviceGetAttribute(&cus, hipDeviceAttributeMultiprocessorCount, dev) != hipSuccess) { fprintf(stderr, "kernel_launch: device query failed\n"); grid = -1; return; }
        if (hipFuncSetAttribute((const void*)mk_fwd, hipFuncAttributeMaxDynamicSharedMemorySize, LDS_BYTES) != hipSuccess) { fprintf(stderr, "kernel_launch: hipFuncSetAttribute failed\n"); grid = -1; return; }
        if (hipOccupancyMaxActiveBlocksPerMultiprocessor(&per_cu, (const void*)mk_fwd, 512, LDS_BYTES) != hipSuccess || per_cu < 1)
            fprintf(stderr, "kernel_launch: note: occupancy query reports %d workgroups per CU\n", per_cu);
        (void)hipGetLastError();
        if (cus * (pg8::RT_UNITS / 2) < MAXT * 8) { fprintf(stderr, "kernel_launch: %d CUs: the MoE phases' per-workgroup LDS row tables are sized for >= %d workgroups; nothing launched\n", cus, (MAXT * 8 + pg8::RT_UNITS / 2 - 1) / (pg8::RT_UNITS / 2)); grid = -1; return; }
        grid = cus;
    }
    if (grid < 0) return;
    if (hipMemsetAsync((char*)d_ws + WS_CTL, 0, CTL_ZERO_BYTES, stream) != hipSuccess) { fprintf(stderr, "kernel_launch: memset failed\n"); return; }
    Params p{};
    p.x = (const float*)d_in[0]; p.c = (const float*)d_in[1]; p.ctx = (const float*)d_in[2]; p.c_ctx = (const float*)d_in[3]; p.w_mod = (const float*)d_in[4]; p.b_mod = (const float*)d_in[5];
    p.ln_g = (const float*)d_in[6]; p.ln_b = (const float*)d_in[7]; p.w_qkv = (const float*)d_in[8]; p.q_gain = (const float*)d_in[9]; p.k_gain = (const float*)d_in[10]; p.w_o = (const float*)d_in[11];
    p.w_pool = (const float*)d_in[12]; p.pool_scale = (const float*)d_in[13]; p.w_router = (const float*)d_in[14]; p.router_bias = (const float*)d_in[15];
    p.w_gate = (const float*)d_in[16]; p.w_up = (const float*)d_in[17]; p.w_down = (const float*)d_in[18];
    p.out = (float*)d_out; p.ws = (unsigned char*)d_ws;
#if MK_PER_PHASE
    for (int k = 0; k < NPHASE; ++k) { p.ph_lo = k; p.ph_hi = k + 1;
        hipLaunchKernelGGL(mk_fwd, dim3(grid), dim3(512), LDS_BYTES, stream, p);
        const hipError_t le = hipPeekAtLastError(); if (le != hipSuccess) { fprintf(stderr, "kernel_launch: launch %d failed: %s\n", k, hipGetErrorName(le)); break; } }
#else
    p.ph_lo = 0; p.ph_hi = NPHASE;
    hipLaunchKernelGGL(mk_fwd, dim3(grid), dim3(512), LDS_BYTES, stream, p);
    const hipError_t le = hipPeekAtLastError(); if (le != hipSuccess) fprintf(stderr, "kernel_launch: launch failed: %s\n", hipGetErrorName(le));
#endif
}
```

```cpp
#include <hip/hip_runtime.h>
#include <cstdio>
#include <cstdint>

#ifndef REP_MASK
#define REP_MASK 0
#endif
#ifndef MK_PER_PHASE
#define MK_PER_PHASE 0
#endif

constexpr int DM = 2048, NB = 2, SEQ = 8192, CTXL = 256;
constexpr int NCTX = NB * CTXL, NLAT = NB * SEQ, MT = NCTX + NLAT;
constexpr int NH = 16, NKV = 4, HD = 128, KVD = NKV * HD, QKVD = DM + 2 * KVD;
constexpr int SKV = CTXL + SEQ;
constexpr int NE = 32, DE = 1024;
constexpr int MAXT = 164, NSLOT = MAXT * 256;
constexpr float ALPHA = 1.41421356237309515f;
constexpr float LN_EPS = 1e-6f, RMS_EPS = 1e-6f;
constexpr int NPHASE = 18;

constexpr size_t MiB = 1u << 20;
constexpr size_t WS_CTL = 0, CTL_ZERO_BYTES = 1 * MiB;
constexpr size_t WS_MOD = 1 * MiB;
constexpr size_t WS_ROPE = WS_MOD + 512 * 1024;
constexpr size_t WS_WR = WS_MOD + 768 * 1024;
constexpr size_t WS_WQKV = 2 * MiB;
constexpr size_t WS_WO = 14 * MiB;
constexpr size_t WS_WPOOL = 22 * MiB;
constexpr size_t WS_WGU = 24 * MiB;
constexpr size_t WS_WD = 536 * MiB;
constexpr size_t WS_Y = 792 * MiB;
constexpr size_t WS_X1 = 924 * MiB;
constexpr size_t WS_X2 = 1056 * MiB;
constexpr size_t WS_H = 1188 * MiB;
constexpr size_t WS_LIST = 1254 * MiB;
constexpr size_t WS_SLOT = 1259 * MiB;
constexpr size_t WS_SH = 1260 * MiB;
constexpr size_t WS_U = WS_SH;
constexpr size_t WS_QKVR = WS_SH + 66 * MiB;
constexpr size_t WS_Q = WS_SH + 165 * MiB;
constexpr size_t WS_K = WS_SH + 231 * MiB;
constexpr size_t WS_V = WS_SH + 248 * MiB;
constexpr size_t WS_O = WS_SH + 265 * MiB;
constexpr size_t WS_HS = WS_SH;
constexpr size_t WS_ACT = WS_SH + 164 * MiB;
constexpr size_t WS_FB = WS_SH + 246 * MiB;
constexpr size_t WS_DP = WS_SH;
constexpr size_t WS_PQ = WS_SH + 510 * MiB;
constexpr size_t WS_PO = WS_PQ + 48 * MiB;
constexpr size_t WS_END = WS_PO + 32 * MiB;
static_assert((size_t)MT * DM * 4 <= 132 * MiB && (size_t)NSLOT * 2048 * 2 <= 164 * MiB && (size_t)2 * MT * DM * 4 <= 264 * MiB, "ws map");
static_assert((size_t)32 * MT * 8 <= 5 * MiB && (size_t)NSLOT * 8 <= 1 * MiB, "ws map 2");
constexpr int CW_CNT = 64;
constexpr int CW_Q = 3072;
constexpr int CW_MQ = 3136;
constexpr int CW_WQ = 3104;
constexpr int CW_DONE = 8192;
constexpr int CW_GUD = 16384;
constexpr int CW_YD = 40960;
constexpr int CW_P6Q = 3168;
constexpr int CW_BAR = 4096;

constexpr int RING_BYTES = 131072;
constexpr int MISC_OFF = RING_BYTES;
constexpr int TAB_OFF = MISC_OFF + 256;
constexpr int LDS_BYTES = 147456;

#define GAS __attribute__((address_space(1)))
#define LAS __attribute__((address_space(3)))
typedef unsigned short bf16_t;
typedef unsigned v4u __attribute__((ext_vector_type(4)));
typedef unsigned v2u __attribute__((ext_vector_type(2)));
typedef float f32x4 __attribute__((ext_vector_type(4)));
typedef float f32x2 __attribute__((ext_vector_type(2)));
typedef short bf16x8 __attribute__((ext_vector_type(8)));
typedef short s16x4 __attribute__((ext_vector_type(4)));
typedef float f32x16 __attribute__((ext_vector_type(16)));
typedef GAS unsigned gu32;
#define RLX_AGENT __ATOMIC_RELAXED, __HIP_MEMORY_SCOPE_AGENT
#define LDS_WAIT() asm volatile("s_waitcnt lgkmcnt(0)" ::: "memory")
#define VM_WAIT() asm volatile("s_waitcnt vmcnt(0)" ::: "memory")
__device__ __forceinline__ unsigned f2bf(float f) { unsigned u = __builtin_bit_cast(unsigned, f); return (u + 0x7fffu + ((u >> 16) & 1u)) >> 16; }
__device__ __forceinline__ unsigned pk2(float lo, float hi) { unsigned r; asm("v_cvt_pk_bf16_f32 %0, %1, %2" : "=v"(r) : "v"(lo), "v"(hi)); return r; }
__device__ __forceinline__ float bf2f(unsigned b) { return __builtin_bit_cast(float, b << 16); }
__device__ __forceinline__ unsigned cvt_pk_bf16(float lo, float hi) { unsigned r; asm volatile("v_cvt_pk_bf16_f32 %0, %1, %2" : "=v"(r) : "v"(lo), "v"(hi)); return r; }
__device__ __forceinline__ f32x4 bf4(v2u q) { return (f32x4){bf2f(q.x & 0xffffu), bf2f(q.x >> 16), bf2f(q.y & 0xffffu), bf2f(q.y >> 16)}; }
template <int CTRL> __device__ __forceinline__ float dppf(float v) { return __builtin_bit_cast(float, __builtin_amdgcn_update_dpp(0, __builtin_bit_cast(int, v), CTRL, 0xF, 0xF, true)); }
template <int CTRL> __device__ __forceinline__ int dppi(int v) { return __builtin_amdgcn_update_dpp(0, v, CTRL, 0xF, 0xF, true); }
__device__ __forceinline__ float wave_sum(float v) {
    v += dppf<0xB1>(v); v += dppf<0x4E>(v); v += dppf<0x141>(v); v += dppf<0x140>(v);
    { const auto r = __builtin_amdgcn_permlane16_swap(__float_as_uint(v), __float_as_uint(v), false, false); v = __uint_as_float(r[0]) + __uint_as_float(r[1]); }
    { const auto r = __builtin_amdgcn_permlane32_swap(__float_as_uint(v), __float_as_uint(v), false, false); v = __uint_as_float(r[0]) + __uint_as_float(r[1]); }
    return v;
}
__device__ __forceinline__ float silu_f(float x) { return x / (1.0f + __expf(-x)); }
__device__ __forceinline__ int row_cond(int row) { return row < NCTX ? 2 : ((row - NCTX) >> 13); }
__device__ __forceinline__ int otid() { int t = threadIdx.x; asm volatile("" : "+v"(t)); return t; }
__device__ __forceinline__ int obid() { int t = blockIdx.x; asm volatile("" : "+s"(t)); return t; }
__device__ __forceinline__ int ogrid() { int t = gridDim.x; asm volatile("" : "+s"(t)); return t; }

#define XB_TMO      128
#define XB_XCNT(j)  (256  + 64 * (j))
#define XB_XSUB(j)  (1280 + 64 * (j))
#define XB_XGEN(j)  (2304 + 64 * (j))
#define XB_TOP      3328
#define XB_TOPGEN   3392
#define XCD_BAR_WORDS 3456
#define XB_SPIN_CAP (1u << 20)
__device__ __forceinline__ unsigned xb_ld(unsigned* p)              { return __hip_atomic_load(p, __ATOMIC_RELAXED, __HIP_MEMORY_SCOPE_AGENT); }
__device__ __forceinline__ unsigned xb_add(unsigned* p, unsigned v) { return __hip_atomic_fetch_add(p, v, __ATOMIC_RELAXED, __HIP_MEMORY_SCOPE_AGENT); }
__device__ __forceinline__ unsigned xb_xcc_id() { return (unsigned)__builtin_amdgcn_s_getreg((3 << 11) | 20) & 0xFu; }
#define XB_SPIN(cond, bar) do { unsigned _sp = 0; while (cond) { __builtin_amdgcn_s_sleep(1); \
    if ((++_sp & 255u) == 0u) { if (xb_ld(&(bar)[XB_TMO])) break; if (_sp > XB_SPIN_CAP) { atomicAdd(&(bar)[XB_TMO], 1u); break; } } } } while (0)
struct XcdBarrier { unsigned* bar; unsigned x; volatile LAS unsigned* st; };
__device__ __forceinline__ XcdBarrier xcd_barrier_post(unsigned* bar, volatile LAS unsigned* st) {
    XcdBarrier b; b.bar = bar; b.x = xb_xcc_id(); b.st = st;
    if (threadIdx.x == 0) (void)xb_add(&bar[XB_XCNT(b.x)], 1u);
    return b;
}
__device__ __forceinline__ void xcd_barrier_complete(unsigned* bar, unsigned x, unsigned& nloc, unsigned& nx) {
    const unsigned G = gridDim.x * gridDim.y * gridDim.z;
    unsigned sum, cnt, mine, sp = 0u;
    for (;;) {
        sum = 0u; cnt = 0u; mine = 0u;
#pragma unroll 1
        for (unsigned j = 0; j < 16; ++j) { const unsigned c = xb_ld(&bar[XB_XCNT(j)]); sum += c; cnt += (c > 0u) ? 1u : 0u; }
        if (sum == G) break;
        __builtin_amdgcn_s_sleep(1);
        if ((++sp & 255u) == 0u) { if (xb_ld(&bar[XB_TMO])) break; if (sp > XB_SPIN_CAP) { atomicAdd(&bar[XB_TMO], 1u); break; } }
    }
    mine = xb_ld(&bar[XB_XCNT(x)]);
    nloc = mine > 0u ? mine : 1u; nx = cnt > 0u ? cnt : 1u;
}
__device__ __forceinline__ void xcd_barrier(const XcdBarrier& b) {
    asm volatile("s_waitcnt vmcnt(0)" ::: "memory");
    __syncthreads();
    if (threadIdx.x == 0) {
        unsigned* bar = b.bar;
        __builtin_amdgcn_s_waitcnt(0);
        unsigned nloc = b.st[0], nx = b.st[1];
        if (nloc == 0u) { xcd_barrier_complete(bar, b.x, nloc, nx); b.st[0] = nloc; b.st[1] = nx; }
        const unsigned old = xb_add(&bar[XB_XSUB(b.x)], 1u);
        const unsigned gen = old / nloc;
        if (old + 1u == (gen + 1u) * nloc) {
            __builtin_amdgcn_fence(__ATOMIC_RELEASE, "agent");
            asm volatile("s_waitcnt vmcnt(0)" ::: "memory");
            const unsigned og = xb_add(&bar[XB_TOP], 1u);
            const unsigned tg = og / nx;
            if (og + 1u == (tg + 1u) * nx) xb_add(&bar[XB_TOPGEN], 1u);
            else XB_SPIN(xb_ld(&bar[XB_TOPGEN]) == tg, bar);
            __builtin_amdgcn_fence(__ATOMIC_ACQUIRE, "agent");
            xb_add(&bar[XB_XGEN(b.x)], 1u);
            asm volatile("s_waitcnt vmcnt(0)" ::: "memory");
        } else {
            XB_SPIN(xb_ld(&bar[XB_XGEN(b.x)]) == gen, bar);
            __builtin_amdgcn_fence(__ATOMIC_ACQUIRE, "agent");
            asm volatile("s_waitcnt vmcnt(0)" ::: "memory");
        }
    }
    __syncthreads();
}

namespace pg8 {
#define PG8_LAS __attribute__((address_space(3)))
constexpr int BM = 256, BK = 64, HALF = 128, HTB = HALF * BK * 2, STAGE_BYTES = 8 * HTB, NXCD = 8, WGM = 8;
__host__ __device__ __forceinline__ int lds_byte(int r, int c) { const int st = (r >> 4) * 2 + (c >> 5), rr = r & 15, cc = c & 31, ob = rr * 64 + cc * 2; return st * 1024 + (ob ^ (((ob >> 9) & 1) << 5)); }
__host__ __device__ __forceinline__ void stage_rc(int b, int& R, int& C) { const int st = b / 1024, sb = b % 1024, swz = sb ^ (((sb >> 9) & 1) << 5); R = (st >> 1) * 16 + swz / 64; C = (st & 1) * 32 + (swz % 64) / 2; }
__host__ __device__ __forceinline__ int perm32(int rho) { const int n = rho >> 4, i = rho & 15; return 8 * (i >> 2) + 4 * n + (i & 3); }

struct Unit { const char* A; const char* B; int pm, pn, aux, kt, rb, cn, ui; };
struct Gemm { int lda, ldb, K; };

struct TileOrder {
    int nM, nN, nwg, G, c, rot = 0;
    __device__ __forceinline__ void init(int nM_, int nN_, int G_, int c_) { nM = nM_; nN = nN_; nwg = nM * nN; G = G_; c = c_; }
    __device__ __forceinline__ bool get(int i, int& pm, int& pn) const { return map((long)i * G + c, pm, pn); }
    __device__ __forceinline__ bool map(long L, int& pm, int& pn) const {
        if (L >= nwg) return false;
        const int nig = WGM * nN;
        int wgid = (int)L; { const int q = nwg / NXCD, r = nwg % NXCD, xcd = wgid % NXCD; int off = wgid / NXCD; const int cs = (xcd < r ? xcd * (q + 1) : r * (q + 1) + (xcd - r) * q), len = q + (xcd < r ? 1 : 0);
            if (rot) { const int lead = (nig - cs % nig) % nig; if (lead < len) { off += lead; if (off >= len) off -= len; } }
            wgid = cs + off; }
        const int gid = wgid / nig, fm = gid * WGM, gsz = (nM - fm) < WGM ? (nM - fm) : WGM;
        pm = fm + ((wgid % nig) % gsz); pn = (wgid % nig) / gsz; return true;
    }
};

template <class Epi, class Sched, bool ALIGN_EPI, bool GATHER = false>
__device__ __forceinline__ void gemm_phase(PG8_LAS unsigned char* lds, const Gemm g, const Sched& S, const Epi& E) {
    const int tid = otid(), wid = __builtin_amdgcn_readfirstlane(tid >> 6), lane = tid & 63, wr = wid >> 2, wc = wid & 3, fr = lane & 15, fq = lane >> 4;
    unsigned vc[2][2], vn[2][2], voffB[2]; int Rr[2], Cc = 0;
#pragma unroll
    for (int i = 0; i < 2; ++i) { int R, C; stage_rc(tid * 16 + i * 8192, R, C); const int Rb = Epi::PERM ? ((R & ~31) + perm32(R & 31)) : R; Rr[i] = R; Cc = C;
        vc[0][i] = (unsigned)(R * g.lda + C) * 2u; vc[1][i] = vc[0][i] + (unsigned)(HALF * g.lda) * 2u; voffB[i] = (unsigned)(Rb * g.ldb + C) * 2u; }
#define PG8_ROWS(ui_, v) do { _Pragma("unroll") for (int _h = 0; _h < 2; ++_h) _Pragma("unroll") for (int _i = 0; _i < 2; ++_i) \
        v[_h][_i] = (unsigned)S.rowtok((ui_), Rr[_i] + HALF * _h) * (unsigned)(g.lda * 2) + (unsigned)Cc * 2u; } while (0)
    const size_t kstep = (size_t)(BK * 2);
    const size_t hsB = (size_t)HALF * g.ldb * 2;
    const unsigned ldsw = (unsigned)wid * 1024u;
    const int aoff = lds_byte(wr * 64 + fr, fq * 8), boff = lds_byte(wc * 32 + fr, fq * 8);
#define PG8_SA(b, h) (((b) * 2 + (h)) * HTB)
#define PG8_SB(b, h) ((4 + (b) * 2 + (h)) * HTB)
#define PG8_STAGE(bufoff, gbase, voff) do { _Pragma("unroll") for (int _i = 0; _i < 2; ++_i) \
        __builtin_amdgcn_global_load_lds((const unsigned*)((const char*)(gbase) + (voff)[_i]), (PG8_LAS unsigned*)(lds + (bufoff) + ldsw + _i * 8192), 16, 0, 0); } while (0)
#define PG8_LDA(dst, b, h) do { _Pragma("unroll") for (int m = 0; m < 4; ++m) _Pragma("unroll") for (int k = 0; k < 2; ++k) dst[m][k] = *(const PG8_LAS bf16x8*)(lds + PG8_SA(b, h) + aoff + m * 2048 + k * 1024); } while (0)
#define PG8_LDB(dst, b, h) do { _Pragma("unroll") for (int n = 0; n < 2; ++n) _Pragma("unroll") for (int k = 0; k < 2; ++k) dst[n][k] = *(const PG8_LAS bf16x8*)(lds + PG8_SB(b, h) + boff + n * 2048 + k * 1024); } while (0)
#define PG8_MMA(ai, bj, At, Bt) do { __builtin_amdgcn_s_setprio(1); _Pragma("unroll") for (int m = 0; m < 4; ++m) _Pragma("unroll") for (int n = 0; n < 2; ++n) _Pragma("unroll") for (int k = 0; k < 2; ++k) \
        acc[ai][bj][m][n] = __builtin_amdgcn_mfma_f32_16x16x32_bf16(Bt[n][k], At[m][k], acc[ai][bj][m][n], 0, 0, 0); __builtin_amdgcn_s_setprio(0); } while (0)
#define PG8_WAIT_V(n) asm volatile("s_waitcnt vmcnt(" #n ")" ::: "memory")
#define PG8_WAIT_L(n) asm volatile("s_waitcnt lgkmcnt(" #n ")" ::: "memory")
#define PG8_BAR __builtin_amdgcn_s_barrier()
#define PG8_SCHED __builtin_amdgcn_sched_barrier(0)
    Unit cur, nxt; int ui = 0; int pend = -1, pend2 = -1, wst = 0; unsigned pv = 8u; (void)pend; (void)pend2; (void)wst; (void)pv;
    if (!S.next(0, cur)) return;
    if constexpr (Sched::WAITS) S.wait_ready(cur);
    if constexpr (GATHER) PG8_ROWS(0, vc);
    f32x4 acc[2][2][4][2];
#pragma unroll
    for (int a = 0; a < 2; ++a)
#pragma unroll
        for (int b = 0; b < 2; ++b)
#pragma unroll
            for (int m = 0; m < 4; ++m)
#pragma unroll
                for (int n = 0; n < 2; ++n) acc[a][b][m][n] = (f32x4){0.f, 0.f, 0.f, 0.f};
    bf16x8 At[4][2], B0[2][2], B1[2][2];
    const char* cA = cur.A; const char* cB = cur.B;
    PG8_STAGE(PG8_SB(0, 0), cB, voffB); PG8_STAGE(PG8_SB(0, 1), cB + hsB, voffB); PG8_STAGE(PG8_SA(0, 0), cA, vc[0]); PG8_STAGE(PG8_SA(0, 1), cA, vc[1]);
    if (wr == 1) PG8_BAR;
    PG8_WAIT_V(2); PG8_BAR;
    PG8_STAGE(PG8_SB(1, 0), cB + kstep, voffB); PG8_STAGE(PG8_SA(1, 0), cA + kstep, vc[0]); PG8_STAGE(PG8_SB(1, 1), cB + hsB + kstep, voffB);
    PG8_WAIT_V(6); PG8_BAR;
    for (;;) {
        const bool has_next = S.next(ui + 1, nxt);
        if constexpr (Sched::WAITS) wst = has_next ? 1 : 0;
        const char* nA = has_next ? nxt.A : cA; const char* nB = has_next ? nxt.B : cB;
        if constexpr (GATHER) { if (has_next) PG8_ROWS(ui + 1, vn); else {
#pragma unroll
            for (int h = 0; h < 2; ++h) { vn[h][0] = vc[h][0]; vn[h][1] = vc[h][1]; } } }
        const int nt = cur.kt;
        for (int t = 0; t < nt; t += 2) {
            const bool last = (t == nt - 2);
            const char* a1 = cA + (size_t)(t + 1) * kstep;
            const char* a2 = last ? nA : cA + (size_t)(t + 2) * kstep; const char* b2 = last ? nB : cB + (size_t)(t + 2) * kstep;
            const char* a3 = a2 + kstep; const char* b3 = b2 + kstep;
            unsigned o0[2], o1[2];
#pragma unroll
            for (int i = 0; i < 2; ++i) { o0[i] = (GATHER && last) ? vn[0][i] : vc[0][i]; o1[i] = (GATHER && last) ? vn[1][i] : vc[1][i]; }
            PG8_LDB(B0, 0, 0); PG8_LDB(B1, 0, 1); PG8_SCHED; PG8_LDA(At, 0, 0); PG8_STAGE(PG8_SA(1, 1), a1, vc[1]);
            PG8_WAIT_V(8); PG8_WAIT_L(0); PG8_BAR; PG8_MMA(0, 0, At, B0); PG8_MMA(0, 1, At, B1); PG8_BAR; PG8_SCHED;
            PG8_LDA(At, 0, 1); PG8_STAGE(PG8_SB(0, 0), b2, voffB); PG8_STAGE(PG8_SB(0, 1), b2 + hsB, voffB); PG8_STAGE(PG8_SA(0, 0), a2, o0);
            PG8_WAIT_V(8); PG8_WAIT_L(0); PG8_BAR; PG8_MMA(1, 0, At, B0); PG8_MMA(1, 1, At, B1); PG8_BAR; PG8_SCHED;
            PG8_LDB(B0, 1, 0); PG8_LDB(B1, 1, 1); PG8_SCHED; PG8_LDA(At, 1, 0); PG8_STAGE(PG8_SA(0, 1), a2, o1);
            PG8_WAIT_V(8); PG8_WAIT_L(0); PG8_BAR; PG8_MMA(0, 0, At, B0); PG8_MMA(0, 1, At, B1); PG8_BAR; PG8_SCHED;
            PG8_LDA(At, 1, 1); PG8_STAGE(PG8_SB(1, 0), b3, voffB); PG8_STAGE(PG8_SB(1, 1), b3 + hsB, voffB); PG8_STAGE(PG8_SA(1, 0), a3, o0);
            PG8_WAIT_V(8); PG8_WAIT_L(0); PG8_BAR; PG8_MMA(1, 0, At, B0); PG8_MMA(1, 1, At, B1); PG8_BAR; PG8_SCHED;
            if constexpr (Sched::SIGNALS) { if (pend >= 0) { pend2 = pend; pend = -1; } else if (pend2 >= 0) { S.signal(pend2, lane, wid); pend2 = -1; } }
            if constexpr (Sched::WAITS) { if (wst == 1) { pv = S.poll(nxt); wst = 2; } else if (wst == 2) { wst = 0; if (pv < 8u) S.spin(nxt); } }
        }
        if constexpr (ALIGN_EPI) { if (wr == 0) PG8_BAR; }
        E(acc, cur, wr, wc, fr, fq);
        if constexpr (Sched::SIGNALS) pend = cur.pm;
        if (!has_next) break;
#pragma unroll
        for (int a = 0; a < 2; ++a)
#pragma unroll
            for (int b = 0; b < 2; ++b)
#pragma unroll
                for (int m = 0; m < 4; ++m)
#pragma unroll
                    for (int n = 0; n < 2; ++n) acc[a][b][m][n] = (f32x4){0.f, 0.f, 0.f, 0.f};
        cur = nxt; cA = nA; cB = nB; ++ui;
        if constexpr (GATHER) {
#pragma unroll
            for (int h = 0; h < 2; ++h) { vc[h][0] = vn[h][0]; vc[h][1] = vn[h][1]; } }
        if constexpr (ALIGN_EPI) { if (wr == 1) PG8_BAR; }
    }
    PG8_WAIT_V(0);
    if constexpr (!ALIGN_EPI) { if (wr == 0) PG8_BAR; }
    PG8_BAR;
    if constexpr (Sched::SIGNALS) { if (pend >= 0) S.signal(pend, lane, wid); }
#undef PG8_ROWS
#undef PG8_SA
#undef PG8_SB
#undef PG8_STAGE
#undef PG8_LDA
#undef PG8_LDB
#undef PG8_MMA
#undef PG8_WAIT_V
#undef PG8_WAIT_L
#undef PG8_BAR
#undef PG8_SCHED
}

template <unsigned AT, unsigned BT, int KT>
struct SchedDense {
    static constexpr bool SIGNALS = false, WAITS = false;
    TileOrder o; const char* A; const char* B; int pm0;
    __device__ __forceinline__ int rowtok(int, int) const { return 0; }
    __device__ __forceinline__ bool next(int i, Unit& u) const { int pm, pn; if (!o.get(i, pm, pn)) return false;
        u.rb = 0; u.cn = 0; u.pm = pm0 + pm; u.pn = pn; u.aux = 0; u.kt = KT; u.A = A + (size_t)((unsigned)u.pm * AT); u.B = B + (size_t)((unsigned)pn * BT); return true; }
};
template <unsigned AT, unsigned BT, int KT, int NN>
struct SchedSplit {
    static constexpr bool SIGNALS = false, WAITS = false;
    TileOrder o; const char* A; const char* B; int G, c; bool split;
    __device__ __forceinline__ int rowtok(int, int) const { return 0; }
    __device__ __forceinline__ void init(int G_, int c_) { G = G_; c = c_; split = ((64 * NN) % G_ == 0) && (2 * NN * 8 <= G_); if (split) o.init(64, NN, G_, c_); else o.init(66, NN, G_, c_); }
    __device__ __forceinline__ bool next(int i, Unit& u) const { u.rb = 0; u.cn = 0;
        if (!split) { int pm, pn; if (!o.get(i, pm, pn)) return false; u.pm = pm; u.pn = pn; u.aux = 0; u.kt = KT; u.A = A + (size_t)((unsigned)pm * AT); u.B = B + (size_t)((unsigned)pn * BT); return true; }
        const int fr = (64 * NN) / G;
        if (i < fr) { int pm, pn; o.get(i, pm, pn); u.pm = 2 + pm; u.pn = pn; u.aux = 0; u.kt = KT; u.A = A + (size_t)((unsigned)u.pm * AT); u.B = B + (size_t)((unsigned)pn * BT); return true; }
        if (i > fr || c >= 2 * NN * 8) return false;
        const int ks = c & 7, t = c >> 3; u.pm = t / NN; u.pn = t % NN; u.aux = ks + 1; u.kt = KT / 8;
        u.A = A + (size_t)((unsigned)u.pm * AT + (unsigned)ks * (KT / 8) * 128u); u.B = B + (size_t)((unsigned)u.pn * BT + (unsigned)ks * (KT / 8) * 128u); return true; }
};
struct SchedPool {
    static constexpr bool SIGNALS = false, WAITS = false;
    TileOrder o; const char* A; const char* B;
    __device__ __forceinline__ int rowtok(int, int) const { return 0; }
    __device__ __forceinline__ bool next(int i, Unit& u) const { int pm, pn; if (!o.get(i, pm, pn)) return false;
        u.rb = 0; u.cn = 0; u.pm = 2 + pm; u.pn = pn; u.aux = 0; u.kt = 8; const int g = pn >> 1;
        u.A = A + (size_t)((unsigned)u.pm * (256u * DM * 2u) + (unsigned)g * 1024u); u.B = B + (size_t)((unsigned)g * (512u * 512u * 2u) + (unsigned)(pn & 1) * (256u * 512u * 2u)); return true; }
};
struct SchedOne {
    static constexpr bool SIGNALS = false, WAITS = false;
    Unit u;
    __device__ __forceinline__ int rowtok(int, int) const { return 0; }
    __device__ __forceinline__ bool next(int i, Unit& o) const { if (i != 0) return false; o = u; return true; }
};
constexpr int RT_UNITS = 14;
template <unsigned AT, unsigned BT, unsigned BE, int KT, bool GATHER>
struct SchedMoe {
    static constexpr bool SIGNALS = GATHER, WAITS = !GATHER;
    unsigned* ctr;
    __device__ __forceinline__ void signal(int pm, int lane, int wid) const { if (wid == 0 && lane == 0) (void)xb_add(ctr + 32 * pm, 1u); }
    __device__ __forceinline__ void wait_ready(const Unit& u) const { while (xb_ld(ctr + 32 * u.pm) < 8u) __builtin_amdgcn_s_sleep(2); asm volatile("" ::: "memory"); }
    __device__ __forceinline__ unsigned poll(const Unit& u) const { return xb_ld(ctr + 32 * u.pm); }
    __device__ __forceinline__ void spin(const Unit& u) const { while (xb_ld(ctr + 32 * u.pm) < 8u) __builtin_amdgcn_s_sleep(2); }
    __device__ __forceinline__ void acquire_async() const { asm volatile("buffer_inv sc1" ::: "memory"); }
    TileOrder o; const char* A; const char* B; const PG8_LAS int* texp; const PG8_LAS int* tbase; const PG8_LAS int* tcnt; const PG8_LAS int* rt; const int* list;
    int rem = 0, nl = 0;
    __device__ __forceinline__ bool next(int i, Unit& u) const { int pm, pn;
        if (GATHER) { if (!o.get(i, pm, pn)) return false; }
        else { const bool light = o.c >= rem; const long L = (light && i < 2) ? (long)i * nl + (o.c - rem) : 2L * nl + (long)(light ? i - 2 : i) * o.G + o.c; if (!o.map(L, pm, pn)) return false; }
        const int e = __builtin_amdgcn_readfirstlane(texp[pm]);
        u.pm = pm; u.pn = pn; u.aux = e; u.kt = KT; u.ui = i; u.rb = (pm - __builtin_amdgcn_readfirstlane(tbase[e])) * 256; u.cn = __builtin_amdgcn_readfirstlane(tcnt[e]);
        u.A = GATHER ? A : A + (size_t)((unsigned)pm * AT); u.B = B + (size_t)((unsigned)e * BE + (unsigned)pn * BT); return true; }
    __device__ __forceinline__ int tok_of(const Unit& u, int row) const { const int pos = u.rb + row; return pos < u.cn ? (list[(size_t)u.aux * MT + pos] >> 1) : 0; }
    __device__ __forceinline__ int rowtok(int ui, int row) const { if (ui < RT_UNITS) return rt[ui * 256 + row]; Unit u; next(ui, u); return tok_of(u, row); }
    __device__ __forceinline__ void fill_dst(PG8_LAS int* rtw, const float* listg, int tid) const {
        int dv[RT_UNITS / 2]; float gv[RT_UNITS / 2]; bool ok[RT_UNITS / 2];
#pragma unroll
        for (int i = 0; i < RT_UNITS / 2; ++i) { Unit u; ok[i] = next(i, u); dv[i] = -1; gv[i] = 0.f;
            if (ok[i] && tid < 256) { const int pos = u.rb + tid; if (pos < u.cn) { const size_t li = (size_t)u.aux * MT + pos; dv[i] = list[li]; gv[i] = listg[li]; } } }
#pragma unroll
        for (int i = 0; i < RT_UNITS / 2; ++i) if (ok[i] && tid < 256) { rtw[i * 512 + tid] = dv[i]; rtw[i * 512 + 256 + tid] = (int)__float_as_uint(gv[i]); }
        __syncthreads(); }
    __device__ __forceinline__ void fill_rows(PG8_LAS int* rtw, int tid) const {
#pragma unroll
        for (int h = 0; h < 2; ++h) { int tk[RT_UNITS / 2]; bool ok[RT_UNITS / 2];
#pragma unroll
            for (int q = 0; q < RT_UNITS / 2; ++q) { Unit u; ok[q] = next(h * (RT_UNITS / 2) + q, u); tk[q] = 0; if (ok[q] && tid < 256) tk[q] = tok_of(u, tid); }
#pragma unroll
            for (int q = 0; q < RT_UNITS / 2; ++q) if (ok[q] && tid < 256) rtw[(h * (RT_UNITS / 2) + q) * 256 + tid] = tk[q]; }
        __syncthreads(); }
};

struct EpiBf16 {
    static constexpr bool PERM = true;
    bf16_t* O; int ldc; float* P;
    __device__ __forceinline__ void operator()(const f32x4 (&acc)[2][2][4][2], const Unit& u, int wr, int wc, int fr, int fq) const {
        const int row0 = u.pm * BM + wr * 64 + fr, col0 = u.pn * BM + wc * 32 + 8 * fq;
        if (u.aux == 0) {
#pragma unroll
            for (int ai = 0; ai < 2; ++ai)
#pragma unroll
                for (int m = 0; m < 4; ++m) { bf16_t* rowp = O + (size_t)(row0 + ai * HALF + m * 16) * ldc + col0;
#pragma unroll
                    for (int bj = 0; bj < 2; ++bj) { const f32x4 v0 = acc[ai][bj][m][0], v1 = acc[ai][bj][m][1];
                        v4u w; w.x = cvt_pk_bf16(v0[0], v0[1]); w.y = cvt_pk_bf16(v0[2], v0[3]); w.z = cvt_pk_bf16(v1[0], v1[1]); w.w = cvt_pk_bf16(v1[2], v1[3]);
                        *(v4u*)(rowp + bj * HALF) = w; } }
        } else {
            float* pb = P + (size_t)(u.aux - 1) * 512 * ldc;
#pragma unroll
            for (int ai = 0; ai < 2; ++ai)
#pragma unroll
                for (int m = 0; m < 4; ++m) { float* rowp = pb + (size_t)(row0 + ai * HALF + m * 16) * ldc + col0;
#pragma unroll
                    for (int bj = 0; bj < 2; ++bj) { *(f32x4*)(rowp + bj * HALF) = acc[ai][bj][m][0]; *(f32x4*)(rowp + bj * HALF + 4) = acc[ai][bj][m][1]; } }
        }
    }
};
struct EpiBf16W {
    static constexpr bool PERM = true;
    bf16_t* O; int ldc;
    __device__ __forceinline__ void operator()(const f32x4 (&acc)[2][2][4][2], const Unit& u, int wr, int wc, int fr, int fq) const {
        const int row0 = u.pm * BM + wr * 64 + fr, col0 = u.pn * BM + wc * 32 + 8 * fq;
#pragma unroll
        for (int ai = 0; ai < 2; ++ai)
#pragma unroll
            for (int m = 0; m < 4; ++m) { bf16_t* rowp = O + (size_t)(row0 + ai * HALF + m * 16) * ldc + col0;
#pragma unroll
                for (int bj = 0; bj < 2; ++bj) { const f32x4 v0 = acc[ai][bj][m][0], v1 = acc[ai][bj][m][1];
                    v4u w; w.x = cvt_pk_bf16(v0[0], v0[1]); w.y = cvt_pk_bf16(v0[2], v0[3]); w.z = cvt_pk_bf16(v1[0], v1[1]); w.w = cvt_pk_bf16(v1[2], v1[3]);
                    const bf16_t* gp = rowp + bj * HALF;
                    asm volatile("global_store_dwordx4 %0, %1, off sc1\n\ts_nop 1" :: "v"(gp), "v"(w) : "memory"); } }
    }
};
struct EpiQkv {
    static constexpr bool PERM = true;
    bf16_t* O; int ldc; float* P; bf16_t* V;
    __device__ __forceinline__ void operator()(const f32x4 (&acc)[2][2][4][2], const Unit& u, int wr, int wc, int fr, int fq) const {
        const int row0 = u.pm * BM + wr * 64 + fr, col0 = u.pn * BM + wc * 32 + 8 * fq;
        if (u.aux == 0) {
            const bool isV = u.pn >= (DM + KVD) / BM;
#pragma unroll
            for (int ai = 0; ai < 2; ++ai)
#pragma unroll
                for (int m = 0; m < 4; ++m) { const int row = row0 + ai * HALF + m * 16; bf16_t* rowp = O + (size_t)row * ldc + col0; size_t vstep = HALF;
                    if (isV) { const bool lat = row >= NCTX; const int lr = row - NCTX, b = lat ? (lr >> 13) : (row >> 8), kpos = lat ? (CTXL + (lr & 8191)) : (row & 255);
                        rowp = V + (((size_t)b * NKV + (size_t)(u.pn - (DM + KVD) / BM) * 2) * SKV + kpos) * HD + wc * 32 + 8 * fq; vstep = (size_t)SKV * HD; }
#pragma unroll
                    for (int bj = 0; bj < 2; ++bj) { const f32x4 v0 = acc[ai][bj][m][0], v1 = acc[ai][bj][m][1];
                        v4u w; w.x = cvt_pk_bf16(v0[0], v0[1]); w.y = cvt_pk_bf16(v0[2], v0[3]); w.z = cvt_pk_bf16(v1[0], v1[1]); w.w = cvt_pk_bf16(v1[2], v1[3]);
                        *(v4u*)(rowp + bj * vstep) = w; } }
        } else {
            float* pb = P + (size_t)(u.aux - 1) * 512 * ldc;
#pragma unroll
            for (int ai = 0; ai < 2; ++ai)
#pragma unroll
                for (int m = 0; m < 4; ++m) { float* rowp = pb + (size_t)(row0 + ai * HALF + m * 16) * ldc + col0;
#pragma unroll
                    for (int bj = 0; bj < 2; ++bj) { *(f32x4*)(rowp + bj * HALF) = acc[ai][bj][m][0]; *(f32x4*)(rowp + bj * HALF + 4) = acc[ai][bj][m][1]; } }
        }
    }
};
struct EpiGateUp {
    static constexpr bool PERM = true;
    bf16_t* ACT;
    __device__ __forceinline__ void operator()(const f32x4 (&acc)[2][2][4][2], const Unit& u, int wr, int wc, int fr, int fq) const {
        const int row0 = u.pm * BM + wr * 64 + fr, col0 = u.pn * HALF + wc * 32 + 8 * fq;
#pragma unroll
        for (int ai = 0; ai < 2; ++ai)
#pragma unroll
            for (int m = 0; m < 4; ++m) { bf16_t* rowp = ACT + (size_t)(row0 + ai * HALF + m * 16) * DE + col0;
                float v[8];
#pragma unroll
                for (int n = 0; n < 2; ++n)
#pragma unroll
                    for (int j = 0; j < 4; ++j) v[n * 4 + j] = silu_f(acc[ai][0][m][n][j]) * acc[ai][1][m][n][j];
                v4u w; w.x = cvt_pk_bf16(v[0], v[1]); w.y = cvt_pk_bf16(v[2], v[3]); w.z = cvt_pk_bf16(v[4], v[5]); w.w = cvt_pk_bf16(v[6], v[7]);
                asm volatile("global_store_dwordx4 %0, %1, off sc1\n\ts_nop 1" :: "v"(rowp), "v"(w) : "memory"); }
    }
};
struct EpiDown {
    static constexpr bool PERM = true;
    bf16_t* FB; const PG8_LAS int* rt;
    __device__ __forceinline__ void operator()(const f32x4 (&acc)[2][2][4][2], const Unit& u, int wr, int wc, int fr, int fq) const {
        const int r0 = wr * 64 + fr, col0 = u.pn * BM + wc * 32 + 8 * fq; const PG8_LAS int* tb = rt + u.ui * 512 + r0;
#pragma unroll
        for (int ai = 0; ai < 2; ++ai)
#pragma unroll
            for (int m = 0; m < 4; ++m) { const int d_ = tb[ai * HALF + m * 16]; const float g_ = __uint_as_float((unsigned)tb[256 + ai * HALF + m * 16]);
                if (d_ >= 0) { bf16_t* fr_ = FB + (size_t)d_ * DM + col0;
#pragma unroll
                    for (int bj = 0; bj < 2; ++bj) { const f32x4 v0 = acc[ai][bj][m][0] * g_, v1 = acc[ai][bj][m][1] * g_;
                        v4u w; w.x = cvt_pk_bf16(v0[0], v0[1]); w.y = cvt_pk_bf16(v0[2], v0[3]); w.z = cvt_pk_bf16(v1[0], v1[1]); w.w = cvt_pk_bf16(v1[2], v1[3]);
                        *(v4u*)(fr_ + bj * HALF) = w; } } }
    }
};
}

namespace att {
constexpr int D = 128, NW = 8, QBLK = 32, KVBLK = 64;
constexpr float SCALE = 0.088388347648318440f;
constexpr float THR = 8.f;
#ifndef ATT_SDEPTH
#define ATT_SDEPTH 1
#endif
constexpr int SDEPTH = ATT_SDEPTH;
constexpr int LDQ = DM, LDK = HD, LDO = DM;
constexpr size_t SHM_V = KVBLK * D * 2, SHM_K = KVBLK * D * 2, SHM_ATTN = 2 * SHM_V + 2 * SHM_K + NW * 64 * 4;
typedef unsigned u32x4 __attribute__((ext_vector_type(4)));
#define KSWZ(row, colB) ((row) * 256 + ((colB) ^ (((row) & 7) << 4)))
#define SBAR() __builtin_amdgcn_sched_barrier(0)
__device__ __forceinline__ int crow(int r, int hi) { return (r & 3) + 8 * (r >> 2) + 4 * hi; }
__device__ __forceinline__ unsigned cvtpk(float lo, float hi) { unsigned r; asm volatile("v_cvt_pk_bf16_f32 %0, %1, %2" : "=v"(r) : "v"(lo), "v"(hi)); return r; }
__device__ __forceinline__ bf16x8 ld8(const bf16_t* p) { return *reinterpret_cast<const bf16x8*>(p); }

__device__ __forceinline__ void partialSM(f32x16& p0, f32x16& p1, float& m_reg, float& mn, float& alpha) {
  constexpr float C = SCALE * 1.4426950408889634f;
  float pmax = p0[0]; for (int r = 1; r < 16; ++r) pmax = fmaxf(pmax, p0[r]); for (int r = 0; r < 16; ++r) pmax = fmaxf(pmax, p1[r]);
  { auto rr = __builtin_amdgcn_permlane32_swap(__float_as_uint(pmax), __float_as_uint(pmax), false, false);
    pmax = fmaxf(__uint_as_float(rr[0]), __uint_as_float(rr[1])); }
  if (__builtin_expect(__all(pmax - m_reg <= THR / SCALE), 1)) { mn = m_reg; alpha = 1.f; }
  else { mn = fmaxf(m_reg, pmax); alpha = __builtin_amdgcn_exp2f((m_reg - mn) * C); m_reg = mn; }
  float mnC = -mn * C;
  for (int r = 0; r < 16; ++r) p0[r] = fmaf(p0[r], C, mnC); for (int r = 0; r < 16; ++r) p1[r] = fmaf(p1[r], C, mnC);
  for (int r = 0; r < 16; ++r) p0[r] = __builtin_amdgcn_exp2f(p0[r]);
}
__device__ __forceinline__ void finishSM(f32x16& p0, f32x16& p1, float alpha, float& l_reg, bf16x8& pa0, bf16x8& pa1, bf16x8& pa2, bf16x8& pa3) {
  for (int r = 0; r < 16; ++r) p1[r] = __builtin_amdgcn_exp2f(p1[r]);
  float ps = 0; for (int r = 0; r < 16; ++r) ps += p0[r]; for (int r = 0; r < 16; ++r) ps += p1[r];
  { auto rr = __builtin_amdgcn_permlane32_swap(__float_as_uint(ps), __float_as_uint(ps), false, false);
    ps = __uint_as_float(rr[0]) + __uint_as_float(rr[1]); }
  l_reg = l_reg * alpha + ps;
#define PK4(P, BASE, OUT) do { unsigned a0 = cvtpk(P[BASE + 0], P[BASE + 1]), a1 = cvtpk(P[BASE + 2], P[BASE + 3]);   \
    unsigned b0 = cvtpk(P[BASE + 4], P[BASE + 5]), b1 = cvtpk(P[BASE + 6], P[BASE + 7]);                              \
    auto r0 = __builtin_amdgcn_permlane32_swap(a0, b0, false, false); auto r1 = __builtin_amdgcn_permlane32_swap(a1, b1, false, false); \
    u32x4 w = {r0[0], r1[0], r0[1], r1[1]}; OUT = *reinterpret_cast<bf16x8*>(&w); } while (0)
  PK4(p0, 0, pa0); PK4(p0, 8, pa1); PK4(p1, 0, pa2); PK4(p1, 8, pa3);
#undef PK4
}
__device__ __forceinline__ void qkt(f32x16& p0, f32x16& p1, const bf16_t* Ks, const bf16x8* qr, int r32, int hi) {
  p0 = f32x16{}; p1 = f32x16{};
  for (int d0 = 0; d0 < 8; ++d0) { int cb = (d0 * 16 + hi * 8) * 2;
    bf16x8 b0 = *reinterpret_cast<const bf16x8*>((const char*)Ks + KSWZ(r32, cb));
    bf16x8 b1 = *reinterpret_cast<const bf16x8*>((const char*)Ks + KSWZ(32 + r32, cb));
    p0 = __builtin_amdgcn_mfma_f32_32x32x16_bf16(b0, qr[d0], p0, 0, 0, 0);
    p1 = __builtin_amdgcn_mfma_f32_32x32x16_bf16(b1, qr[d0], p1, 0, 0, 0); }
}
__device__ __forceinline__ int v_st(int k, int c) { const int kk = (k & ~0xC) | ((k & 4) << 1) | ((k & 8) >> 1); return ((kk >> 3) * 4 + (c >> 5)) * 512 + ((kk & 7) * 32 + (c & 31)) * 2; }
__device__ __forceinline__ int v_rd_base(int lane) { return ((lane & 3) << 3) | (((lane >> 2) & 3) << 6) | (((lane >> 4) & 1) << 5) | (((lane >> 5) & 1) << 8); }
constexpr int v_rd_off(int d0, int ks, int half) { return d0 * 512 + ks * 4096 + half * 2048; }
template <int OFF> __device__ __forceinline__ s16x4 tr_read(int vb) {
  s16x4 r; asm volatile("ds_read_b64_tr_b16 %0, %1 offset:%2" : "=&v"(r) : "v"(vb), "i"(OFF) : "memory"); return r;
}
template <int D0> __device__ __forceinline__ void pv_one(f32x16& od, int vb, bf16x8 pa0, bf16x8 pa1, bf16x8 pa2, bf16x8 pa3) {
  const s16x4 l0 = tr_read<v_rd_off(D0, 0, 0)>(vb), h0 = tr_read<v_rd_off(D0, 0, 1)>(vb), l1 = tr_read<v_rd_off(D0, 1, 0)>(vb), h1 = tr_read<v_rd_off(D0, 1, 1)>(vb);
  const s16x4 l2 = tr_read<v_rd_off(D0, 2, 0)>(vb), h2 = tr_read<v_rd_off(D0, 2, 1)>(vb), l3 = tr_read<v_rd_off(D0, 3, 0)>(vb), h3 = tr_read<v_rd_off(D0, 3, 1)>(vb);
  asm volatile("s_waitcnt lgkmcnt(0)" ::: "memory"); SBAR();
#define PK(L, H) (bf16x8){L[0], L[1], L[2], L[3], H[0], H[1], H[2], H[3]}
  od = __builtin_amdgcn_mfma_f32_32x32x16_bf16(pa0, PK(l0, h0), od, 0, 0, 0);
  od = __builtin_amdgcn_mfma_f32_32x32x16_bf16(pa1, PK(l1, h1), od, 0, 0, 0);
  od = __builtin_amdgcn_mfma_f32_32x32x16_bf16(pa2, PK(l2, h2), od, 0, 0, 0);
  od = __builtin_amdgcn_mfma_f32_32x32x16_bf16(pa3, PK(l3, h3), od, 0, 0, 0);
#undef PK
}
__device__ __forceinline__ void pv_d0(f32x16* o, int vb, bf16x8 pa0, bf16x8 pa1, bf16x8 pa2, bf16x8 pa3) {
  pv_one<0>(o[0], vb, pa0, pa1, pa2, pa3); pv_one<1>(o[1], vb, pa0, pa1, pa2, pa3); pv_one<2>(o[2], vb, pa0, pa1, pa2, pa3); pv_one<3>(o[3], vb, pa0, pa1, pa2, pa3);
}
__device__ __forceinline__ void attn_dense_body(const bf16_t* __restrict__ Qb, const bf16_t* __restrict__ Kh, const bf16_t* __restrict__ Vh,
                                                bf16_t* __restrict__ Ob, int seq, char* lds) {
  const int tid = otid(), wid = tid >> 6, lane = tid & 63, r32 = lane & 31, hi = lane >> 5;
  bf16_t* V_lds = (bf16_t*)lds; bf16_t* K_lds = (bf16_t*)(lds + 2 * SHM_V);
  float* ws = (float*)(lds + 2 * SHM_V + 2 * SHM_K) + wid * 64; float* li_l = ws; float* al_l = ws + 32;
  float m_reg = -1e30f, l_reg = 0; f32x16 o[4] = {}; bf16x8 qr[8];
  const bf16_t* Qw = Qb + (long)(wid * QBLK + r32) * LDQ + hi * 8;
#pragma unroll
  for (int d0 = 0; d0 < 8; ++d0) qr[d0] = ld8(Qw + d0 * 16);
  const int sr = tid >> 4, sc = (tid & 15) * 8, vst0 = v_st(sr, sc), vst1 = v_st(32 + sr, sc);
  const int vb0 = (int)(uintptr_t)V_lds + v_rd_base(lane);
  struct { bf16x8 vs0, vs1, ks0, ks1; } sr_[SDEPTH];
#define SLOAD(i, k0) do { sr_[i].vs0 = ld8(&Vh[(long)((k0) + sr) * LDK + sc]); sr_[i].vs1 = ld8(&Vh[(long)((k0) + 32 + sr) * LDK + sc]); \
    sr_[i].ks0 = ld8(&Kh[(long)((k0) + sr) * LDK + sc]); sr_[i].ks1 = ld8(&Kh[(long)((k0) + 32 + sr) * LDK + sc]); } while (0)
#define SWRITE(b, i) do { *(bf16x8*)((char*)V_lds + (b) * SHM_V + vst0) = sr_[i].vs0;          \
    *(bf16x8*)((char*)V_lds + (b) * SHM_V + vst1) = sr_[i].vs1; int kc = sc * 2;               \
    *(bf16x8*)((char*)K_lds + (b) * SHM_K + KSWZ(sr, kc)) = sr_[i].ks0;                       \
    *(bf16x8*)((char*)K_lds + (b) * SHM_K + KSWZ(32 + sr, kc)) = sr_[i].ks1; } while (0)
#define SWAIT() do { if constexpr (SDEPTH == 2) asm volatile("s_waitcnt vmcnt(4)" ::: "memory"); else asm volatile("s_waitcnt vmcnt(0)" ::: "memory"); } while (0)
#define RESC(a) do { if (__any((a) < 1.f)) { if (hi == 0) al_l[r32] = (a); asm volatile("s_waitcnt lgkmcnt(0)" ::: "memory"); \
    for (int d = 0; d < 4; ++d) for (int r = 0; r < 16; ++r) o[d][r] *= al_l[crow(r, hi)]; } } while (0)
  f32x16 pA0, pA1, pB0, pB1; float mnA, mnB, alA, alB; bf16x8 pa0, pa1, pa2, pa3; const int NT = seq / KVBLK;
  constexpr int SE = 0, SO = SDEPTH - 1;
  SLOAD(SE, 0); asm volatile("s_waitcnt vmcnt(0)" ::: "memory"); SWRITE(0, SE); __syncthreads();
  qkt(pA0, pA1, K_lds, qr, r32, hi); partialSM(pA0, pA1, m_reg, mnA, alA);
  SLOAD(SO, KVBLK); if constexpr (SDEPTH == 2) { if (2 < NT) SLOAD(SE, 2 * KVBLK); }
  SWAIT(); SWRITE(1, SO); __syncthreads();
  for (int j = 1; j + 1 < NT; j += 2) {
    SBAR(); qkt(pB0, pB1, (bf16_t*)((char*)K_lds + SHM_K), qr, r32, hi);
    finishSM(pA0, pA1, alA, l_reg, pa0, pa1, pa2, pa3); SBAR();
    SLOAD(SO, (j + SDEPTH) * KVBLK); SBAR();
    pv_d0(o, vb0, pa0, pa1, pa2, pa3); partialSM(pB0, pB1, m_reg, mnB, alB);
    __syncthreads(); SWAIT(); SWRITE(0, SE);
    RESC(alB); __syncthreads();
    SBAR(); qkt(pA0, pA1, K_lds, qr, r32, hi);
    finishSM(pB0, pB1, alB, l_reg, pa0, pa1, pa2, pa3); SBAR();
    if (SDEPTH == 1 || j + 3 < NT) SLOAD(SE, (j + 1 + SDEPTH) * KVBLK); SBAR();
    pv_d0(o, vb0 + (int)SHM_V, pa0, pa1, pa2, pa3); partialSM(pA0, pA1, m_reg, mnA, alA);
    __syncthreads(); SWAIT(); SWRITE(1, SO);
    RESC(alA); __syncthreads();
  }
  SBAR(); qkt(pB0, pB1, (bf16_t*)((char*)K_lds + SHM_K), qr, r32, hi);
  finishSM(pA0, pA1, alA, l_reg, pa0, pa1, pa2, pa3); SBAR();
  pv_d0(o, vb0, pa0, pa1, pa2, pa3); partialSM(pB0, pB1, m_reg, mnB, alB);
  __syncthreads(); RESC(alB);
  finishSM(pB0, pB1, alB, l_reg, pa0, pa1, pa2, pa3); SBAR();
  pv_d0(o, vb0 + (int)SHM_V, pa0, pa1, pa2, pa3);
  if (hi == 0) li_l[r32] = l_reg; asm volatile("s_waitcnt lgkmcnt(0)" ::: "memory");
  float rli[16];
#pragma unroll
  for (int r = 0; r < 16; ++r) rli[r] = __builtin_amdgcn_rcpf(li_l[crow(r, hi)]);
  bf16_t* Ow = Ob + (long)(wid * QBLK) * LDO;
#pragma unroll
  for (int r = 0; r < 16; ++r) { int orow = crow(r, hi);
    for (int d0 = 0; d0 < 4; ++d0) Ow[(long)orow * LDO + d0 * 32 + r32] = (bf16_t)f2bf(o[d0][r] * rli[r]); }
  asm volatile("s_waitcnt vmcnt(0) lgkmcnt(0)" ::: "memory");
  __syncthreads();
#undef SLOAD
#undef SWRITE
#undef SWAIT
#undef RESC
}
constexpr size_t SHM_SLOT = 32768, SHM_DMA = 3 * SHM_SLOT + NW * 64 * 4;
#define ATT_WAIT_BAR() asm volatile("s_waitcnt vmcnt(0) lgkmcnt(0)\n\ts_barrier" ::: "memory")
__device__ __forceinline__ void attn_dma_body(const bf16_t* __restrict__ Qb, int ldq, int tpos0, const float* __restrict__ rope, const float* __restrict__ qgain,
                                              const bf16_t* __restrict__ Kh, const bf16_t* __restrict__ Vh, bf16_t* __restrict__ Ob, int seq, char* lds) {
  const int tid = otid(), wid = tid >> 6, lane = tid & 63, r32 = lane & 31, hi = lane >> 5;
  float* ws = (float*)(lds + 3 * SHM_SLOT) + wid * 64; float* li_l = ws; float* al_l = ws + 32;
  float m_reg = -1e30f, l_reg = 0; f32x16 o[4] = {}; bf16x8 qr[8];
  const bf16_t* Qw = Qb + (long)(wid * QBLK + r32) * ldq + hi * 8;
  unsigned koff[2], voff[2];
#pragma unroll
  for (int c = 0; c < 2; ++c) { const int g = c * 512 + tid;
    { const int row = g >> 4, ch = (g & 15) ^ (row & 7); koff[c] = (unsigned)(row * 128 + ch * 8) * 2u; }
    { const int sub = g >> 5, kk = (sub >> 2) * 8 + ((g >> 2) & 7), k = (kk & ~0xC) | ((kk & 4) << 1) | ((kk & 8) >> 1), col = (sub & 3) * 32 + (g & 3) * 8; voff[c] = (unsigned)(k * 128 + col) * 2u; } }
  const unsigned wbase = (unsigned)__builtin_amdgcn_readfirstlane(wid) * 1024u;
  typedef __attribute__((address_space(3))) unsigned lds_u32;
  lds_u32* ldsl = (lds_u32*)(__attribute__((address_space(3))) char*)lds;
#define ATT_DMA(t, slot) do { const char* kt_ = (const char*)Kh + (size_t)(t) * (KVBLK * D * 2); const char* vt_ = (const char*)Vh + (size_t)(t) * (KVBLK * D * 2); \
    _Pragma("unroll") for (int c_ = 0; c_ < 2; ++c_) { \
      __builtin_amdgcn_global_load_lds((const unsigned*)(kt_ + koff[c_]), (lds_u32*)((__attribute__((address_space(3))) char*)ldsl + (slot) * SHM_SLOT + c_ * 8192 + wbase), 16, 0, 0); \
      __builtin_amdgcn_global_load_lds((const unsigned*)(vt_ + voff[c_]), (lds_u32*)((__attribute__((address_space(3))) char*)ldsl + (slot) * SHM_SLOT + 16384 + c_ * 8192 + wbase), 16, 0, 0); } } while (0)
#define RESC(a) do { if (__any((a) < 1.f)) { if (hi == 0) al_l[r32] = (a); asm volatile("s_waitcnt lgkmcnt(0)" ::: "memory"); \
    for (int d = 0; d < 4; ++d) for (int r = 0; r < 16; ++r) o[d][r] *= al_l[crow(r, hi)]; } } while (0)
  const int NT = seq / KVBLK;
  ATT_DMA(0, 0); ATT_DMA(1, 1);
#pragma unroll
  for (int d0 = 0; d0 < 8; ++d0) qr[d0] = ld8(Qw + d0 * 16);
  if (tpos0 >= 0) {
    float ss = 0.f;
#pragma unroll
    for (int d0 = 0; d0 < 8; ++d0)
#pragma unroll
      for (int i = 0; i < 8; ++i) { const float x = bf2f((unsigned)(unsigned short)qr[d0][i]); ss += x * x; }
    { auto rr = __builtin_amdgcn_permlane32_swap(__float_as_uint(ss), __float_as_uint(ss), false, false); ss = __uint_as_float(rr[0]) + __uint_as_float(rr[1]); }
    const float rinv = 1.0f / sqrtf(ss * (1.0f / 128.0f) + RMS_EPS);
    const int t = tpos0 + wid * QBLK + r32;
#pragma unroll
    for (int ax = 0; ax < 2; ++ax) { const int pos = ax ? (t & 63) : (t >> 6);
#pragma unroll
      for (int q = 0; q < 2; ++q) { const int dl = 4 * ax + q, dh = dl + 2, p0 = q * 16 + 8 * hi;
        const float* cp_ = rope + pos * 32 + p0; const float* gl = qgain + dl * 16 + 8 * hi; const float* gh = qgain + dh * 16 + 8 * hi;
        float cs[8], sn[8], lo[8], hv[8];
#pragma unroll
        for (int i = 0; i < 8; ++i) { cs[i] = cp_[i]; sn[i] = cp_[4096 + i];
          lo[i] = bf2f((unsigned)(unsigned short)qr[dl][i]) * rinv * gl[i]; hv[i] = bf2f((unsigned)(unsigned short)qr[dh][i]) * rinv * gh[i]; }
        u32x4 wl, wh;
#pragma unroll
        for (int i = 0; i < 4; ++i) { const float l0 = lo[2 * i] * cs[2 * i] - hv[2 * i] * sn[2 * i], l1 = lo[2 * i + 1] * cs[2 * i + 1] - hv[2 * i + 1] * sn[2 * i + 1];
          const float h0 = hv[2 * i] * cs[2 * i] + lo[2 * i] * sn[2 * i], h1 = hv[2 * i + 1] * cs[2 * i + 1] + lo[2 * i + 1] * sn[2 * i + 1];
          wl[i] = pk2(l0, l1); wh[i] = pk2(h0, h1); }
        qr[dl] = *reinterpret_cast<bf16x8*>(&wl); qr[dh] = *reinterpret_cast<bf16x8*>(&wh); } } }
#pragma unroll
  for (int d0 = 0; d0 < 8; ++d0) asm volatile("" : "+v"(qr[d0]));
  ATT_WAIT_BAR();
  if (2 < NT) ATT_DMA(2, 2);
  const int vb0 = (int)(uintptr_t)lds + 16384 + v_rd_base(lane);
  f32x16 pA0, pA1, pB0, pB1; float mnA, mnB, alA, alB; bf16x8 pa0, pa1, pa2, pa3;
  qkt(pA0, pA1, (const bf16_t*)lds, qr, r32, hi); partialSM(pA0, pA1, m_reg, mnA, alA);
  int sj = 1;
  for (int j = 1; j + 1 < NT; j += 2) {
    { const int sp = sj == 0 ? 2 : sj - 1;
      SBAR(); qkt(pB0, pB1, (const bf16_t*)(lds + sj * SHM_SLOT), qr, r32, hi);
      finishSM(pA0, pA1, alA, l_reg, pa0, pa1, pa2, pa3); SBAR();
      pv_d0(o, vb0 + sp * (int)SHM_SLOT, pa0, pa1, pa2, pa3); partialSM(pB0, pB1, m_reg, mnB, alB);
      ATT_WAIT_BAR();
      if (j + 2 < NT) ATT_DMA(j + 2, sp);
      RESC(alB); }
    { const int s1 = sj == 2 ? 0 : sj + 1;
      SBAR(); qkt(pA0, pA1, (const bf16_t*)(lds + s1 * SHM_SLOT), qr, r32, hi);
      finishSM(pB0, pB1, alB, l_reg, pa0, pa1, pa2, pa3); SBAR();
      pv_d0(o, vb0 + sj * (int)SHM_SLOT, pa0, pa1, pa2, pa3); partialSM(pA0, pA1, m_reg, mnA, alA);
      ATT_WAIT_BAR();
      if (j + 3 < NT) ATT_DMA(j + 3, sj);
      RESC(alA);
      sj = s1 == 2 ? 0 : s1 + 1; }
  }
  { const int sp = sj == 0 ? 2 : sj - 1;
    SBAR(); qkt(pB0, pB1, (const bf16_t*)(lds + sj * SHM_SLOT), qr, r32, hi);
    finishSM(pA0, pA1, alA, l_reg, pa0, pa1, pa2, pa3); SBAR();
    pv_d0(o, vb0 + sp * (int)SHM_SLOT, pa0, pa1, pa2, pa3); partialSM(pB0, pB1, m_reg, mnB, alB);
    RESC(alB);
    finishSM(pB0, pB1, alB, l_reg, pa0, pa1, pa2, pa3); SBAR();
    pv_d0(o, vb0 + sj * (int)SHM_SLOT, pa0, pa1, pa2, pa3); }
  if (hi == 0) li_l[r32] = l_reg; asm volatile("s_waitcnt lgkmcnt(0)" ::: "memory");
  float rli[16];
#pragma unroll
  for (int r = 0; r < 16; ++r) rli[r] = __builtin_amdgcn_rcpf(li_l[crow(r, hi)]);
  bf16_t* Ow = Ob + (long)(wid * QBLK) * LDO;
  asm volatile("s_waitcnt lgkmcnt(0)\n\ts_barrier" ::: "memory");
  { char* st = lds + wid * 8704;
#pragma unroll
    for (int r = 0; r < 16; ++r) { const int orow = crow(r, hi);
#pragma unroll
      for (int d0 = 0; d0 < 4; ++d0) *(bf16_t*)(st + orow * 272 + (d0 * 32 + r32) * 2) = (bf16_t)f2bf(o[d0][r] * rli[r]); }
    asm volatile("s_waitcnt lgkmcnt(0)" ::: "memory");
#pragma unroll
    for (int i = 0; i < 8; ++i) { const int c = i * 64 + lane, row = c >> 4, cc = c & 15; const u32x4 v = *(const u32x4*)(st + row * 272 + cc * 16);
      const bf16_t* gp = Ow + (long)row * LDO + cc * 8;
      asm volatile("global_store_dwordx4 %0, %1, off sc1\n\ts_nop 1" :: "v"(gp), "v"(v) : "memory"); } }
  ATT_WAIT_BAR();
#undef ATT_DMA
#undef RESC
}
#undef KSWZ
}

struct Params {
    const float *x, *c, *ctx, *c_ctx, *w_mod, *b_mod, *ln_g, *ln_b, *w_qkv, *q_gain, *k_gain, *w_o, *w_pool, *pool_scale, *w_router, *router_bias, *w_gate, *w_up, *w_down;
    float* out; unsigned char* ws; int ph_lo, ph_hi;
};

struct TItem { const float* W; bf16_t* WT; int K, N, kind, k0, n0; };
__device__ __forceinline__ int t_drow(int kind, int n) { return kind == 0 ? n : ((n >> 7) * 256 + (kind == 2 ? 128 : 0) + (n & 127)); }
__device__ __forceinline__ void t_load(const TItem& d, f32x4 (&r)[8], int lane) {
    const float* p = d.W + (size_t)(d.k0 + (lane >> 3)) * d.N + d.n0 + (lane & 7) * 4;
#pragma unroll
    for (int i = 0; i < 8; ++i) r[i] = __builtin_nontemporal_load((const f32x4*)(p + (size_t)(8 * i) * d.N));
}
__device__ __forceinline__ void t_store(const TItem& d, const f32x4 (&r)[8], LAS float* scr, int lane) {
#pragma unroll
    for (int i = 0; i < 8; ++i) *(LAS f32x4*)(scr + (8 * i + (lane >> 3)) * 32 + (((lane & 7) * 4 + 8 * i) & 31)) = r[i];
    LDS_WAIT(); asm volatile("" ::: "memory");
    const int c = lane >> 3, nl = lane & 7;
#pragma unroll
    for (int j = 0; j < 4; ++j) { const int n = nl + 8 * j; const LAS float* s = scr + (8 * c) * 32 + ((n + 8 * c) & 31);
        v4u o; o.x = pk2(s[0 * 32], s[1 * 32]); o.y = pk2(s[2 * 32], s[3 * 32]); o.z = pk2(s[4 * 32], s[5 * 32]); o.w = pk2(s[6 * 32], s[7 * 32]);
        __builtin_nontemporal_store(o, (GAS v4u*)(d.WT + (size_t)t_drow(d.kind, d.n0 + n) * d.K + d.k0 + 8 * c)); }
    LDS_WAIT(); asm volatile("" ::: "memory");
}

__device__ __forceinline__ void mod_prepare(const float* cl, const float* cc, LAS float* sv, int tid) {
    for (int i = tid; i < 3 * DM; i += 512) { const int cd = i >> 11, k = i & 2047; const float v = (cd < 2) ? cl[cd * DM + k] : cc[k]; sv[i] = v / (1.0f + expf(-v)); }
    __syncthreads();
}
__device__ __forceinline__ void mod_item(int it, const float* wm, const float* bm, float* MOD, const LAS float* sv, LAS float* red, int tid, int lane, int wave) {
    const int c4 = lane & 7, kr = (lane >> 3) + 8 * wave;
    const int l = it / 384, nb = it % 384; const float* W = wm + (size_t)l * DM * 12288 + nb * 32 + c4 * 4;
    f32x4 a0 = {0, 0, 0, 0}, a1 = a0, a2 = a0;
#pragma unroll 16
    for (int s = 0; s < 32; ++s) { const int k = s * 64 + kr; const f32x4 w = *(const f32x4*)(W + (size_t)k * 12288);
        a0 += w * sv[k]; a1 += w * sv[DM + k]; a2 += w * sv[2 * DM + k]; }
    *(LAS f32x4*)(red + (kr * 3 + 0) * 32 + c4 * 4) = a0; *(LAS f32x4*)(red + (kr * 3 + 1) * 32 + c4 * 4) = a1; *(LAS f32x4*)(red + (kr * 3 + 2) * 32 + c4 * 4) = a2;
    __syncthreads();
    if (tid < 96) { const int cd = tid >> 5, n = tid & 31; float s = 0.f; for (int r = 0; r < 64; ++r) s += red[(r * 3 + cd) * 32 + n];
        MOD[((size_t)l * 3 + cd) * 12288 + nb * 32 + n] = s + bm[l * 12288 + nb * 32 + n]; }
    __syncthreads();
}

typedef const __attribute__((address_space(4))) Params CParams;
__device__ __forceinline__ CParams* kparams() { CParams* k = (CParams*)__builtin_amdgcn_kernarg_segment_ptr(); asm volatile("" : "+s"(k)); return k; }
#define WSP(T, off) ((T*)(kp->ws + (off)))


#define IN(k) (lo <= (k) && (k) < hi)
#define NREP(k) (1 + ((REP_MASK >> (k)) & 1))
#define SEAM(k) do { if (IN(k) && IN((k) + 1)) xcd_barrier(bar); } while (0)
#define TIDS const int tid = otid(), lane = tid & 63, wave = __builtin_amdgcn_readfirstlane(tid >> 6), G = ogrid(), bx = obid(), gw = bx * 8 + wave, NGW = G * 8; (void)lane; (void)gw; (void)NGW


template <int layer>
__device__ __forceinline__ void layer_half(const int lo, const int hi, const XcdBarrier& bar, LAS unsigned char* L, LAS int* tcnt, LAS int* tbase, LAS int* texp) {
        const int P6 = 6 + 7 * layer;
        if (IN(P6)) _Pragma("unroll 1") for (int rep_ = 0; rep_ < NREP(6); ++rep_) {
            CParams* kp = kparams(); TIDS;
            const int row_lo = layer == 0 ? 0 : NCTX;
            const float* modl = WSP(float, WS_MOD) + (size_t)layer * 3 * 12288;
            unsigned* cnt = WSP(unsigned, WS_CTL) + CW_CNT + layer * 1024;
            const bf16_t* Y = WSP(bf16_t, WS_Y); float* X1 = WSP(float, WS_X1); bf16_t* Hb = WSP(bf16_t, WS_H);
            const float* xlat = kp->x; const float* xctx = kp->ctx; const bf16_t* X2b = WSP(bf16_t, WS_X2);
            const float* pscale = kp->pool_scale;
            int* LIST = WSP(int, WS_LIST); float* LISTG = WSP(float, WS_LIST) + (size_t)32 * MT;
            const float* rbias = kp->router_bias;
            LAS bf16_t* hp = (LAS bf16_t*)L;
            LAS float* part = (LAS float*)(L + 65536);
            LAS int* lcnt = (LAS int*)(L + 65536 + 8192); LAS int* lbase = lcnt + 32;
            LAS int* asg = (LAS int*)(L + 65536 + 8192 + 256);
            LAS float* vG1 = (LAS float*)(L + 82176); LAS float* vLG = vG1 + DM; LAS float* vLB = vLG + DM; LAS float* vSC = vLB + DM; LAS float* vSH = vSC + DM;
            const float* lg = kp->ln_g + (size_t)(layer * 2 + 0) * DM; const float* lb = kp->ln_b + (size_t)(layer * 2 + 0) * DM;
            const int ngrp = (MT - row_lo) / 8;
            const bool agg = ((ngrp + G - 1) / G) * 16 <= 512;
            if (tid < 32) lcnt[tid] = 0;
            const int ti = lane & 31, hi = lane >> 5;
            const bf16_t* w1p = WSP(bf16_t, WS_WR) + ((size_t)(wave * 16) * 64 + lane) * 8; const bf16_t* w2p = w1p + 32 * DM;
            const LAS bf16_t* a1p = hp + (ti & 7) * DM + wave * 256 + 8 * hi; const LAS bf16_t* a2p = a1p + 8 * DM;
            f32x4 xv[8]; v2u xb[8], yv[8];
#define P6_LOAD(grp_) do { const int row_ = row_lo + (grp_) * 8 + wave; const float* xr_ = (row_ < NCTX) ? xctx + (size_t)row_ * DM : xlat + (size_t)(row_ - NCTX) * DM; const bf16_t* yr_ = Y + (size_t)row_ * DM; const bf16_t* xb_ = X2b + (size_t)row_ * DM; \
                _Pragma("unroll") for (int j = 0; j < 8; ++j) { if (layer == 0) xv[j] = *(const f32x4*)(xr_ + (j * 64 + lane) * 4); else xb[j] = *(const v2u*)(xb_ + (j * 64 + lane) * 4); yv[j] = *(const v2u*)(yr_ + (j * 64 + lane) * 4); } } while (0)
            LAS int* rdy = (LAS int*)(L + 124928); unsigned* yd = WSP(unsigned, WS_CTL) + CW_YD; volatile LAS unsigned* MISC = (volatile LAS unsigned*)(L + MISC_OFF);
            const bool dyn = (layer == 0) && (G % 2 == 0); const int pcls = bx & 1; unsigned* q6 = WSP(unsigned, WS_CTL) + CW_P6Q + 32 * pcls;
            auto gmap = [&](unsigned pos) -> int { return pos >= 1056u ? -1 : (pos < 32u ? pcls * 32 + (int)pos : 64 + pcls * 1024 + ((int)pos - 32)); };
            auto seq = [&](int k) -> int { const int g_ = bx + k * G; return g_ < ngrp ? g_ : -1; };
            auto ensure = [&](int g_) { if (layer == 0) { const int pm_ = g_ < 64 ? (g_ >> 5) : 2 + ((g_ - 64) >> 5); if (!rdy[pm_]) { while (xb_ld(yd + 32 * pm_) < 8u) __builtin_amdgcn_s_sleep(4); asm volatile("" ::: "memory"); } } };
            if (layer == 0) { if (tid < 66) rdy[tid] = xb_ld(yd + 32 * tid) >= 8u ? 1 : 0;
                if (tid == 0) { __builtin_amdgcn_fence(__ATOMIC_ACQUIRE, "agent"); asm volatile("s_waitcnt vmcnt(0)" ::: "memory");
                    if (dyn) { MISC[36] = xb_add(q6, 1u); MISC[37] = xb_add(q6, 1u); } }
                __syncthreads(); }
            int grp = dyn ? gmap(MISC[36]) : seq(0), nxt_ = dyn ? gmap(MISC[37]) : seq(1);
            if (grp >= 0) ensure(grp);
            P6_LOAD(grp >= 0 ? grp : 0);
            int it_ = 0, cur_cd = -1;
            for (; grp >= 0; ++it_) {
                const int pf_ = nxt_ >= 0 ? nxt_ : grp; if (nxt_ >= 0) ensure(nxt_);
                unsigned tk2 = 0xffffffffu;
                if (dyn && tid == 0 && nxt_ >= 0 && it_ + 2 < 32) tk2 = xb_add(q6, 1u);
                const int row = row_lo + grp * 8 + wave; const int cd = row_cond(row_lo + grp * 8);
                if (cd != cur_cd) {
                    const float* g1 = modl + (size_t)cd * 12288 + 2 * DM;
                    float t0[4], t1[4], t2[4], t3[4], t4[4], t5[4];
                    __syncthreads();
#pragma unroll
                    for (int q = 0; q < 4; ++q) { const int i = tid + q * 512; t0[q] = g1[i]; t1[q] = (layer == 1) ? pscale[i] : 1.0f; t2[q] = lg[i]; t3[q] = lb[i]; t4[q] = g1[DM + i]; t5[q] = g1[2 * DM + i]; }
#pragma unroll
                    for (int q = 0; q < 4; ++q) { const int i = tid + q * 512; vG1[i] = t0[q] * t1[q]; vLG[i] = t2[q]; vLB[i] = t3[q]; vSH[i] = t4[q]; vSC[i] = t5[q] + 1.0f; }
                    cur_cd = cd; __syncthreads(); }
                f32x4 v[8]; float s = 0.f;
#pragma unroll
                for (int j = 0; j < 8; ++j) { const int c = (j * 64 + lane) * 4; const f32x4 gv = *(const LAS f32x4*)(vG1 + c);
                    const f32x4 yf = {bf2f(yv[j].x & 0xffffu), bf2f(yv[j].x >> 16), bf2f(yv[j].y & 0xffffu), bf2f(yv[j].y >> 16)};
                    const f32x4 xf = (layer == 0) ? xv[j] : bf4(xb[j]);
                    v[j] = xf * ALPHA + gv * yf; s += (v[j][0] + v[j][1]) + (v[j][2] + v[j][3]); }
                const float mean = wave_sum(s) * (1.0f / DM); float s2 = 0.f;
#pragma unroll
                for (int j = 0; j < 8; ++j) { v[j] = v[j] - mean; s2 += (v[j][0] * v[j][0] + v[j][1] * v[j][1]) + (v[j][2] * v[j][2] + v[j][3] * v[j][3]); }
                const float rstd = 1.0f / sqrtf(wave_sum(s2) * (1.0f / DM) + LN_EPS);
#pragma unroll
                for (int j = 0; j < 8; ++j) { const int c = (j * 64 + lane) * 4;
                    const f32x4 x1 = v[j] * rstd * *(const LAS f32x4*)(vLG + c) + *(const LAS f32x4*)(vLB + c);
                    { v2u xw; xw.x = pk2(x1[0], x1[1]); xw.y = pk2(x1[2], x1[3]); *(v2u*)((bf16_t*)X1 + (size_t)row * DM + c) = xw; }
                    const f32x4 hv = x1 * *(const LAS f32x4*)(vSC + c) + *(const LAS f32x4*)(vSH + c);
                    v2u w; w.x = pk2(hv[0], hv[1]); w.y = pk2(hv[2], hv[3]); *(v2u*)(Hb + (size_t)row * DM + c) = w;
                    v2u w2; w2.x = pk2(hv[0] - bf2f(w.x & 0xffffu), hv[1] - bf2f(w.x >> 16)); w2.y = pk2(hv[2] - bf2f(w.y & 0xffffu), hv[3] - bf2f(w.y >> 16));
                    *(LAS v2u*)(hp + wave * DM + c) = w; *(LAS v2u*)(hp + (8 + wave) * DM + c) = w2; }
                const bf16_t* w1q = w1p; asm volatile("" : "+v"(w1q));
                const bf16_t* w2q = w1q + 32 * DM;
                bf16x8 wA1[4], wA2[4], wB1[4], wB2[4];
#define P6_WLOAD(d1, d2, q0) do { _Pragma("unroll") for (int q_ = 0; q_ < 4; ++q_) { d1[q_] = *(const GAS bf16x8*)(w1q + ((q0) + q_) * 512); d2[q_] = *(const GAS bf16x8*)(w2q + ((q0) + q_) * 512); } } while (0)
#define P6_MMA(s1, s2, q0) do { _Pragma("unroll") for (int q_ = 0; q_ < 4; ++q_) { const bf16x8 a1 = *(const LAS bf16x8*)(a1p + ((q0) + q_) * 16), a2 = *(const LAS bf16x8*)(a2p + ((q0) + q_) * 16); \
                    acc = __builtin_amdgcn_mfma_f32_32x32x16_bf16(a1, s1[q_], acc, 0, 0, 0); acc = __builtin_amdgcn_mfma_f32_32x32x16_bf16(a1, s2[q_], acc, 0, 0, 0); acc = __builtin_amdgcn_mfma_f32_32x32x16_bf16(a2, s1[q_], acc, 0, 0, 0); } } while (0)
                P6_WLOAD(wA1, wA2, 0); P6_WLOAD(wB1, wB2, 4);
                __syncthreads();
                {
                    f32x16 acc = {};
                    __builtin_amdgcn_sched_barrier(0); P6_MMA(wA1, wA2, 0); __builtin_amdgcn_sched_barrier(0);
                    P6_WLOAD(wA1, wA2, 8); __builtin_amdgcn_sched_barrier(0); P6_MMA(wB1, wB2, 4); __builtin_amdgcn_sched_barrier(0);
                    P6_WLOAD(wB1, wB2, 12); __builtin_amdgcn_sched_barrier(0);
                    P6_LOAD(pf_);
                    __builtin_amdgcn_sched_barrier(0); P6_MMA(wA1, wA2, 8); __builtin_amdgcn_sched_barrier(0);
                    P6_MMA(wB1, wB2, 12);
#pragma unroll
                    for (int r = 0; r < 4; ++r) part[(wave * 8 + r + 4 * hi) * 32 + ti] = acc[r];
                }
                if (dyn && tid == 0) MISC[38] = tk2;
                __syncthreads();
                {
                    const int rr = row_lo + grp * 8 + wave, e = lane & 31; float lgt = 0.f;
#pragma unroll
                    for (int k = 0; k < 8; ++k) lgt += part[(k * 8 + wave) * 32 + e];
                    const float aff = 1.0f / (1.0f + expf(-lgt)); const float sel = aff + rbias[e];
                    const float o1 = dppf<0xB1>(sel), mx1 = fmaxf(sel, o1), mn1 = fminf(sel, o1);
                    const float mx2 = dppf<0x4E>(mx1), mn2 = dppf<0x4E>(mn1);
                    float gs = fmaxf(mx1, mx2) + fmaxf(fminf(mx1, mx2), fmaxf(mn1, mn2)); int bg = e >> 2;
                    { const float og = dppf<0x141>(gs); const int ob = dppi<0x141>(bg); if (og > gs || (og == gs && ob < bg)) { gs = og; bg = ob; } }
                    { const float og = dppf<0x140>(gs); const int ob = dppi<0x140>(bg); if (og > gs || (og == gs && ob < bg)) { gs = og; bg = ob; } }
                    { const auto rg = __builtin_amdgcn_permlane16_swap(__float_as_uint(gs), __float_as_uint(gs), false, false); const auto rb = __builtin_amdgcn_permlane16_swap((unsigned)bg, (unsigned)bg, false, false);
                      const bool odd = (lane & 16) != 0; const float og = __uint_as_float(odd ? rg[0] : rg[1]); const int ob = (int)(odd ? rb[0] : rb[1]); if (og > gs || (og == gs && ob < bg)) { gs = og; bg = ob; } }
                    const int bgs = __builtin_amdgcn_readfirstlane(bg);
                    float s4[4], a4[4];
#pragma unroll
                    for (int j = 0; j < 4; ++j) { s4[j] = __uint_as_float((unsigned)__builtin_amdgcn_readlane((int)__float_as_uint(sel), bgs * 4 + j)); a4[j] = __uint_as_float((unsigned)__builtin_amdgcn_readlane((int)__float_as_uint(aff), bgs * 4 + j)); }
                    int i0 = 0; float m0 = s4[0], g0 = a4[0];
#pragma unroll
                    for (int j = 1; j < 4; ++j) if (s4[j] > m0) { m0 = s4[j]; i0 = j; g0 = a4[j]; }
                    int i1 = -1; float m1 = -1e30f, g1_ = 0.f;
#pragma unroll
                    for (int j = 0; j < 4; ++j) if (j != i0 && s4[j] > m1) { m1 = s4[j]; i1 = j; g1_ = a4[j]; }
                    const int e0 = __builtin_amdgcn_readfirstlane(bg * 4 + i0), e1 = __builtin_amdgcn_readfirstlane(bg * 4 + i1);
                    const float inv = 1.0f / (g0 + g1_);
                    if (lane == 0 && rep_ == 0) {
                        if (agg) { const int q0 = __hip_atomic_fetch_add(&lcnt[e0], 1, __ATOMIC_RELAXED, __HIP_MEMORY_SCOPE_WORKGROUP), q1 = __hip_atomic_fetch_add(&lcnt[e1], 1, __ATOMIC_RELAXED, __HIP_MEMORY_SCOPE_WORKGROUP);
                            LAS int* ap = asg + (it_ * 8 + wave) * 8;
                            ap[0] = e0; ap[1] = q0; ap[2] = rr * 2; ap[3] = (int)__float_as_uint(g0 * inv); ap[4] = e1; ap[5] = q1; ap[6] = rr * 2 + 1; ap[7] = (int)__float_as_uint(g1_ * inv);
                        } else {
                            const unsigned p0 = __hip_atomic_fetch_add(&cnt[e0 * 32], 1u, RLX_AGENT), p1 = __hip_atomic_fetch_add(&cnt[e1 * 32], 1u, RLX_AGENT);
                            LIST[(size_t)e0 * MT + p0] = rr * 2; LISTG[(size_t)e0 * MT + p0] = g0 * inv;
                            LIST[(size_t)e1 * MT + p1] = rr * 2 + 1; LISTG[(size_t)e1 * MT + p1] = g1_ * inv; } }
                }
                grp = nxt_; nxt_ = dyn ? gmap(MISC[38]) : seq(it_ + 2);
            }
#undef P6_LOAD
#undef P6_WLOAD
#undef P6_MMA
            __syncthreads();
            if (agg && rep_ == 0) {
                if (tid < 32) lbase[tid] = (int)__hip_atomic_fetch_add(&cnt[tid * 32], (unsigned)lcnt[tid], RLX_AGENT);
                __syncthreads();
                for (int i = tid; i < it_ * 16; i += 512) { const int e = asg[i * 4], q = asg[i * 4 + 1], src = asg[i * 4 + 2]; const float gt = __uint_as_float((unsigned)asg[i * 4 + 3]);
                    const size_t o = (size_t)e * MT + (size_t)(lbase[e] + q); LIST[o] = src; LISTG[o] = gt; }
            }
            __syncthreads();
        }
        SEAM(P6);
        int NT = 0;
        if (IN(P6 + 1) || IN(P6 + 2) || IN(P6 + 3)) {
            CParams* kp = kparams(); unsigned* cnt = WSP(unsigned, WS_CTL) + CW_CNT + layer * 1024;
            const int ttid = otid();
            if (ttid < 64) { const int ln = ttid, e = ln & 31; const int c = (int)__hip_atomic_load(&cnt[e * 32], RLX_AGENT); const int nt_ = (c + 255) >> 8; int inc = nt_;
#pragma unroll
                for (int o = 1; o < 32; o <<= 1) { const int t_ = __shfl_up(inc, o); if ((ln & 31) >= o) inc += t_; }
                if (ln < 32) { tcnt[e] = c; tbase[e] = inc - nt_; if (e == 31) tbase[32] = inc; for (int t_ = inc - nt_; t_ < inc; ++t_) texp[t_] = e; } }
            __syncthreads();
            NT = __builtin_amdgcn_readfirstlane(tbase[32]);
        }
        if (IN(P6 + 2)) _Pragma("unroll 1") for (int rep_ = 0; rep_ < NREP(8); ++rep_) {
            CParams* kp = kparams();
            typedef pg8::SchedMoe<256u * DM * 2u, 256u * DM * 2u, 2048u * DM * 2u, DM / 64, true> Sch;
            LAS int* rt = (LAS int*)(L + TAB_OFF + 1024);
            pg8::Gemm g{DM, DM, DM}; Sch S; S.o.init(NT, 8, ogrid(), obid()); S.A = WSP(const char, WS_H); S.B = WSP(const char, WS_WGU) + (size_t)layer * 32 * 2048 * DM * 2;
            S.texp = texp; S.tbase = tbase; S.tcnt = tcnt; S.rt = rt; S.list = WSP(int, WS_LIST); S.ctr = WSP(unsigned, WS_CTL) + CW_GUD + layer * 8192;
            S.fill_rows(rt, otid());
            pg8::EpiGateUp E{WSP(bf16_t, WS_ACT)};
            pg8::gemm_phase<pg8::EpiGateUp, Sch, true, true>(L, g, S, E);
        }
        if (IN(P6 + 2)) _Pragma("unroll 1") for (int rep_ = 0; rep_ < NREP(9); ++rep_) {
            CParams* kp = kparams();
            typedef pg8::SchedMoe<256u * DE * 2u, 256u * DE * 2u, (unsigned)DM * DE * 2u, DE / 64, false> Sch;
            pg8::Gemm g{DE, DE, DE}; Sch S; S.o.init(NT, 8, ogrid(), obid()); S.o.rot = 1; S.rem = (NT * 8) % ogrid(); S.nl = ogrid() - S.rem; S.A = WSP(const char, WS_ACT); S.B = WSP(const char, WS_WD) + (size_t)layer * 32 * DM * DE * 2;
            LAS int* rt = (LAS int*)(L + TAB_OFF + 1024);
            S.texp = texp; S.tbase = tbase; S.tcnt = tcnt; S.rt = nullptr; S.list = WSP(int, WS_LIST); S.ctr = WSP(unsigned, WS_CTL) + CW_GUD + layer * 8192;
            if (otid() == 0) { __builtin_amdgcn_fence(__ATOMIC_ACQUIRE, "agent"); asm volatile("s_waitcnt vmcnt(0)" ::: "memory"); }
            S.fill_dst(rt, WSP(float, WS_LIST) + (size_t)32 * MT, otid());
            pg8::EpiDown E{WSP(bf16_t, WS_FB), rt};
            pg8::gemm_phase<pg8::EpiDown, Sch, true, false>(L, g, S, E);
        }
        SEAM(P6 + 3);
        if (IN(P6 + 4)) _Pragma("unroll 1") for (int rep_ = 0; rep_ < NREP(10); ++rep_) {
            CParams* kp = kparams(); TIDS;
            const int row_lo = layer == 0 ? 0 : NCTX;
            const float* modl = WSP(float, WS_MOD) + (size_t)layer * 3 * 12288; const float* X1 = WSP(float, WS_X1); const bf16_t* FB = WSP(bf16_t, WS_FB);
            float* dstb = kp->out - (size_t)NCTX * DM; bf16_t* X2b = WSP(bf16_t, WS_X2);
            LAS float* vG2 = (LAS float*)L; LAS float* vLG = vG2 + 3 * DM; LAS float* vLB = vLG + DM;
            { const float* lg = kp->ln_g + (size_t)(layer * 2 + 1) * DM; const float* lb = kp->ln_b + (size_t)(layer * 2 + 1) * DM;
              float t0[12], t1[4], t2[4];
#pragma unroll
              for (int q = 0; q < 12; ++q) { const int i = tid + q * 512; t0[q] = modl[(size_t)(i >> 11) * 12288 + 5 * DM + (i & 2047)]; }
#pragma unroll
              for (int q = 0; q < 4; ++q) { const int i = tid + q * 512; t1[q] = lg[i]; t2[q] = lb[i]; }
#pragma unroll
              for (int q = 0; q < 12; ++q) vG2[tid + q * 512] = t0[q];
#pragma unroll
              for (int q = 0; q < 4; ++q) { vLG[tid + q * 512] = t1[q]; vLB[tid + q * 512] = t2[q]; } }
            __syncthreads();
            f32x4 xa[8]; v2u fa[8], fb[8];
#define P10_LOAD(row_) do { const float* xr_ = X1 + (size_t)(row_) * DM; const bf16_t* xb_ = (const bf16_t*)X1 + (size_t)(row_) * DM; const bf16_t* f0_ = FB + (size_t)((row_) * 2) * DM; \
                _Pragma("unroll") for (int j = 0; j < 8; ++j) { const int c = (j * 64 + lane) * 4; \
                    { const v2u q_ = *(const v2u*)(xb_ + c); xa[j] = (f32x4){bf2f(q_.x & 0xffffu), bf2f(q_.x >> 16), bf2f(q_.y & 0xffffu), bf2f(q_.y >> 16)}; } \
                    fa[j] = *(const v2u*)(f0_ + c); fb[j] = *(const v2u*)(f0_ + DM + c); } } while (0)
            { const int r0 = row_lo + gw; P10_LOAD(r0 < MT ? r0 : row_lo); }
            for (int row = row_lo + gw; row < MT; row += NGW) { const int cd = row_cond(row);
                f32x4 v[8]; float s = 0.f;
#pragma unroll
                for (int j = 0; j < 8; ++j) { const int c = (j * 64 + lane) * 4;
                    const f32x4 fs = {bf2f(fa[j].x & 0xffffu) + bf2f(fb[j].x & 0xffffu), bf2f(fa[j].x >> 16) + bf2f(fb[j].x >> 16), bf2f(fa[j].y & 0xffffu) + bf2f(fb[j].y & 0xffffu), bf2f(fa[j].y >> 16) + bf2f(fb[j].y >> 16)};
                    v[j] = xa[j] * ALPHA + *(const LAS f32x4*)(vG2 + cd * DM + c) * fs; s += (v[j][0] + v[j][1]) + (v[j][2] + v[j][3]); }
                if (row + NGW < MT) P10_LOAD(row + NGW);
                const float mean = wave_sum(s) * (1.0f / DM); float s2 = 0.f;
#pragma unroll
                for (int j = 0; j < 8; ++j) { v[j] = v[j] - mean; s2 += (v[j][0] * v[j][0] + v[j][1] * v[j][1]) + (v[j][2] * v[j][2] + v[j][3] * v[j][3]); }
                const float rstd = 1.0f / sqrtf(wave_sum(s2) * (1.0f / DM) + LN_EPS);
                float* dst = dstb + (size_t)row * DM;
#pragma unroll
                for (int j = 0; j < 8; ++j) { const int c = (j * 64 + lane) * 4; const f32x4 r_ = v[j] * rstd * *(const LAS f32x4*)(vLG + c) + *(const LAS f32x4*)(vLB + c);
                    if (layer == 0) { v2u w; w.x = pk2(r_[0], r_[1]); w.y = pk2(r_[2], r_[3]); *(v2u*)(X2b + (size_t)row * DM + c) = w; } else *(f32x4*)(dst + c) = r_; } }
#undef P10_LOAD
            __syncthreads();
        }
        if constexpr (layer == 0) {
            SEAM(10);
            if (IN(11)) _Pragma("unroll 1") for (int rep_ = 0; rep_ < NREP(11); ++rep_) {
                CParams* kp = kparams(); TIDS;
                const bf16_t* X2 = WSP(bf16_t, WS_X2); bf16_t* DP = WSP(bf16_t, WS_DP);
                const float* sc1 = WSP(float, WS_MOD) + (size_t)3 * 12288 + DM;
                const int c = tid * 4, gch = c >> 9, hw = 1 << gch;
                for (int chunk = bx; chunk < NLAT / 64; chunk += G) { const int b = chunk >> 7, t0 = (chunk & 127) * 64;
                    const bf16_t* base = X2 + ((size_t)NCTX + (size_t)b * SEQ) * DM + c; bf16_t* dbase = DP + ((size_t)NCTX + (size_t)b * SEQ) * DM + c;
                    const f32x4 a1 = *(const f32x4*)(sc1 + (size_t)b * 12288 + c) + 1.0f;
                    f32x4 s = {0, 0, 0, 0};
                    { v2u wv[16];
#pragma unroll
                      for (int q = 0; q < 16; ++q) { const int p_ = t0 - 8 + q; wv[q] = *(const v2u*)(base + (size_t)(p_ < 0 ? 0 : p_) * DM); }
#pragma unroll
                      for (int q = 0; q < 16; ++q) { const int p_ = t0 - 8 + q; const bool in_ = p_ >= 0 && p_ >= t0 - hw && p_ < t0 + hw; s += bf4(wv[q]) * (in_ ? 1.0f : 0.0f); } }
#pragma unroll 8
                    for (int i = 0; i < 64; ++i) { const int t = t0 + i; const int tn = t + hw, to = t - hw;
                        const f32x4 xc = bf4(*(const v2u*)(base + (size_t)t * DM));
                        const f32x4 xn = bf4(*(const v2u*)(base + (size_t)(tn < SEQ ? tn : SEQ - 1) * DM)), xo = bf4(*(const v2u*)(base + (size_t)(to >= 0 ? to : 0) * DM));
                        const int lo_ = to < 0 ? 0 : to, hi_ = tn > SEQ ? SEQ : tn;
                        const f32x4 d = a1 * (s * (1.0f / (float)(hi_ - lo_)) - xc);
                        v2u w; w.x = pk2(d[0], d[1]); w.y = pk2(d[2], d[3]); *(v2u*)(dbase + (size_t)t * DM) = w;
                        s = s + xn * (tn < SEQ ? 1.0f : 0.0f) - xo * (to >= 0 ? 1.0f : 0.0f); }
                }
            }
            SEAM(11);
            if (IN(12)) _Pragma("unroll 1") for (int rep_ = 0; rep_ < NREP(12); ++rep_) {
                CParams* kp = kparams();
                pg8::Gemm g{DM, 512, 512}; pg8::SchedPool S; S.o.init(NLAT / 256, 8, ogrid(), obid()); S.A = WSP(const char, WS_DP); S.B = WSP(const char, WS_WPOOL);
                pg8::EpiBf16 E{WSP(bf16_t, WS_Y), DM, nullptr};
                pg8::gemm_phase<pg8::EpiBf16, pg8::SchedPool, true, false>(L, g, S, E);
            }
            SEAM(12);
        }
    }

__global__ void __launch_bounds__(512, 2) mk_fwd(Params p_unused) {
    extern __shared__ __attribute__((aligned(16))) unsigned char lds[];
    LAS unsigned char* L = (LAS unsigned char*)lds;
    volatile LAS unsigned* MISC = (volatile LAS unsigned*)(L + MISC_OFF);
    LAS int* tcnt = (LAS int*)(L + TAB_OFF); LAS int* tbase = tcnt + 32; LAS int* texp = tcnt + 80;
    if (threadIdx.x < 64) MISC[threadIdx.x] = 0u;
    __syncthreads();
    int lo, hi; XcdBarrier bar;
    { CParams* kp = kparams(); lo = kp->ph_lo; hi = kp->ph_hi; unsigned* bw = (unsigned*)(kp->ws + WS_CTL) + CW_BAR;
      bar.bar = bw; bar.x = 0; bar.st = nullptr; if (hi - lo > 1) bar = xcd_barrier_post(bw, MISC + 8); }
    if (IN(0)) _Pragma("unroll 1") for (int rep_ = 0; rep_ < NREP(0); ++rep_) {
        CParams* kp = kparams(); TIDS;
        float* MOD = WSP(float, WS_MOD); float* ROPE = WSP(float, WS_ROPE);
        for (int i = bx * 512 + tid; i < 4096; i += G * 512) { const int pos = i >> 5, pp = i & 31;
            const float inv = exp2f(-(float)pp * (13.287712379549449f / 32.0f)); const float ang = (float)pos * inv;
            float sn, cs; sincosf(ang, &sn, &cs); ROPE[i] = cs; ROPE[4096 + i] = sn; }
        { const float* wrt = kp->w_router; bf16_t* WR = WSP(bf16_t, WS_WR);
          for (int i = bx * 512 + tid; i < 32 * DM; i += G * 512) { const int ii = i & 7, ln = (i >> 3) & 63, kq = (i >> 9) & 15, w = i >> 13; const int e = ln & 31, k = w * 256 + kq * 16 + 8 * (ln >> 5) + ii;
              const float wv = wrt[k * 32 + e]; const unsigned h1 = f2bf(wv); const unsigned h2 = f2bf(wv - bf2f(h1)); WR[i] = (bf16_t)h1; WR[32 * DM + i] = (bf16_t)h2; } }
        {
            LAS float* sv = (LAS float*)L;
            LAS float* red = (LAS float*)(L + 32768);
            mod_prepare(kp->c, kp->c_ctx, sv, tid);
            for (int it = bx; it < 384; it += G) mod_item(it, kp->w_mod, kp->b_mod, MOD, sv, red, tid, lane, wave);
        }
        {
            LAS float* scr = (LAS float*)(L + wave * 16384);
            constexpr int I_QKV = (DM / 64) * (QKVD / 32), I_O = (DM / 64) * (DM / 32), I_P = (512 / 64) * (512 / 32), I_G = (DM / 64) * (DE / 32), I_D = (DE / 64) * (DM / 32);
            constexpr int NITEMS = I_QKV + I_O + 4 * I_P;
            (void)I_G; (void)I_D;
            auto decode = [&](int it) { TItem d; int r = it;
                if (r < I_QKV) { d.W = kp->w_qkv; d.WT = WSP(bf16_t, WS_WQKV); d.K = DM; d.N = QKVD; d.kind = 0; }
                else if ((r -= I_QKV) < I_O) { d.W = kp->w_o; d.WT = WSP(bf16_t, WS_WO); d.K = DM; d.N = DM; d.kind = 0; }
                else { r -= I_O; const int g = r / I_P; r -= g * I_P; d.W = kp->w_pool + (size_t)g * 512 * 512; d.WT = WSP(bf16_t, WS_WPOOL) + (size_t)g * 512 * 512; d.K = 512; d.N = 512; d.kind = 0; }
                const int nblk = d.N / 32; d.k0 = 64 * (r / nblk); d.n0 = 32 * (r % nblk); return d; };
            for (int it = gw; it < NITEMS; it += 2 * NGW) {
                const TItem d0 = decode(it); f32x4 ra[8], rb[8]; t_load(d0, ra, lane);
                const bool two = it + NGW < NITEMS; TItem d1 = d0; if (two) { d1 = decode(it + NGW); t_load(d1, rb, lane); }
                t_store(d0, ra, scr, lane); if (two) t_store(d1, rb, scr, lane);
            }
        }
        __syncthreads();
    }
    SEAM(0);

    if (IN(1)) _Pragma("unroll 1") for (int rep_ = 0; rep_ < NREP(1); ++rep_) {
        CParams* kp = kparams(); TIDS;
        const float* MOD = WSP(float, WS_MOD); bf16_t* U = WSP(bf16_t, WS_U); const float* xl = kp->x; const float* xc = kp->ctx;
        const int R = (MT + NGW - 1) / NGW, r0 = gw * R, r1 = (r0 + R) < MT ? (r0 + R) : MT;
        f32x4 sa[8], sb[8], xv[8]; int cur = -1;
#define P1_LOAD(row_) do { const float* xr_ = ((row_) < NCTX) ? xc + (size_t)(row_) * DM : xl + (size_t)((row_) - NCTX) * DM; _Pragma("unroll") for (int j = 0; j < 8; ++j) xv[j] = *(const f32x4*)(xr_ + (j * 64 + lane) * 4); } while (0)
        if (r0 < r1) P1_LOAD(r0); else P1_LOAD(0);
        for (int row = r0; row < r1; ++row) { const int cd = row_cond(row);
            if (cd != cur) { const float* sh = MOD + (size_t)cd * 12288; const float* sc = sh + DM;
#pragma unroll
                for (int j = 0; j < 8; ++j) { const int c = (j * 64 + lane) * 4; sa[j] = *(const f32x4*)(sc + c) + 1.0f; sb[j] = *(const f32x4*)(sh + c); }
                cur = cd; }
            f32x4 o[8];
#pragma unroll
            for (int j = 0; j < 8; ++j) o[j] = xv[j] * sa[j] + sb[j];
            if (row + 1 < r1) P1_LOAD(row + 1);
#pragma unroll
            for (int j = 0; j < 8; ++j) { const int c = (j * 64 + lane) * 4; v2u w; w.x = pk2(o[j][0], o[j][1]); w.y = pk2(o[j][2], o[j][3]); *(v2u*)(U + (size_t)row * DM + c) = w; } }
#undef P1_LOAD
    }
    SEAM(1);

    if (IN(2)) _Pragma("unroll 1") for (int rep_ = 0; rep_ < NREP(2); ++rep_) {
        CParams* kp = kparams();
        typedef pg8::SchedSplit<256u * DM * 2u, 256u * DM * 2u, DM / 64, QKVD / 256> Sch;
        pg8::Gemm g{DM, DM, DM}; Sch S; S.init(ogrid(), obid()); S.A = WSP(const char, WS_U); S.B = WSP(const char, WS_WQKV);
        pg8::EpiQkv E{WSP(bf16_t, WS_QKVR), QKVD, WSP(float, WS_PQ), WSP(bf16_t, WS_V)};
        pg8::gemm_phase<pg8::EpiQkv, Sch, true, false>(L, g, S, E);
    }
    SEAM(2);

    if (IN(3)) _Pragma("unroll 1") for (int rep_ = 0; rep_ < NREP(3); ++rep_) {
        CParams* kp = kparams(); TIDS;
        const float* ROPE = WSP(float, WS_ROPE); const bf16_t* QKVR = WSP(bf16_t, WS_QKVR); bf16_t* Qb = WSP(bf16_t, WS_Q); bf16_t* Kb = WSP(bf16_t, WS_K); bf16_t* Vb = WSP(bf16_t, WS_V);
        const int sub = lane >> 4, l16 = lane & 15, d0 = l16 * 8, ax = l16 >> 3, hh = (l16 >> 2) & 1, p0 = (l16 & 3) * 8;
        const bool split3 = ((64 * (QKVD / 256)) % G == 0) && (2 * (QKVD / 256) * 8 <= G);
        const float* PQ = WSP(float, WS_PQ);
        float qg[8], kg[8];
        { const float* qgn = kp->q_gain; const float* kgn = kp->k_gain;
#pragma unroll
          for (int i = 0; i < 8; ++i) { qg[i] = qgn[d0 + i]; kg[i] = kgn[d0 + i]; } }
        v4u rw[6];
#define P3_LOAD(row_) do { const bf16_t* s_ = QKVR + (size_t)(row_) * QKVD + sub * 128 + d0; const bool all_ = (row_) < NCTX; _Pragma("unroll") for (int it = 0; it < 6; ++it) if (it == 4 || all_) rw[it] = *(const v4u*)(s_ + it * 512); } while (0)
        for (int r4 = NCTX + gw * 4; r4 < MT; r4 += NGW * 4) {
            v4u kr[4]; f32x4 c0[4], c1[4], s0[4], s1[4];
#pragma unroll
            for (int q = 0; q < 4; ++q) { const int row = r4 + q, t = (row - NCTX) & 8191; kr[q] = *(const v4u*)(QKVR + (size_t)row * QKVD + 2048 + sub * 128 + d0);
                const int pos = ax ? (t & 63) : (t >> 6); const float* cp_ = ROPE + pos * 32 + p0; c0[q] = *(const f32x4*)cp_; c1[q] = *(const f32x4*)(cp_ + 4); s0[q] = *(const f32x4*)(cp_ + 4096); s1[q] = *(const f32x4*)(cp_ + 4100); }
#pragma unroll
            for (int q = 0; q < 4; ++q) { const int row = r4 + q, lr = row - NCTX, b = lr >> 13, kpos = CTXL + (lr & 8191); const v4u raw = kr[q];
                float f[8], cs[8], sn[8];
#pragma unroll
                for (int i = 0; i < 4; ++i) { f[2 * i] = bf2f(raw[i] & 0xffffu); f[2 * i + 1] = bf2f(raw[i] >> 16); cs[i] = c0[q][i]; cs[4 + i] = c1[q][i]; sn[i] = hh ? s0[q][i] : -s0[q][i]; sn[4 + i] = hh ? s1[q][i] : -s1[q][i]; }
                float ss = 0.f;
#pragma unroll
                for (int i = 0; i < 8; ++i) ss += f[i] * f[i];
                ss += __shfl_xor(ss, 1); ss += __shfl_xor(ss, 2); ss += __shfl_xor(ss, 4); ss += __shfl_xor(ss, 8);
                const float r = 1.0f / sqrtf(ss * (1.0f / 128.0f) + RMS_EPS);
                float o[8];
#pragma unroll
                for (int i = 0; i < 8; ++i) { const float y = f[i] * r * kg[i]; const float pr = __shfl_xor(y, 4); o[i] = y * cs[i] + pr * sn[i]; }
                v4u w; w.x = pk2(o[0], o[1]); w.y = pk2(o[2], o[3]); w.z = pk2(o[4], o[5]); w.w = pk2(o[6], o[7]);
                *(v4u*)(Kb + (((size_t)b * NKV + sub) * SKV + kpos) * HD + d0) = w; }
        }
        P3_LOAD(gw < NCTX ? gw : 0);
        for (int row = gw; row < NCTX; row += NGW) {
            const bool lat = row >= NCTX; const int lr = row - NCTX; const int b = lat ? (lr >> 13) : (row >> 8); const int t = lat ? (lr & 8191) : 0;
            const int kpos = lat ? (CTXL + t) : (row & 255);
            v4u cur[6];
#pragma unroll
            for (int it = 0; it < 6; ++it) cur[it] = rw[it];
            if (row + NGW < NCTX) P3_LOAD(row + NGW);
            float cs[8], sn[8];
#pragma unroll
            for (int i = 0; i < 8; ++i) { cs[i] = 1.f; sn[i] = 0.f; }
            if (lat) { const int pos = ax ? (t & 63) : (t >> 6); const float* cp_ = ROPE + pos * 32 + p0;
                const f32x4 c0 = *(const f32x4*)cp_, c1 = *(const f32x4*)(cp_ + 4), s0 = *(const f32x4*)(cp_ + 4096), s1 = *(const f32x4*)(cp_ + 4100);
#pragma unroll
                for (int i = 0; i < 4; ++i) { cs[i] = c0[i]; cs[4 + i] = c1[i]; sn[i] = hh ? s0[i] : -s0[i]; sn[4 + i] = hh ? s1[i] : -s1[i]; } }
#pragma unroll
            for (int it = 0; it < 6; ++it) { const int h = it * 4 + sub;
                if (lat && it != 4) continue;
                if (it == 5 && !split3) continue;
                float f[8]; v4u raw;
                if (!lat && split3) {
                    f32x4 q0[8]; const float* pp_ = PQ + (size_t)row * QKVD + h * 128 + d0;
#pragma unroll
                    for (int ks = 0; ks < 8; ++ks) q0[ks] = *(const f32x4*)(pp_ + (size_t)ks * 512 * QKVD);
                    f32x4 a0 = q0[0];
#pragma unroll
                    for (int ks = 1; ks < 8; ++ks) a0 += q0[ks];
#pragma unroll
                    for (int ks = 0; ks < 8; ++ks) q0[ks] = *(const f32x4*)(pp_ + (size_t)ks * 512 * QKVD + 4);
                    f32x4 a1 = q0[0];
#pragma unroll
                    for (int ks = 1; ks < 8; ++ks) a1 += q0[ks];
#pragma unroll
                    for (int i = 0; i < 4; ++i) { f[i] = a0[i]; f[4 + i] = a1[i]; }
                    raw.x = pk2(f[0], f[1]); raw.y = pk2(f[2], f[3]); raw.z = pk2(f[4], f[5]); raw.w = pk2(f[6], f[7]);
#pragma unroll
                    for (int i = 0; i < 4; ++i) { f[2 * i] = bf2f(raw[i] & 0xffffu); f[2 * i + 1] = bf2f(raw[i] >> 16); }
                } else { raw = cur[it];
#pragma unroll
                    for (int i = 0; i < 4; ++i) { f[2 * i] = bf2f(raw[i] & 0xffffu); f[2 * i + 1] = bf2f(raw[i] >> 16); } }
                if (it == 5) { *(v4u*)(Vb + (((size_t)b * NKV + (h - 20)) * SKV + kpos) * HD + d0) = raw; continue; }
                float ss = 0.f;
#pragma unroll
                for (int i = 0; i < 8; ++i) ss += f[i] * f[i];
                ss += __shfl_xor(ss, 1); ss += __shfl_xor(ss, 2); ss += __shfl_xor(ss, 4); ss += __shfl_xor(ss, 8);
                const float r = 1.0f / sqrtf(ss * (1.0f / 128.0f) + RMS_EPS);
                float o[8];
#pragma unroll
                for (int i = 0; i < 8; ++i) { const float y = f[i] * r * (it < 4 ? qg[i] : kg[i]); const float pr = __shfl_xor(y, 4); o[i] = y * cs[i] + pr * sn[i]; }
                v4u w; w.x = pk2(o[0], o[1]); w.y = pk2(o[2], o[3]); w.z = pk2(o[4], o[5]); w.w = pk2(o[6], o[7]);
                bf16_t* d = (it < 4) ? Qb + (size_t)row * DM + h * 128 + d0 : Kb + (((size_t)b * NKV + (h - 16)) * SKV + kpos) * HD + d0;
                *(v4u*)d = w; }
        }
#undef P3_LOAD
    }
    SEAM(3);

    if (IN(4)) _Pragma("unroll 1") for (int rep_ = 0; rep_ < NREP(4); ++rep_) {
        CParams* kp = kparams();
        const bf16_t* Qb = WSP(bf16_t, WS_Q); const bf16_t* Kb = WSP(bf16_t, WS_K); const bf16_t* Vb = WSP(bf16_t, WS_V); bf16_t* Ob = WSP(bf16_t, WS_O);
        const bf16_t* QKVR = WSP(bf16_t, WS_QKVR); const float* ROPE = WSP(float, WS_ROPE); const float* qgn = kp->q_gain;
        const int G = ogrid(), bx = obid(); const bool fast = (G % 8) == 0;
        const int NR = fast ? (G >> 3) : G, rank = fast ? (bx >> 3) : bx, tot = fast ? 132 : 1056;
        const bool split = fast && NR == 32; const int NA = split ? 26 : NR;
        if (rank < NA) for (int i = 0;; ++i) {
            int w = rank + NA * i;
            if (split && i == 5) w = rank >= 24 ? rank + 106 : tot;
            if (w >= tot) break;
            const int combo = fast ? (bx & 7) : (w / 132), ww = fast ? w : (w % 132), b = combo >> 2, kvh = combo & 3;
            const bool isl = ww < 128; const int rbk = ww >> 2; const int h = kvh * 4 + (isl ? (ww & 3) : (ww - 128));
            const size_t row0 = isl ? ((size_t)NCTX + (size_t)b * SEQ + (size_t)rbk * 256) : ((size_t)b * CTXL);
            if (isl) att::attn_dma_body(QKVR + row0 * QKVD + h * HD, QKVD, rbk * 256, ROPE, qgn, Kb + (size_t)combo * SKV * HD, Vb + (size_t)combo * SKV * HD, Ob + row0 * DM + h * HD, SKV, (char*)lds);
            else att::attn_dma_body(Qb + row0 * DM + h * HD, DM, -1, ROPE, qgn, Kb + (size_t)combo * SKV * HD, Vb + (size_t)combo * SKV * HD, Ob + row0 * DM + h * HD, CTXL, (char*)lds);
            if (otid() == 0) { asm volatile("s_waitcnt vmcnt(0)" ::: "memory");
                (void)xb_add(WSP(unsigned, WS_CTL) + CW_DONE + 32 * (isl ? (b * 32 + rbk) : (64 + b)), 1u); }
        }
        {
            const int tid = otid(), lane = tid & 63, wave = __builtin_amdgcn_readfirstlane(tid >> 6);
            unsigned* mq = WSP(unsigned, WS_CTL) + CW_MQ; bool prepared = false;
            for (;;) {
                if (tid == 0) MISC[34] = xb_add(mq, 1u);
                __syncthreads();
                const unsigned t = MISC[34];
                __syncthreads();
                if (t >= 384u) break;
                if (!prepared) { mod_prepare(kp->c, kp->c_ctx, (LAS float*)L, tid); prepared = true; }
                mod_item(384 + (int)t, kp->w_mod, kp->b_mod, WSP(float, WS_MOD), (const LAS float*)L, (LAS float*)(L + 32768), tid, lane, wave);
            }
        }
        {
            const int tid = otid(), lane = tid & 63, wave = __builtin_amdgcn_readfirstlane(tid >> 6);
            LAS float* scr = (LAS float*)(L + wave * 16384);
            unsigned* qc = WSP(unsigned, WS_CTL) + CW_Q;
            constexpr int I_G = (DM / 64) * (DE / 32), I_D = (DE / 64) * (DM / 32), PER = 2 * I_G + I_D; constexpr unsigned NTICK = 64u * PER / 2u;
            auto decode = [&](int it) { TItem d; const int le = it / PER; int r = it - le * PER;
                if (r < I_G) { d.W = kp->w_gate + (size_t)le * DM * DE; d.WT = WSP(bf16_t, WS_WGU) + (size_t)le * 2048 * DM; d.K = DM; d.N = DE; d.kind = 1; }
                else if ((r -= I_G) < I_G) { d.W = kp->w_up + (size_t)le * DM * DE; d.WT = WSP(bf16_t, WS_WGU) + (size_t)le * 2048 * DM; d.K = DM; d.N = DE; d.kind = 2; }
                else { r -= I_G; d.W = kp->w_down + (size_t)le * DE * DM; d.WT = WSP(bf16_t, WS_WD) + (size_t)le * DM * DE; d.K = DE; d.N = DM; d.kind = 0; }
                const int nblk = d.N / 32; d.k0 = 64 * (r / nblk); d.n0 = 32 * (r % nblk); return d; };
            auto grab = [&]() { unsigned t = 0; if (lane == 0) t = __hip_atomic_fetch_add(qc, 1u, __ATOMIC_RELAXED, __HIP_MEMORY_SCOPE_AGENT); return (unsigned)__builtin_amdgcn_readfirstlane((int)t); };
            unsigned tk = grab();
            while (tk < NTICK) {
                const unsigned nx = grab();
                const TItem d0 = decode((int)(2u * tk)); TItem d1 = d0; d1.n0 += 32;
                f32x4 ra[8], rb[8]; t_load(d0, ra, lane); t_load(d1, rb, lane);
                t_store(d0, ra, scr, lane); t_store(d1, rb, scr, lane);
                tk = nx;
            }
        }
        __syncthreads();
        {
            unsigned* wq = WSP(unsigned, WS_CTL) + CW_WQ; unsigned* done = WSP(unsigned, WS_CTL) + CW_DONE; unsigned* yd = WSP(unsigned, WS_CTL) + CW_YD; unsigned* bw = WSP(unsigned, WS_CTL) + CW_BAR;
            const char* Oc = WSP(const char, WS_O); const char* Wc = WSP(const char, WS_WO);
            pg8::Gemm g{DM, DM, DM}; pg8::EpiBf16W E{WSP(bf16_t, WS_Y), DM};
            int tail = obid(); bool queue = true;
            for (;;) {
                if (otid() == 0) { int pm = -1, pn = 0, fl = 0;
                    if (queue) { const unsigned t = xb_add(wq, 1u);
                        if (t < 416u) { const int rbk = (int)t >> 4, b = ((int)t >> 3) & 1; pn = (int)t & 7; pm = 2 + b * 32 + rbk; fl = b * 32 + rbk; }
                        else if (t < 432u) { const int c = (int)t - 416; pm = c >> 3; pn = c & 7; fl = 64 + pm; } }
                    else if (tail < 96) { const int rbk = 26 + (tail >> 4), b = (tail >> 3) & 1; pn = tail & 7; pm = 2 + b * 32 + rbk; fl = b * 32 + rbk; }
                    if (pm >= 0) { XB_SPIN(xb_ld(&done[32 * fl]) < 16u, bw);
                        __builtin_amdgcn_fence(__ATOMIC_ACQUIRE, "agent"); asm volatile("s_waitcnt vmcnt(0)" ::: "memory"); }
                    MISC[32] = (unsigned)pm; MISC[33] = (unsigned)pn; }
                __syncthreads();
                const int pm = (int)MISC[32], pn = (int)MISC[33];
                __syncthreads();
                if (pm < 0) { if (!queue) break; queue = false; continue; }
                pg8::SchedOne S; S.u.A = Oc + (size_t)((unsigned)pm * (256u * DM * 2u)); S.u.B = Wc + (size_t)((unsigned)pn * (256u * DM * 2u)); S.u.pm = pm; S.u.pn = pn; S.u.aux = 0; S.u.kt = DM / 64; S.u.rb = 0; S.u.cn = 0; S.u.ui = 0;
                pg8::gemm_phase<pg8::EpiBf16W, pg8::SchedOne, true, false>(L, g, S, E);
                if (otid() == 0) (void)xb_add(&yd[32 * pm], 1u);
                if (!queue) tail += ogrid();
            }
        }
    }


    layer_half<0>(lo, hi, bar, L, tcnt, tbase, texp);
    layer_half<1>(lo, hi, bar, L, tcnt, tbase, texp);
#undef IN
#undef SEAM
#undef TIDS
}

extern "C" void kernel_launch(void* const* d_in, const int* in_sizes, int n_in, void* d_out, int out_size, void* d_ws, size_t ws_size, hipStream_t stream) {
    static int grid = 0;
    if (grid == 0) {
        if (n_in != 19 || in_sizes[0] != NLAT * DM || out_size != NLAT * DM || ws_size < WS_END) {
            fprintf(stderr, "kernel_launch: shape mismatch: n_in %d in0 %d out %d ws %zu (need %zu); nothing launched\n", n_in, n_in > 0 ? in_sizes[0] : -1, out_size, ws_size, (size_t)WS_END); grid = -1; return; }
        int dev = 0, cus = 0, per_cu = 0;
        if (hipGetDevice(&dev) != hipSuccess || hipDeviceGetAttribute(&cus, hipDeviceAttributeMultiprocessorCount, dev) != hipSuccess) { fprintf(stderr, "kernel_launch: device query failed\n"); grid = -1; return; }
        if (hipFuncSetAttribute((const void*)mk_fwd, hipFuncAttributeMaxDynamicSharedMemorySize, LDS_BYTES) != hipSuccess) { fprintf(stderr, "kernel_launch: hipFuncSetAttribute failed\n"); grid = -1; return; }
        if (hipOccupancyMaxActiveBlocksPerMultiprocessor(&per_cu, (const void*)mk_fwd, 512, LDS_BYTES) != hipSuccess || per_cu < 1)
            fprintf(stderr, "kernel_launch: note: occupancy query reports %d workgroups per CU\n", per_cu);
        (void)hipGetLastError();
        if (cus * (pg8::RT_UNITS / 2) < MAXT * 8) { fprintf(stderr, "kernel_launch: %d CUs: the MoE phases' per-workgroup LDS row tables are sized for >= %d workgroups; nothing launched\n", cus, (MAXT * 8 + pg8::RT_UNITS / 2 - 1) / (pg8::RT_UNITS / 2)); grid = -1; return; }
        grid = cus;
    }
    if (grid < 0) return;
    if (hipMemsetAsync((char*)d_ws + WS_CTL, 0, CTL_ZERO_BYTES, stream) != hipSuccess) { fprintf(stderr, "kernel_launch: memset failed\n"); return; }
    Params p{};
    p.x = (const float*)d_in[0]; p.c = (const float*)d_in[1]; p.ctx = (const float*)d_in[2]; p.c_ctx = (const float*)d_in[3]; p.w_mod = (const float*)d_in[4]; p.b_mod = (const float*)d_in[5];
    p.ln_g = (const float*)d_in[6]; p.ln_b = (const float*)d_in[7]; p.w_qkv = (const float*)d_in[8]; p.q_gain = (const float*)d_in[9]; p.k_gain = (const float*)d_in[10]; p.w_o = (const float*)d_in[11];
    p.w_pool = (const float*)d_in[12]; p.pool_scale = (const float*)d_in[13]; p.w_router = (const float*)d_in[14]; p.router_bias = (const float*)d_in[15];
    p.w_gate = (const float*)d_in[16]; p.w_up = (const float*)d_in[17]; p.w_down = (const float*)d_in[18];
    p.out = (float*)d_out; p.ws = (unsigned char*)d_ws;
#if MK_PER_PHASE
    for (int k = 0; k < NPHASE; ++k) { p.ph_lo = k; p.ph_hi = k + 1;
        hipLaunchKernelGGL(mk_fwd, dim3(grid), dim3(512), LDS_BYTES, stream, p);
        const hipError_t le = hipPeekAtLastError(); if (le != hipSuccess) { fprintf(stderr, "kernel_launch: launch %d failed: %s\n", k, hipGetErrorName(le)); break; } }
#else
    p.ph_lo = 0; p.ph_hi = NPHASE;
    hipLaunchKernelGGL(mk_fwd, dim3(grid), dim3(512), LDS_BYTES, stream, p);
    const hipError_t le = hipPeekAtLastError(); if (le != hipSuccess) fprintf(stderr, "kernel_launch: launch failed: %s\n", hipGetErrorName(le));
#endif
}
```

```cpp
#include <hip/hip_runtime.h>
#include <cstdio>
#include <cstdint>

#ifndef REP_MASK
#define REP_MASK 0
#endif
#ifndef MK_PER_PHASE
#define MK_PER_PHASE 0
#endif

constexpr int DM = 2048, NB = 2, SEQ = 8192, CTXL = 256;
constexpr int NCTX = NB * CTXL, NLAT = NB * SEQ, MT = NCTX + NLAT;
constexpr int NH = 16, NKV = 4, HD = 128, KVD = NKV * HD, QKVD = DM + 2 * KVD;
constexpr int SKV = CTXL + SEQ;
constexpr int NE = 32, DE = 1024;
constexpr int MAXT = 164, NSLOT = MAXT * 256;
constexpr float ALPHA = 1.41421356237309515f;
constexpr float LN_EPS = 1e-6f, RMS_EPS = 1e-6f;
constexpr int NPHASE = 18;

constexpr size_t MiB = 1u << 20;
constexpr size_t WS_CTL = 0, CTL_ZERO_BYTES = 1 * MiB;
constexpr size_t WS_MOD = 1 * MiB;
constexpr size_t WS_ROPE = WS_MOD + 512 * 1024;
constexpr size_t WS_WR = WS_MOD + 768 * 1024;
constexpr size_t WS_WQKV = 2 * MiB;
constexpr size_t WS_WO = 14 * MiB;
constexpr size_t WS_WPOOL = 22 * MiB;
constexpr size_t WS_WGU = 24 * MiB;
constexpr size_t WS_WD = 536 * MiB;
constexpr size_t WS_Y = 792 * MiB;
constexpr size_t WS_X1 = 924 * MiB;
constexpr size_t WS_X2 = 1056 * MiB;
constexpr size_t WS_H = 1188 * MiB;
constexpr size_t WS_LIST = 1254 * MiB;
constexpr size_t WS_SLOT = 1259 * MiB;
constexpr size_t WS_SH = 1260 * MiB;
constexpr size_t WS_U = WS_SH;
constexpr size_t WS_QKVR = WS_SH + 66 * MiB;
constexpr size_t WS_Q = WS_SH + 165 * MiB;
constexpr size_t WS_K = WS_SH + 231 * MiB;
constexpr size_t WS_V = WS_SH + 248 * MiB;
constexpr size_t WS_O = WS_SH + 265 * MiB;
constexpr size_t WS_HS = WS_SH;
constexpr size_t WS_ACT = WS_SH + 164 * MiB;
constexpr size_t WS_FB = WS_SH + 246 * MiB;
constexpr size_t WS_DP = WS_SH;
constexpr size_t WS_PQ = WS_SH + 510 * MiB;
constexpr size_t WS_PO = WS_PQ + 48 * MiB;
constexpr size_t WS_END = WS_PO + 32 * MiB;
static_assert((size_t)MT * DM * 4 <= 132 * MiB && (size_t)NSLOT * 2048 * 2 <= 164 * MiB && (size_t)2 * MT * DM * 4 <= 264 * MiB, "ws map");
static_assert((size_t)32 * MT * 8 <= 5 * MiB && (size_t)NSLOT * 8 <= 1 * MiB, "ws map 2");
constexpr int CW_CNT = 64;
constexpr int CW_Q = 3072;
constexpr int CW_MQ = 3136;
constexpr int CW_WQ = 3104;
constexpr int CW_DONE = 8192;
constexpr int CW_GUD = 16384;
constexpr int CW_YD = 40960;
constexpr int CW_P6Q = 3168;
constexpr int CW_BAR = 4096;

constexpr int RING_BYTES = 131072;
constexpr int MISC_OFF = RING_BYTES;
constexpr int TAB_OFF = MISC_OFF + 256;
constexpr int LDS_BYTES = 147456;

#define GAS __attribute__((address_space(1)))
#define LAS __attribute__((address_space(3)))
typedef unsigned short bf16_t;
typedef unsigned v4u __attribute__((ext_vector_type(4)));
typedef unsigned v2u __attribute__((ext_vector_type(2)));
typedef float f32x4 __attribute__((ext_vector_type(4)));
typedef float f32x2 __attribute__((ext_vector_type(2)));
typedef short bf16x8 __attribute__((ext_vector_type(8)));
typedef short s16x4 __attribute__((ext_vector_type(4)));
typedef float f32x16 __attribute__((ext_vector_type(16)));
typedef GAS unsigned gu32;
#define RLX_AGENT __ATOMIC_RELAXED, __HIP_MEMORY_SCOPE_AGENT
#define LDS_WAIT() asm volatile("s_waitcnt lgkmcnt(0)" ::: "memory")
#define VM_WAIT() asm volatile("s_waitcnt vmcnt(0)" ::: "memory")
__device__ __forceinline__ unsigned f2bf(float f) { unsigned u = __builtin_bit_cast(unsigned, f); return (u + 0x7fffu + ((u >> 16) & 1u)) >> 16; }
__device__ __forceinline__ unsigned pk2(float lo, float hi) { unsigned r; asm("v_cvt_pk_bf16_f32 %0, %1, %2" : "=v"(r) : "v"(lo), "v"(hi)); return r; }
__device__ __forceinline__ float bf2f(unsigned b) { return __builtin_bit_cast(float, b << 16); }
__device__ __forceinline__ unsigned cvt_pk_bf16(float lo, float hi) { unsigned r; asm volatile("v_cvt_pk_bf16_f32 %0, %1, %2" : "=v"(r) : "v"(lo), "v"(hi)); return r; }
__device__ __forceinline__ f32x4 bf4(v2u q) { return (f32x4){bf2f(q.x & 0xffffu), bf2f(q.x >> 16), bf2f(q.y & 0xffffu), bf2f(q.y >> 16)}; }
template <int CTRL> __device__ __forceinline__ float dppf(float v) { return __builtin_bit_cast(float, __builtin_amdgcn_update_dpp(0, __builtin_bit_cast(int, v), CTRL, 0xF, 0xF, true)); }
template <int CTRL> __device__ __forceinline__ int dppi(int v) { return __builtin_amdgcn_update_dpp(0, v, CTRL, 0xF, 0xF, true); }
__device__ __forceinline__ float wave_sum(float v) {
    v += dppf<0xB1>(v); v += dppf<0x4E>(v); v += dppf<0x141>(v); v += dppf<0x140>(v);
    { const auto r = __builtin_amdgcn_permlane16_swap(__float_as_uint(v), __float_as_uint(v), false, false); v = __uint_as_float(r[0]) + __uint_as_float(r[1]); }
    { const auto r = __builtin_amdgcn_permlane32_swap(__float_as_uint(v), __float_as_uint(v), false, false); v = __uint_as_float(r[0]) + __uint_as_float(r[1]); }
    return v;
}
__device__ __forceinline__ float silu_f(float x) { return x / (1.0f + __expf(-x)); }
__device__ __forceinline__ int row_cond(int row) { return row < NCTX ? 2 : ((row - NCTX) >> 13); }
__device__ __forceinline__ int otid() { int t = threadIdx.x; asm volatile("" : "+v"(t)); return t; }
__device__ __forceinline__ int obid() { int t = blockIdx.x; asm volatile("" : "+s"(t)); return t; }
__device__ __forceinline__ int ogrid() { int t = gridDim.x; asm volatile("" : "+s"(t)); return t; }

#define XB_TMO      128
#define XB_XCNT(j)  (256  + 64 * (j))
#define XB_XSUB(j)  (1280 + 64 * (j))
#define XB_XGEN(j)  (2304 + 64 * (j))
#define XB_TOP      3328
#define XB_TOPGEN   3392
#define XCD_BAR_WORDS 3456
#define XB_SPIN_CAP (1u << 20)
__device__ __forceinline__ unsigned xb_ld(unsigned* p)              { return __hip_atomic_load(p, __ATOMIC_RELAXED, __HIP_MEMORY_SCOPE_AGENT); }
__device__ __forceinline__ unsigned xb_add(unsigned* p, unsigned v) { return __hip_atomic_fetch_add(p, v, __ATOMIC_RELAXED, __HIP_MEMORY_SCOPE_AGENT); }
__device__ __forceinline__ unsigned xb_xcc_id() { return (unsigned)__builtin_amdgcn_s_getreg((3 << 11) | 20) & 0xFu; }
#define XB_SPIN(cond, bar) do { unsigned _sp = 0; while (cond) { __builtin_amdgcn_s_sleep(1); \
    if ((++_sp & 255u) == 0u) { if (xb_ld(&(bar)[XB_TMO])) break; if (_sp > XB_SPIN_CAP) { atomicAdd(&(bar)[XB_TMO], 1u); break; } } } } while (0)
struct XcdBarrier { unsigned* bar; unsigned x; volatile LAS unsigned* st; };
__device__ __forceinline__ XcdBarrier xcd_barrier_post(unsigned* bar, volatile LAS unsigned* st) {
    XcdBarrier b; b.bar = bar; b.x = xb_xcc_id(); b.st = st;
    if (threadIdx.x == 0) (void)xb_add(&bar[XB_XCNT(b.x)], 1u);
    return b;
}
__device__ __forceinline__ void xcd_barrier_complete(unsigned* bar, unsigned x, unsigned& nloc, unsigned& nx) {
    const unsigned G = gridDim.x * gridDim.y * gridDim.z;
    unsigned sum, cnt, mine, sp = 0u;
    for (;;) {
        sum = 0u; cnt = 0u; mine = 0u;
#pragma unroll 1
        for (unsigned j = 0; j < 16; ++j) { const unsigned c = xb_ld(&bar[XB_XCNT(j)]); sum += c; cnt += (c > 0u) ? 1u : 0u; }
        if (sum == G) break;
        __builtin_amdgcn_s_sleep(1);
        if ((++sp & 255u) == 0u) { if (xb_ld(&bar[XB_TMO])) break; if (sp > XB_SPIN_CAP) { atomicAdd(&bar[XB_TMO], 1u); break; } }
    }
    mine = xb_ld(&bar[XB_XCNT(x)]);
    nloc = mine > 0u ? mine : 1u; nx = cnt > 0u ? cnt : 1u;
}
__device__ __forceinline__ void xcd_barrier(const XcdBarrier& b) {
    asm volatile("s_waitcnt vmcnt(0)" ::: "memory");
    __syncthreads();
    if (threadIdx.x == 0) {
        unsigned* bar = b.bar;
        __builtin_amdgcn_s_waitcnt(0);
        unsigned nloc = b.st[0], nx = b.st[1];
        if (nloc == 0u) { xcd_barrier_complete(bar, b.x, nloc, nx); b.st[0] = nloc; b.st[1] = nx; }
        const unsigned old = xb_add(&bar[XB_XSUB(b.x)], 1u);
        const unsigned gen = old / nloc;
        if (old + 1u == (gen + 1u) * nloc) {
            __builtin_amdgcn_fence(__ATOMIC_RELEASE, "agent");
            asm volatile("s_waitcnt vmcnt(0)" ::: "memory");
            const unsigned og = xb_add(&bar[XB_TOP], 1u);
            const unsigned tg = og / nx;
            if (og + 1u == (tg + 1u) * nx) xb_add(&bar[XB_TOPGEN], 1u);
            else XB_SPIN(xb_ld(&bar[XB_TOPGEN]) == tg, bar);
            __builtin_amdgcn_fence(__ATOMIC_ACQUIRE, "agent");
            xb_add(&bar[XB_XGEN(b.x)], 1u);
            asm volatile("s_waitcnt vmcnt(0)" ::: "memory");
        } else {
            XB_SPIN(xb_ld(&bar[XB_XGEN(b.x)]) == gen, bar);
            __builtin_amdgcn_fence(__ATOMIC_ACQUIRE, "agent");
            asm volatile("s_waitcnt vmcnt(0)" ::: "memory");
        }
    }
    __syncthreads();
}

namespace pg8 {
#define PG8_LAS __attribute__((address_space(3)))
constexpr int BM = 256, BK = 64, HALF = 128, HTB = HALF * BK * 2, STAGE_BYTES = 8 * HTB, NXCD = 8, WGM = 8;
__host__ __device__ __forceinline__ int lds_byte(int r, int c) { const int st = (r >> 4) * 2 + (c >> 5), rr = r & 15, cc = c & 31, ob = rr * 64 + cc * 2; return st * 1024 + (ob ^ (((ob >> 9) & 1) << 5)); }
__host__ __device__ __forceinline__ void stage_rc(int b, int& R, int& C) { const int st = b / 1024, sb = b % 1024, swz = sb ^ (((sb >> 9) & 1) << 5); R = (st >> 1) * 16 + swz / 64; C = (st & 1) * 32 + (swz % 64) / 2; }
__host__ __device__ __forceinline__ int perm32(int rho) { const int n = rho >> 4, i = rho & 15; return 8 * (i >> 2) + 4 * n + (i & 3); }

struct Unit { const char* A; const char* B; int pm, pn, aux, kt, rb, cn, ui; };
struct Gemm { int lda, ldb, K; };

struct TileOrder {
    int nM, nN, nwg, G, c, rot = 0;
    __device__ __forceinline__ void init(int nM_, int nN_, int G_, int c_) { nM = nM_; nN = nN_; nwg = nM * nN; G = G_; c = c_; }
    __device__ __forceinline__ bool get(int i, int& pm, int& pn) const { return map((long)i * G + c, pm, pn); }
    __device__ __forceinline__ bool map(long L, int& pm, int& pn) const {
        if (L >= nwg) return false;
        const int nig = WGM * nN;
        int wgid = (int)L; { const int q = nwg / NXCD, r = nwg % NXCD, xcd = wgid % NXCD; int off = wgid / NXCD; const int cs = (xcd < r ? xcd * (q + 1) : r * (q + 1) + (xcd - r) * q), len = q + (xcd < r ? 1 : 0);
            if (rot) { const int lead = (nig - cs % nig) % nig; if (lead < len) { off += lead; if (off >= len) off -= len; } }
            wgid = cs + off; }
        const int gid = wgid / nig, fm = gid * WGM, gsz = (nM - fm) < WGM ? (nM - fm) : WGM;
        pm = fm + ((wgid % nig) % gsz); pn = (wgid % nig) / gsz; return true;
    }
};

template <class Epi, class Sched, bool ALIGN_EPI, bool GATHER = false>
__device__ __forceinline__ void gemm_phase(PG8_LAS unsigned char* lds, const Gemm g, const Sched& S, const Epi& E) {
    const int tid = otid(), wid = __builtin_amdgcn_readfirstlane(tid >> 6), lane = tid & 63, wr = wid >> 2, wc = wid & 3, fr = lane & 15, fq = lane >> 4;
    unsigned vc[2][2], vn[2][2], voffB[2]; int Rr[2], Cc = 0;
#pragma unroll
    for (int i = 0; i < 2; ++i) { int R, C; stage_rc(tid * 16 + i * 8192, R, C); const int Rb = Epi::PERM ? ((R & ~31) + perm32(R & 31)) : R; Rr[i] = R; Cc = C;
        vc[0][i] = (unsigned)(R * g.lda + C) * 2u; vc[1][i] = vc[0][i] + (unsigned)(HALF * g.lda) * 2u; voffB[i] = (unsigned)(Rb * g.ldb + C) * 2u; }
#define PG8_ROWS(ui_, v) do { _Pragma("unroll") for (int _h = 0; _h < 2; ++_h) _Pragma("unroll") for (int _i = 0; _i < 2; ++_i) \
        v[_h][_i] = (unsigned)S.rowtok((ui_), Rr[_i] + HALF * _h) * (unsigned)(g.lda * 2) + (unsigned)Cc * 2u; } while (0)
    const size_t kstep = (size_t)(BK * 2);
    const size_t hsB = (size_t)HALF * g.ldb * 2;
    const unsigned ldsw = (unsigned)wid * 1024u;
    const int aoff = lds_byte(wr * 64 + fr, fq * 8), boff = lds_byte(wc * 32 + fr, fq * 8);
#define PG8_SA(b, h) (((b) * 2 + (h)) * HTB)
#define PG8_SB(b, h) ((4 + (b) * 2 + (h)) * HTB)
#define PG8_STAGE(bufoff, gbase, voff) do { _Pragma("unroll") for (int _i = 0; _i < 2; ++_i) \
        __builtin_amdgcn_global_load_lds((const unsigned*)((const char*)(gbase) + (voff)[_i]), (PG8_LAS unsigned*)(lds + (bufoff) + ldsw + _i * 8192), 16, 0, 0); } while (0)
#define PG8_LDA(dst, b, h) do { _Pragma("unroll") for (int m = 0; m < 4; ++m) _Pragma("unroll") for (int k = 0; k < 2; ++k) dst[m][k] = *(const PG8_LAS bf16x8*)(lds + PG8_SA(b, h) + aoff + m * 2048 + k * 1024); } while (0)
#define PG8_LDB(dst, b, h) do { _Pragma("unroll") for (int n = 0; n < 2; ++n) _Pragma("unroll") for (int k = 0; k < 2; ++k) dst[n][k] = *(const PG8_LAS bf16x8*)(lds + PG8_SB(b, h) + boff + n * 2048 + k * 1024); } while (0)
#define PG8_MMA(ai, bj, At, Bt) do { __builtin_amdgcn_s_setprio(1); _Pragma("unroll") for (int m = 0; m < 4; ++m) _Pragma("unroll") for (int n = 0; n < 2; ++n) _Pragma("unroll") for (int k = 0; k < 2; ++k) \
        acc[ai][bj][m][n] = __builtin_amdgcn_mfma_f32_16x16x32_bf16(Bt[n][k], At[m][k], acc[ai][bj][m][n], 0, 0, 0); __builtin_amdgcn_s_setprio(0); } while (0)
#define PG8_WAIT_V(n) asm volatile("s_waitcnt vmcnt(" #n ")" ::: "memory")
#define PG8_WAIT_L(n) asm volatile("s_waitcnt lgkmcnt(" #n ")" ::: "memory")
#define PG8_BAR __builtin_amdgcn_s_barrier()
#define PG8_SCHED __builtin_amdgcn_sched_barrier(0)
    Unit cur, nxt; int ui = 0; int pend = -1, pend2 = -1, wst = 0; unsigned pv = 8u; (void)pend; (void)pend2; (void)wst; (void)pv;
    if (!S.next(0, cur)) return;
    if constexpr (Sched::WAITS) S.wait_ready(cur);
    if constexpr (GATHER) PG8_ROWS(0, vc);
    f32x4 acc[2][2][4][2];
#pragma unroll
    for (int a = 0; a < 2; ++a)
#pragma unroll
        for (int b = 0; b < 2; ++b)
#pragma unroll
            for (int m = 0; m < 4; ++m)
#pragma unroll
                for (int n = 0; n < 2; ++n) acc[a][b][m][n] = (f32x4){0.f, 0.f, 0.f, 0.f};
    bf16x8 At[4][2], B0[2][2], B1[2][2];
    const char* cA = cur.A; const char* cB = cur.B;
    PG8_STAGE(PG8_SB(0, 0), cB, voffB); PG8_STAGE(PG8_SB(0, 1), cB + hsB, voffB); PG8_STAGE(PG8_SA(0, 0), cA, vc[0]); PG8_STAGE(PG8_SA(0, 1), cA, vc[1]);
    if (wr == 1) PG8_BAR;
    PG8_WAIT_V(2); PG8_BAR;
    PG8_STAGE(PG8_SB(1, 0), cB + kstep, voffB); PG8_STAGE(PG8_SA(1, 0), cA + kstep, vc[0]); PG8_STAGE(PG8_SB(1, 1), cB + hsB + kstep, voffB);
    PG8_WAIT_V(6); PG8_BAR;
    for (;;) {
        const bool has_next = S.next(ui + 1, nxt);
        if constexpr (Sched::WAITS) wst = has_next ? 1 : 0;
        const char* nA = has_next ? nxt.A : cA; const char* nB = has_next ? nxt.B : cB;
        if constexpr (GATHER) { if (has_next) PG8_ROWS(ui + 1, vn); else {
#pragma unroll
            for (int h = 0; h < 2; ++h) { vn[h][0] = vc[h][0]; vn[h][1] = vc[h][1]; } } }
        const int nt = cur.kt;
        for (int t = 0; t < nt; t += 2) {
            const bool last = (t == nt - 2);
            const char* a1 = cA + (size_t)(t + 1) * kstep;
            const char* a2 = last ? nA : cA + (size_t)(t + 2) * kstep; const char* b2 = last ? nB : cB + (size_t)(t + 2) * kstep;
            const char* a3 = a2 + kstep; const char* b3 = b2 + kstep;
            unsigned o0[2], o1[2];
#pragma unroll
            for (int i = 0; i < 2; ++i) { o0[i] = (GATHER && last) ? vn[0][i] : vc[0][i]; o1[i] = (GATHER && last) ? vn[1][i] : vc[1][i]; }
            PG8_LDB(B0, 0, 0); PG8_LDB(B1, 0, 1); PG8_SCHED; PG8_LDA(At, 0, 0); PG8_STAGE(PG8_SA(1, 1), a1, vc[1]);
            PG8_WAIT_V(8); PG8_WAIT_L(0); PG8_BAR; PG8_MMA(0, 0, At, B0); PG8_MMA(0, 1, At, B1); PG8_BAR; PG8_SCHED;
            PG8_LDA(At, 0, 1); PG8_STAGE(PG8_SB(0, 0), b2, voffB); PG8_STAGE(PG8_SB(0, 1), b2 + hsB, voffB); PG8_STAGE(PG8_SA(0, 0), a2, o0);
            PG8_WAIT_V(8); PG8_WAIT_L(0); PG8_BAR; PG8_MMA(1, 0, At, B0); PG8_MMA(1, 1, At, B1); PG8_BAR; PG8_SCHED;
            PG8_LDB(B0, 1, 0); PG8_LDB(B1, 1, 1); PG8_SCHED; PG8_LDA(At, 1, 0); PG8_STAGE(PG8_SA(0, 1), a2, o1);
            PG8_WAIT_V(8); PG8_WAIT_L(0); PG8_BAR; PG8_MMA(0, 0, At, B0); PG8_MMA(0, 1, At, B1); PG8_BAR; PG8_SCHED;
            PG8_LDA(At, 1, 1); PG8_STAGE(PG8_SB(1, 0), b3, voffB); PG8_STAGE(PG8_SB(1, 1), b3 + hsB, voffB); PG8_STAGE(PG8_SA(1, 0), a3, o0);
            PG8_WAIT_V(8); PG8_WAIT_L(0); PG8_BAR; PG8_MMA(1, 0, At, B0); PG8_MMA(1, 1, At, B1); PG8_BAR; PG8_SCHED;
            if constexpr (Sched::SIGNALS) { if (pend >= 0) { pend2 = pend; pend = -1; } else if (pend2 >= 0) { S.signal(pend2, lane, wid); pend2 = -1; } }
            if constexpr (Sched::WAITS) { if (wst == 1) { pv = S.poll(nxt); wst = 2; } else if (wst == 2) { wst = 0; if (pv < 8u) S.spin(nxt); } }
        }
        if constexpr (ALIGN_EPI) { if (wr == 0) PG8_BAR; }
        E(acc, cur, wr, wc, fr, fq);
        if constexpr (Sched::SIGNALS) pend = cur.pm;
        if (!has_next) break;
#pragma unroll
        for (int a = 0; a < 2; ++a)
#pragma unroll
            for (int b = 0; b < 2; ++b)
#pragma unroll
                for (int m = 0; m < 4; ++m)
#pragma unroll
                    for (int n = 0; n < 2; ++n) acc[a][b][m][n] = (f32x4){0.f, 0.f, 0.f, 0.f};
        cur = nxt; cA = nA; cB = nB; ++ui;
        if constexpr (GATHER) {
#pragma unroll
            for (int h = 0; h < 2; ++h) { vc[h][0] = vn[h][0]; vc[h][1] = vn[h][1]; } }
        if constexpr (ALIGN_EPI) { if (wr == 1) PG8_BAR; }
    }
    PG8_WAIT_V(0);
    if constexpr (!ALIGN_EPI) { if (wr == 0) PG8_BAR; }
    PG8_BAR;
    if constexpr (Sched::SIGNALS) { if (pend >= 0) S.signal(pend, lane, wid); }
#undef PG8_ROWS
#undef PG8_SA
#undef PG8_SB
#undef PG8_STAGE
#undef PG8_LDA
#undef PG8_LDB
#undef PG8_MMA
#undef PG8_WAIT_V
#undef PG8_WAIT_L
#undef PG8_BAR
#undef PG8_SCHED
}

template <unsigned AT, unsigned BT, int KT>
struct SchedDense {
    static constexpr bool SIGNALS = false, WAITS = false;
    TileOrder o; const char* A; const char* B; int pm0;
    __device__ __forceinline__ int rowtok(int, int) const { return 0; }
    __device__ __forceinline__ bool next(int i, Unit& u) const { int pm, pn; if (!o.get(i, pm, pn)) return false;
        u.rb = 0; u.cn = 0; u.pm = pm0 + pm; u.pn = pn; u.aux = 0; u.kt = KT; u.A = A + (size_t)((unsigned)u.pm * AT); u.B = B + (size_t)((unsigned)pn * BT); return true; }
};
template <unsigned AT, unsigned BT, int KT, int NN>
struct SchedSplit {
    static constexpr bool SIGNALS = false, WAITS = false;
    TileOrder o; const char* A; const char* B; int G, c; bool split;
    __device__ __forceinline__ int rowtok(int, int) const { return 0; }
    __device__ __forceinline__ void init(int G_, int c_) { G = G_; c = c_; split = ((64 * NN) % G_ == 0) && (2 * NN * 8 <= G_); if (split) o.init(64, NN, G_, c_); else o.init(66, NN, G_, c_); }
    __device__ __forceinline__ bool next(int i, Unit& u) const { u.rb = 0; u.cn = 0;
        if (!split) { int pm, pn; if (!o.get(i, pm, pn)) return false; u.pm = pm; u.pn = pn; u.aux = 0; u.kt = KT; u.A = A + (size_t)((unsigned)pm * AT); u.B = B + (size_t)((unsigned)pn * BT); return true; }
        const int fr = (64 * NN) / G;
        if (i < fr) { int pm, pn; o.get(i, pm, pn); u.pm = 2 + pm; u.pn = pn; u.aux = 0; u.kt = KT; u.A = A + (size_t)((unsigned)u.pm * AT); u.B = B + (size_t)((unsigned)pn * BT); return true; }
        if (i > fr || c >= 2 * NN * 8) return false;
        const int ks = c & 7, t = c >> 3; u.pm = t / NN; u.pn = t % NN; u.aux = ks + 1; u.kt = KT / 8;
        u.A = A + (size_t)((unsigned)u.pm * AT + (unsigned)ks * (KT / 8) * 128u); u.B = B + (size_t)((unsigned)u.pn * BT + (unsigned)ks * (KT / 8) * 128u); return true; }
};
struct SchedPool {
    static constexpr bool SIGNALS = false, WAITS = false;
    TileOrder o; const char* A; const char* B;
    __device__ __forceinline__ int rowtok(int, int) const { return 0; }
    __device__ __forceinline__ bool next(int i, Unit& u) const { int pm, pn; if (!o.get(i, pm, pn)) return false;
        u.rb = 0; u.cn = 0; u.pm = 2 + pm; u.pn = pn; u.aux = 0; u.kt = 8; const int g = pn >> 1;
        u.A = A + (size_t)((unsigned)u.pm * (256u * DM * 2u) + (unsigned)g * 1024u); u.B = B + (size_t)((unsigned)g * (512u * 512u * 2u) + (unsigned)(pn & 1) * (256u * 512u * 2u)); return true; }
};
struct SchedOne {
    static constexpr bool SIGNALS = false, WAITS = false;
    Unit u;
    __device__ __forceinline__ int rowtok(int, int) const { return 0; }
    __device__ __forceinline__ bool next(int i, Unit& o) const { if (i != 0) return false; o = u; return true; }
};
constexpr int RT_UNITS = 14;
template <unsigned AT, unsigned BT, unsigned BE, int KT, bool GATHER>
struct SchedMoe {
    static constexpr bool SIGNALS = GATHER, WAITS = !GATHER;
    unsigned* ctr;
    __device__ __forceinline__ void signal(int pm, int lane, int wid) const { if (wid == 0 && lane == 0) (void)xb_add(ctr + 32 * pm, 1u); }
    __device__ __forceinline__ void wait_ready(const Unit& u) const { while (xb_ld(ctr + 32 * u.pm) < 8u) __builtin_amdgcn_s_sleep(2); asm volatile("" ::: "memory"); }
    __device__ __forceinline__ unsigned poll(const Unit& u) const { return xb_ld(ctr + 32 * u.pm); }
    __device__ __forceinline__ void spin(const Unit& u) const { while (xb_ld(ctr + 32 * u.pm) < 8u) __builtin_amdgcn_s_sleep(2); }
    __device__ __forceinline__ void acquire_async() const { asm volatile("buffer_inv sc1" ::: "memory"); }
    TileOrder o; const char* A; const char* B; const PG8_LAS int* texp; const PG8_LAS int* tbase; const PG8_LAS int* tcnt; const PG8_LAS int* rt; const int* list;
    int rem = 0, nl = 0;
    __device__ __forceinline__ bool next(int i, Unit& u) const { int pm, pn;
        if (GATHER) { if (!o.get(i, pm, pn)) return false; }
        else { const bool light = o.c >= rem; const long L = (light && i < 2) ? (long)i * nl + (o.c - rem) : 2L * nl + (long)(light ? i - 2 : i) * o.G + o.c; if (!o.map(L, pm, pn)) return false; }
        const int e = __builtin_amdgcn_readfirstlane(texp[pm]);
        u.pm = pm; u.pn = pn; u.aux = e; u.kt = KT; u.ui = i; u.rb = (pm - __builtin_amdgcn_readfirstlane(tbase[e])) * 256; u.cn = __builtin_amdgcn_readfirstlane(tcnt[e]);
        u.A = GATHER ? A : A + (size_t)((unsigned)pm * AT); u.B = B + (size_t)((unsigned)e * BE + (unsigned)pn * BT); return true; }
    __device__ __forceinline__ int tok_of(const Unit& u, int row) const { const int pos = u.rb + row; return pos < u.cn ? (list[(size_t)u.aux * MT + pos] >> 1) : 0; }
    __device__ __forceinline__ int rowtok(int ui, int row) const { if (ui < RT_UNITS) return rt[ui * 256 + row]; Unit u; next(ui, u); return tok_of(u, row); }
    __device__ __forceinline__ void fill_dst(PG8_LAS int* rtw, const float* listg, int tid) const {
        int dv[RT_UNITS / 2]; float gv[RT_UNITS / 2]; bool ok[RT_UNITS / 2];
#pragma unroll
        for (int i = 0; i < RT_UNITS / 2; ++i) { Unit u; ok[i] = next(i, u); dv[i] = -1; gv[i] = 0.f;
            if (ok[i] && tid < 256) { const int pos = u.rb + tid; if (pos < u.cn) { const size_t li = (size_t)u.aux * MT + pos; dv[i] = list[li]; gv[i] = listg[li]; } } }
#pragma unroll
        for (int i = 0; i < RT_UNITS / 2; ++i) if (ok[i] && tid < 256) { rtw[i * 512 + tid] = dv[i]; rtw[i * 512 + 256 + tid] = (int)__float_as_uint(gv[i]); }
        __syncthreads(); }
    __device__ __forceinline__ void fill_rows(PG8_LAS int* rtw, int tid) const {
#pragma unroll
        for (int h = 0; h < 2; ++h) { int tk[RT_UNITS / 2]; bool ok[RT_UNITS / 2];
#pragma unroll
            for (int q = 0; q < RT_UNITS / 2; ++q) { Unit u; ok[q] = next(h * (RT_UNITS / 2) + q, u); tk[q] = 0; if (ok[q] && tid < 256) tk[q] = tok_of(u, tid); }
#pragma unroll
            for (int q = 0; q < RT_UNITS / 2; ++q) if (ok[q] && tid < 256) rtw[(h * (RT_UNITS / 2) + q) * 256 + tid] = tk[q]; }
        __syncthreads(); }
};

struct EpiBf16 {
    static constexpr bool PERM = true;
    bf16_t* O; int ldc; float* P;
    __device__ __forceinline__ void operator()(const f32x4 (&acc)[2][2][4][2], const Unit& u, int wr, int wc, int fr, int fq) const {
        const int row0 = u.pm * BM + wr * 64 + fr, col0 = u.pn * BM + wc * 32 + 8 * fq;
        if (u.aux == 0) {
#pragma unroll
            for (int ai = 0; ai < 2; ++ai)
#pragma unroll
                for (int m = 0; m < 4; ++m) { bf16_t* rowp = O + (size_t)(row0 + ai * HALF + m * 16) * ldc + col0;
#pragma unroll
                    for (int bj = 0; bj < 2; ++bj) { const f32x4 v0 = acc[ai][bj][m][0], v1 = acc[ai][bj][m][1];
                        v4u w; w.x = cvt_pk_bf16(v0[0], v0[1]); w.y = cvt_pk_bf16(v0[2], v0[3]); w.z = cvt_pk_bf16(v1[0], v1[1]); w.w = cvt_pk_bf16(v1[2], v1[3]);
                        *(v4u*)(rowp + bj * HALF) = w; } }
        } else {
            float* pb = P + (size_t)(u.aux - 1) * 512 * ldc;
#pragma unroll
            for (int ai = 0; ai < 2; ++ai)
#pragma unroll
                for (int m = 0; m < 4; ++m) { float* rowp = pb + (size_t)(row0 + ai * HALF + m * 16) * ldc + col0;
#pragma unroll
                    for (int bj = 0; bj < 2; ++bj) { *(f32x4*)(rowp + bj * HALF) = acc[ai][bj][m][0]; *(f32x4*)(rowp + bj * HALF + 4) = acc[ai][bj][m][1]; } }
        }
    }
};
struct EpiBf16W {
    static constexpr bool PERM = true;
    bf16_t* O; int ldc;
    __device__ __forceinline__ void operator()(const f32x4 (&acc)[2][2][4][2], const Unit& u, int wr, int wc, int fr, int fq) const {
        const int row0 = u.pm * BM + wr * 64 + fr, col0 = u.pn * BM + wc * 32 + 8 * fq;
#pragma unroll
        for (int ai = 0; ai < 2; ++ai)
#pragma unroll
            for (int m = 0; m < 4; ++m) { bf16_t* rowp = O + (size_t)(row0 + ai * HALF + m * 16) * ldc + col0;
#pragma unroll
                for (int bj = 0; bj < 2; ++bj) { const f32x4 v0 = acc[ai][bj][m][0], v1 = acc[ai][bj][m][1];
                    v4u w; w.x = cvt_pk_bf16(v0[0], v0[1]); w.y = cvt_pk_bf16(v0[2], v0[3]); w.z = cvt_pk_bf16(v1[0], v1[1]); w.w = cvt_pk_bf16(v1[2], v1[3]);
                    const bf16_t* gp = rowp + bj * HALF;
                    asm volatile("global_store_dwordx4 %0, %1, off sc1\n\ts_nop 1" :: "v"(gp), "v"(w) : "memory"); } }
    }
};
struct EpiQkv {
    static constexpr bool PERM = true;
    bf16_t* O; int ldc; float* P; bf16_t* V;
    __device__ __forceinline__ void operator()(const f32x4 (&acc)[2][2][4][2], const Unit& u, int wr, int wc, int fr, int fq) const {
        const int row0 = u.pm * BM + wr * 64 + fr, col0 = u.pn * BM + wc * 32 + 8 * fq;
        if (u.aux == 0) {
            const bool isV = u.pn >= (DM + KVD) / BM;
#pragma unroll
            for (int ai = 0; ai < 2; ++ai)
#pragma unroll
                for (int m = 0; m < 4; ++m) { const int row = row0 + ai * HALF + m * 16; bf16_t* rowp = O + (size_t)row * ldc + col0; size_t vstep = HALF;
                    if (isV) { const bool lat = row >= NCTX; const int lr = row - NCTX, b = lat ? (lr >> 13) : (row >> 8), kpos = lat ? (CTXL + (lr & 8191)) : (row & 255);
                        rowp = V + (((size_t)b * NKV + (size_t)(u.pn - (DM + KVD) / BM) * 2) * SKV + kpos) * HD + wc * 32 + 8 * fq; vstep = (size_t)SKV * HD; }
#pragma unroll
                    for (int bj = 0; bj < 2; ++bj) { const f32x4 v0 = acc[ai][bj][m][0], v1 = acc[ai][bj][m][1];
                        v4u w; w.x = cvt_pk_bf16(v0[0], v0[1]); w.y = cvt_pk_bf16(v0[2], v0[3]); w.z = cvt_pk_bf16(v1[0], v1[1]); w.w = cvt_pk_bf16(v1[2], v1[3]);
                        *(v4u*)(rowp + bj * vstep) = w; } }
        } else {
            float* pb = P + (size_t)(u.aux - 1) * 512 * ldc;
#pragma unroll
            for (int ai = 0; ai < 2; ++ai)
#pragma unroll
                for (int m = 0; m < 4; ++m) { float* rowp = pb + (size_t)(row0 + ai * HALF + m * 16) * ldc + col0;
#pragma unroll
                    for (int bj = 0; bj < 2; ++bj) { *(f32x4*)(rowp + bj * HALF) = acc[ai][bj][m][0]; *(f32x4*)(rowp + bj * HALF + 4) = acc[ai][bj][m][1]; } }
        }
    }
};
struct EpiGateUp {
    static constexpr bool PERM = true;
    bf16_t* ACT;
    __device__ __forceinline__ void operator()(const f32x4 (&acc)[2][2][4][2], const Unit& u, int wr, int wc, int fr, int fq) const {
        const int row0 = u.pm * BM + wr * 64 + fr, col0 = u.pn * HALF + wc * 32 + 8 * fq;
#pragma unroll
        for (int ai = 0; ai < 2; ++ai)
#pragma unroll
            for (int m = 0; m < 4; ++m) { bf16_t* rowp = ACT + (size_t)(row0 + ai * HALF + m * 16) * DE + col0;
                float v[8];
#pragma unroll
                for (int n = 0; n < 2; ++n)
#pragma unroll
                    for (int j = 0; j < 4; ++j) v[n * 4 + j] = silu_f(acc[ai][0][m][n][j]) * acc[ai][1][m][n][j];
                v4u w; w.x = cvt_pk_bf16(v[0], v[1]); w.y = cvt_pk_bf16(v[2], v[3]); w.z = cvt_pk_bf16(v[4], v[5]); w.w = cvt_pk_bf16(v[6], v[7]);
                asm volatile("global_store_dwordx4 %0, %1, off sc1\n\ts_nop 1" :: "v"(rowp), "v"(w) : "memory"); }
    }
};
struct EpiDown {
    static constexpr bool PERM = true;
    bf16_t* FB; const PG8_LAS int* rt;
    __device__ __forceinline__ void operator()(const f32x4 (&acc)[2][2][4][2], const Unit& u, int wr, int wc, int fr, int fq) const {
        const int r0 = wr * 64 + fr, col0 = u.pn * BM + wc * 32 + 8 * fq; const PG8_LAS int* tb = rt + u.ui * 512 + r0;
#pragma unroll
        for (int ai = 0; ai < 2; ++ai)
#pragma unroll
            for (int m = 0; m < 4; ++m) { const int d_ = tb[ai * HALF + m * 16]; const float g_ = __uint_as_float((unsigned)tb[256 + ai * HALF + m * 16]);
                if (d_ >= 0) { bf16_t* fr_ = FB + (size_t)d_ * DM + col0;
#pragma unroll
                    for (int bj = 0; bj < 2; ++bj) { const f32x4 v0 = acc[ai][bj][m][0] * g_, v1 = acc[ai][bj][m][1] * g_;
                        v4u w; w.x = cvt_pk_bf16(v0[0], v0[1]); w.y = cvt_pk_bf16(v0[2], v0[3]); w.z = cvt_pk_bf16(v1[0], v1[1]); w.w = cvt_pk_bf16(v1[2], v1[3]);
                        *(v4u*)(fr_ + bj * HALF) = w; } } }
    }
};
}

namespace att {
constexpr int D = 128, NW = 8, QBLK = 32, KVBLK = 64;
constexpr float SCALE = 0.088388347648318440f;
constexpr float THR = 8.f;
#ifndef ATT_SDEPTH
#define ATT_SDEPTH 1
#endif
constexpr int SDEPTH = ATT_SDEPTH;
constexpr int LDQ = DM, LDK = HD, LDO = DM;
constexpr size_t SHM_V = KVBLK * D * 2, SHM_K = KVBLK * D * 2, SHM_ATTN = 2 * SHM_V + 2 * SHM_K + NW * 64 * 4;
typedef unsigned u32x4 __attribute__((ext_vector_type(4)));
#define KSWZ(row, colB) ((row) * 256 + ((colB) ^ (((row) & 7) << 4)))
#define SBAR() __builtin_amdgcn_sched_barrier(0)
__device__ __forceinline__ int crow(int r, int hi) { return (r & 3) + 8 * (r >> 2) + 4 * hi; }
__device__ __forceinline__ unsigned cvtpk(float lo, float hi) { unsigned r; asm volatile("v_cvt_pk_bf16_f32 %0, %1, %2" : "=v"(r) : "v"(lo), "v"(hi)); return r; }
__device__ __forceinline__ bf16x8 ld8(const bf16_t* p) { return *reinterpret_cast<const bf16x8*>(p); }

__device__ __forceinline__ void partialSM(f32x16& p0, f32x16& p1, float& m_reg, float& mn, float& alpha) {
  constexpr float C = SCALE * 1.4426950408889634f;
  float pmax = p0[0]; for (int r = 1; r < 16; ++r) pmax = fmaxf(pmax, p0[r]); for (int r = 0; r < 16; ++r) pmax = fmaxf(pmax, p1[r]);
  { auto rr = __builtin_amdgcn_permlane32_swap(__float_as_uint(pmax), __float_as_uint(pmax), false, false);
    pmax = fmaxf(__uint_as_float(rr[0]), __uint_as_float(rr[1])); }
  if (__builtin_expect(__all(pmax - m_reg <= THR / SCALE), 1)) { mn = m_reg; alpha = 1.f; }
  else { mn = fmaxf(m_reg, pmax); alpha = __builtin_amdgcn_exp2f((m_reg - mn) * C); m_reg = mn; }
  float mnC = -mn * C;
  for (int r = 0; r < 16; ++r) p0[r] = fmaf(p0[r], C, mnC); for (int r = 0; r < 16; ++r) p1[r] = fmaf(p1[r], C, mnC);
  for (int r = 0; r < 16; ++r) p0[r] = __builtin_amdgcn_exp2f(p0[r]);
}
__device__ __forceinline__ void finishSM(f32x16& p0, f32x16& p1, float alpha, float& l_reg, bf16x8& pa0, bf16x8& pa1, bf16x8& pa2, bf16x8& pa3) {
  for (int r = 0; r < 16; ++r) p1[r] = __builtin_amdgcn_exp2f(p1[r]);
  float ps = 0; for (int r = 0; r < 16; ++r) ps += p0[r]; for (int r = 0; r < 16; ++r) ps += p1[r];
  { auto rr = __builtin_amdgcn_permlane32_swap(__float_as_uint(ps), __float_as_uint(ps), false, false);
    ps = __uint_as_float(rr[0]) + __uint_as_float(rr[1]); }
  l_reg = l_reg * alpha + ps;
#define PK4(P, BASE, OUT) do { unsigned a0 = cvtpk(P[BASE + 0], P[BASE + 1]), a1 = cvtpk(P[BASE + 2], P[BASE + 3]);   \
    unsigned b0 = cvtpk(P[BASE + 4], P[BASE + 5]), b1 = cvtpk(P[BASE + 6], P[BASE + 7]);                              \
    auto r0 = __builtin_amdgcn_permlane32_swap(a0, b0, false, false); auto r1 = __builtin_amdgcn_permlane32_swap(a1, b1, false, false); \
    u32x4 w = {r0[0], r1[0], r0[1], r1[1]}; OUT = *reinterpret_cast<bf16x8*>(&w); } while (0)
  PK4(p0, 0, pa0); PK4(p0, 8, pa1); PK4(p1, 0, pa2); PK4(p1, 8, pa3);
#undef PK4
}
__device__ __forceinline__ void qkt(f32x16& p0, f32x16& p1, const bf16_t* Ks, const bf16x8* qr, int r32, int hi) {
  p0 = f32x16{}; p1 = f32x16{};
  for (int d0 = 0; d0 < 8; ++d0) { int cb = (d0 * 16 + hi * 8) * 2;
    bf16x8 b0 = *reinterpret_cast<const bf16x8*>((const char*)Ks + KSWZ(r32, cb));
    bf16x8 b1 = *reinterpret_cast<const bf16x8*>((const char*)Ks + KSWZ(32 + r32, cb));
    p0 = __builtin_amdgcn_mfma_f32_32x32x16_bf16(b0, qr[d0], p0, 0, 0, 0);
    p1 = __builtin_amdgcn_mfma_f32_32x32x16_bf16(b1, qr[d0], p1, 0, 0, 0); }
}
__device__ __forceinline__ int v_st(int k, int c) { const int kk = (k & ~0xC) | ((k & 4) << 1) | ((k & 8) >> 1); return ((kk >> 3) * 4 + (c >> 5)) * 512 + ((kk & 7) * 32 + (c & 31)) * 2; }
__device__ __forceinline__ int v_rd_base(int lane) { return ((lane & 3) << 3) | (((lane >> 2) & 3) << 6) | (((lane >> 4) & 1) << 5) | (((lane >> 5) & 1) << 8); }
constexpr int v_rd_off(int d0, int ks, int half) { return d0 * 512 + ks * 4096 + half * 2048; }
template <int OFF> __device__ __forceinline__ s16x4 tr_read(int vb) {
  s16x4 r; asm volatile("ds_read_b64_tr_b16 %0, %1 offset:%2" : "=&v"(r) : "v"(vb), "i"(OFF) : "memory"); return r;
}
template <int D0> __device__ __forceinline__ void pv_one(f32x16& od, int vb, bf16x8 pa0, bf16x8 pa1, bf16x8 pa2, bf16x8 pa3) {
  const s16x4 l0 = tr_read<v_rd_off(D0, 0, 0)>(vb), h0 = tr_read<v_rd_off(D0, 0, 1)>(vb), l1 = tr_read<v_rd_off(D0, 1, 0)>(vb), h1 = tr_read<v_rd_off(D0, 1, 1)>(vb);
  const s16x4 l2 = tr_read<v_rd_off(D0, 2, 0)>(vb), h2 = tr_read<v_rd_off(D0, 2, 1)>(vb), l3 = tr_read<v_rd_off(D0, 3, 0)>(vb), h3 = tr_read<v_rd_off(D0, 3, 1)>(vb);
  asm volatile("s_waitcnt lgkmcnt(0)" ::: "memory"); SBAR();
#define PK(L, H) (bf16x8){L[0], L[1], L[2], L[3], H[0], H[1], H[2], H[3]}
  od = __builtin_amdgcn_mfma_f32_32x32x16_bf16(pa0, PK(l0, h0), od, 0, 0, 0);
  od = __builtin_amdgcn_mfma_f32_32x32x16_bf16(pa1, PK(l1, h1), od, 0, 0, 0);
  od = __builtin_amdgcn_mfma_f32_32x32x16_bf16(pa2, PK(l2, h2), od, 0, 0, 0);
  od = __builtin_amdgcn_mfma_f32_32x32x16_bf16(pa3, PK(l3, h3), od, 0, 0, 0);
#undef PK
}
__device__ __forceinline__ void pv_d0(f32x16* o, int vb, bf16x8 pa0, bf16x8 pa1, bf16x8 pa2, bf16x8 pa3) {
  pv_one<0>(o[0], vb, pa0, pa1, pa2, pa3); pv_one<1>(o[1], vb, pa0, pa1, pa2, pa3); pv_one<2>(o[2], vb, pa0, pa1, pa2, pa3); pv_one<3>(o[3], vb, pa0, pa1, pa2, pa3);
}
__device__ __forceinline__ void attn_dense_body(const bf16_t* __restrict__ Qb, const bf16_t* __restrict__ Kh, const bf16_t* __restrict__ Vh,
                                                bf16_t* __restrict__ Ob, int seq, char* lds) {
  const int tid = otid(), wid = tid >> 6, lane = tid & 63, r32 = lane & 31, hi = lane >> 5;
  bf16_t* V_lds = (bf16_t*)lds; bf16_t* K_lds = (bf16_t*)(lds + 2 * SHM_V);
  float* ws = (float*)(lds + 2 * SHM_V + 2 * SHM_K) + wid * 64; float* li_l = ws; float* al_l = ws + 32;
  float m_reg = -1e30f, l_reg = 0; f32x16 o[4] = {}; bf16x8 qr[8];
  const bf16_t* Qw = Qb + (long)(wid * QBLK + r32) * LDQ + hi * 8;
#pragma unroll
  for (int d0 = 0; d0 < 8; ++d0) qr[d0] = ld8(Qw + d0 * 16);
  const int sr = tid >> 4, sc = (tid & 15) * 8, vst0 = v_st(sr, sc), vst1 = v_st(32 + sr, sc);
  const int vb0 = (int)(uintptr_t)V_lds + v_rd_base(lane);
  struct { bf16x8 vs0, vs1, ks0, ks1; } sr_[SDEPTH];
#define SLOAD(i, k0) do { sr_[i].vs0 = ld8(&Vh[(long)((k0) + sr) * LDK + sc]); sr_[i].vs1 = ld8(&Vh[(long)((k0) + 32 + sr) * LDK + sc]); \
    sr_[i].ks0 = ld8(&Kh[(long)((k0) + sr) * LDK + sc]); sr_[i].ks1 = ld8(&Kh[(long)((k0) + 32 + sr) * LDK + sc]); } while (0)
#define SWRITE(b, i) do { *(bf16x8*)((char*)V_lds + (b) * SHM_V + vst0) = sr_[i].vs0;          \
    *(bf16x8*)((char*)V_lds + (b) * SHM_V + vst1) = sr_[i].vs1; int kc = sc * 2;               \
    *(bf16x8*)((char*)K_lds + (b) * SHM_K + KSWZ(sr, kc)) = sr_[i].ks0;                       \
    *(bf16x8*)((char*)K_lds + (b) * SHM_K + KSWZ(32 + sr, kc)) = sr_[i].ks1; } while (0)
#define SWAIT() do { if constexpr (SDEPTH == 2) asm volatile("s_waitcnt vmcnt(4)" ::: "memory"); else asm volatile("s_waitcnt vmcnt(0)" ::: "memory"); } while (0)
#define RESC(a) do { if (__any((a) < 1.f)) { if (hi == 0) al_l[r32] = (a); asm volatile("s_waitcnt lgkmcnt(0)" ::: "memory"); \
    for (int d = 0; d < 4; ++d) for (int r = 0; r < 16; ++r) o[d][r] *= al_l[crow(r, hi)]; } } while (0)
  f32x16 pA0, pA1, pB0, pB1; float mnA, mnB, alA, alB; bf16x8 pa0, pa1, pa2, pa3; const int NT = seq / KVBLK;
  constexpr int SE = 0, SO = SDEPTH - 1;
  SLOAD(SE, 0); asm volatile("s_waitcnt vmcnt(0)" ::: "memory"); SWRITE(0, SE); __syncthreads();
  qkt(pA0, pA1, K_lds, qr, r32, hi); partialSM(pA0, pA1, m_reg, mnA, alA);
  SLOAD(SO, KVBLK); if constexpr (SDEPTH == 2) { if (2 < NT) SLOAD(SE, 2 * KVBLK); }
  SWAIT(); SWRITE(1, SO); __syncthreads();
  for (int j = 1; j + 1 < NT; j += 2) {
    SBAR(); qkt(pB0, pB1, (bf16_t*)((char*)K_lds + SHM_K), qr, r32, hi);
    finishSM(pA0, pA1, alA, l_reg, pa0, pa1, pa2, pa3); SBAR();
    SLOAD(SO, (j + SDEPTH) * KVBLK); SBAR();
    pv_d0(o, vb0, pa0, pa1, pa2, pa3); partialSM(pB0, pB1, m_reg, mnB, alB);
    __syncthreads(); SWAIT(); SWRITE(0, SE);
    RESC(alB); __syncthreads();
    SBAR(); qkt(pA0, pA1, K_lds, qr, r32, hi);
    finishSM(pB0, pB1, alB, l_reg, pa0, pa1, pa2, pa3); SBAR();
    if (SDEPTH == 1 || j + 3 < NT) SLOAD(SE, (j + 1 + SDEPTH) * KVBLK); SBAR();
    pv_d0(o, vb0 + (int)SHM_V, pa0, pa1, pa2, pa3); partialSM(pA0, pA1, m_reg, mnA, alA);
    __syncthreads(); SWAIT(); SWRITE(1, SO);
    RESC(alA); __syncthreads();
  }
  SBAR(); qkt(pB0, pB1, (bf16_t*)((char*)K_lds + SHM_K), qr, r32, hi);
  finishSM(pA0, pA1, alA, l_reg, pa0, pa1, pa2, pa3); SBAR();
  pv_d0(o, vb0, pa0, pa1, pa2, pa3); partialSM(pB0, pB1, m_reg, mnB, alB);
  __syncthreads(); RESC(alB);
  finishSM(pB0, pB1, alB, l_reg, pa0, pa1, pa2, pa3); SBAR();
  pv_d0(o, vb0 + (int)SHM_V, pa0, pa1, pa2, pa3);
  if (hi == 0) li_l[r32] = l_reg; asm volatile("s_waitcnt lgkmcnt(0)" ::: "memory");
  float rli[16];
#pragma unroll
  for (int r = 0; r < 16; ++r) rli[r] = __builtin_amdgcn_rcpf(li_l[crow(r, hi)]);
  bf16_t* Ow = Ob + (long)(wid * QBLK) * LDO;
#pragma unroll
  for (int r = 0; r < 16; ++r) { int orow = crow(r, hi);
    for (int d0 = 0; d0 < 4; ++d0) Ow[(long)orow * LDO + d0 * 32 + r32] = (bf16_t)f2bf(o[d0][r] * rli[r]); }
  asm volatile("s_waitcnt vmcnt(0) lgkmcnt(0)" ::: "memory");
  __syncthreads();
#undef SLOAD
#undef SWRITE
#undef SWAIT
#undef RESC
}
constexpr size_t SHM_SLOT = 32768, SHM_DMA = 3 * SHM_SLOT + NW * 64 * 4;
#define ATT_WAIT_BAR() asm volatile("s_waitcnt vmcnt(0) lgkmcnt(0)\n\ts_barrier" ::: "memory")
__device__ __forceinline__ void attn_dma_body(const bf16_t* __restrict__ Qb, int ldq, int tpos0, const float* __restrict__ rope, const float* __restrict__ qgain,
                                              const bf16_t* __restrict__ Kh, const bf16_t* __restrict__ Vh, bf16_t* __restrict__ Ob, int seq, char* lds) {
  const int tid = otid(), wid = tid >> 6, lane = tid & 63, r32 = lane & 31, hi = lane >> 5;
  float* ws = (float*)(lds + 3 * SHM_SLOT) + wid * 64; float* li_l = ws; float* al_l = ws + 32;
  float m_reg = -1e30f, l_reg = 0; f32x16 o[4] = {}; bf16x8 qr[8];
  const bf16_t* Qw = Qb + (long)(wid * QBLK + r32) * ldq + hi * 8;
  unsigned koff[2], voff[2];
#pragma unroll
  for (int c = 0; c < 2; ++c) { const int g = c * 512 + tid;
    { const int row = g >> 4, ch = (g & 15) ^ (row & 7); koff[c] = (unsigned)(row * 128 + ch * 8) * 2u; }
    { const int sub = g >> 5, kk = (sub >> 2) * 8 + ((g >> 2) & 7), k = (kk & ~0xC) | ((kk & 4) << 1) | ((kk & 8) >> 1), col = (sub & 3) * 32 + (g & 3) * 8; voff[c] = (unsigned)(k * 128 + col) * 2u; } }
  const unsigned wbase = (unsigned)__builtin_amdgcn_readfirstlane(wid) * 1024u;
  typedef __attribute__((address_space(3))) unsigned lds_u32;
  lds_u32* ldsl = (lds_u32*)(__attribute__((address_space(3))) char*)lds;
#define ATT_DMA(t, slot) do { const char* kt_ = (const char*)Kh + (size_t)(t) * (KVBLK * D * 2); const char* vt_ = (const char*)Vh + (size_t)(t) * (KVBLK * D * 2); \
    _Pragma("unroll") for (int c_ = 0; c_ < 2; ++c_) { \
      __builtin_amdgcn_global_load_lds((const unsigned*)(kt_ + koff[c_]), (lds_u32*)((__attribute__((address_space(3))) char*)ldsl + (slot) * SHM_SLOT + c_ * 8192 + wbase), 16, 0, 0); \
      __builtin_amdgcn_global_load_lds((const unsigned*)(vt_ + voff[c_]), (lds_u32*)((__attribute__((address_space(3))) char*)ldsl + (slot) * SHM_SLOT + 16384 + c_ * 8192 + wbase), 16, 0, 0); } } while (0)
#define RESC(a) do { if (__any((a) < 1.f)) { if (hi == 0) al_l[r32] = (a); asm volatile("s_waitcnt lgkmcnt(0)" ::: "memory"); \
    for (int d = 0; d < 4; ++d) for (int r = 0; r < 16; ++r) o[d][r] *= al_l[crow(r, hi)]; } } while (0)
  const int NT = seq / KVBLK;
  ATT_DMA(0, 0); ATT_DMA(1, 1);
#pragma unroll
  for (int d0 = 0; d0 < 8; ++d0) qr[d0] = ld8(Qw + d0 * 16);
  if (tpos0 >= 0) {
    float ss = 0.f;
#pragma unroll
    for (int d0 = 0; d0 < 8; ++d0)
#pragma unroll
      for (int i = 0; i < 8; ++i) { const float x = bf2f((unsigned)(unsigned short)qr[d0][i]); ss += x * x; }
    { auto rr = __builtin_amdgcn_permlane32_swap(__float_as_uint(ss), __float_as_uint(ss), false, false); ss = __uint_as_float(rr[0]) + __uint_as_float(rr[1]); }
    const float rinv = 1.0f / sqrtf(ss * (1.0f / 128.0f) + RMS_EPS);
    const int t = tpos0 + wid * QBLK + r32;
#pragma unroll
    for (int ax = 0; ax < 2; ++ax) { const int pos = ax ? (t & 63) : (t >> 6);
#pragma unroll
      for (int q = 0; q < 2; ++q) { const int dl = 4 * ax + q, dh = dl + 2, p0 = q * 16 + 8 * hi;
        const float* cp_ = rope + pos * 32 + p0; const float* gl = qgain + dl * 16 + 8 * hi; const float* gh = qgain + dh * 16 + 8 * hi;
        float cs[8], sn[8], lo[8], hv[8];
#pragma unroll
        for (int i = 0; i < 8; ++i) { cs[i] = cp_[i]; sn[i] = cp_[4096 + i];
          lo[i] = bf2f((unsigned)(unsigned short)qr[dl][i]) * rinv * gl[i]; hv[i] = bf2f((unsigned)(unsigned short)qr[dh][i]) * rinv * gh[i]; }
        u32x4 wl, wh;
#pragma unroll
        for (int i = 0; i < 4; ++i) { const float l0 = lo[2 * i] * cs[2 * i] - hv[2 * i] * sn[2 * i], l1 = lo[2 * i + 1] * cs[2 * i + 1] - hv[2 * i + 1] * sn[2 * i + 1];
          const float h0 = hv[2 * i] * cs[2 * i] + lo[2 * i] * sn[2 * i], h1 = hv[2 * i + 1] * cs[2 * i + 1] + lo[2 * i + 1] * sn[2 * i + 1];
          wl[i] = pk2(l0, l1); wh[i] = pk2(h0, h1); }
        qr[dl] = *reinterpret_cast<bf16x8*>(&wl); qr[dh] = *reinterpret_cast<bf16x8*>(&wh); } } }
#pragma unroll
  for (int d0 = 0; d0 < 8; ++d0) asm volatile("" : "+v"(qr[d0]));
  ATT_WAIT_BAR();
  if (2 < NT) ATT_DMA(2, 2);
  const int vb0 = (int)(uintptr_t)lds + 16384 + v_rd_base(lane);
  f32x16 pA0, pA1, pB0, pB1; float mnA, mnB, alA, alB; bf16x8 pa0, pa1, pa2, pa3;
  qkt(pA0, pA1, (const bf16_t*)lds, qr, r32, hi); partialSM(pA0, pA1, m_reg, mnA, alA);
  int sj = 1;
  for (int j = 1; j + 1 < NT; j += 2) {
    { const int sp = sj == 0 ? 2 : sj - 1;
      SBAR(); qkt(pB0, pB1, (const bf16_t*)(lds + sj * SHM_SLOT), qr, r32, hi);
      finishSM(pA0, pA1, alA, l_reg, pa0, pa1, pa2, pa3); SBAR();
      pv_d0(o, vb0 + sp * (int)SHM_SLOT, pa0, pa1, pa2, pa3); partialSM(pB0, pB1, m_reg, mnB, alB);
      ATT_WAIT_BAR();
      if (j + 2 < NT) ATT_DMA(j + 2, sp);
      RESC(alB); }
    { const int s1 = sj == 2 ? 0 : sj + 1;
      SBAR(); qkt(pA0, pA1, (const bf16_t*)(lds + s1 * SHM_SLOT), qr, r32, hi);
      finishSM(pB0, pB1, alB, l_reg, pa0, pa1, pa2, pa3); SBAR();
      pv_d0(o, vb0 + sj * (int)SHM_SLOT, pa0, pa1, pa2, pa3); partialSM(pA0, pA1, m_reg, mnA, alA);
      ATT_WAIT_BAR();
      if (j + 3 < NT) ATT_DMA(j + 3, sj);
      RESC(alA);
      sj = s1 == 2 ? 0 : s1 + 1; }
  }
  { const int sp = sj == 0 ? 2 : sj - 1;
    SBAR(); qkt(pB0, pB1, (const bf16_t*)(lds + sj * SHM_SLOT), qr, r32, hi);
    finishSM(pA0, pA1, alA, l_reg, pa0, pa1, pa2, pa3); SBAR();
    pv_d0(o, vb0 + sp * (int)SHM_SLOT, pa0, pa1, pa2, pa3); partialSM(pB0, pB1, m_reg, mnB, alB);
    RESC(alB);
    finishSM(pB0, pB1, alB, l_reg, pa0, pa1, pa2, pa3); SBAR();
    pv_d0(o, vb0 + sj * (int)SHM_SLOT, pa0, pa1, pa2, pa3); }
  if (hi == 0) li_l[r32] = l_reg; asm volatile("s_waitcnt lgkmcnt(0)" ::: "memory");
  float rli[16];
#pragma unroll
  for (int r = 0; r < 16; ++r) rli[r] = __builtin_amdgcn_rcpf(li_l[crow(r, hi)]);
  bf16_t* Ow = Ob + (long)(wid * QBLK) * LDO;
  asm volatile("s_waitcnt lgkmcnt(0)\n\ts_barrier" ::: "memory");
  { char* st = lds + wid * 8704;
#pragma unroll
    for (int r = 0; r < 16; ++r) { const int orow = crow(r, hi);
#pragma unroll
      for (int d0 = 0; d0 < 4; ++d0) *(bf16_t*)(st + orow * 272 + (d0 * 32 + r32) * 2) = (bf16_t)f2bf(o[d0][r] * rli[r]); }
    asm volatile("s_waitcnt lgkmcnt(0)" ::: "memory");
#pragma unroll
    for (int i = 0; i < 8; ++i) { const int c = i * 64 + lane, row = c >> 4, cc = c & 15; const u32x4 v = *(const u32x4*)(st + row * 272 + cc * 16);
      const bf16_t* gp = Ow + (long)row * LDO + cc * 8;
      asm volatile("global_store_dwordx4 %0, %1, off sc1\n\ts_nop 1" :: "v"(gp), "v"(v) : "memory"); } }
  ATT_WAIT_BAR();
#undef ATT_DMA
#undef RESC
}
#undef KSWZ
}

struct Params {
    const float *x, *c, *ctx, *c_ctx, *w_mod, *b_mod, *ln_g, *ln_b, *w_qkv, *q_gain, *k_gain, *w_o, *w_pool, *pool_scale, *w_router, *router_bias, *w_gate, *w_up, *w_down;
    float* out; unsigned char* ws; int ph_lo, ph_hi;
};

struct TItem { const float* W; bf16_t* WT; int K, N, kind, k0, n0; };
__device__ __forceinline__ int t_drow(int kind, int n) { return kind == 0 ? n : ((n >> 7) * 256 + (kind == 2 ? 128 : 0) + (n & 127)); }
__device__ __forceinline__ void t_load(const TItem& d, f32x4 (&r)[8], int lane) {
    const float* p = d.W + (size_t)(d.k0 + (lane >> 3)) * d.N + d.n0 + (lane & 7) * 4;
#pragma unroll
    for (int i = 0; i < 8; ++i) r[i] = __builtin_nontemporal_load((const f32x4*)(p + (size_t)(8 * i) * d.N));
}
__device__ __forceinline__ void t_store(const TItem& d, const f32x4 (&r)[8], LAS float* scr, int lane) {
#pragma unroll
    for (int i = 0; i < 8; ++i) *(LAS f32x4*)(scr + (8 * i + (lane >> 3)) * 32 + (((lane & 7) * 4 + 8 * i) & 31)) = r[i];
    LDS_WAIT(); asm volatile("" ::: "memory");
    const int c = lane >> 3, nl = lane & 7;
#pragma unroll
    for (int j = 0; j < 4; ++j) { const int n = nl + 8 * j; const LAS float* s = scr + (8 * c) * 32 + ((n + 8 * c) & 31);
        v4u o; o.x = pk2(s[0 * 32], s[1 * 32]); o.y = pk2(s[2 * 32], s[3 * 32]); o.z = pk2(s[4 * 32], s[5 * 32]); o.w = pk2(s[6 * 32], s[7 * 32]);
        __builtin_nontemporal_store(o, (GAS v4u*)(d.WT + (size_t)t_drow(d.kind, d.n0 + n) * d.K + d.k0 + 8 * c)); }
    LDS_WAIT(); asm volatile("" ::: "memory");
}

__device__ __forceinline__ void mod_prepare(const float* cl, const float* cc, LAS float* sv, int tid) {
    for (int i = tid; i < 3 * DM; i += 512) { const int cd = i >> 11, k = i & 2047; const float v = (cd < 2) ? cl[cd * DM + k] : cc[k]; sv[i] = v / (1.0f + expf(-v)); }
    __syncthreads();
}
__device__ __forceinline__ void mod_item(int it, const float* wm, const float* bm, float* MOD, const LAS float* sv, LAS float* red, int tid, int lane, int wave) {
    const int c4 = lane & 7, kr = (lane >> 3) + 8 * wave;
    const int l = it / 384, nb = it % 384; const float* W = wm + (size_t)l * DM * 12288 + nb * 32 + c4 * 4;
    f32x4 a0 = {0, 0, 0, 0}, a1 = a0, a2 = a0;
#pragma unroll 16
    for (int s = 0; s < 32; ++s) { const int k = s * 64 + kr; const f32x4 w = *(const f32x4*)(W + (size_t)k * 12288);
        a0 += w * sv[k]; a1 += w * sv[DM + k]; a2 += w * sv[2 * DM + k]; }
    *(LAS f32x4*)(red + (kr * 3 + 0) * 32 + c4 * 4) = a0; *(LAS f32x4*)(red + (kr * 3 + 1) * 32 + c4 * 4) = a1; *(LAS f32x4*)(red + (kr * 3 + 2) * 32 + c4 * 4) = a2;
    __syncthreads();
    if (tid < 96) { const int cd = tid >> 5, n = tid & 31; float s = 0.f; for (int r = 0; r < 64; ++r) s += red[(r * 3 + cd) * 32 + n];
        MOD[((size_t)l * 3 + cd) * 12288 + nb * 32 + n] = s + bm[l * 12288 + nb * 32 + n]; }
    __syncthreads();
}

typedef const __attribute__((address_space(4))) Params CParams;
__device__ __forceinline__ CParams* kparams() { CParams* k = (CParams*)__builtin_amdgcn_kernarg_segment_ptr(); asm volatile("" : "+s"(k)); return k; }
#define WSP(T, off) ((T*)(kp->ws + (off)))


#define IN(k) (lo <= (k) && (k) < hi)
#define NREP(k) (1 + ((REP_MASK >> (k)) & 1))
#define SEAM(k) do { if (IN(k) && IN((k) + 1)) xcd_barrier(bar); } while (0)
#define TIDS const int tid = otid(), lane = tid & 63, wave = __builtin_amdgcn_readfirstlane(tid >> 6), G = ogrid(), bx = obid(), gw = bx * 8 + wave, NGW = G * 8; (void)lane; (void)gw; (void)NGW


template <int layer>
__device__ __forceinline__ void layer_half(const int lo, const int hi, const XcdBarrier& bar, LAS unsigned char* L, LAS int* tcnt, LAS int* tbase, LAS int* texp) {
        const int P6 = 6 + 7 * layer;
        if (IN(P6)) _Pragma("unroll 1") for (int rep_ = 0; rep_ < NREP(6); ++rep_) {
            CParams* kp = kparams(); TIDS;
            const int row_lo = layer == 0 ? 0 : NCTX;
            const float* modl = WSP(float, WS_MOD) + (size_t)layer * 3 * 12288;
            unsigned* cnt = WSP(unsigned, WS_CTL) + CW_CNT + layer * 1024;
            const bf16_t* Y = WSP(bf16_t, WS_Y); float* X1 = WSP(float, WS_X1); bf16_t* Hb = WSP(bf16_t, WS_H);
            const float* xlat = kp->x; const float* xctx = kp->ctx; const bf16_t* X2b = WSP(bf16_t, WS_X2);
            const float* pscale = kp->pool_scale;
            int* LIST = WSP(int, WS_LIST); float* LISTG = WSP(float, WS_LIST) + (size_t)32 * MT;
            const float rb_e = kp->router_bias[lane & 31];
            LAS bf16_t* hp = (LAS bf16_t*)L;
            LAS float* part = (LAS float*)(L + 65536);
            LAS int* lcnt = (LAS int*)(L + 65536 + 8192); LAS int* lbase = lcnt + 32;
            LAS int* asg = (LAS int*)(L + 65536 + 8192 + 256);
            LAS float* vG1 = (LAS float*)(L + 82176); LAS float* vLG = vG1 + DM; LAS float* vLB = vLG + DM; LAS float* vSC = vLB + DM; LAS float* vSH = vSC + DM;
            const float* lg = kp->ln_g + (size_t)(layer * 2 + 0) * DM; const float* lb = kp->ln_b + (size_t)(layer * 2 + 0) * DM;
            const int ngrp = (MT - row_lo) / 8;
            const bool agg = ((ngrp + G - 1) / G) * 16 <= 512;
            if (tid < 32) lcnt[tid] = 0;
            const int ti = lane & 31, hi = lane >> 5;
            const bf16_t* w1p = WSP(bf16_t, WS_WR) + ((size_t)(wave * 16) * 64 + lane) * 8; const bf16_t* w2p = w1p + 32 * DM;
            const LAS bf16_t* a1p = hp + (ti & 7) * DM + wave * 256 + 8 * hi; const LAS bf16_t* a2p = a1p + 8 * DM;
            f32x4 xv[8]; v2u xb[8], yv[8];
#define P6_LOAD(grp_) do { const int row_ = row_lo + (grp_) * 8 + wave; const float* xr_ = (row_ < NCTX) ? xctx + (size_t)row_ * DM : xlat + (size_t)(row_ - NCTX) * DM; const bf16_t* yr_ = Y + (size_t)row_ * DM; const bf16_t* xb_ = X2b + (size_t)row_ * DM; \
                _Pragma("unroll") for (int j = 0; j < 8; ++j) { if (layer == 0) xv[j] = *(const f32x4*)(xr_ + (j * 64 + lane) * 4); else xb[j] = *(const v2u*)(xb_ + (j * 64 + lane) * 4); yv[j] = *(const v2u*)(yr_ + (j * 64 + lane) * 4); } } while (0)
            LAS int* rdy = (LAS int*)(L + 124928); unsigned* yd = WSP(unsigned, WS_CTL) + CW_YD; volatile LAS unsigned* MISC = (volatile LAS unsigned*)(L + MISC_OFF);
            const bool dyn = (layer == 0) && (G % 2 == 0); const int pcls = bx & 1; unsigned* q6 = WSP(unsigned, WS_CTL) + CW_P6Q + 32 * pcls;
            auto gmap = [&](unsigned pos) -> int { return pos >= 1056u ? -1 : (pos < 32u ? pcls * 32 + (int)pos : 64 + pcls * 1024 + ((int)pos - 32)); };
            auto seq = [&](int k) -> int { const int g_ = bx + k * G; return g_ < ngrp ? g_ : -1; };
            auto ensure = [&](int g_) { if (layer == 0) { const int pm_ = g_ < 64 ? (g_ >> 5) : 2 + ((g_ - 64) >> 5); if (!rdy[pm_]) { while (xb_ld(yd + 32 * pm_) < 8u) __builtin_amdgcn_s_sleep(4); asm volatile("" ::: "memory"); } } };
            if (layer == 0) { if (tid < 66) rdy[tid] = xb_ld(yd + 32 * tid) >= 8u ? 1 : 0;
                if (tid == 0) { __builtin_amdgcn_fence(__ATOMIC_ACQUIRE, "agent"); asm volatile("s_waitcnt vmcnt(0)" ::: "memory");
                    if (dyn) { MISC[36] = xb_add(q6, 1u); MISC[37] = xb_add(q6, 1u); } }
                __syncthreads(); }
            int grp = dyn ? gmap(MISC[36]) : seq(0), nxt_ = dyn ? gmap(MISC[37]) : seq(1);
            if (grp >= 0) ensure(grp);
            P6_LOAD(grp >= 0 ? grp : 0);
            int it_ = 0, cur_cd = -1;
            for (; grp >= 0; ++it_) {
                const int pf_ = nxt_ >= 0 ? nxt_ : grp; if (nxt_ >= 0) ensure(nxt_);
                unsigned tk2 = 0xffffffffu;
                if (dyn && tid == 0 && nxt_ >= 0 && it_ + 2 < 32) tk2 = xb_add(q6, 1u);
                const int row = row_lo + grp * 8 + wave; const int cd = row_cond(row_lo + grp * 8);
                if (cd != cur_cd) {
                    const float* g1 = modl + (size_t)cd * 12288 + 2 * DM;
                    float t0[4], t1[4], t2[4], t3[4], t4[4], t5[4];
                    __syncthreads();
#pragma unroll
                    for (int q = 0; q < 4; ++q) { const int i = tid + q * 512; t0[q] = g1[i]; t1[q] = (layer == 1) ? pscale[i] : 1.0f; t2[q] = lg[i]; t3[q] = lb[i]; t4[q] = g1[DM + i]; t5[q] = g1[2 * DM + i]; }
#pragma unroll
                    for (int q = 0; q < 4; ++q) { const int i = tid + q * 512; vG1[i] = t0[q] * t1[q]; vLG[i] = t2[q]; vLB[i] = t3[q]; vSH[i] = t4[q]; vSC[i] = t5[q] + 1.0f; }
                    cur_cd = cd; __syncthreads(); }
                f32x4 v[8]; float s = 0.f;
#pragma unroll
                for (int j = 0; j < 8; ++j) { const int c = (j * 64 + lane) * 4; const f32x4 gv = *(const LAS f32x4*)(vG1 + c);
                    const f32x4 yf = {bf2f(yv[j].x & 0xffffu), bf2f(yv[j].x >> 16), bf2f(yv[j].y & 0xffffu), bf2f(yv[j].y >> 16)};
                    const f32x4 xf = (layer == 0) ? xv[j] : bf4(xb[j]);
                    v[j] = xf * ALPHA + gv * yf; s += (v[j][0] + v[j][1]) + (v[j][2] + v[j][3]); }
                const float mean = wave_sum(s) * (1.0f / DM); float s2 = 0.f;
#pragma unroll
                for (int j = 0; j < 8; ++j) { v[j] = v[j] - mean; s2 += (v[j][0] * v[j][0] + v[j][1] * v[j][1]) + (v[j][2] * v[j][2] + v[j][3] * v[j][3]); }
                const float rstd = 1.0f / sqrtf(wave_sum(s2) * (1.0f / DM) + LN_EPS);
#pragma unroll
                for (int j = 0; j < 8; ++j) { const int c = (j * 64 + lane) * 4;
                    const f32x4 x1 = v[j] * rstd * *(const LAS f32x4*)(vLG + c) + *(const LAS f32x4*)(vLB + c);
                    { v2u xw; xw.x = pk2(x1[0], x1[1]); xw.y = pk2(x1[2], x1[3]); *(v2u*)((bf16_t*)X1 + (size_t)row * DM + c) = xw; }
                    const f32x4 hv = x1 * *(const LAS f32x4*)(vSC + c) + *(const LAS f32x4*)(vSH + c);
                    v2u w; w.x = pk2(hv[0], hv[1]); w.y = pk2(hv[2], hv[3]); *(v2u*)(Hb + (size_t)row * DM + c) = w;
                    v2u w2; w2.x = pk2(hv[0] - bf2f(w.x & 0xffffu), hv[1] - bf2f(w.x >> 16)); w2.y = pk2(hv[2] - bf2f(w.y & 0xffffu), hv[3] - bf2f(w.y >> 16));
                    *(LAS v2u*)(hp + wave * DM + c) = w; *(LAS v2u*)(hp + (8 + wave) * DM + c) = w2; }
                const bf16_t* w1q = w1p; asm volatile("" : "+v"(w1q));
                const bf16_t* w2q = w1q + 32 * DM;
                bf16x8 wA1[4], wA2[4], wB1[4], wB2[4];
#define P6_WLOAD(d1, d2, q0) do { _Pragma("unroll") for (int q_ = 0; q_ < 4; ++q_) { d1[q_] = *(const GAS bf16x8*)(w1q + ((q0) + q_) * 512); d2[q_] = *(const GAS bf16x8*)(w2q + ((q0) + q_) * 512); } } while (0)
#define P6_MMA(s1, s2, q0) do { _Pragma("unroll") for (int q_ = 0; q_ < 4; ++q_) { const bf16x8 a1 = *(const LAS bf16x8*)(a1p + ((q0) + q_) * 16), a2 = *(const LAS bf16x8*)(a2p + ((q0) + q_) * 16); \
                    acc = __builtin_amdgcn_mfma_f32_32x32x16_bf16(a1, s1[q_], acc, 0, 0, 0); acc = __builtin_amdgcn_mfma_f32_32x32x16_bf16(a1, s2[q_], acc, 0, 0, 0); acc = __builtin_amdgcn_mfma_f32_32x32x16_bf16(a2, s1[q_], acc, 0, 0, 0); } } while (0)
                P6_WLOAD(wA1, wA2, 0); P6_WLOAD(wB1, wB2, 4);
                __syncthreads();
                {
                    f32x16 acc = {};
                    __builtin_amdgcn_sched_barrier(0); P6_MMA(wA1, wA2, 0); __builtin_amdgcn_sched_barrier(0);
                    P6_WLOAD(wA1, wA2, 8); __builtin_amdgcn_sched_barrier(0); P6_MMA(wB1, wB2, 4); __builtin_amdgcn_sched_barrier(0);
                    P6_WLOAD(wB1, wB2, 12); __builtin_amdgcn_sched_barrier(0);
                    P6_LOAD(pf_);
                    __builtin_amdgcn_sched_barrier(0); P6_MMA(wA1, wA2, 8); __builtin_amdgcn_sched_barrier(0);
                    P6_MMA(wB1, wB2, 12);
#pragma unroll
                    for (int r = 0; r < 4; ++r) part[(wave * 8 + r + 4 * hi) * 32 + ti] = acc[r];
                }
                if (dyn && tid == 0) MISC[38] = tk2;
                __syncthreads();
                {
                    const int rr = row_lo + grp * 8 + wave, e = lane & 31; float lgt = 0.f;
#pragma unroll
                    for (int k = 0; k < 8; ++k) lgt += part[(k * 8 + wave) * 32 + e];
                    const float aff = 1.0f / (1.0f + expf(-lgt)); const float sel = aff + rb_e;
                    const float o1 = dppf<0xB1>(sel), mx1 = fmaxf(sel, o1), mn1 = fminf(sel, o1);
                    const float mx2 = dppf<0x4E>(mx1), mn2 = dppf<0x4E>(mn1);
                    float gs = fmaxf(mx1, mx2) + fmaxf(fminf(mx1, mx2), fmaxf(mn1, mn2)); int bg = e >> 2;
                    { const float og = dppf<0x141>(gs); const int ob = dppi<0x141>(bg); if (og > gs || (og == gs && ob < bg)) { gs = og; bg = ob; } }
                    { const float og = dppf<0x140>(gs); const int ob = dppi<0x140>(bg); if (og > gs || (og == gs && ob < bg)) { gs = og; bg = ob; } }
                    { const auto rg = __builtin_amdgcn_permlane16_swap(__float_as_uint(gs), __float_as_uint(gs), false, false); const auto rb = __builtin_amdgcn_permlane16_swap((unsigned)bg, (unsigned)bg, false, false);
                      const bool odd = (lane & 16) != 0; const float og = __uint_as_float(odd ? rg[0] : rg[1]); const int ob = (int)(odd ? rb[0] : rb[1]); if (og > gs || (og == gs && ob < bg)) { gs = og; bg = ob; } }
                    const int bgs = __builtin_amdgcn_readfirstlane(bg);
                    float s4[4], a4[4];
#pragma unroll
                    for (int j = 0; j < 4; ++j) { s4[j] = __uint_as_float((unsigned)__builtin_amdgcn_readlane((int)__float_as_uint(sel), bgs * 4 + j)); a4[j] = __uint_as_float((unsigned)__builtin_amdgcn_readlane((int)__float_as_uint(aff), bgs * 4 + j)); }
                    int i0 = 0; float m0 = s4[0], g0 = a4[0];
#pragma unroll
                    for (int j = 1; j < 4; ++j) if (s4[j] > m0) { m0 = s4[j]; i0 = j; g0 = a4[j]; }
                    int i1 = -1; float m1 = -1e30f, g1_ = 0.f;
#pragma unroll
                    for (int j = 0; j < 4; ++j) if (j != i0 && s4[j] > m1) { m1 = s4[j]; i1 = j; g1_ = a4[j]; }
                    const int e0 = __builtin_amdgcn_readfirstlane(bg * 4 + i0), e1 = __builtin_amdgcn_readfirstlane(bg * 4 + i1);
                    const float inv = 1.0f / (g0 + g1_);
                    if (lane == 0 && rep_ == 0) {
                        if (agg) { const int q0 = __hip_atomic_fetch_add(&lcnt[e0], 1, __ATOMIC_RELAXED, __HIP_MEMORY_SCOPE_WORKGROUP), q1 = __hip_atomic_fetch_add(&lcnt[e1], 1, __ATOMIC_RELAXED, __HIP_MEMORY_SCOPE_WORKGROUP);
                            LAS int* ap = asg + (it_ * 8 + wave) * 8;
                            ap[0] = e0; ap[1] = q0; ap[2] = rr * 2; ap[3] = (int)__float_as_uint(g0 * inv); ap[4] = e1; ap[5] = q1; ap[6] = rr * 2 + 1; ap[7] = (int)__float_as_uint(g1_ * inv);
                        } else {
                            const unsigned p0 = __hip_atomic_fetch_add(&cnt[e0 * 32], 1u, RLX_AGENT), p1 = __hip_atomic_fetch_add(&cnt[e1 * 32], 1u, RLX_AGENT);
                            LIST[(size_t)e0 * MT + p0] = rr * 2; LISTG[(size_t)e0 * MT + p0] = g0 * inv;
                            LIST[(size_t)e1 * MT + p1] = rr * 2 + 1; LISTG[(size_t)e1 * MT + p1] = g1_ * inv; } }
                }
                grp = nxt_; nxt_ = dyn ? gmap(MISC[38]) : seq(it_ + 2);
            }
#undef P6_LOAD
#undef P6_WLOAD
#undef P6_MMA
            __syncthreads();
            if (agg && rep_ == 0) {
                if (tid < 32) lbase[tid] = (int)__hip_atomic_fetch_add(&cnt[tid * 32], (unsigned)lcnt[tid], RLX_AGENT);
                __syncthreads();
                for (int i = tid; i < it_ * 16; i += 512) { const int e = asg[i * 4], q = asg[i * 4 + 1], src = asg[i * 4 + 2]; const float gt = __uint_as_float((unsigned)asg[i * 4 + 3]);
                    const size_t o = (size_t)e * MT + (size_t)(lbase[e] + q); LIST[o] = src; LISTG[o] = gt; }
            }
            __syncthreads();
        }
        SEAM(P6);
        int NT = 0;
        if (IN(P6 + 1) || IN(P6 + 2) || IN(P6 + 3)) {
            CParams* kp = kparams(); unsigned* cnt = WSP(unsigned, WS_CTL) + CW_CNT + layer * 1024;
            const int ttid = otid();
            if (ttid < 64) { const int ln = ttid, e = ln & 31; const int c = (int)__hip_atomic_load(&cnt[e * 32], RLX_AGENT); const int nt_ = (c + 255) >> 8; int inc = nt_;
#pragma unroll
                for (int o = 1; o < 32; o <<= 1) { const int t_ = __shfl_up(inc, o); if ((ln & 31) >= o) inc += t_; }
                if (ln < 32) { tcnt[e] = c; tbase[e] = inc - nt_; if (e == 31) tbase[32] = inc; for (int t_ = inc - nt_; t_ < inc; ++t_) texp[t_] = e; } }
            __syncthreads();
            NT = __builtin_amdgcn_readfirstlane(tbase[32]);
        }
        if (IN(P6 + 2)) _Pragma("unroll 1") for (int rep_ = 0; rep_ < NREP(8); ++rep_) {
            CParams* kp = kparams();
            typedef pg8::SchedMoe<256u * DM * 2u, 256u * DM * 2u, 2048u * DM * 2u, DM / 64, true> Sch;
            LAS int* rt = (LAS int*)(L + TAB_OFF + 1024);
            pg8::Gemm g{DM, DM, DM}; Sch S; S.o.init(NT, 8, ogrid(), obid()); S.A = WSP(const char, WS_H); S.B = WSP(const char, WS_WGU) + (size_t)layer * 32 * 2048 * DM * 2;
            S.texp = texp; S.tbase = tbase; S.tcnt = tcnt; S.rt = rt; S.list = WSP(int, WS_LIST); S.ctr = WSP(unsigned, WS_CTL) + CW_GUD + layer * 8192;
            S.fill_rows(rt, otid());
            pg8::EpiGateUp E{WSP(bf16_t, WS_ACT)};
            pg8::gemm_phase<pg8::EpiGateUp, Sch, true, true>(L, g, S, E);
        }
        if (IN(P6 + 2)) _Pragma("unroll 1") for (int rep_ = 0; rep_ < NREP(9); ++rep_) {
            CParams* kp = kparams();
            typedef pg8::SchedMoe<256u * DE * 2u, 256u * DE * 2u, (unsigned)DM * DE * 2u, DE / 64, false> Sch;
            pg8::Gemm g{DE, DE, DE}; Sch S; S.o.init(NT, 8, ogrid(), obid()); S.o.rot = 1; S.rem = (NT * 8) % ogrid(); S.nl = ogrid() - S.rem; S.A = WSP(const char, WS_ACT); S.B = WSP(const char, WS_WD) + (size_t)layer * 32 * DM * DE * 2;
            LAS int* rt = (LAS int*)(L + TAB_OFF + 1024);
            S.texp = texp; S.tbase = tbase; S.tcnt = tcnt; S.rt = nullptr; S.list = WSP(int, WS_LIST); S.ctr = WSP(unsigned, WS_CTL) + CW_GUD + layer * 8192;
            if (otid() == 0) { __builtin_amdgcn_fence(__ATOMIC_ACQUIRE, "agent"); asm volatile("s_waitcnt vmcnt(0)" ::: "memory"); }
            S.fill_dst(rt, WSP(float, WS_LIST) + (size_t)32 * MT, otid());
            pg8::EpiDown E{WSP(bf16_t, WS_FB), rt};
            pg8::gemm_phase<pg8::EpiDown, Sch, true, false>(L, g, S, E);
        }
        SEAM(P6 + 3);
        if (IN(P6 + 4)) _Pragma("unroll 1") for (int rep_ = 0; rep_ < NREP(10); ++rep_) {
            CParams* kp = kparams(); TIDS;
            const int row_lo = layer == 0 ? 0 : NCTX;
            const float* modl = WSP(float, WS_MOD) + (size_t)layer * 3 * 12288; const float* X1 = WSP(float, WS_X1); const bf16_t* FB = WSP(bf16_t, WS_FB);
            float* dstb = kp->out - (size_t)NCTX * DM; bf16_t* X2b = WSP(bf16_t, WS_X2);
            LAS float* vG2 = (LAS float*)L; LAS float* vLG = vG2 + 3 * DM; LAS float* vLB = vLG + DM;
            { const float* lg = kp->ln_g + (size_t)(layer * 2 + 1) * DM; const float* lb = kp->ln_b + (size_t)(layer * 2 + 1) * DM;
              float t0[12], t1[4], t2[4];
#pragma unroll
              for (int q = 0; q < 12; ++q) { const int i = tid + q * 512; t0[q] = modl[(size_t)(i >> 11) * 12288 + 5 * DM + (i & 2047)]; }
#pragma unroll
              for (int q = 0; q < 4; ++q) { const int i = tid + q * 512; t1[q] = lg[i]; t2[q] = lb[i]; }
#pragma unroll
              for (int q = 0; q < 12; ++q) vG2[tid + q * 512] = t0[q];
#pragma unroll
              for (int q = 0; q < 4; ++q) { vLG[tid + q * 512] = t1[q]; vLB[tid + q * 512] = t2[q]; } }
            __syncthreads();
            f32x4 xa[8]; v2u fa[8], fb[8];
#define P10_LOAD(row_) do { const float* xr_ = X1 + (size_t)(row_) * DM; const bf16_t* xb_ = (const bf16_t*)X1 + (size_t)(row_) * DM; const bf16_t* f0_ = FB + (size_t)((row_) * 2) * DM; \
                _Pragma("unroll") for (int j = 0; j < 8; ++j) { const int c = (j * 64 + lane) * 4; \
                    { const v2u q_ = *(const v2u*)(xb_ + c); xa[j] = (f32x4){bf2f(q_.x & 0xffffu), bf2f(q_.x >> 16), bf2f(q_.y & 0xffffu), bf2f(q_.y >> 16)}; } \
                    fa[j] = *(const v2u*)(f0_ + c); fb[j] = *(const v2u*)(f0_ + DM + c); } } while (0)
            { const int r0 = row_lo + gw; P10_LOAD(r0 < MT ? r0 : row_lo); }
            for (int row = row_lo + gw; row < MT; row += NGW) { const int cd = row_cond(row);
                f32x4 v[8]; float s = 0.f;
#pragma unroll
                for (int j = 0; j < 8; ++j) { const int c = (j * 64 + lane) * 4;
                    const f32x4 fs = {bf2f(fa[j].x & 0xffffu) + bf2f(fb[j].x & 0xffffu), bf2f(fa[j].x >> 16) + bf2f(fb[j].x >> 16), bf2f(fa[j].y & 0xffffu) + bf2f(fb[j].y & 0xffffu), bf2f(fa[j].y >> 16) + bf2f(fb[j].y >> 16)};
                    v[j] = xa[j] * ALPHA + *(const LAS f32x4*)(vG2 + cd * DM + c) * fs; s += (v[j][0] + v[j][1]) + (v[j][2] + v[j][3]); }
                if (row + NGW < MT) P10_LOAD(row + NGW);
                const float mean = wave_sum(s) * (1.0f / DM); float s2 = 0.f;
#pragma unroll
                for (int j = 0; j < 8; ++j) { v[j] = v[j] - mean; s2 += (v[j][0] * v[j][0] + v[j][1] * v[j][1]) + (v[j][2] * v[j][2] + v[j][3] * v[j][3]); }
                const float rstd = 1.0f / sqrtf(wave_sum(s2) * (1.0f / DM) + LN_EPS);
                float* dst = dstb + (size_t)row * DM;
#pragma unroll
                for (int j = 0; j < 8; ++j) { const int c = (j * 64 + lane) * 4; const f32x4 r_ = v[j] * rstd * *(const LAS f32x4*)(vLG + c) + *(const LAS f32x4*)(vLB + c);
                    if (layer == 0) { v2u w; w.x = pk2(r_[0], r_[1]); w.y = pk2(r_[2], r_[3]); *(v2u*)(X2b + (size_t)row * DM + c) = w; } else *(f32x4*)(dst + c) = r_; } }
#undef P10_LOAD
            __syncthreads();
        }
        if constexpr (layer == 0) {
            SEAM(10);
            if (IN(11)) _Pragma("unroll 1") for (int rep_ = 0; rep_ < NREP(11); ++rep_) {
                CParams* kp = kparams(); TIDS;
                const bf16_t* X2 = WSP(bf16_t, WS_X2); bf16_t* DP = WSP(bf16_t, WS_DP);
                const float* sc1 = WSP(float, WS_MOD) + (size_t)3 * 12288 + DM;
                const int c = tid * 4, gch = c >> 9, hw = 1 << gch;
                for (int chunk = bx; chunk < NLAT / 64; chunk += G) { const int b = chunk >> 7, t0 = (chunk & 127) * 64;
                    const bf16_t* base = X2 + ((size_t)NCTX + (size_t)b * SEQ) * DM + c; bf16_t* dbase = DP + ((size_t)NCTX + (size_t)b * SEQ) * DM + c;
                    const f32x4 a1 = *(const f32x4*)(sc1 + (size_t)b * 12288 + c) + 1.0f;
                    f32x4 s = {0, 0, 0, 0};
                    { v2u wv[16];
#pragma unroll
                      for (int q = 0; q < 16; ++q) { const int p_ = t0 - 8 + q; wv[q] = *(const v2u*)(base + (size_t)(p_ < 0 ? 0 : p_) * DM); }
#pragma unroll
                      for (int q = 0; q < 16; ++q) { const int p_ = t0 - 8 + q; const bool in_ = p_ >= 0 && p_ >= t0 - hw && p_ < t0 + hw; s += bf4(wv[q]) * (in_ ? 1.0f : 0.0f); } }
#pragma unroll 8
                    for (int i = 0; i < 64; ++i) { const int t = t0 + i; const int tn = t + hw, to = t - hw;
                        const f32x4 xc = bf4(*(const v2u*)(base + (size_t)t * DM));
                        const f32x4 xn = bf4(*(const v2u*)(base + (size_t)(tn < SEQ ? tn : SEQ - 1) * DM)), xo = bf4(*(const v2u*)(base + (size_t)(to >= 0 ? to : 0) * DM));
                        const int lo_ = to < 0 ? 0 : to, hi_ = tn > SEQ ? SEQ : tn;
                        const f32x4 d = a1 * (s * (1.0f / (float)(hi_ - lo_)) - xc);
                        v2u w; w.x = pk2(d[0], d[1]); w.y = pk2(d[2], d[3]); *(v2u*)(dbase + (size_t)t * DM) = w;
                        s = s + xn * (tn < SEQ ? 1.0f : 0.0f) - xo * (to >= 0 ? 1.0f : 0.0f); }
                }
            }
            SEAM(11);
            if (IN(12)) _Pragma("unroll 1") for (int rep_ = 0; rep_ < NREP(12); ++rep_) {
                CParams* kp = kparams();
                pg8::Gemm g{DM, 512, 512}; pg8::SchedPool S; S.o.init(NLAT / 256, 8, ogrid(), obid()); S.A = WSP(const char, WS_DP); S.B = WSP(const char, WS_WPOOL);
                pg8::EpiBf16 E{WSP(bf16_t, WS_Y), DM, nullptr};
                pg8::gemm_phase<pg8::EpiBf16, pg8::SchedPool, true, false>(L, g, S, E);
            }
            SEAM(12);
        }
    }

__global__ void __launch_bounds__(512, 2) mk_fwd(Params p_unused) {
    extern __shared__ __attribute__((aligned(16))) unsigned char lds[];
    LAS unsigned char* L = (LAS unsigned char*)lds;
    volatile LAS unsigned* MISC = (volatile LAS unsigned*)(L + MISC_OFF);
    LAS int* tcnt = (LAS int*)(L + TAB_OFF); LAS int* tbase = tcnt + 32; LAS int* texp = tcnt + 80;
    if (threadIdx.x < 64) MISC[threadIdx.x] = 0u;
    __syncthreads();
    int lo, hi; XcdBarrier bar;
    { CParams* kp = kparams(); lo = kp->ph_lo; hi = kp->ph_hi; unsigned* bw = (unsigned*)(kp->ws + WS_CTL) + CW_BAR;
      bar.bar = bw; bar.x = 0; bar.st = nullptr; if (hi - lo > 1) bar = xcd_barrier_post(bw, MISC + 8); }
    if (IN(0)) _Pragma("unroll 1") for (int rep_ = 0; rep_ < NREP(0); ++rep_) {
        CParams* kp = kparams(); TIDS;
        float* MOD = WSP(float, WS_MOD); float* ROPE = WSP(float, WS_ROPE);
        for (int i = bx * 512 + tid; i < 4096; i += G * 512) { const int pos = i >> 5, pp = i & 31;
            const float inv = exp2f(-(float)pp * (13.287712379549449f / 32.0f)); const float ang = (float)pos * inv;
            float sn, cs; sincosf(ang, &sn, &cs); ROPE[i] = cs; ROPE[4096 + i] = sn; }
        { const float* wrt = kp->w_router; bf16_t* WR = WSP(bf16_t, WS_WR);
          for (int i = bx * 512 + tid; i < 32 * DM; i += G * 512) { const int ii = i & 7, ln = (i >> 3) & 63, kq = (i >> 9) & 15, w = i >> 13; const int e = ln & 31, k = w * 256 + kq * 16 + 8 * (ln >> 5) + ii;
              const float wv = wrt[k * 32 + e]; const unsigned h1 = f2bf(wv); const unsigned h2 = f2bf(wv - bf2f(h1)); WR[i] = (bf16_t)h1; WR[32 * DM + i] = (bf16_t)h2; } }
        {
            LAS float* sv = (LAS float*)L;
            LAS float* red = (LAS float*)(L + 32768);
            mod_prepare(kp->c, kp->c_ctx, sv, tid);
            for (int it = bx; it < 384; it += G) mod_item(it, kp->w_mod, kp->b_mod, MOD, sv, red, tid, lane, wave);
        }
        {
            LAS float* scr = (LAS float*)(L + wave * 16384);
            constexpr int I_QKV = (DM / 64) * (QKVD / 32), I_O = (DM / 64) * (DM / 32), I_P = (512 / 64) * (512 / 32), I_G = (DM / 64) * (DE / 32), I_D = (DE / 64) * (DM / 32);
            constexpr int NITEMS = I_QKV + I_O + 4 * I_P;
            (void)I_G; (void)I_D;
            auto decode = [&](int it) { TItem d; int r = it;
                if (r < I_QKV) { d.W = kp->w_qkv; d.WT = WSP(bf16_t, WS_WQKV); d.K = DM; d.N = QKVD; d.kind = 0; }
                else if ((r -= I_QKV) < I_O) { d.W = kp->w_o; d.WT = WSP(bf16_t, WS_WO); d.K = DM; d.N = DM; d.kind = 0; }
                else { r -= I_O; const int g = r / I_P; r -= g * I_P; d.W = kp->w_pool + (size_t)g * 512 * 512; d.WT = WSP(bf16_t, WS_WPOOL) + (size_t)g * 512 * 512; d.K = 512; d.N = 512; d.kind = 0; }
                const int nblk = d.N / 32; d.k0 = 64 * (r / nblk); d.n0 = 32 * (r % nblk); return d; };
            for (int it = gw; it < NITEMS; it += 2 * NGW) {
                const TItem d0 = decode(it); f32x4 ra[8], rb[8]; t_load(d0, ra, lane);
                const bool two = it + NGW < NITEMS; TItem d1 = d0; if (two) { d1 = decode(it + NGW); t_load(d1, rb, lane); }
                t_store(d0, ra, scr, lane); if (two) t_store(d1, rb, scr, lane);
            }
        }
        __syncthreads();
    }
    SEAM(0);

    if (IN(1)) _Pragma("unroll 1") for (int rep_ = 0; rep_ < NREP(1); ++rep_) {
        CParams* kp = kparams(); TIDS;
        const float* MOD = WSP(float, WS_MOD); bf16_t* U = WSP(bf16_t, WS_U); const float* xl = kp->x; const float* xc = kp->ctx;
        const int R = (MT + NGW - 1) / NGW, r0 = gw * R, r1 = (r0 + R) < MT ? (r0 + R) : MT;
        f32x4 sa[8], sb[8], xv[8]; int cur = -1;
#define P1_LOAD(row_) do { const float* xr_ = ((row_) < NCTX) ? xc + (size_t)(row_) * DM : xl + (size_t)((row_) - NCTX) * DM; _Pragma("unroll") for (int j = 0; j < 8; ++j) xv[j] = *(const f32x4*)(xr_ + (j * 64 + lane) * 4); } while (0)
        if (r0 < r1) P1_LOAD(r0); else P1_LOAD(0);
        for (int row = r0; row < r1; ++row) { const int cd = row_cond(row);
            if (cd != cur) { const float* sh = MOD + (size_t)cd * 12288; const float* sc = sh + DM;
#pragma unroll
                for (int j = 0; j < 8; ++j) { const int c = (j * 64 + lane) * 4; sa[j] = *(const f32x4*)(sc + c) + 1.0f; sb[j] = *(const f32x4*)(sh + c); }
                cur = cd; }
            f32x4 o[8];
#pragma unroll
            for (int j = 0; j < 8; ++j) o[j] = xv[j] * sa[j] + sb[j];
            if (row + 1 < r1) P1_LOAD(row + 1);
#pragma unroll
            for (int j = 0; j < 8; ++j) { const int c = (j * 64 + lane) * 4; v2u w; w.x = pk2(o[j][0], o[j][1]); w.y = pk2(o[j][2], o[j][3]); *(v2u*)(U + (size_t)row * DM + c) = w; } }
#undef P1_LOAD
    }
    SEAM(1);

    if (IN(2)) _Pragma("unroll 1") for (int rep_ = 0; rep_ < NREP(2); ++rep_) {
        CParams* kp = kparams();
        typedef pg8::SchedSplit<256u * DM * 2u, 256u * DM * 2u, DM / 64, QKVD / 256> Sch;
        pg8::Gemm g{DM, DM, DM}; Sch S; S.init(ogrid(), obid()); S.A = WSP(const char, WS_U); S.B = WSP(const char, WS_WQKV);
        pg8::EpiQkv E{WSP(bf16_t, WS_QKVR), QKVD, WSP(float, WS_PQ), WSP(bf16_t, WS_V)};
        pg8::gemm_phase<pg8::EpiQkv, Sch, true, false>(L, g, S, E);
    }
    SEAM(2);

    if (IN(3)) _Pragma("unroll 1") for (int rep_ = 0; rep_ < NREP(3); ++rep_) {
        CParams* kp = kparams(); TIDS;
        const float* ROPE = WSP(float, WS_ROPE); const bf16_t* QKVR = WSP(bf16_t, WS_QKVR); bf16_t* Qb = WSP(bf16_t, WS_Q); bf16_t* Kb = WSP(bf16_t, WS_K); bf16_t* Vb = WSP(bf16_t, WS_V);
        const int sub = lane >> 4, l16 = lane & 15, d0 = l16 * 8, ax = l16 >> 3, hh = (l16 >> 2) & 1, p0 = (l16 & 3) * 8;
        const bool split3 = ((64 * (QKVD / 256)) % G == 0) && (2 * (QKVD / 256) * 8 <= G);
        const float* PQ = WSP(float, WS_PQ);
        float qg[8], kg[8];
        { const float* qgn = kp->q_gain; const float* kgn = kp->k_gain;
#pragma unroll
          for (int i = 0; i < 8; ++i) { qg[i] = qgn[d0 + i]; kg[i] = kgn[d0 + i]; } }
        v4u rw[6];
#define P3_LOAD(row_) do { const bf16_t* s_ = QKVR + (size_t)(row_) * QKVD + sub * 128 + d0; const bool all_ = (row_) < NCTX; _Pragma("unroll") for (int it = 0; it < 6; ++it) if (it == 4 || all_) rw[it] = *(const v4u*)(s_ + it * 512); } while (0)
        for (int r4 = NCTX + gw * 4; r4 < MT; r4 += NGW * 4) {
            v4u kr[4]; f32x4 c0[4], c1[4], s0[4], s1[4];
#pragma unroll
            for (int q = 0; q < 4; ++q) { const int row = r4 + q, t = (row - NCTX) & 8191; kr[q] = *(const v4u*)(QKVR + (size_t)row * QKVD + 2048 + sub * 128 + d0);
                const int pos = ax ? (t & 63) : (t >> 6); const float* cp_ = ROPE + pos * 32 + p0; c0[q] = *(const f32x4*)cp_; c1[q] = *(const f32x4*)(cp_ + 4); s0[q] = *(const f32x4*)(cp_ + 4096); s1[q] = *(const f32x4*)(cp_ + 4100); }
#pragma unroll
            for (int q = 0; q < 4; ++q) { const int row = r4 + q, lr = row - NCTX, b = lr >> 13, kpos = CTXL + (lr & 8191); const v4u raw = kr[q];
                float f[8], cs[8], sn[8];
#pragma unroll
                for (int i = 0; i < 4; ++i) { f[2 * i] = bf2f(raw[i] & 0xffffu); f[2 * i + 1] = bf2f(raw[i] >> 16); cs[i] = c0[q][i]; cs[4 + i] = c1[q][i]; sn[i] = hh ? s0[q][i] : -s0[q][i]; sn[4 + i] = hh ? s1[q][i] : -s1[q][i]; }
                float ss = 0.f;
#pragma unroll
                for (int i = 0; i < 8; ++i) ss += f[i] * f[i];
                ss += __shfl_xor(ss, 1); ss += __shfl_xor(ss, 2); ss += __shfl_xor(ss, 4); ss += __shfl_xor(ss, 8);
                const float r = 1.0f / sqrtf(ss * (1.0f / 128.0f) + RMS_EPS);
                float o[8];
#pragma unroll
                for (int i = 0; i < 8; ++i) { const float y = f[i] * r * kg[i]; const float pr = __shfl_xor(y, 4); o[i] = y * cs[i] + pr * sn[i]; }
                v4u w; w.x = pk2(o[0], o[1]); w.y = pk2(o[2], o[3]); w.z = pk2(o[4], o[5]); w.w = pk2(o[6], o[7]);
                *(v4u*)(Kb + (((size_t)b * NKV + sub) * SKV + kpos) * HD + d0) = w; }
        }
        P3_LOAD(gw < NCTX ? gw : 0);
        for (int row = gw; row < NCTX; row += NGW) {
            const bool lat = row >= NCTX; const int lr = row - NCTX; const int b = lat ? (lr >> 13) : (row >> 8); const int t = lat ? (lr & 8191) : 0;
            const int kpos = lat ? (CTXL + t) : (row & 255);
            v4u cur[6];
#pragma unroll
            for (int it = 0; it < 6; ++it) cur[it] = rw[it];
            if (row + NGW < NCTX) P3_LOAD(row + NGW);
            float cs[8], sn[8];
#pragma unroll
            for (int i = 0; i < 8; ++i) { cs[i] = 1.f; sn[i] = 0.f; }
            if (lat) { const int pos = ax ? (t & 63) : (t >> 6); const float* cp_ = ROPE + pos * 32 + p0;
                const f32x4 c0 = *(const f32x4*)cp_, c1 = *(const f32x4*)(cp_ + 4), s0 = *(const f32x4*)(cp_ + 4096), s1 = *(const f32x4*)(cp_ + 4100);
#pragma unroll
                for (int i = 0; i < 4; ++i) { cs[i] = c0[i]; cs[4 + i] = c1[i]; sn[i] = hh ? s0[i] : -s0[i]; sn[4 + i] = hh ? s1[i] : -s1[i]; } }
#pragma unroll
            for (int it = 0; it < 6; ++it) { const int h = it * 4 + sub;
                if (lat && it != 4) continue;
                if (it == 5 && !split3) continue;
                float f[8]; v4u raw;
                if (!lat && split3) {
                    f32x4 q0[8]; const float* pp_ = PQ + (size_t)row * QKVD + h * 128 + d0;
#pragma unroll
                    for (int ks = 0; ks < 8; ++ks) q0[ks] = *(const f32x4*)(pp_ + (size_t)ks * 512 * QKVD);
                    f32x4 a0 = q0[0];
#pragma unroll
                    for (int ks = 1; ks < 8; ++ks) a0 += q0[ks];
#pragma unroll
                    for (int ks = 0; ks < 8; ++ks) q0[ks] = *(const f32x4*)(pp_ + (size_t)ks * 512 * QKVD + 4);
                    f32x4 a1 = q0[0];
#pragma unroll
                    for (int ks = 1; ks < 8; ++ks) a1 += q0[ks];
#pragma unroll
                    for (int i = 0; i < 4; ++i) { f[i] = a0[i]; f[4 + i] = a1[i]; }
                    raw.x = pk2(f[0], f[1]); raw.y = pk2(f[2], f[3]); raw.z = pk2(f[4], f[5]); raw.w = pk2(f[6], f[7]);
#pragma unroll
                    for (int i = 0; i < 4; ++i) { f[2 * i] = bf2f(raw[i] & 0xffffu); f[2 * i + 1] = bf2f(raw[i] >> 16); }
                } else { raw = cur[it];
#pragma unroll
                    for (int i = 0; i < 4; ++i) { f[2 * i] = bf2f(raw[i] & 0xffffu); f[2 * i + 1] = bf2f(raw[i] >> 16); } }
                if (it == 5) { *(v4u*)(Vb + (((size_t)b * NKV + (h - 20)) * SKV + kpos) * HD + d0) = raw; continue; }
                float ss = 0.f;
#pragma unroll
                for (int i = 0; i < 8; ++i) ss += f[i] * f[i];
                ss += __shfl_xor(ss, 1); ss += __shfl_xor(ss, 2); ss += __shfl_xor(ss, 4); ss += __shfl_xor(ss, 8);
                const float r = 1.0f / sqrtf(ss * (1.0f / 128.0f) + RMS_EPS);
                float o[8];
#pragma unroll
                for (int i = 0; i < 8; ++i) { const float y = f[i] * r * (it < 4 ? qg[i] : kg[i]); const float pr = __shfl_xor(y, 4); o[i] = y * cs[i] + pr * sn[i]; }
                v4u w; w.x = pk2(o[0], o[1]); w.y = pk2(o[2], o[3]); w.z = pk2(o[4], o[5]); w.w = pk2(o[6], o[7]);
                bf16_t* d = (it < 4) ? Qb + (size_t)row * DM + h * 128 + d0 : Kb + (((size_t)b * NKV + (h - 16)) * SKV + kpos) * HD + d0;
                *(v4u*)d = w; }
        }
#undef P3_LOAD
    }
    SEAM(3);

    if (IN(4)) _Pragma("unroll 1") for (int rep_ = 0; rep_ < NREP(4); ++rep_) {
        CParams* kp = kparams();
        const bf16_t* Qb = WSP(bf16_t, WS_Q); const bf16_t* Kb = WSP(bf16_t, WS_K); const bf16_t* Vb = WSP(bf16_t, WS_V); bf16_t* Ob = WSP(bf16_t, WS_O);
        const bf16_t* QKVR = WSP(bf16_t, WS_QKVR); const float* ROPE = WSP(float, WS_ROPE); const float* qgn = kp->q_gain;
        const int G = ogrid(), bx = obid(); const bool fast = (G % 8) == 0;
        const int NR = fast ? (G >> 3) : G, rank = fast ? (bx >> 3) : bx, tot = fast ? 132 : 1056;
        const bool split = fast && NR == 32; const int NA = split ? 26 : NR;
        if (rank < NA) for (int i = 0;; ++i) {
            int w = rank + NA * i;
            if (split && i == 5) w = rank >= 24 ? rank + 106 : tot;
            if (w >= tot) break;
            const int combo = fast ? (bx & 7) : (w / 132), ww = fast ? w : (w % 132), b = combo >> 2, kvh = combo & 3;
            const bool isl = ww < 128; const int rbk = ww >> 2; const int h = kvh * 4 + (isl ? (ww & 3) : (ww - 128));
            const size_t row0 = isl ? ((size_t)NCTX + (size_t)b * SEQ + (size_t)rbk * 256) : ((size_t)b * CTXL);
            if (isl) att::attn_dma_body(QKVR + row0 * QKVD + h * HD, QKVD, rbk * 256, ROPE, qgn, Kb + (size_t)combo * SKV * HD, Vb + (size_t)combo * SKV * HD, Ob + row0 * DM + h * HD, SKV, (char*)lds);
            else att::attn_dma_body(Qb + row0 * DM + h * HD, DM, -1, ROPE, qgn, Kb + (size_t)combo * SKV * HD, Vb + (size_t)combo * SKV * HD, Ob + row0 * DM + h * HD, CTXL, (char*)lds);
            if (otid() == 0) { asm volatile("s_waitcnt vmcnt(0)" ::: "memory");
                (void)xb_add(WSP(unsigned, WS_CTL) + CW_DONE + 32 * (isl ? (b * 32 + rbk) : (64 + b)), 1u); }
        }
        {
            const int tid = otid(), lane = tid & 63, wave = __builtin_amdgcn_readfirstlane(tid >> 6);
            unsigned* mq = WSP(unsigned, WS_CTL) + CW_MQ; bool prepared = false;
            for (;;) {
                if (tid == 0) MISC[34] = xb_add(mq, 1u);
                __syncthreads();
                const unsigned t = MISC[34];
                __syncthreads();
                if (t >= 384u) break;
                if (!prepared) { mod_prepare(kp->c, kp->c_ctx, (LAS float*)L, tid); prepared = true; }
                mod_item(384 + (int)t, kp->w_mod, kp->b_mod, WSP(float, WS_MOD), (const LAS float*)L, (LAS float*)(L + 32768), tid, lane, wave);
            }
        }
        {
            const int tid = otid(), lane = tid & 63, wave = __builtin_amdgcn_readfirstlane(tid >> 6);
            LAS float* scr = (LAS float*)(L + wave * 16384);
            unsigned* qc = WSP(unsigned, WS_CTL) + CW_Q;
            constexpr int I_G = (DM / 64) * (DE / 32), I_D = (DE / 64) * (DM / 32), PER = 2 * I_G + I_D; constexpr unsigned NTICK = 64u * PER / 2u;
            auto decode = [&](int it) { TItem d; const int le = it / PER; int r = it - le * PER;
                if (r < I_G) { d.W = kp->w_gate + (size_t)le * DM * DE; d.WT = WSP(bf16_t, WS_WGU) + (size_t)le * 2048 * DM; d.K = DM; d.N = DE; d.kind = 1; }
                else if ((r -= I_G) < I_G) { d.W = kp->w_up + (size_t)le * DM * DE; d.WT = WSP(bf16_t, WS_WGU) + (size_t)le * 2048 * DM; d.K = DM; d.N = DE; d.kind = 2; }
                else { r -= I_G; d.W = kp->w_down + (size_t)le * DE * DM; d.WT = WSP(bf16_t, WS_WD) + (size_t)le * DM * DE; d.K = DE; d.N = DM; d.kind = 0; }
                const int nblk = d.N / 32; d.k0 = 64 * (r / nblk); d.n0 = 32 * (r % nblk); return d; };
            auto grab = [&]() { unsigned t = 0; if (lane == 0) t = __hip_atomic_fetch_add(qc, 1u, __ATOMIC_RELAXED, __HIP_MEMORY_SCOPE_AGENT); return (unsigned)__builtin_amdgcn_readfirstlane((int)t); };
            unsigned tk = grab();
            while (tk < NTICK) {
                const unsigned nx = grab();
                const TItem d0 = decode((int)(2u * tk)); TItem d1 = d0; d1.n0 += 32;
                f32x4 ra[8], rb[8]; t_load(d0, ra, lane); t_load(d1, rb, lane);
                t_store(d0, ra, scr, lane); t_store(d1, rb, scr, lane);
                tk = nx;
            }
        }
        __syncthreads();
        {
            unsigned* wq = WSP(unsigned, WS_CTL) + CW_WQ; unsigned* done = WSP(unsigned, WS_CTL) + CW_DONE; unsigned* yd = WSP(unsigned, WS_CTL) + CW_YD; unsigned* bw = WSP(unsigned, WS_CTL) + CW_BAR;
            const char* Oc = WSP(const char, WS_O); const char* Wc = WSP(const char, WS_WO);
            pg8::Gemm g{DM, DM, DM}; pg8::EpiBf16W E{WSP(bf16_t, WS_Y), DM};
            int tail = obid(); bool queue = true;
            for (;;) {
                if (otid() == 0) { int pm = -1, pn = 0, fl = 0;
                    if (queue) { const unsigned t = xb_add(wq, 1u);
                        if (t < 416u) { const int rbk = (int)t >> 4, b = ((int)t >> 3) & 1; pn = (int)t & 7; pm = 2 + b * 32 + rbk; fl = b * 32 + rbk; }
                        else if (t < 432u) { const int c = (int)t - 416; pm = c >> 3; pn = c & 7; fl = 64 + pm; } }
                    else if (tail < 96) { const int rbk = 26 + (tail >> 4), b = (tail >> 3) & 1; pn = tail & 7; pm = 2 + b * 32 + rbk; fl = b * 32 + rbk; }
                    if (pm >= 0) { XB_SPIN(xb_ld(&done[32 * fl]) < 16u, bw);
                        __builtin_amdgcn_fence(__ATOMIC_ACQUIRE, "agent"); asm volatile("s_waitcnt vmcnt(0)" ::: "memory"); }
                    MISC[32] = (unsigned)pm; MISC[33] = (unsigned)pn; }
                __syncthreads();
                const int pm = (int)MISC[32], pn = (int)MISC[33];
                __syncthreads();
                if (pm < 0) { if (!queue) break; queue = false; continue; }
                pg8::SchedOne S; S.u.A = Oc + (size_t)((unsigned)pm * (256u * DM * 2u)); S.u.B = Wc + (size_t)((unsigned)pn * (256u * DM * 2u)); S.u.pm = pm; S.u.pn = pn; S.u.aux = 0; S.u.kt = DM / 64; S.u.rb = 0; S.u.cn = 0; S.u.ui = 0;
                pg8::gemm_phase<pg8::EpiBf16W, pg8::SchedOne, true, false>(L, g, S, E);
                if (otid() == 0) (void)xb_add(&yd[32 * pm], 1u);
                if (!queue) tail += ogrid();
            }
        }
    }


    layer_half<0>(lo, hi, bar, L, tcnt, tbase, texp);
    layer_half<1>(lo, hi, bar, L, tcnt, tbase, texp);
#undef IN
#undef SEAM
#undef TIDS
}

extern "C" void kernel_launch(void* const* d_in, const int* in_sizes, int n_in, void* d_out, int out_size, void* d_ws, size_t ws_size, hipStream_t stream) {
    static int grid = 0;
    if (grid == 0) {
        if (n_in != 19 || in_sizes[0] != NLAT * DM || out_size != NLAT * DM || ws_size < WS_END) {
            fprintf(stderr, "kernel_launch: shape mismatch: n_in %d in0 %d out %d ws %zu (need %zu); nothing launched\n", n_in, n_in > 0 ? in_sizes[0] : -1, out_size, ws_size, (size_t)WS_END); grid = -1; return; }
        int dev = 0, cus = 0, per_cu = 0;
        if (hipGetDevice(&dev) != hipSuccess || hipDeviceGetAttribute(&cus, hipDeviceAttributeMultiprocessorCount, dev) != hipSuccess) { fprintf(stderr, "kernel_launch: device query failed\n"); grid = -1; return; }
        if (hipFuncSetAttribute((const void*)mk_fwd, hipFuncAttributeMaxDynamicSharedMemorySize, LDS_BYTES) != hipSuccess) { fprintf(stderr, "kernel_launch: hipFuncSetAttribute failed\n"); grid = -1; return; }
        if (hipOccupancyMaxActiveBlocksPerMultiprocessor(&per_cu, (const void*)mk_fwd, 512, LDS_BYTES) != hipSuccess || per_cu < 1)
            fprintf(stderr, "kernel_launch: note: occupancy query reports %d workgroups per CU\n", per_cu);
        (void)hipGetLastError();
        if (cus * (pg8::RT_UNITS / 2) < MAXT * 8) { fprintf(stderr, "kernel_launch: %d CUs: the MoE phases' per-workgroup LDS row tables are sized for >= %d workgroups; nothing launched\n", cus, (MAXT * 8 + pg8::RT_UNITS / 2 - 1) / (pg8::RT_UNITS / 2)); grid = -1; return; }
        grid = cus;
    }
    if (grid < 0) return;
    if (hipMemsetAsync((char*)d_ws + WS_CTL, 0, CTL_ZERO_BYTES, stream) != hipSuccess) { fprintf(stderr, "kernel_launch: memset failed\n"); return; }
    Params p{};
    p.x = (const float*)d_in[0]; p.c = (const float*)d_in[1]; p.ctx = (const float*)d_in[2]; p.c_ctx = (const float*)d_in[3]; p.w_mod = (const float*)d_in[4]; p.b_mod = (const float*)d_in[5];
    p.ln_g = (const float*)d_in[6]; p.ln_b = (const float*)d_in[7]; p.w_qkv = (const float*)d_in[8]; p.q_gain = (const float*)d_in[9]; p.k_gain = (const float*)d_in[10]; p.w_o = (const float*)d_in[11];
    p.w_pool = (const float*)d_in[12]; p.pool_scale = (const float*)d_in[13]; p.w_router = (const float*)d_in[14]; p.router_bias = (const float*)d_in[15];
    p.w_gate = (const float*)d_in[16]; p.w_up = (const float*)d_in[17]; p.w_down = (const float*)d_in[18];
    p.out = (float*)d_out; p.ws = (unsigned char*)d_ws;
#if MK_PER_PHASE
    for (int k = 0; k < NPHASE; ++k) { p.ph_lo = k; p.ph_hi = k + 1;
        hipLaunchKernelGGL(mk_fwd, dim3(grid), dim3(512), LDS_BYTES, stream, p);
        const hipError_t le = hipPeekAtLastError(); if (le != hipSuccess) { fprintf(stderr, "kernel_launch: launch %d failed: %s\n", k, hipGetErrorName(le)); break; } }
#else
    p.ph_lo = 0; p.ph_hi = NPHASE;
    hipLaunchKernelGGL(mk_fwd, dim3(grid), dim3(512), LDS_BYTES, stream, p);
    const hipError_t le = hipPeekAtLastError(); if (le != hipSuccess) fprintf(stderr, "kernel_launch: launch failed: %s\n", hipGetErrorName(le));
#endif
}
```

```cpp
#include <hip/hip_runtime.h>
#include <cstdio>
#include <cstdint>

#ifndef REP_MASK
#define REP_MASK 0
#endif
#ifndef MK_PER_PHASE
#define MK_PER_PHASE 0
#endif

constexpr int DM = 2048, NB = 2, SEQ = 8192, CTXL = 256;
constexpr int NCTX = NB * CTXL, NLAT = NB * SEQ, MT = NCTX + NLAT;
constexpr int NH = 16, NKV = 4, HD = 128, KVD = NKV * HD, QKVD = DM + 2 * KVD;
constexpr int SKV = CTXL + SEQ;
constexpr int NE = 32, DE = 1024;
constexpr int MAXT = 164, NSLOT = MAXT * 256;
constexpr float ALPHA = 1.41421356237309515f;
constexpr float LN_EPS = 1e-6f, RMS_EPS = 1e-6f;
constexpr int NPHASE = 18;

constexpr size_t MiB = 1u << 20;
constexpr size_t WS_CTL = 0, CTL_ZERO_BYTES = 1 * MiB;
constexpr size_t WS_MOD = 1 * MiB;
constexpr size_t WS_ROPE = WS_MOD + 512 * 1024;
constexpr size_t WS_WR = WS_MOD + 768 * 1024;
constexpr size_t WS_WQKV = 2 * MiB;
constexpr size_t WS_WO = 14 * MiB;
constexpr size_t WS_WPOOL = 22 * MiB;
constexpr size_t WS_WGU = 24 * MiB;
constexpr size_t WS_WD = 536 * MiB;
constexpr size_t WS_Y = 792 * MiB;
constexpr size_t WS_X1 = 924 * MiB;
constexpr size_t WS_X2 = 1056 * MiB;
constexpr size_t WS_H = 1188 * MiB;
constexpr size_t WS_LIST = 1254 * MiB;
constexpr size_t WS_SLOT = 1259 * MiB;
constexpr size_t WS_SH = 1260 * MiB;
constexpr size_t WS_U = WS_SH;
constexpr size_t WS_QKVR = WS_SH + 66 * MiB;
constexpr size_t WS_Q = WS_SH + 165 * MiB;
constexpr size_t WS_K = WS_SH + 231 * MiB;
constexpr size_t WS_V = WS_SH + 248 * MiB;
constexpr size_t WS_O = WS_SH + 265 * MiB;
constexpr size_t WS_HS = WS_SH;
constexpr size_t WS_ACT = WS_SH + 164 * MiB;
constexpr size_t WS_FB = WS_SH + 246 * MiB;
constexpr size_t WS_DP = WS_SH;
constexpr size_t WS_PQ = WS_SH + 510 * MiB;
constexpr size_t WS_PO = WS_PQ + 48 * MiB;
constexpr size_t WS_END = WS_PO + 32 * MiB;
static_assert((size_t)MT * DM * 4 <= 132 * MiB && (size_t)NSLOT * 2048 * 2 <= 164 * MiB && (size_t)2 * MT * DM * 4 <= 264 * MiB, "ws map");
static_assert((size_t)32 * MT * 8 <= 5 * MiB && (size_t)NSLOT * 8 <= 1 * MiB, "ws map 2");
constexpr int CW_CNT = 64;
constexpr int CW_Q = 3072;
constexpr int CW_MQ = 3136;
constexpr int CW_WQ = 3104;
constexpr int CW_DONE = 8192;
constexpr int CW_GUD = 16384;
constexpr int CW_YD = 40960;
constexpr int CW_P6Q = 3168;
constexpr int CW_BAR = 4096;

constexpr int RING_BYTES = 131072;
constexpr int MISC_OFF = RING_BYTES;
constexpr int TAB_OFF = MISC_OFF + 256;
constexpr int LDS_BYTES = 147456;

#define GAS __attribute__((address_space(1)))
#define LAS __attribute__((address_space(3)))
typedef unsigned short bf16_t;
typedef unsigned v4u __attribute__((ext_vector_type(4)));
typedef unsigned v2u __attribute__((ext_vector_type(2)));
typedef float f32x4 __attribute__((ext_vector_type(4)));
typedef float f32x2 __attribute__((ext_vector_type(2)));
typedef short bf16x8 __attribute__((ext_vector_type(8)));
typedef short s16x4 __attribute__((ext_vector_type(4)));
typedef float f32x16 __attribute__((ext_vector_type(16)));
typedef GAS unsigned gu32;
#define RLX_AGENT __ATOMIC_RELAXED, __HIP_MEMORY_SCOPE_AGENT
#define LDS_WAIT() asm volatile("s_waitcnt lgkmcnt(0)" ::: "memory")
#define VM_WAIT() asm volatile("s_waitcnt vmcnt(0)" ::: "memory")
__device__ __forceinline__ unsigned f2bf(float f) { unsigned u = __builtin_bit_cast(unsigned, f); return (u + 0x7fffu + ((u >> 16) & 1u)) >> 16; }
__device__ __forceinline__ unsigned pk2(float lo, float hi) { unsigned r; asm("v_cvt_pk_bf16_f32 %0, %1, %2" : "=v"(r) : "v"(lo), "v"(hi)); return r; }
__device__ __forceinline__ float bf2f(unsigned b) { return __builtin_bit_cast(float, b << 16); }
__device__ __forceinline__ unsigned cvt_pk_bf16(float lo, float hi) { unsigned r; asm volatile("v_cvt_pk_bf16_f32 %0, %1, %2" : "=v"(r) : "v"(lo), "v"(hi)); return r; }
__device__ __forceinline__ f32x4 bf4(v2u q) { return (f32x4){bf2f(q.x & 0xffffu), bf2f(q.x >> 16), bf2f(q.y & 0xffffu), bf2f(q.y >> 16)}; }
template <int CTRL> __device__ __forceinline__ float dppf(float v) { return __builtin_bit_cast(float, __builtin_amdgcn_update_dpp(0, __builtin_bit_cast(int, v), CTRL, 0xF, 0xF, true)); }
template <int CTRL> __device__ __forceinline__ int dppi(int v) { return __builtin_amdgcn_update_dpp(0, v, CTRL, 0xF, 0xF, true); }
__device__ __forceinline__ float wave_sum(float v) {
    v += dppf<0xB1>(v); v += dppf<0x4E>(v); v += dppf<0x141>(v); v += dppf<0x140>(v);
    { const auto r = __builtin_amdgcn_permlane16_swap(__float_as_uint(v), __float_as_uint(v), false, false); v = __uint_as_float(r[0]) + __uint_as_float(r[1]); }
    { const auto r = __builtin_amdgcn_permlane32_swap(__float_as_uint(v), __float_as_uint(v), false, false); v = __uint_as_float(r[0]) + __uint_as_float(r[1]); }
    return v;
}
__device__ __forceinline__ float silu_f(float x) { return x / (1.0f + __expf(-x)); }
__device__ __forceinline__ int row_cond(int row) { return row < NCTX ? 2 : ((row - NCTX) >> 13); }
__device__ __forceinline__ int otid() { int t = threadIdx.x; asm volatile("" : "+v"(t)); return t; }
__device__ __forceinline__ int obid() { int t = blockIdx.x; asm volatile("" : "+s"(t)); return t; }
__device__ __forceinline__ int ogrid() { int t = gridDim.x; asm volatile("" : "+s"(t)); return t; }

#define XB_TMO      128
#define XB_XCNT(j)  (256  + 64 * (j))
#define XB_XSUB(j)  (1280 + 64 * (j))
#define XB_XGEN(j)  (2304 + 64 * (j))
#define XB_TOP      3328
#define XB_TOPGEN   3392
#define XCD_BAR_WORDS 3456
#define XB_SPIN_CAP (1u << 20)
__device__ __forceinline__ unsigned xb_ld(unsigned* p)              { return __hip_atomic_load(p, __ATOMIC_RELAXED, __HIP_MEMORY_SCOPE_AGENT); }
__device__ __forceinline__ unsigned xb_add(unsigned* p, unsigned v) { return __hip_atomic_fetch_add(p, v, __ATOMIC_RELAXED, __HIP_MEMORY_SCOPE_AGENT); }
__device__ __forceinline__ unsigned xb_xcc_id() { return (unsigned)__builtin_amdgcn_s_getreg((3 << 11) | 20) & 0xFu; }
#define XB_SPIN(cond, bar) do { unsigned _sp = 0; while (cond) { __builtin_amdgcn_s_sleep(1); \
    if ((++_sp & 255u) == 0u) { if (xb_ld(&(bar)[XB_TMO])) break; if (_sp > XB_SPIN_CAP) { atomicAdd(&(bar)[XB_TMO], 1u); break; } } } } while (0)
struct XcdBarrier { unsigned* bar; unsigned x; volatile LAS unsigned* st; };
__device__ __forceinline__ XcdBarrier xcd_barrier_post(unsigned* bar, volatile LAS unsigned* st) {
    XcdBarrier b; b.bar = bar; b.x = xb_xcc_id(); b.st = st;
    if (threadIdx.x == 0) (void)xb_add(&bar[XB_XCNT(b.x)], 1u);
    return b;
}
__device__ __forceinline__ void xcd_barrier_complete(unsigned* bar, unsigned x, unsigned& nloc, unsigned& nx) {
    const unsigned G = gridDim.x * gridDim.y * gridDim.z;
    unsigned sum, cnt, mine, sp = 0u;
    for (;;) {
        sum = 0u; cnt = 0u; mine = 0u;
#pragma unroll 1
        for (unsigned j = 0; j < 16; ++j) { const unsigned c = xb_ld(&bar[XB_XCNT(j)]); sum += c; cnt += (c > 0u) ? 1u : 0u; }
        if (sum == G) break;
        __builtin_amdgcn_s_sleep(1);
        if ((++sp & 255u) == 0u) { if (xb_ld(&bar[XB_TMO])) break; if (sp > XB_SPIN_CAP) { atomicAdd(&bar[XB_TMO], 1u); break; } }
    }
    mine = xb_ld(&bar[XB_XCNT(x)]);
    nloc = mine > 0u ? mine : 1u; nx = cnt > 0u ? cnt : 1u;
}
__device__ __forceinline__ void xcd_barrier(const XcdBarrier& b) {
    asm volatile("s_waitcnt vmcnt(0)" ::: "memory");
    __syncthreads();
    if (threadIdx.x == 0) {
        unsigned* bar = b.bar;
        __builtin_amdgcn_s_waitcnt(0);
        unsigned nloc = b.st[0], nx = b.st[1];
        if (nloc == 0u) { xcd_barrier_complete(bar, b.x, nloc, nx); b.st[0] = nloc; b.st[1] = nx; }
        const unsigned old = xb_add(&bar[XB_XSUB(b.x)], 1u);
        const unsigned gen = old / nloc;
        if (old + 1u == (gen + 1u) * nloc) {
            __builtin_amdgcn_fence(__ATOMIC_RELEASE, "agent");
            asm volatile("s_waitcnt vmcnt(0)" ::: "memory");
            const unsigned og = xb_add(&bar[XB_TOP], 1u);
            const unsigned tg = og / nx;
            if (og + 1u == (tg + 1u) * nx) xb_add(&bar[XB_TOPGEN], 1u);
            else XB_SPIN(xb_ld(&bar[XB_TOPGEN]) == tg, bar);
            __builtin_amdgcn_fence(__ATOMIC_ACQUIRE, "agent");
            xb_add(&bar[XB_XGEN(b.x)], 1u);
            asm volatile("s_waitcnt vmcnt(0)" ::: "memory");
        } else {
            XB_SPIN(xb_ld(&bar[XB_XGEN(b.x)]) == gen, bar);
            __builtin_amdgcn_fence(__ATOMIC_ACQUIRE, "agent");
            asm volatile("s_waitcnt vmcnt(0)" ::: "memory");
        }
    }
    __syncthreads();
}

namespace pg8 {
#define PG8_LAS __attribute__((address_space(3)))
constexpr int BM = 256, BK = 64, HALF = 128, HTB = HALF * BK * 2, STAGE_BYTES = 8 * HTB, NXCD = 8, WGM = 8;
__host__ __device__ __forceinline__ int lds_byte(int r, int c) { const int st = (r >> 4) * 2 + (c >> 5), rr = r & 15, cc = c & 31, ob = rr * 64 + cc * 2; return st * 1024 + (ob ^ (((ob >> 9) & 1) << 5)); }
__host__ __device__ __forceinline__ void stage_rc(int b, int& R, int& C) { const int st = b / 1024, sb = b % 1024, swz = sb ^ (((sb >> 9) & 1) << 5); R = (st >> 1) * 16 + swz / 64; C = (st & 1) * 32 + (swz % 64) / 2; }
__host__ __device__ __forceinline__ int perm32(int rho) { const int n = rho >> 4, i = rho & 15; return 8 * (i >> 2) + 4 * n + (i & 3); }

struct Unit { const char* A; const char* B; int pm, pn, aux, kt, rb, cn, ui; };
struct Gemm { int lda, ldb, K; };

struct TileOrder {
    int nM, nN, nwg, G, c, rot = 0;
    __device__ __forceinline__ void init(int nM_, int nN_, int G_, int c_) { nM = nM_; nN = nN_; nwg = nM * nN; G = G_; c = c_; }
    __device__ __forceinline__ bool get(int i, int& pm, int& pn) const { return map((long)i * G + c, pm, pn); }
    __device__ __forceinline__ bool map(long L, int& pm, int& pn) const {
        if (L >= nwg) return false;
        const int nig = WGM * nN;
        int wgid = (int)L; { const int q = nwg / NXCD, r = nwg % NXCD, xcd = wgid % NXCD; int off = wgid / NXCD; const int cs = (xcd < r ? xcd * (q + 1) : r * (q + 1) + (xcd - r) * q), len = q + (xcd < r ? 1 : 0);
            if (rot) { const int lead = (nig - cs % nig) % nig; if (lead < len) { off += lead; if (off >= len) off -= len; } }
            wgid = cs + off; }
        const int gid = wgid / nig, fm = gid * WGM, gsz = (nM - fm) < WGM ? (nM - fm) : WGM;
        pm = fm + ((wgid % nig) % gsz); pn = (wgid % nig) / gsz; return true;
    }
};

template <class Epi, class Sched, bool ALIGN_EPI, bool GATHER = false>
__device__ __forceinline__ void gemm_phase(PG8_LAS unsigned char* lds, const Gemm g, const Sched& S, const Epi& E) {
    const int tid = otid(), wid = __builtin_amdgcn_readfirstlane(tid >> 6), lane = tid & 63, wr = wid >> 2, wc = wid & 3, fr = lane & 15, fq = lane >> 4;
    unsigned vc[2][2], vn[2][2], voffB[2]; int Rr[2], Cc = 0;
#pragma unroll
    for (int i = 0; i < 2; ++i) { int R, C; stage_rc(tid * 16 + i * 8192, R, C); const int Rb = Epi::PERM ? ((R & ~31) + perm32(R & 31)) : R; Rr[i] = R; Cc = C;
        vc[0][i] = (unsigned)(R * g.lda + C) * 2u; vc[1][i] = vc[0][i] + (unsigned)(HALF * g.lda) * 2u; voffB[i] = (unsigned)(Rb * g.ldb + C) * 2u; }
#define PG8_ROWS(ui_, v) do { _Pragma("unroll") for (int _h = 0; _h < 2; ++_h) _Pragma("unroll") for (int _i = 0; _i < 2; ++_i) \
        v[_h][_i] = (unsigned)S.rowtok((ui_), Rr[_i] + HALF * _h) * (unsigned)(g.lda * 2) + (unsigned)Cc * 2u; } while (0)
    const size_t kstep = (size_t)(BK * 2);
    const size_t hsB = (size_t)HALF * g.ldb * 2;
    const unsigned ldsw = (unsigned)wid * 1024u;
    const int aoff = lds_byte(wr * 64 + fr, fq * 8), boff = lds_byte(wc * 32 + fr, fq * 8);
#define PG8_SA(b, h) (((b) * 2 + (h)) * HTB)
#define PG8_SB(b, h) ((4 + (b) * 2 + (h)) * HTB)
#define PG8_STAGE(bufoff, gbase, voff) do { _Pragma("unroll") for (int _i = 0; _i < 2; ++_i) \
        __builtin_amdgcn_global_load_lds((const unsigned*)((const char*)(gbase) + (voff)[_i]), (PG8_LAS unsigned*)(lds + (bufoff) + ldsw + _i * 8192), 16, 0, 0); } while (0)
#define PG8_LDA(dst, b, h) do { _Pragma("unroll") for (int m = 0; m < 4; ++m) _Pragma("unroll") for (int k = 0; k < 2; ++k) dst[m][k] = *(const PG8_LAS bf16x8*)(lds + PG8_SA(b, h) + aoff + m * 2048 + k * 1024); } while (0)
#define PG8_LDB(dst, b, h) do { _Pragma("unroll") for (int n = 0; n < 2; ++n) _Pragma("unroll") for (int k = 0; k < 2; ++k) dst[n][k] = *(const PG8_LAS bf16x8*)(lds + PG8_SB(b, h) + boff + n * 2048 + k * 1024); } while (0)
#define PG8_MMA(ai, bj, At, Bt) do { __builtin_amdgcn_s_setprio(1); _Pragma("unroll") for (int m = 0; m < 4; ++m) _Pragma("unroll") for (int n = 0; n < 2; ++n) _Pragma("unroll") for (int k = 0; k < 2; ++k) \
        acc[ai][bj][m][n] = __builtin_amdgcn_mfma_f32_16x16x32_bf16(Bt[n][k], At[m][k], acc[ai][bj][m][n], 0, 0, 0); __builtin_amdgcn_s_setprio(0); } while (0)
#define PG8_WAIT_V(n) asm volatile("s_waitcnt vmcnt(" #n ")" ::: "memory")
#define PG8_WAIT_L(n) asm volatile("s_waitcnt lgkmcnt(" #n ")" ::: "memory")
#define PG8_BAR __builtin_amdgcn_s_barrier()
#define PG8_SCHED __builtin_amdgcn_sched_barrier(0)
    Unit cur, nxt; int ui = 0; int pend = -1, pend2 = -1, wst = 0; unsigned pv = 8u; (void)pend; (void)pend2; (void)wst; (void)pv;
    if (!S.next(0, cur)) return;
    if constexpr (Sched::WAITS) S.wait_ready(cur);
    if constexpr (GATHER) PG8_ROWS(0, vc);
    f32x4 acc[2][2][4][2];
#pragma unroll
    for (int a = 0; a < 2; ++a)
#pragma unroll
        for (int b = 0; b < 2; ++b)
#pragma unroll
            for (int m = 0; m < 4; ++m)
#pragma unroll
                for (int n = 0; n < 2; ++n) acc[a][b][m][n] = (f32x4){0.f, 0.f, 0.f, 0.f};
    bf16x8 At[4][2], B0[2][2], B1[2][2];
    const char* cA = cur.A; const char* cB = cur.B;
    PG8_STAGE(PG8_SB(0, 0), cB, voffB); PG8_STAGE(PG8_SB(0, 1), cB + hsB, voffB); PG8_STAGE(PG8_SA(0, 0), cA, vc[0]); PG8_STAGE(PG8_SA(0, 1), cA, vc[1]);
    if (wr == 1) PG8_BAR;
    PG8_WAIT_V(2); PG8_BAR;
    PG8_STAGE(PG8_SB(1, 0), cB + kstep, voffB); PG8_STAGE(PG8_SA(1, 0), cA + kstep, vc[0]); PG8_STAGE(PG8_SB(1, 1), cB + hsB + kstep, voffB);
    PG8_WAIT_V(6); PG8_BAR;
    for (;;) {
        const bool has_next = S.next(ui + 1, nxt);
        if constexpr (Sched::WAITS) wst = has_next ? 1 : 0;
        const char* nA = has_next ? nxt.A : cA; const char* nB = has_next ? nxt.B : cB;
        if constexpr (GATHER) { if (has_next) PG8_ROWS(ui + 1, vn); else {
#pragma unroll
            for (int h = 0; h < 2; ++h) { vn[h][0] = vc[h][0]; vn[h][1] = vc[h][1]; } } }
        const int nt = cur.kt;
        for (int t = 0; t < nt; t += 2) {
            const bool last = (t == nt - 2);
            const char* a1 = cA + (size_t)(t + 1) * kstep;
            const char* a2 = last ? nA : cA + (size_t)(t + 2) * kstep; const char* b2 = last ? nB : cB + (size_t)(t + 2) * kstep;
            const char* a3 = a2 + kstep; const char* b3 = b2 + kstep;
            unsigned o0[2], o1[2];
#pragma unroll
            for (int i = 0; i < 2; ++i) { o0[i] = (GATHER && last) ? vn[0][i] : vc[0][i]; o1[i] = (GATHER && last) ? vn[1][i] : vc[1][i]; }
            PG8_LDB(B0, 0, 0); PG8_LDB(B1, 0, 1); PG8_SCHED; PG8_LDA(At, 0, 0); PG8_STAGE(PG8_SA(1, 1), a1, vc[1]);
            PG8_WAIT_V(8); PG8_WAIT_L(0); PG8_BAR; PG8_MMA(0, 0, At, B0); PG8_MMA(0, 1, At, B1); PG8_BAR; PG8_SCHED;
            PG8_LDA(At, 0, 1); PG8_STAGE(PG8_SB(0, 0), b2, voffB); PG8_STAGE(PG8_SB(0, 1), b2 + hsB, voffB); PG8_STAGE(PG8_SA(0, 0), a2, o0);
            PG8_WAIT_V(8); PG8_WAIT_L(0); PG8_BAR; PG8_MMA(1, 0, At, B0); PG8_MMA(1, 1, At, B1); PG8_BAR; PG8_SCHED;
            PG8_LDB(B0, 1, 0); PG8_LDB(B1, 1, 1); PG8_SCHED; PG8_LDA(At, 1, 0); PG8_STAGE(PG8_SA(0, 1), a2, o1);
            PG8_WAIT_V(8); PG8_WAIT_L(0); PG8_BAR; PG8_MMA(0, 0, At, B0); PG8_MMA(0, 1, At, B1); PG8_BAR; PG8_SCHED;
            PG8_LDA(At, 1, 1); PG8_STAGE(PG8_SB(1, 0), b3, voffB); PG8_STAGE(PG8_SB(1, 1), b3 + hsB, voffB); PG8_STAGE(PG8_SA(1, 0), a3, o0);
            PG8_WAIT_V(8); PG8_WAIT_L(0); PG8_BAR; PG8_MMA(1, 0, At, B0); PG8_MMA(1, 1, At, B1); PG8_BAR; PG8_SCHED;
            if constexpr (Sched::SIGNALS) { if (pend >= 0) { pend2 = pend; pend = -1; } else if (pend2 >= 0) { S.signal(pend2, lane, wid); pend2 = -1; } }
            if constexpr (Sched::WAITS) { if (wst == 1) { pv = S.poll(nxt); wst = 2; } else if (wst == 2) { wst = 0; if (pv < 8u) S.spin(nxt); } }
        }
        if constexpr (ALIGN_EPI) { if (wr == 0) PG8_BAR; }
        E(acc, cur, wr, wc, fr, fq);
        if constexpr (Sched::SIGNALS) pend = cur.pm;
        if (!has_next) break;
#pragma unroll
        for (int a = 0; a < 2; ++a)
#pragma unroll
            for (int b = 0; b < 2; ++b)
#pragma unroll
                for (int m = 0; m < 4; ++m)
#pragma unroll
                    for (int n = 0; n < 2; ++n) acc[a][b][m][n] = (f32x4){0.f, 0.f, 0.f, 0.f};
        cur = nxt; cA = nA; cB = nB; ++ui;
        if constexpr (GATHER) {
#pragma unroll
            for (int h = 0; h < 2; ++h) { vc[h][0] = vn[h][0]; vc[h][1] = vn[h][1]; } }
        if constexpr (ALIGN_EPI) { if (wr == 1) PG8_BAR; }
    }
    PG8_WAIT_V(0);
    if constexpr (!ALIGN_EPI) { if (wr == 0) PG8_BAR; }
    PG8_BAR;
    if constexpr (Sched::SIGNALS) { if (pend >= 0) S.signal(pend, lane, wid); }
#undef PG8_ROWS
#undef PG8_SA
#undef PG8_SB
#undef PG8_STAGE
#undef PG8_LDA
#undef PG8_LDB
#undef PG8_MMA
#undef PG8_WAIT_V
#undef PG8_WAIT_L
#undef PG8_BAR
#undef PG8_SCHED
}

template <unsigned AT, unsigned BT, int KT>
struct SchedDense {
    static constexpr bool SIGNALS = false, WAITS = false;
    TileOrder o; const char* A; const char* B; int pm0;
    __device__ __forceinline__ int rowtok(int, int) const { return 0; }
    __device__ __forceinline__ bool next(int i, Unit& u) const { int pm, pn; if (!o.get(i, pm, pn)) return false;
        u.rb = 0; u.cn = 0; u.pm = pm0 + pm; u.pn = pn; u.aux = 0; u.kt = KT; u.A = A + (size_t)((unsigned)u.pm * AT); u.B = B + (size_t)((unsigned)pn * BT); return true; }
};
template <unsigned AT, unsigned BT, int KT, int NN>
struct SchedSplit {
    static constexpr bool SIGNALS = false, WAITS = false;
    TileOrder o; const char* A; const char* B; int G, c; bool split;
    __device__ __forceinline__ int rowtok(int, int) const { return 0; }
    __device__ __forceinline__ void init(int G_, int c_) { G = G_; c = c_; split = ((64 * NN) % G_ == 0) && (2 * NN * 8 <= G_); if (split) o.init(64, NN, G_, c_); else o.init(66, NN, G_, c_); }
    __device__ __forceinline__ bool next(int i, Unit& u) const { u.rb = 0; u.cn = 0;
        if (!split) { int pm, pn; if (!o.get(i, pm, pn)) return false; u.pm = pm; u.pn = pn; u.aux = 0; u.kt = KT; u.A = A + (size_t)((unsigned)pm * AT); u.B = B + (size_t)((unsigned)pn * BT); return true; }
        const int fr = (64 * NN) / G;
        if (i < fr) { int pm, pn; o.get(i, pm, pn); u.pm = 2 + pm; u.pn = pn; u.aux = 0; u.kt = KT; u.A = A + (size_t)((unsigned)u.pm * AT); u.B = B + (size_t)((unsigned)pn * BT); return true; }
        if (i > fr || c >= 2 * NN * 8) return false;
        const int ks = c & 7, t = c >> 3; u.pm = t / NN; u.pn = t % NN; u.aux = ks + 1; u.kt = KT / 8;
        u.A = A + (size_t)((unsigned)u.pm * AT + (unsigned)ks * (KT / 8) * 128u); u.B = B + (size_t)((unsigned)u.pn * BT + (unsigned)ks * (KT / 8) * 128u); return true; }
};
struct SchedPool {
    static constexpr bool SIGNALS = false, WAITS = false;
    TileOrder o; const char* A; const char* B;
    __device__ __forceinline__ int rowtok(int, int) const { return 0; }
    __device__ __forceinline__ bool next(int i, Unit& u) const { int pm, pn; if (!o.get(i, pm, pn)) return false;
        u.rb = 0; u.cn = 0; u.pm = 2 + pm; u.pn = pn; u.aux = 0; u.kt = 8; const int g = pn >> 1;
        u.A = A + (size_t)((unsigned)u.pm * (256u * DM * 2u) + (unsigned)g * 1024u); u.B = B + (size_t)((unsigned)g * (512u * 512u * 2u) + (unsigned)(pn & 1) * (256u * 512u * 2u)); return true; }
};
struct SchedOne {
    static constexpr bool SIGNALS = false, WAITS = false;
    Unit u;
    __device__ __forceinline__ int rowtok(int, int) const { return 0; }
    __device__ __forceinline__ bool next(int i, Unit& o) const { if (i != 0) return false; o = u; return true; }
};
constexpr int RT_UNITS = 14;
template <unsigned AT, unsigned BT, unsigned BE, int KT, bool GATHER>
struct SchedMoe {
    static constexpr bool SIGNALS = GATHER, WAITS = !GATHER;
    unsigned* ctr;
    __device__ __forceinline__ void signal(int pm, int lane, int wid) const { if (wid == 0 && lane == 0) (void)xb_add(ctr + 32 * pm, 1u); }
    __device__ __forceinline__ void wait_ready(const Unit& u) const { while (xb_ld(ctr + 32 * u.pm) < 8u) __builtin_amdgcn_s_sleep(2); asm volatile("" ::: "memory"); }
    __device__ __forceinline__ unsigned poll(const Unit& u) const { return xb_ld(ctr + 32 * u.pm); }
    __device__ __forceinline__ void spin(const Unit& u) const { while (xb_ld(ctr + 32 * u.pm) < 8u) __builtin_amdgcn_s_sleep(2); }
    __device__ __forceinline__ void acquire_async() const { asm volatile("buffer_inv sc1" ::: "memory"); }
    TileOrder o; const char* A; const char* B; const PG8_LAS int* texp; const PG8_LAS int* tbase; const PG8_LAS int* tcnt; const PG8_LAS int* rt; const int* list;
    int rem = 0, nl = 0;
    __device__ __forceinline__ bool next(int i, Unit& u) const { int pm, pn;
        if (GATHER) { if (!o.get(i, pm, pn)) return false; }
        else { const bool light = o.c >= rem; const long L = (light && i < 2) ? (long)i * nl + (o.c - rem) : 2L * nl + (long)(light ? i - 2 : i) * o.G + o.c; if (!o.map(L, pm, pn)) return false; }
        const int e = __builtin_amdgcn_readfirstlane(texp[pm]);
        u.pm = pm; u.pn = pn; u.aux = e; u.kt = KT; u.ui = i; u.rb = (pm - __builtin_amdgcn_readfirstlane(tbase[e])) * 256; u.cn = __builtin_amdgcn_readfirstlane(tcnt[e]);
        u.A = GATHER ? A : A + (size_t)((unsigned)pm * AT); u.B = B + (size_t)((unsigned)e * BE + (unsigned)pn * BT); return true; }
    __device__ __forceinline__ int tok_of(const Unit& u, int row) const { const int pos = u.rb + row; return pos < u.cn ? (list[(size_t)u.aux * MT + pos] >> 1) : 0; }
    __device__ __forceinline__ int rowtok(int ui, int row) const { if (ui < RT_UNITS) return rt[ui * 256 + row]; Unit u; next(ui, u); return tok_of(u, row); }
    __device__ __forceinline__ void fill_dst(PG8_LAS int* rtw, const float* listg, int tid) const {
        int dv[RT_UNITS / 2]; float gv[RT_UNITS / 2]; bool ok[RT_UNITS / 2];
#pragma unroll
        for (int i = 0; i < RT_UNITS / 2; ++i) { Unit u; ok[i] = next(i, u); dv[i] = -1; gv[i] = 0.f;
            if (ok[i] && tid < 256) { const int pos = u.rb + tid; if (pos < u.cn) { const size_t li = (size_t)u.aux * MT + pos; dv[i] = list[li]; gv[i] = listg[li]; } } }
#pragma unroll
        for (int i = 0; i < RT_UNITS / 2; ++i) if (ok[i] && tid < 256) { rtw[i * 512 + tid] = dv[i]; rtw[i * 512 + 256 + tid] = (int)__float_as_uint(gv[i]); }
        __syncthreads(); }
    __device__ __forceinline__ void fill_rows(PG8_LAS int* rtw, int tid) const {
#pragma unroll
        for (int h = 0; h < 2; ++h) { int tk[RT_UNITS / 2]; bool ok[RT_UNITS / 2];
#pragma unroll
            for (int q = 0; q < RT_UNITS / 2; ++q) { Unit u; ok[q] = next(h * (RT_UNITS / 2) + q, u); tk[q] = 0; if (ok[q] && tid < 256) tk[q] = tok_of(u, tid); }
#pragma unroll
            for (int q = 0; q < RT_UNITS / 2; ++q) if (ok[q] && tid < 256) rtw[(h * (RT_UNITS / 2) + q) * 256 + tid] = tk[q]; }
        __syncthreads(); }
};

struct EpiBf16 {
    static constexpr bool PERM = true;
    bf16_t* O; int ldc; float* P;
    __device__ __forceinline__ void operator()(const f32x4 (&acc)[2][2][4][2], const Unit& u, int wr, int wc, int fr, int fq) const {
        const int row0 = u.pm * BM + wr * 64 + fr, col0 = u.pn * BM + wc * 32 + 8 * fq;
        if (u.aux == 0) {
#pragma unroll
            for (int ai = 0; ai < 2; ++ai)
#pragma unroll
                for (int m = 0; m < 4; ++m) { bf16_t* rowp = O + (size_t)(row0 + ai * HALF + m * 16) * ldc + col0;
#pragma unroll
                    for (int bj = 0; bj < 2; ++bj) { const f32x4 v0 = acc[ai][bj][m][0], v1 = acc[ai][bj][m][1];
                        v4u w; w.x = cvt_pk_bf16(v0[0], v0[1]); w.y = cvt_pk_bf16(v0[2], v0[3]); w.z = cvt_pk_bf16(v1[0], v1[1]); w.w = cvt_pk_bf16(v1[2], v1[3]);
                        *(v4u*)(rowp + bj * HALF) = w; } }
        } else {
            float* pb = P + (size_t)(u.aux - 1) * 512 * ldc;
#pragma unroll
            for (int ai = 0; ai < 2; ++ai)
#pragma unroll
                for (int m = 0; m < 4; ++m) { float* rowp = pb + (size_t)(row0 + ai * HALF + m * 16) * ldc + col0;
#pragma unroll
                    for (int bj = 0; bj < 2; ++bj) { *(f32x4*)(rowp + bj * HALF) = acc[ai][bj][m][0]; *(f32x4*)(rowp + bj * HALF + 4) = acc[ai][bj][m][1]; } }
        }
    }
};
struct EpiBf16W {
    static constexpr bool PERM = true;
    bf16_t* O; int ldc;
    __device__ __forceinline__ void operator()(const f32x4 (&acc)[2][2][4][2], const Unit& u, int wr, int wc, int fr, int fq) const {
        const int row0 = u.pm * BM + wr * 64 + fr, col0 = u.pn * BM + wc * 32 + 8 * fq;
#pragma unroll
        for (int ai = 0; ai < 2; ++ai)
#pragma unroll
            for (int m = 0; m < 4; ++m) { bf16_t* rowp = O + (size_t)(row0 + ai * HALF + m * 16) * ldc + col0;
#pragma unroll
                for (int bj = 0; bj < 2; ++bj) { const f32x4 v0 = acc[ai][bj][m][0], v1 = acc[ai][bj][m][1];
                    v4u w; w.x = cvt_pk_bf16(v0[0], v0[1]); w.y = cvt_pk_bf16(v0[2], v0[3]); w.z = cvt_pk_bf16(v1[0], v1[1]); w.w = cvt_pk_bf16(v1[2], v1[3]);
                    const bf16_t* gp = rowp + bj * HALF;
                    asm volatile("global_store_dwordx4 %0, %1, off sc1\n\ts_nop 1" :: "v"(gp), "v"(w) : "memory"); } }
    }
};
struct EpiQkv {
    static constexpr bool PERM = true;
    bf16_t* O; int ldc; float* P; bf16_t* V;
    __device__ __forceinline__ void operator()(const f32x4 (&acc)[2][2][4][2], const Unit& u, int wr, int wc, int fr, int fq) const {
        const int row0 = u.pm * BM + wr * 64 + fr, col0 = u.pn * BM + wc * 32 + 8 * fq;
        if (u.aux == 0) {
            const bool isV = u.pn >= (DM + KVD) / BM;
#pragma unroll
            for (int ai = 0; ai < 2; ++ai)
#pragma unroll
                for (int m = 0; m < 4; ++m) { const int row = row0 + ai * HALF + m * 16; bf16_t* rowp = O + (size_t)row * ldc + col0; size_t vstep = HALF;
                    if (isV) { const bool lat = row >= NCTX; const int lr = row - NCTX, b = lat ? (lr >> 13) : (row >> 8), kpos = lat ? (CTXL + (lr & 8191)) : (row & 255);
                        rowp = V + (((size_t)b * NKV + (size_t)(u.pn - (DM + KVD) / BM) * 2) * SKV + kpos) * HD + wc * 32 + 8 * fq; vstep = (size_t)SKV * HD; }
#pragma unroll
                    for (int bj = 0; bj < 2; ++bj) { const f32x4 v0 = acc[ai][bj][m][0], v1 = acc[ai][bj][m][1];
                        v4u w; w.x = cvt_pk_bf16(v0[0], v0[1]); w.y = cvt_pk_bf16(v0[2], v0[3]); w.z = cvt_pk_bf16(v1[0], v1[1]); w.w = cvt_pk_bf16(v1[2], v1[3]);
                        *(v4u*)(rowp + bj * vstep) = w; } }
        } else {
            float* pb = P + (size_t)(u.aux - 1) * 512 * ldc;
#pragma unroll
            for (int ai = 0; ai < 2; ++ai)
#pragma unroll
                for (int m = 0; m < 4; ++m) { float* rowp = pb + (size_t)(row0 + ai * HALF + m * 16) * ldc + col0;
#pragma unroll
                    for (int bj = 0; bj < 2; ++bj) { *(f32x4*)(rowp + bj * HALF) = acc[ai][bj][m][0]; *(f32x4*)(rowp + bj * HALF + 4) = acc[ai][bj][m][1]; } }
        }
    }
};
struct EpiGateUp {
    static constexpr bool PERM = true;
    bf16_t* ACT;
    __device__ __forceinline__ void operator()(const f32x4 (&acc)[2][2][4][2], const Unit& u, int wr, int wc, int fr, int fq) const {
        const int row0 = u.pm * BM + wr * 64 + fr, col0 = u.pn * HALF + wc * 32 + 8 * fq;
#pragma unroll
        for (int ai = 0; ai < 2; ++ai)
#pragma unroll
            for (int m = 0; m < 4; ++m) { bf16_t* rowp = ACT + (size_t)(row0 + ai * HALF + m * 16) * DE + col0;
                float v[8];
#pragma unroll
                for (int n = 0; n < 2; ++n)
#pragma unroll
                    for (int j = 0; j < 4; ++j) v[n * 4 + j] = silu_f(acc[ai][0][m][n][j]) * acc[ai][1][m][n][j];
                v4u w; w.x = cvt_pk_bf16(v[0], v[1]); w.y = cvt_pk_bf16(v[2], v[3]); w.z = cvt_pk_bf16(v[4], v[5]); w.w = cvt_pk_bf16(v[6], v[7]);
                asm volatile("global_store_dwordx4 %0, %1, off sc1\n\ts_nop 1" :: "v"(rowp), "v"(w) : "memory"); }
    }
};
struct EpiDown {
    static constexpr bool PERM = true;
    bf16_t* FB; const PG8_LAS int* rt;
    __device__ __forceinline__ void operator()(const f32x4 (&acc)[2][2][4][2], const Unit& u, int wr, int wc, int fr, int fq) const {
        const int r0 = wr * 64 + fr, col0 = u.pn * BM + wc * 32 + 8 * fq; const PG8_LAS int* tb = rt + u.ui * 512 + r0;
#pragma unroll
        for (int ai = 0; ai < 2; ++ai)
#pragma unroll
            for (int m = 0; m < 4; ++m) { const int d_ = tb[ai * HALF + m * 16]; const float g_ = __uint_as_float((unsigned)tb[256 + ai * HALF + m * 16]);
                if (d_ >= 0) { bf16_t* fr_ = FB + (size_t)d_ * DM + col0;
#pragma unroll
                    for (int bj = 0; bj < 2; ++bj) { const f32x4 v0 = acc[ai][bj][m][0] * g_, v1 = acc[ai][bj][m][1] * g_;
                        v4u w; w.x = cvt_pk_bf16(v0[0], v0[1]); w.y = cvt_pk_bf16(v0[2], v0[3]); w.z = cvt_pk_bf16(v1[0], v1[1]); w.w = cvt_pk_bf16(v1[2], v1[3]);
                        *(v4u*)(fr_ + bj * HALF) = w; } } }
    }
};
}

namespace att {
constexpr int D = 128, NW = 8, QBLK = 32, KVBLK = 64;
constexpr float SCALE = 0.088388347648318440f;
constexpr float THR = 8.f;
#ifndef ATT_SDEPTH
#define ATT_SDEPTH 1
#endif
constexpr int SDEPTH = ATT_SDEPTH;
constexpr int LDQ = DM, LDK = HD, LDO = DM;
constexpr size_t SHM_V = KVBLK * D * 2, SHM_K = KVBLK * D * 2, SHM_ATTN = 2 * SHM_V + 2 * SHM_K + NW * 64 * 4;
typedef unsigned u32x4 __attribute__((ext_vector_type(4)));
#define KSWZ(row, colB) ((row) * 256 + ((colB) ^ (((row) & 7) << 4)))
#define SBAR() __builtin_amdgcn_sched_barrier(0)
__device__ __forceinline__ int crow(int r, int hi) { return (r & 3) + 8 * (r >> 2) + 4 * hi; }
__device__ __forceinline__ unsigned cvtpk(float lo, float hi) { unsigned r; asm volatile("v_cvt_pk_bf16_f32 %0, %1, %2" : "=v"(r) : "v"(lo), "v"(hi)); return r; }
__device__ __forceinline__ bf16x8 ld8(const bf16_t* p) { return *reinterpret_cast<const bf16x8*>(p); }

__device__ __forceinline__ void partialSM(f32x16& p0, f32x16& p1, float& m_reg, float& mn, float& alpha) {
  constexpr float C = SCALE * 1.4426950408889634f;
  float pmax = p0[0]; for (int r = 1; r < 16; ++r) pmax = fmaxf(pmax, p0[r]); for (int r = 0; r < 16; ++r) pmax = fmaxf(pmax, p1[r]);
  { auto rr = __builtin_amdgcn_permlane32_swap(__float_as_uint(pmax), __float_as_uint(pmax), false, false);
    pmax = fmaxf(__uint_as_float(rr[0]), __uint_as_float(rr[1])); }
  if (__builtin_expect(__all(pmax - m_reg <= THR / SCALE), 1)) { mn = m_reg; alpha = 1.f; }
  else { mn = fmaxf(m_reg, pmax); alpha = __builtin_amdgcn_exp2f((m_reg - mn) * C); m_reg = mn; }
  float mnC = -mn * C;
  for (int r = 0; r < 16; ++r) p0[r] = fmaf(p0[r], C, mnC); for (int r = 0; r < 16; ++r) p1[r] = fmaf(p1[r], C, mnC);
  for (int r = 0; r < 16; ++r) p0[r] = __builtin_amdgcn_exp2f(p0[r]);
}
__device__ __forceinline__ void finishSM(f32x16& p0, f32x16& p1, float alpha, float& l_reg, bf16x8& pa0, bf16x8& pa1, bf16x8& pa2, bf16x8& pa3) {
  for (int r = 0; r < 16; ++r) p1[r] = __builtin_amdgcn_exp2f(p1[r]);
  float ps = 0; for (int r = 0; r < 16; ++r) ps += p0[r]; for (int r = 0; r < 16; ++r) ps += p1[r];
  { auto rr = __builtin_amdgcn_permlane32_swap(__float_as_uint(ps), __float_as_uint(ps), false, false);
    ps = __uint_as_float(rr[0]) + __uint_as_float(rr[1]); }
  l_reg = l_reg * alpha + ps;
#define PK4(P, BASE, OUT) do { unsigned a0 = cvtpk(P[BASE + 0], P[BASE + 1]), a1 = cvtpk(P[BASE + 2], P[BASE + 3]);   \
    unsigned b0 = cvtpk(P[BASE + 4], P[BASE + 5]), b1 = cvtpk(P[BASE + 6], P[BASE + 7]);                              \
    auto r0 = __builtin_amdgcn_permlane32_swap(a0, b0, false, false); auto r1 = __builtin_amdgcn_permlane32_swap(a1, b1, false, false); \
    u32x4 w = {r0[0], r1[0], r0[1], r1[1]}; OUT = *reinterpret_cast<bf16x8*>(&w); } while (0)
  PK4(p0, 0, pa0); PK4(p0, 8, pa1); PK4(p1, 0, pa2); PK4(p1, 8, pa3);
#undef PK4
}
__device__ __forceinline__ void qkt(f32x16& p0, f32x16& p1, const bf16_t* Ks, const bf16x8* qr, int r32, int hi) {
  p0 = f32x16{}; p1 = f32x16{};
  for (int d0 = 0; d0 < 8; ++d0) { int cb = (d0 * 16 + hi * 8) * 2;
    bf16x8 b0 = *reinterpret_cast<const bf16x8*>((const char*)Ks + KSWZ(r32, cb));
    bf16x8 b1 = *reinterpret_cast<const bf16x8*>((const char*)Ks + KSWZ(32 + r32, cb));
    p0 = __builtin_amdgcn_mfma_f32_32x32x16_bf16(b0, qr[d0], p0, 0, 0, 0);
    p1 = __builtin_amdgcn_mfma_f32_32x32x16_bf16(b1, qr[d0], p1, 0, 0, 0); }
}
__device__ __forceinline__ int v_st(int k, int c) { const int kk = (k & ~0xC) | ((k & 4) << 1) | ((k & 8) >> 1); return ((kk >> 3) * 4 + (c >> 5)) * 512 + ((kk & 7) * 32 + (c & 31)) * 2; }
__device__ __forceinline__ int v_rd_base(int lane) { return ((lane & 3) << 3) | (((lane >> 2) & 3) << 6) | (((lane >> 4) & 1) << 5) | (((lane >> 5) & 1) << 8); }
constexpr int v_rd_off(int d0, int ks, int half) { return d0 * 512 + ks * 4096 + half * 2048; }
template <int OFF> __device__ __forceinline__ s16x4 tr_read(int vb) {
  s16x4 r; asm volatile("ds_read_b64_tr_b16 %0, %1 offset:%2" : "=&v"(r) : "v"(vb), "i"(OFF) : "memory"); return r;
}
template <int D0> __device__ __forceinline__ void pv_one(f32x16& od, int vb, bf16x8 pa0, bf16x8 pa1, bf16x8 pa2, bf16x8 pa3) {
  const s16x4 l0 = tr_read<v_rd_off(D0, 0, 0)>(vb), h0 = tr_read<v_rd_off(D0, 0, 1)>(vb), l1 = tr_read<v_rd_off(D0, 1, 0)>(vb), h1 = tr_read<v_rd_off(D0, 1, 1)>(vb);
  const s16x4 l2 = tr_read<v_rd_off(D0, 2, 0)>(vb), h2 = tr_read<v_rd_off(D0, 2, 1)>(vb), l3 = tr_read<v_rd_off(D0, 3, 0)>(vb), h3 = tr_read<v_rd_off(D0, 3, 1)>(vb);
  asm volatile("s_waitcnt lgkmcnt(0)" ::: "memory"); SBAR();
#define PK(L, H) (bf16x8){L[0], L[1], L[2], L[3], H[0], H[1], H[2], H[3]}
  od = __builtin_amdgcn_mfma_f32_32x32x16_bf16(pa0, PK(l0, h0), od, 0, 0, 0);
  od = __builtin_amdgcn_mfma_f32_32x32x16_bf16(pa1, PK(l1, h1), od, 0, 0, 0);
  od = __builtin_amdgcn_mfma_f32_32x32x16_bf16(pa2, PK(l2, h2), od, 0, 0, 0);
  od = __builtin_amdgcn_mfma_f32_32x32x16_bf16(pa3, PK(l3, h3), od, 0, 0, 0);
#undef PK
}
__device__ __forceinline__ void pv_d0(f32x16* o, int vb, bf16x8 pa0, bf16x8 pa1, bf16x8 pa2, bf16x8 pa3) {
  pv_one<0>(o[0], vb, pa0, pa1, pa2, pa3); pv_one<1>(o[1], vb, pa0, pa1, pa2, pa3); pv_one<2>(o[2], vb, pa0, pa1, pa2, pa3); pv_one<3>(o[3], vb, pa0, pa1, pa2, pa3);
}
__device__ __forceinline__ void attn_dense_body(const bf16_t* __restrict__ Qb, const bf16_t* __restrict__ Kh, const bf16_t* __restrict__ Vh,
                                                bf16_t* __restrict__ Ob, int seq, char* lds) {
  const int tid = otid(), wid = tid >> 6, lane = tid & 63, r32 = lane & 31, hi = lane >> 5;
  bf16_t* V_lds = (bf16_t*)lds; bf16_t* K_lds = (bf16_t*)(lds + 2 * SHM_V);
  float* ws = (float*)(lds + 2 * SHM_V + 2 * SHM_K) + wid * 64; float* li_l = ws; float* al_l = ws + 32;
  float m_reg = -1e30f, l_reg = 0; f32x16 o[4] = {}; bf16x8 qr[8];
  const bf16_t* Qw = Qb + (long)(wid * QBLK + r32) * LDQ + hi * 8;
#pragma unroll
  for (int d0 = 0; d0 < 8; ++d0) qr[d0] = ld8(Qw + d0 * 16);
  const int sr = tid >> 4, sc = (tid & 15) * 8, vst0 = v_st(sr, sc), vst1 = v_st(32 + sr, sc);
  const int vb0 = (int)(uintptr_t)V_lds + v_rd_base(lane);
  struct { bf16x8 vs0, vs1, ks0, ks1; } sr_[SDEPTH];
#define SLOAD(i, k0) do { sr_[i].vs0 = ld8(&Vh[(long)((k0) + sr) * LDK + sc]); sr_[i].vs1 = ld8(&Vh[(long)((k0) + 32 + sr) * LDK + sc]); \
    sr_[i].ks0 = ld8(&Kh[(long)((k0) + sr) * LDK + sc]); sr_[i].ks1 = ld8(&Kh[(long)((k0) + 32 + sr) * LDK + sc]); } while (0)
#define SWRITE(b, i) do { *(bf16x8*)((char*)V_lds + (b) * SHM_V + vst0) = sr_[i].vs0;          \
    *(bf16x8*)((char*)V_lds + (b) * SHM_V + vst1) = sr_[i].vs1; int kc = sc * 2;               \
    *(bf16x8*)((char*)K_lds + (b) * SHM_K + KSWZ(sr, kc)) = sr_[i].ks0;                       \
    *(bf16x8*)((char*)K_lds + (b) * SHM_K + KSWZ(32 + sr, kc)) = sr_[i].ks1; } while (0)
#define SWAIT() do { if constexpr (SDEPTH == 2) asm volatile("s_waitcnt vmcnt(4)" ::: "memory"); else asm volatile("s_waitcnt vmcnt(0)" ::: "memory"); } while (0)
#define RESC(a) do { if (__any((a) < 1.f)) { if (hi == 0) al_l[r32] = (a); asm volatile("s_waitcnt lgkmcnt(0)" ::: "memory"); \
    for (int d = 0; d < 4; ++d) for (int r = 0; r < 16; ++r) o[d][r] *= al_l[crow(r, hi)]; } } while (0)
  f32x16 pA0, pA1, pB0, pB1; float mnA, mnB, alA, alB; bf16x8 pa0, pa1, pa2, pa3; const int NT = seq / KVBLK;
  constexpr int SE = 0, SO = SDEPTH - 1;
  SLOAD(SE, 0); asm volatile("s_waitcnt vmcnt(0)" ::: "memory"); SWRITE(0, SE); __syncthreads();
  qkt(pA0, pA1, K_lds, qr, r32, hi); partialSM(pA0, pA1, m_reg, mnA, alA);
  SLOAD(SO, KVBLK); if constexpr (SDEPTH == 2) { if (2 < NT) SLOAD(SE, 2 * KVBLK); }
  SWAIT(); SWRITE(1, SO); __syncthreads();
  for (int j = 1; j + 1 < NT; j += 2) {
    SBAR(); qkt(pB0, pB1, (bf16_t*)((char*)K_lds + SHM_K), qr, r32, hi);
    finishSM(pA0, pA1, alA, l_reg, pa0, pa1, pa2, pa3); SBAR();
    SLOAD(SO, (j + SDEPTH) * KVBLK); SBAR();
    pv_d0(o, vb0, pa0, pa1, pa2, pa3); partialSM(pB0, pB1, m_reg, mnB, alB);
    __syncthreads(); SWAIT(); SWRITE(0, SE);
    RESC(alB); __syncthreads();
    SBAR(); qkt(pA0, pA1, K_lds, qr, r32, hi);
    finishSM(pB0, pB1, alB, l_reg, pa0, pa1, pa2, pa3); SBAR();
    if (SDEPTH == 1 || j + 3 < NT) SLOAD(SE, (j + 1 + SDEPTH) * KVBLK); SBAR();
    pv_d0(o, vb0 + (int)SHM_V, pa0, pa1, pa2, pa3); partialSM(pA0, pA1, m_reg, mnA, alA);
    __syncthreads(); SWAIT(); SWRITE(1, SO);
    RESC(alA); __syncthreads();
  }
  SBAR(); qkt(pB0, pB1, (bf16_t*)((char*)K_lds + SHM_K), qr, r32, hi);
  finishSM(pA0, pA1, alA, l_reg, pa0, pa1, pa2, pa3); SBAR();
  pv_d0(o, vb0, pa0, pa1, pa2, pa3); partialSM(pB0, pB1, m_reg, mnB, alB);
  __syncthreads(); RESC(alB);
  finishSM(pB0, pB1, alB, l_reg, pa0, pa1, pa2, pa3); SBAR();
  pv_d0(o, vb0 + (int)SHM_V, pa0, pa1, pa2, pa3);
  if (hi == 0) li_l[r32] = l_reg; asm volatile("s_waitcnt lgkmcnt(0)" ::: "memory");
  float rli[16];
#pragma unroll
  for (int r = 0; r < 16; ++r) rli[r] = __builtin_amdgcn_rcpf(li_l[crow(r, hi)]);
  bf16_t* Ow = Ob + (long)(wid * QBLK) * LDO;
#pragma unroll
  for (int r = 0; r < 16; ++r) { int orow = crow(r, hi);
    for (int d0 = 0; d0 < 4; ++d0) Ow[(long)orow * LDO + d0 * 32 + r32] = (bf16_t)f2bf(o[d0][r] * rli[r]); }
  asm volatile("s_waitcnt vmcnt(0) lgkmcnt(0)" ::: "memory");
  __syncthreads();
#undef SLOAD
#undef SWRITE
#undef SWAIT
#undef RESC
}
constexpr size_t SHM_SLOT = 32768, SHM_DMA = 4 * SHM_SLOT;
static_assert(4 * SHM_SLOT <= RING_BYTES && TAB_OFF + 1024 + NW * 64 * 4 <= LDS_BYTES, "attention LDS map");
#define ATT_WAIT_BAR() asm volatile("s_waitcnt vmcnt(0) lgkmcnt(0)\n\ts_barrier" ::: "memory")
__device__ __forceinline__ void attn_dma_body(const bf16_t* __restrict__ Qb, int ldq, int tpos0, const float* __restrict__ rope, const float* __restrict__ qgain,
                                              const bf16_t* __restrict__ Kh, const bf16_t* __restrict__ Vh, bf16_t* __restrict__ Ob, int seq, char* lds) {
  const int tid = otid(), wid = tid >> 6, lane = tid & 63, r32 = lane & 31, hi = lane >> 5;
  float* ws = (float*)(lds + TAB_OFF + 1024) + wid * 64; float* li_l = ws; float* al_l = ws + 32;
  float m_reg = -1e30f, l_reg = 0; f32x16 o[4] = {}; bf16x8 qr[8];
  const bf16_t* Qw = Qb + (long)(wid * QBLK + r32) * ldq + hi * 8;
  unsigned koff[2], voff[2];
#pragma unroll
  for (int c = 0; c < 2; ++c) { const int g = c * 512 + tid;
    { const int row = g >> 4, ch = (g & 15) ^ (row & 7); koff[c] = (unsigned)(row * 128 + ch * 8) * 2u; }
    { const int sub = g >> 5, kk = (sub >> 2) * 8 + ((g >> 2) & 7), k = (kk & ~0xC) | ((kk & 4) << 1) | ((kk & 8) >> 1), col = (sub & 3) * 32 + (g & 3) * 8; voff[c] = (unsigned)(k * 128 + col) * 2u; } }
  const unsigned wbase = (unsigned)__builtin_amdgcn_readfirstlane(wid) * 1024u;
  typedef __attribute__((address_space(3))) unsigned lds_u32;
  lds_u32* ldsl = (lds_u32*)(__attribute__((address_space(3))) char*)lds;
#define ATT_DMA(t, slot) do { const char* kt_ = (const char*)Kh + (size_t)(t) * (KVBLK * D * 2); const char* vt_ = (const char*)Vh + (size_t)(t) * (KVBLK * D * 2); \
    _Pragma("unroll") for (int c_ = 0; c_ < 2; ++c_) { \
      __builtin_amdgcn_global_load_lds((const unsigned*)(kt_ + koff[c_]), (lds_u32*)((__attribute__((address_space(3))) char*)ldsl + (slot) * SHM_SLOT + c_ * 8192 + wbase), 16, 0, 0); \
      __builtin_amdgcn_global_load_lds((const unsigned*)(vt_ + voff[c_]), (lds_u32*)((__attribute__((address_space(3))) char*)ldsl + (slot) * SHM_SLOT + 16384 + c_ * 8192 + wbase), 16, 0, 0); } } while (0)
#define RESC(a) do { if (__any((a) < 1.f)) { if (hi == 0) al_l[r32] = (a); asm volatile("s_waitcnt lgkmcnt(0)" ::: "memory"); \
    for (int d = 0; d < 4; ++d) for (int r = 0; r < 16; ++r) o[d][r] *= al_l[crow(r, hi)]; } } while (0)
  const int NT = seq / KVBLK;
  ATT_DMA(0, 0); ATT_DMA(1, 1);
#pragma unroll
  for (int d0 = 0; d0 < 8; ++d0) qr[d0] = ld8(Qw + d0 * 16);
  if (tpos0 >= 0) {
    float ss = 0.f;
#pragma unroll
    for (int d0 = 0; d0 < 8; ++d0)
#pragma unroll
      for (int i = 0; i < 8; ++i) { const float x = bf2f((unsigned)(unsigned short)qr[d0][i]); ss += x * x; }
    { auto rr = __builtin_amdgcn_permlane32_swap(__float_as_uint(ss), __float_as_uint(ss), false, false); ss = __uint_as_float(rr[0]) + __uint_as_float(rr[1]); }
    const float rinv = 1.0f / sqrtf(ss * (1.0f / 128.0f) + RMS_EPS);
    const int t = tpos0 + wid * QBLK + r32;
#pragma unroll
    for (int ax = 0; ax < 2; ++ax) { const int pos = ax ? (t & 63) : (t >> 6);
#pragma unroll
      for (int q = 0; q < 2; ++q) { const int dl = 4 * ax + q, dh = dl + 2, p0 = q * 16 + 8 * hi;
        const float* cp_ = rope + pos * 32 + p0; const float* gl = qgain + dl * 16 + 8 * hi; const float* gh = qgain + dh * 16 + 8 * hi;
        float cs[8], sn[8], lo[8], hv[8];
#pragma unroll
        for (int i = 0; i < 8; ++i) { cs[i] = cp_[i]; sn[i] = cp_[4096 + i];
          lo[i] = bf2f((unsigned)(unsigned short)qr[dl][i]) * rinv * gl[i]; hv[i] = bf2f((unsigned)(unsigned short)qr[dh][i]) * rinv * gh[i]; }
        u32x4 wl, wh;
#pragma unroll
        for (int i = 0; i < 4; ++i) { const float l0 = lo[2 * i] * cs[2 * i] - hv[2 * i] * sn[2 * i], l1 = lo[2 * i + 1] * cs[2 * i + 1] - hv[2 * i + 1] * sn[2 * i + 1];
          const float h0 = hv[2 * i] * cs[2 * i] + lo[2 * i] * sn[2 * i], h1 = hv[2 * i + 1] * cs[2 * i + 1] + lo[2 * i + 1] * sn[2 * i + 1];
          wl[i] = pk2(l0, l1); wh[i] = pk2(h0, h1); }
        qr[dl] = *reinterpret_cast<bf16x8*>(&wl); qr[dh] = *reinterpret_cast<bf16x8*>(&wh); } } }
#pragma unroll
  for (int d0 = 0; d0 < 8; ++d0) asm volatile("" : "+v"(qr[d0]));
  ATT_WAIT_BAR();
  if (2 < NT) ATT_DMA(2, 2);
  const int vb0 = (int)(uintptr_t)lds + 16384 + v_rd_base(lane);
  f32x16 pA0, pA1, pB0, pB1; float mnA, mnB, alA, alB; bf16x8 pa0, pa1, pa2, pa3;
  qkt(pA0, pA1, (const bf16_t*)lds, qr, r32, hi); partialSM(pA0, pA1, m_reg, mnA, alA);
  const bool lead = __builtin_amdgcn_readfirstlane(wid) < 4;
#define ATT_SYNC(jn) do { ATT_WAIT_BAR(); if ((jn) < NT) ATT_DMA((jn), (jn) & 3); } while (0)
  for (int j = 1; j + 1 < NT; j += 2) {
    { SBAR(); qkt(pB0, pB1, (const bf16_t*)(lds + (j & 3) * SHM_SLOT), qr, r32, hi);
      finishSM(pA0, pA1, alA, l_reg, pa0, pa1, pa2, pa3); SBAR();
      if (!lead) ATT_SYNC(j + 2);
      pv_d0(o, vb0 + ((j - 1) & 3) * (int)SHM_SLOT, pa0, pa1, pa2, pa3); partialSM(pB0, pB1, m_reg, mnB, alB);
      if (lead) ATT_SYNC(j + 2);
      RESC(alB); }
    { SBAR(); qkt(pA0, pA1, (const bf16_t*)(lds + ((j + 1) & 3) * SHM_SLOT), qr, r32, hi);
      finishSM(pB0, pB1, alB, l_reg, pa0, pa1, pa2, pa3); SBAR();
      if (!lead) ATT_SYNC(j + 3);
      pv_d0(o, vb0 + (j & 3) * (int)SHM_SLOT, pa0, pa1, pa2, pa3); partialSM(pA0, pA1, m_reg, mnA, alA);
      if (lead) ATT_SYNC(j + 3);
      RESC(alA); }
  }
#undef ATT_SYNC
  { SBAR(); qkt(pB0, pB1, (const bf16_t*)(lds + ((NT - 1) & 3) * SHM_SLOT), qr, r32, hi);
    finishSM(pA0, pA1, alA, l_reg, pa0, pa1, pa2, pa3); SBAR();
    pv_d0(o, vb0 + ((NT - 2) & 3) * (int)SHM_SLOT, pa0, pa1, pa2, pa3); partialSM(pB0, pB1, m_reg, mnB, alB);
    RESC(alB);
    finishSM(pB0, pB1, alB, l_reg, pa0, pa1, pa2, pa3); SBAR();
    pv_d0(o, vb0 + ((NT - 1) & 3) * (int)SHM_SLOT, pa0, pa1, pa2, pa3); }
  if (hi == 0) li_l[r32] = l_reg; asm volatile("s_waitcnt lgkmcnt(0)" ::: "memory");
  float rli[16];
#pragma unroll
  for (int r = 0; r < 16; ++r) rli[r] = __builtin_amdgcn_rcpf(li_l[crow(r, hi)]);
  bf16_t* Ow = Ob + (long)(wid * QBLK) * LDO;
  asm volatile("s_waitcnt lgkmcnt(0)\n\ts_barrier" ::: "memory");
  { char* st = lds + wid * 8704;
#pragma unroll
    for (int r = 0; r < 16; ++r) { const int orow = crow(r, hi);
#pragma unroll
      for (int d0 = 0; d0 < 4; ++d0) *(bf16_t*)(st + orow * 272 + (d0 * 32 + r32) * 2) = (bf16_t)f2bf(o[d0][r] * rli[r]); }
    asm volatile("s_waitcnt lgkmcnt(0)" ::: "memory");
#pragma unroll
    for (int i = 0; i < 8; ++i) { const int c = i * 64 + lane, row = c >> 4, cc = c & 15; const u32x4 v = *(const u32x4*)(st + row * 272 + cc * 16);
      const bf16_t* gp = Ow + (long)row * LDO + cc * 8;
      asm volatile("global_store_dwordx4 %0, %1, off sc1\n\ts_nop 1" :: "v"(gp), "v"(v) : "memory"); } }
  ATT_WAIT_BAR();
#undef ATT_DMA
#undef RESC
}
#undef KSWZ
}

struct Params {
    const float *x, *c, *ctx, *c_ctx, *w_mod, *b_mod, *ln_g, *ln_b, *w_qkv, *q_gain, *k_gain, *w_o, *w_pool, *pool_scale, *w_router, *router_bias, *w_gate, *w_up, *w_down;
    float* out; unsigned char* ws; int ph_lo, ph_hi;
};

struct TItem { const float* W; bf16_t* WT; int K, N, kind, k0, n0; };
__device__ __forceinline__ int t_drow(int kind, int n) { return kind == 0 ? n : ((n >> 7) * 256 + (kind == 2 ? 128 : 0) + (n & 127)); }
__device__ __forceinline__ void t_load(const TItem& d, f32x4 (&r)[8], int lane) {
    const float* p = d.W + (size_t)(d.k0 + (lane >> 3)) * d.N + d.n0 + (lane & 7) * 4;
#pragma unroll
    for (int i = 0; i < 8; ++i) r[i] = __builtin_nontemporal_load((const f32x4*)(p + (size_t)(8 * i) * d.N));
}
__device__ __forceinline__ void t_store(const TItem& d, const f32x4 (&r)[8], LAS float* scr, int lane) {
#pragma unroll
    for (int i = 0; i < 8; ++i) *(LAS f32x4*)(scr + (8 * i + (lane >> 3)) * 32 + (((lane & 7) * 4 + 8 * i) & 31)) = r[i];
    LDS_WAIT(); asm volatile("" ::: "memory");
    const int c = lane >> 3, nl = lane & 7;
#pragma unroll
    for (int j = 0; j < 4; ++j) { const int n = nl + 8 * j; const LAS float* s = scr + (8 * c) * 32 + ((n + 8 * c) & 31);
        v4u o; o.x = pk2(s[0 * 32], s[1 * 32]); o.y = pk2(s[2 * 32], s[3 * 32]); o.z = pk2(s[4 * 32], s[5 * 32]); o.w = pk2(s[6 * 32], s[7 * 32]);
        __builtin_nontemporal_store(o, (GAS v4u*)(d.WT + (size_t)t_drow(d.kind, d.n0 + n) * d.K + d.k0 + 8 * c)); }
    LDS_WAIT(); asm volatile("" ::: "memory");
}

__device__ __forceinline__ void mod_prepare(const float* cl, const float* cc, LAS float* sv, int tid) {
    for (int i = tid; i < 3 * DM; i += 512) { const int cd = i >> 11, k = i & 2047; const float v = (cd < 2) ? cl[cd * DM + k] : cc[k]; sv[i] = v / (1.0f + expf(-v)); }
    __syncthreads();
}
__device__ __forceinline__ void mod_item(int it, const float* wm, const float* bm, float* MOD, const LAS float* sv, LAS float* red, int tid, int lane, int wave) {
    const int c4 = lane & 7, kr = (lane >> 3) + 8 * wave;
    const int l = it / 384, nb = it % 384; const float* W = wm + (size_t)l * DM * 12288 + nb * 32 + c4 * 4;
    f32x4 a0 = {0, 0, 0, 0}, a1 = a0, a2 = a0;
#pragma unroll 16
    for (int s = 0; s < 32; ++s) { const int k = s * 64 + kr; const f32x4 w = *(const f32x4*)(W + (size_t)k * 12288);
        a0 += w * sv[k]; a1 += w * sv[DM + k]; a2 += w * sv[2 * DM + k]; }
    *(LAS f32x4*)(red + (kr * 3 + 0) * 32 + c4 * 4) = a0; *(LAS f32x4*)(red + (kr * 3 + 1) * 32 + c4 * 4) = a1; *(LAS f32x4*)(red + (kr * 3 + 2) * 32 + c4 * 4) = a2;
    __syncthreads();
    if (tid < 96) { const int cd = tid >> 5, n = tid & 31; float s = 0.f; for (int r = 0; r < 64; ++r) s += red[(r * 3 + cd) * 32 + n];
        MOD[((size_t)l * 3 + cd) * 12288 + nb * 32 + n] = s + bm[l * 12288 + nb * 32 + n]; }
    __syncthreads();
}

typedef const __attribute__((address_space(4))) Params CParams;
__device__ __forceinline__ CParams* kparams() { CParams* k = (CParams*)__builtin_amdgcn_kernarg_segment_ptr(); asm volatile("" : "+s"(k)); return k; }
#define WSP(T, off) ((T*)(kp->ws + (off)))


#define IN(k) (lo <= (k) && (k) < hi)
#define NREP(k) (1 + ((REP_MASK >> (k)) & 1))
#define SEAM(k) do { if (IN(k) && IN((k) + 1)) xcd_barrier(bar); } while (0)
#define TIDS const int tid = otid(), lane = tid & 63, wave = __builtin_amdgcn_readfirstlane(tid >> 6), G = ogrid(), bx = obid(), gw = bx * 8 + wave, NGW = G * 8; (void)lane; (void)gw; (void)NGW


template <int layer>
__device__ __forceinline__ void layer_half(const int lo, const int hi, const XcdBarrier& bar, LAS unsigned char* L, LAS int* tcnt, LAS int* tbase, LAS int* texp) {
        const int P6 = 6 + 7 * layer;
        if (IN(P6)) _Pragma("unroll 1") for (int rep_ = 0; rep_ < NREP(6); ++rep_) {
            CParams* kp = kparams(); TIDS;
            const int row_lo = layer == 0 ? 0 : NCTX;
            const float* modl = WSP(float, WS_MOD) + (size_t)layer * 3 * 12288;
            unsigned* cnt = WSP(unsigned, WS_CTL) + CW_CNT + layer * 1024;
            const bf16_t* Y = WSP(bf16_t, WS_Y); float* X1 = WSP(float, WS_X1); bf16_t* Hb = WSP(bf16_t, WS_H);
            const float* xlat = kp->x; const float* xctx = kp->ctx; const bf16_t* X2b = WSP(bf16_t, WS_X2);
            const float* pscale = kp->pool_scale;
            int* LIST = WSP(int, WS_LIST); float* LISTG = WSP(float, WS_LIST) + (size_t)32 * MT;
            const float rb_e = kp->router_bias[lane & 31];
            LAS bf16_t* hp = (LAS bf16_t*)L;
            LAS float* part = (LAS float*)(L + 65536);
            LAS int* lcnt = (LAS int*)(L + 65536 + 8192); LAS int* lbase = lcnt + 32;
            LAS int* asg = (LAS int*)(L + 65536 + 8192 + 256);
            LAS float* vG1 = (LAS float*)(L + 82176); LAS float* vLG = vG1 + DM; LAS float* vLB = vLG + DM; LAS float* vSC = vLB + DM; LAS float* vSH = vSC + DM;
            const float* lg = kp->ln_g + (size_t)(layer * 2 + 0) * DM; const float* lb = kp->ln_b + (size_t)(layer * 2 + 0) * DM;
            const int ngrp = (MT - row_lo) / 8;
            const bool agg = ((ngrp + G - 1) / G) * 16 <= 512;
            if (tid < 32) lcnt[tid] = 0;
            const int ti = lane & 31, hi = lane >> 5;
            const bf16_t* w1p = WSP(bf16_t, WS_WR) + ((size_t)(wave * 16) * 64 + lane) * 8; const bf16_t* w2p = w1p + 32 * DM;
            const LAS bf16_t* a1p = hp + (ti & 7) * DM + wave * 256 + 8 * hi; const LAS bf16_t* a2p = a1p + 8 * DM;
            f32x4 xv[8]; v2u xb[8], yv[8];
#define P6_LOAD(grp_) do { const int row_ = row_lo + (grp_) * 8 + wave; const float* xr_ = (row_ < NCTX) ? xctx + (size_t)row_ * DM : xlat + (size_t)(row_ - NCTX) * DM; const bf16_t* yr_ = Y + (size_t)row_ * DM; const bf16_t* xb_ = X2b + (size_t)row_ * DM; \
                _Pragma("unroll") for (int j = 0; j < 8; ++j) { if (layer == 0) xv[j] = *(const f32x4*)(xr_ + (j * 64 + lane) * 4); else xb[j] = *(const v2u*)(xb_ + (j * 64 + lane) * 4); yv[j] = *(const v2u*)(yr_ + (j * 64 + lane) * 4); } } while (0)
            LAS int* rdy = (LAS int*)(L + 124928); unsigned* yd = WSP(unsigned, WS_CTL) + CW_YD; volatile LAS unsigned* MISC = (volatile LAS unsigned*)(L + MISC_OFF);
            const bool dyn = (layer == 0) && (G % 2 == 0); const int pcls = bx & 1; unsigned* q6 = WSP(unsigned, WS_CTL) + CW_P6Q + 32 * pcls;
            auto gmap = [&](unsigned pos) -> int { return pos >= 1056u ? -1 : (pos < 32u ? pcls * 32 + (int)pos : 64 + pcls * 1024 + ((int)pos - 32)); };
            auto seq = [&](int k) -> int { const int g_ = bx + k * G; return g_ < ngrp ? g_ : -1; };
            auto ensure = [&](int g_) { if (layer == 0) { const int pm_ = g_ < 64 ? (g_ >> 5) : 2 + ((g_ - 64) >> 5); if (!rdy[pm_]) { while (xb_ld(yd + 32 * pm_) < 8u) __builtin_amdgcn_s_sleep(4); asm volatile("" ::: "memory"); } } };
            if (layer == 0) { if (tid < 66) rdy[tid] = xb_ld(yd + 32 * tid) >= 8u ? 1 : 0;
                if (tid == 0) { __builtin_amdgcn_fence(__ATOMIC_ACQUIRE, "agent"); asm volatile("s_waitcnt vmcnt(0)" ::: "memory");
                    if (dyn) { MISC[36] = xb_add(q6, 1u); MISC[37] = xb_add(q6, 1u); } }
                __syncthreads(); }
            int grp = dyn ? gmap(MISC[36]) : seq(0), nxt_ = dyn ? gmap(MISC[37]) : seq(1);
            if (grp >= 0) ensure(grp);
            P6_LOAD(grp >= 0 ? grp : 0);
            int it_ = 0, cur_cd = -1;
            for (; grp >= 0; ++it_) {
                const int pf_ = nxt_ >= 0 ? nxt_ : grp; if (nxt_ >= 0) ensure(nxt_);
                unsigned tk2 = 0xffffffffu;
                if (dyn && tid == 0 && nxt_ >= 0 && it_ + 2 < 32) tk2 = xb_add(q6, 1u);
                const int row = row_lo + grp * 8 + wave; const int cd = row_cond(row_lo + grp * 8);
                if (cd != cur_cd) {
                    const float* g1 = modl + (size_t)cd * 12288 + 2 * DM;
                    float t0[4], t1[4], t2[4], t3[4], t4[4], t5[4];
                    __syncthreads();
#pragma unroll
                    for (int q = 0; q < 4; ++q) { const int i = tid + q * 512; t0[q] = g1[i]; t1[q] = (layer == 1) ? pscale[i] : 1.0f; t2[q] = lg[i]; t3[q] = lb[i]; t4[q] = g1[DM + i]; t5[q] = g1[2 * DM + i]; }
#pragma unroll
                    for (int q = 0; q < 4; ++q) { const int i = tid + q * 512; vG1[i] = t0[q] * t1[q]; vLG[i] = t2[q]; vLB[i] = t3[q]; vSH[i] = t4[q]; vSC[i] = t5[q] + 1.0f; }
                    cur_cd = cd; __syncthreads(); }
                f32x4 v[8]; float s = 0.f;
#pragma unroll
                for (int j = 0; j < 8; ++j) { const int c = (j * 64 + lane) * 4; const f32x4 gv = *(const LAS f32x4*)(vG1 + c);
                    const f32x4 yf = {bf2f(yv[j].x & 0xffffu), bf2f(yv[j].x >> 16), bf2f(yv[j].y & 0xffffu), bf2f(yv[j].y >> 16)};
                    const f32x4 xf = (layer == 0) ? xv[j] : bf4(xb[j]);
                    v[j] = xf * ALPHA + gv * yf; s += (v[j][0] + v[j][1]) + (v[j][2] + v[j][3]); }
                const float mean = wave_sum(s) * (1.0f / DM); float s2 = 0.f;
#pragma unroll
                for (int j = 0; j < 8; ++j) { v[j] = v[j] - mean; s2 += (v[j][0] * v[j][0] + v[j][1] * v[j][1]) + (v[j][2] * v[j][2] + v[j][3] * v[j][3]); }
                const float rstd = 1.0f / sqrtf(wave_sum(s2) * (1.0f / DM) + LN_EPS);
#pragma unroll
                for (int j = 0; j < 8; ++j) { const int c = (j * 64 + lane) * 4;
                    const f32x4 x1 = v[j] * rstd * *(const LAS f32x4*)(vLG + c) + *(const LAS f32x4*)(vLB + c);
                    { v2u xw; xw.x = pk2(x1[0], x1[1]); xw.y = pk2(x1[2], x1[3]); *(v2u*)((bf16_t*)X1 + (size_t)row * DM + c) = xw; }
                    const f32x4 hv = x1 * *(const LAS f32x4*)(vSC + c) + *(const LAS f32x4*)(vSH + c);
                    v2u w; w.x = pk2(hv[0], hv[1]); w.y = pk2(hv[2], hv[3]); *(v2u*)(Hb + (size_t)row * DM + c) = w;
                    v2u w2; w2.x = pk2(hv[0] - bf2f(w.x & 0xffffu), hv[1] - bf2f(w.x >> 16)); w2.y = pk2(hv[2] - bf2f(w.y & 0xffffu), hv[3] - bf2f(w.y >> 16));
                    *(LAS v2u*)(hp + wave * DM + c) = w; *(LAS v2u*)(hp + (8 + wave) * DM + c) = w2; }
                const bf16_t* w1q = w1p; asm volatile("" : "+v"(w1q));
                const bf16_t* w2q = w1q + 32 * DM;
                bf16x8 wA1[4], wA2[4], wB1[4], wB2[4];
#define P6_WLOAD(d1, d2, q0) do { _Pragma("unroll") for (int q_ = 0; q_ < 4; ++q_) { d1[q_] = *(const GAS bf16x8*)(w1q + ((q0) + q_) * 512); d2[q_] = *(const GAS bf16x8*)(w2q + ((q0) + q_) * 512); } } while (0)
#define P6_MMA(s1, s2, q0) do { _Pragma("unroll") for (int q_ = 0; q_ < 4; ++q_) { const bf16x8 a1 = *(const LAS bf16x8*)(a1p + ((q0) + q_) * 16), a2 = *(const LAS bf16x8*)(a2p + ((q0) + q_) * 16); \
                    acc = __builtin_amdgcn_mfma_f32_32x32x16_bf16(a1, s1[q_], acc, 0, 0, 0); acc = __builtin_amdgcn_mfma_f32_32x32x16_bf16(a1, s2[q_], acc, 0, 0, 0); acc = __builtin_amdgcn_mfma_f32_32x32x16_bf16(a2, s1[q_], acc, 0, 0, 0); } } while (0)
                P6_WLOAD(wA1, wA2, 0); P6_WLOAD(wB1, wB2, 4);
                __syncthreads();
                {
                    f32x16 acc = {};
                    __builtin_amdgcn_sched_barrier(0); P6_MMA(wA1, wA2, 0); __builtin_amdgcn_sched_barrier(0);
                    P6_WLOAD(wA1, wA2, 8); __builtin_amdgcn_sched_barrier(0); P6_MMA(wB1, wB2, 4); __builtin_amdgcn_sched_barrier(0);
                    P6_WLOAD(wB1, wB2, 12); __builtin_amdgcn_sched_barrier(0);
                    P6_LOAD(pf_);
                    __builtin_amdgcn_sched_barrier(0); P6_MMA(wA1, wA2, 8); __builtin_amdgcn_sched_barrier(0);
                    P6_MMA(wB1, wB2, 12);
#pragma unroll
                    for (int r = 0; r < 4; ++r) part[(wave * 8 + r + 4 * hi) * 32 + ti] = acc[r];
                }
                if (dyn && tid == 0) MISC[38] = tk2;
                __syncthreads();
                {
                    const int rr = row_lo + grp * 8 + wave, e = lane & 31; float lgt = 0.f;
#pragma unroll
                    for (int k = 0; k < 8; ++k) lgt += part[(k * 8 + wave) * 32 + e];
                    const float aff = 1.0f / (1.0f + expf(-lgt)); const float sel = aff + rb_e;
                    const float o1 = dppf<0xB1>(sel), mx1 = fmaxf(sel, o1), mn1 = fminf(sel, o1);
                    const float mx2 = dppf<0x4E>(mx1), mn2 = dppf<0x4E>(mn1);
                    float gs = fmaxf(mx1, mx2) + fmaxf(fminf(mx1, mx2), fmaxf(mn1, mn2)); int bg = e >> 2;
                    { const float og = dppf<0x141>(gs); const int ob = dppi<0x141>(bg); if (og > gs || (og == gs && ob < bg)) { gs = og; bg = ob; } }
                    { const float og = dppf<0x140>(gs); const int ob = dppi<0x140>(bg); if (og > gs || (og == gs && ob < bg)) { gs = og; bg = ob; } }
                    { const auto rg = __builtin_amdgcn_permlane16_swap(__float_as_uint(gs), __float_as_uint(gs), false, false); const auto rb = __builtin_amdgcn_permlane16_swap((unsigned)bg, (unsigned)bg, false, false);
                      const bool odd = (lane & 16) != 0; const float og = __uint_as_float(odd ? rg[0] : rg[1]); const int ob = (int)(odd ? rb[0] : rb[1]); if (og > gs || (og == gs && ob < bg)) { gs = og; bg = ob; } }
                    const int bgs = __builtin_amdgcn_readfirstlane(bg);
                    float s4[4], a4[4];
#pragma unroll
                    for (int j = 0; j < 4; ++j) { s4[j] = __uint_as_float((unsigned)__builtin_amdgcn_readlane((int)__float_as_uint(sel), bgs * 4 + j)); a4[j] = __uint_as_float((unsigned)__builtin_amdgcn_readlane((int)__float_as_uint(aff), bgs * 4 + j)); }
                    int i0 = 0; float m0 = s4[0], g0 = a4[0];
#pragma unroll
                    for (int j = 1; j < 4; ++j) if (s4[j] > m0) { m0 = s4[j]; i0 = j; g0 = a4[j]; }
                    int i1 = -1; float m1 = -1e30f, g1_ = 0.f;
#pragma unroll
                    for (int j = 0; j < 4; ++j) if (j != i0 && s4[j] > m1) { m1 = s4[j]; i1 = j; g1_ = a4[j]; }
                    const int e0 = __builtin_amdgcn_readfirstlane(bg * 4 + i0), e1 = __builtin_amdgcn_readfirstlane(bg * 4 + i1);
                    const float inv = 1.0f / (g0 + g1_);
                    if (lane == 0 && rep_ == 0) {
                        if (agg) { const int q0 = __hip_atomic_fetch_add(&lcnt[e0], 1, __ATOMIC_RELAXED, __HIP_MEMORY_SCOPE_WORKGROUP), q1 = __hip_atomic_fetch_add(&lcnt[e1], 1, __ATOMIC_RELAXED, __HIP_MEMORY_SCOPE_WORKGROUP);
                            LAS int* ap = asg + (it_ * 8 + wave) * 8;
                            ap[0] = e0; ap[1] = q0; ap[2] = rr * 2; ap[3] = (int)__float_as_uint(g0 * inv); ap[4] = e1; ap[5] = q1; ap[6] = rr * 2 + 1; ap[7] = (int)__float_as_uint(g1_ * inv);
                        } else {
                            const unsigned p0 = __hip_atomic_fetch_add(&cnt[e0 * 32], 1u, RLX_AGENT), p1 = __hip_atomic_fetch_add(&cnt[e1 * 32], 1u, RLX_AGENT);
                            LIST[(size_t)e0 * MT + p0] = rr * 2; LISTG[(size_t)e0 * MT + p0] = g0 * inv;
                            LIST[(size_t)e1 * MT + p1] = rr * 2 + 1; LISTG[(size_t)e1 * MT + p1] = g1_ * inv; } }
                }
                grp = nxt_; nxt_ = dyn ? gmap(MISC[38]) : seq(it_ + 2);
            }
#undef P6_LOAD
#undef P6_WLOAD
#undef P6_MMA
            __syncthreads();
            if (agg && rep_ == 0) {
                if (tid < 32) lbase[tid] = (int)__hip_atomic_fetch_add(&cnt[tid * 32], (unsigned)lcnt[tid], RLX_AGENT);
                __syncthreads();
                for (int i = tid; i < it_ * 16; i += 512) { const int e = asg[i * 4], q = asg[i * 4 + 1], src = asg[i * 4 + 2]; const float gt = __uint_as_float((unsigned)asg[i * 4 + 3]);
                    const size_t o = (size_t)e * MT + (size_t)(lbase[e] + q); LIST[o] = src; LISTG[o] = gt; }
            }
            __syncthreads();
        }
        SEAM(P6);
        int NT = 0;
        if (IN(P6 + 1) || IN(P6 + 2) || IN(P6 + 3)) {
            CParams* kp = kparams(); unsigned* cnt = WSP(unsigned, WS_CTL) + CW_CNT + layer * 1024;
            const int ttid = otid();
            if (ttid < 64) { const int ln = ttid, e = ln & 31; const int c = (int)__hip_atomic_load(&cnt[e * 32], RLX_AGENT); const int nt_ = (c + 255) >> 8; int inc = nt_;
#pragma unroll
                for (int o = 1; o < 32; o <<= 1) { const int t_ = __shfl_up(inc, o); if ((ln & 31) >= o) inc += t_; }
                if (ln < 32) { tcnt[e] = c; tbase[e] = inc - nt_; if (e == 31) tbase[32] = inc; for (int t_ = inc - nt_; t_ < inc; ++t_) texp[t_] = e; } }
            __syncthreads();
            NT = __builtin_amdgcn_readfirstlane(tbase[32]);
        }
        if (IN(P6 + 2)) _Pragma("unroll 1") for (int rep_ = 0; rep_ < NREP(8); ++rep_) {
            CParams* kp = kparams();
            typedef pg8::SchedMoe<256u * DM * 2u, 256u * DM * 2u, 2048u * DM * 2u, DM / 64, true> Sch;
            LAS int* rt = (LAS int*)(L + TAB_OFF + 1024);
            pg8::Gemm g{DM, DM, DM}; Sch S; S.o.init(NT, 8, ogrid(), obid()); S.A = WSP(const char, WS_H); S.B = WSP(const char, WS_WGU) + (size_t)layer * 32 * 2048 * DM * 2;
            S.texp = texp; S.tbase = tbase; S.tcnt = tcnt; S.rt = rt; S.list = WSP(int, WS_LIST); S.ctr = WSP(unsigned, WS_CTL) + CW_GUD + layer * 8192;
            S.fill_rows(rt, otid());
            pg8::EpiGateUp E{WSP(bf16_t, WS_ACT)};
            pg8::gemm_phase<pg8::EpiGateUp, Sch, true, true>(L, g, S, E);
        }
        if (IN(P6 + 2)) _Pragma("unroll 1") for (int rep_ = 0; rep_ < NREP(9); ++rep_) {
            CParams* kp = kparams();
            typedef pg8::SchedMoe<256u * DE * 2u, 256u * DE * 2u, (unsigned)DM * DE * 2u, DE / 64, false> Sch;
            pg8::Gemm g{DE, DE, DE}; Sch S; S.o.init(NT, 8, ogrid(), obid()); S.o.rot = 1; S.rem = (NT * 8) % ogrid(); S.nl = ogrid() - S.rem; S.A = WSP(const char, WS_ACT); S.B = WSP(const char, WS_WD) + (size_t)layer * 32 * DM * DE * 2;
            LAS int* rt = (LAS int*)(L + TAB_OFF + 1024);
            S.texp = texp; S.tbase = tbase; S.tcnt = tcnt; S.rt = nullptr; S.list = WSP(int, WS_LIST); S.ctr = WSP(unsigned, WS_CTL) + CW_GUD + layer * 8192;
            if (otid() == 0) { __builtin_amdgcn_fence(__ATOMIC_ACQUIRE, "agent"); asm volatile("s_waitcnt vmcnt(0)" ::: "memory"); }
            S.fill_dst(rt, WSP(float, WS_LIST) + (size_t)32 * MT, otid());
            pg8::EpiDown E{WSP(bf16_t, WS_FB), rt};
            pg8::gemm_phase<pg8::EpiDown, Sch, true, false>(L, g, S, E);
        }
        SEAM(P6 + 3);
        if (IN(P6 + 4)) _Pragma("unroll 1") for (int rep_ = 0; rep_ < NREP(10); ++rep_) {
            CParams* kp = kparams(); TIDS;
            const int row_lo = layer == 0 ? 0 : NCTX;
            const float* modl = WSP(float, WS_MOD) + (size_t)layer * 3 * 12288; const float* X1 = WSP(float, WS_X1); const bf16_t* FB = WSP(bf16_t, WS_FB);
            float* dstb = kp->out - (size_t)NCTX * DM; bf16_t* X2b = WSP(bf16_t, WS_X2);
            LAS float* vG2 = (LAS float*)L; LAS float* vLG = vG2 + 3 * DM; LAS float* vLB = vLG + DM;
            { const float* lg = kp->ln_g + (size_t)(layer * 2 + 1) * DM; const float* lb = kp->ln_b + (size_t)(layer * 2 + 1) * DM;
              float t0[12], t1[4], t2[4];
#pragma unroll
              for (int q = 0; q < 12; ++q) { const int i = tid + q * 512; t0[q] = modl[(size_t)(i >> 11) * 12288 + 5 * DM + (i & 2047)]; }
#pragma unroll
              for (int q = 0; q < 4; ++q) { const int i = tid + q * 512; t1[q] = lg[i]; t2[q] = lb[i]; }
#pragma unroll
              for (int q = 0; q < 12; ++q) vG2[tid + q * 512] = t0[q];
#pragma unroll
              for (int q = 0; q < 4; ++q) { vLG[tid + q * 512] = t1[q]; vLB[tid + q * 512] = t2[q]; } }
            __syncthreads();
            f32x4 xa[8]; v2u fa[8], fb[8];
#define P10_LOAD(row_) do { const float* xr_ = X1 + (size_t)(row_) * DM; const bf16_t* xb_ = (const bf16_t*)X1 + (size_t)(row_) * DM; const bf16_t* f0_ = FB + (size_t)((row_) * 2) * DM; \
                _Pragma("unroll") for (int j = 0; j < 8; ++j) { const int c = (j * 64 + lane) * 4; \
                    { const v2u q_ = *(const v2u*)(xb_ + c); xa[j] = (f32x4){bf2f(q_.x & 0xffffu), bf2f(q_.x >> 16), bf2f(q_.y & 0xffffu), bf2f(q_.y >> 16)}; } \
                    fa[j] = *(const v2u*)(f0_ + c); fb[j] = *(const v2u*)(f0_ + DM + c); } } while (0)
            { const int r0 = row_lo + gw; P10_LOAD(r0 < MT ? r0 : row_lo); }
            for (int row = row_lo + gw; row < MT; row += NGW) { const int cd = row_cond(row);
                f32x4 v[8]; float s = 0.f;
#pragma unroll
                for (int j = 0; j < 8; ++j) { const int c = (j * 64 + lane) * 4;
                    const f32x4 fs = {bf2f(fa[j].x & 0xffffu) + bf2f(fb[j].x & 0xffffu), bf2f(fa[j].x >> 16) + bf2f(fb[j].x >> 16), bf2f(fa[j].y & 0xffffu) + bf2f(fb[j].y & 0xffffu), bf2f(fa[j].y >> 16) + bf2f(fb[j].y >> 16)};
                    v[j] = xa[j] * ALPHA + *(const LAS f32x4*)(vG2 + cd * DM + c) * fs; s += (v[j][0] + v[j][1]) + (v[j][2] + v[j][3]); }
                if (row + NGW < MT) P10_LOAD(row + NGW);
                const float mean = wave_sum(s) * (1.0f / DM); float s2 = 0.f;
#pragma unroll
                for (int j = 0; j < 8; ++j) { v[j] = v[j] - mean; s2 += (v[j][0] * v[j][0] + v[j][1] * v[j][1]) + (v[j][2] * v[j][2] + v[j][3] * v[j][3]); }
                const float rstd = 1.0f / sqrtf(wave_sum(s2) * (1.0f / DM) + LN_EPS);
                float* dst = dstb + (size_t)row * DM;
#pragma unroll
                for (int j = 0; j < 8; ++j) { const int c = (j * 64 + lane) * 4; const f32x4 r_ = v[j] * rstd * *(const LAS f32x4*)(vLG + c) + *(const LAS f32x4*)(vLB + c);
                    if (layer == 0) { v2u w; w.x = pk2(r_[0], r_[1]); w.y = pk2(r_[2], r_[3]); *(v2u*)(X2b + (size_t)row * DM + c) = w; } else *(f32x4*)(dst + c) = r_; } }
#undef P10_LOAD
            __syncthreads();
        }
        if constexpr (layer == 0) {
            SEAM(10);
            if (IN(11)) _Pragma("unroll 1") for (int rep_ = 0; rep_ < NREP(11); ++rep_) {
                CParams* kp = kparams(); TIDS;
                const bf16_t* X2 = WSP(bf16_t, WS_X2); bf16_t* DP = WSP(bf16_t, WS_DP);
                const float* sc1 = WSP(float, WS_MOD) + (size_t)3 * 12288 + DM;
                const int c = tid * 4, gch = c >> 9, hw = 1 << gch;
                for (int chunk = bx; chunk < NLAT / 64; chunk += G) { const int b = chunk >> 7, t0 = (chunk & 127) * 64;
                    const bf16_t* base = X2 + ((size_t)NCTX + (size_t)b * SEQ) * DM + c; bf16_t* dbase = DP + ((size_t)NCTX + (size_t)b * SEQ) * DM + c;
                    const f32x4 a1 = *(const f32x4*)(sc1 + (size_t)b * 12288 + c) + 1.0f;
                    f32x4 s = {0, 0, 0, 0};
                    { v2u wv[16];
#pragma unroll
                      for (int q = 0; q < 16; ++q) { const int p_ = t0 - 8 + q; wv[q] = *(const v2u*)(base + (size_t)(p_ < 0 ? 0 : p_) * DM); }
#pragma unroll
                      for (int q = 0; q < 16; ++q) { const int p_ = t0 - 8 + q; const bool in_ = p_ >= 0 && p_ >= t0 - hw && p_ < t0 + hw; s += bf4(wv[q]) * (in_ ? 1.0f : 0.0f); } }
#pragma unroll 8
                    for (int i = 0; i < 64; ++i) { const int t = t0 + i; const int tn = t + hw, to = t - hw;
                        const f32x4 xc = bf4(*(const v2u*)(base + (size_t)t * DM));
                        const f32x4 xn = bf4(*(const v2u*)(base + (size_t)(tn < SEQ ? tn : SEQ - 1) * DM)), xo = bf4(*(const v2u*)(base + (size_t)(to >= 0 ? to : 0) * DM));
                        const int lo_ = to < 0 ? 0 : to, hi_ = tn > SEQ ? SEQ : tn;
                        const f32x4 d = a1 * (s * (1.0f / (float)(hi_ - lo_)) - xc);
                        v2u w; w.x = pk2(d[0], d[1]); w.y = pk2(d[2], d[3]); *(v2u*)(dbase + (size_t)t * DM) = w;
                        s = s + xn * (tn < SEQ ? 1.0f : 0.0f) - xo * (to >= 0 ? 1.0f : 0.0f); }
                }
            }
            SEAM(11);
            if (IN(12)) _Pragma("unroll 1") for (int rep_ = 0; rep_ < NREP(12); ++rep_) {
                CParams* kp = kparams();
                pg8::Gemm g{DM, 512, 512}; pg8::SchedPool S; S.o.init(NLAT / 256, 8, ogrid(), obid()); S.A = WSP(const char, WS_DP); S.B = WSP(const char, WS_WPOOL);
                pg8::EpiBf16 E{WSP(bf16_t, WS_Y), DM, nullptr};
                pg8::gemm_phase<pg8::EpiBf16, pg8::SchedPool, true, false>(L, g, S, E);
            }
            SEAM(12);
        }
    }

__global__ void __launch_bounds__(512, 2) mk_fwd(Params p_unused) {
    extern __shared__ __attribute__((aligned(16))) unsigned char lds[];
    LAS unsigned char* L = (LAS unsigned char*)lds;
    volatile LAS unsigned* MISC = (volatile LAS unsigned*)(L + MISC_OFF);
    LAS int* tcnt = (LAS int*)(L + TAB_OFF); LAS int* tbase = tcnt + 32; LAS int* texp = tcnt + 80;
    if (threadIdx.x < 64) MISC[threadIdx.x] = 0u;
    __syncthreads();
    int lo, hi; XcdBarrier bar;
    { CParams* kp = kparams(); lo = kp->ph_lo; hi = kp->ph_hi; unsigned* bw = (unsigned*)(kp->ws + WS_CTL) + CW_BAR;
      bar.bar = bw; bar.x = 0; bar.st = nullptr; if (hi - lo > 1) bar = xcd_barrier_post(bw, MISC + 8); }
    if (IN(0)) _Pragma("unroll 1") for (int rep_ = 0; rep_ < NREP(0); ++rep_) {
        CParams* kp = kparams(); TIDS;
        float* MOD = WSP(float, WS_MOD); float* ROPE = WSP(float, WS_ROPE);
        for (int i = bx * 512 + tid; i < 4096; i += G * 512) { const int pos = i >> 5, pp = i & 31;
            const float inv = exp2f(-(float)pp * (13.287712379549449f / 32.0f)); const float ang = (float)pos * inv;
            float sn, cs; sincosf(ang, &sn, &cs); ROPE[i] = cs; ROPE[4096 + i] = sn; }
        { const float* wrt = kp->w_router; bf16_t* WR = WSP(bf16_t, WS_WR);
          for (int i = bx * 512 + tid; i < 32 * DM; i += G * 512) { const int ii = i & 7, ln = (i >> 3) & 63, kq = (i >> 9) & 15, w = i >> 13; const int e = ln & 31, k = w * 256 + kq * 16 + 8 * (ln >> 5) + ii;
              const float wv = wrt[k * 32 + e]; const unsigned h1 = f2bf(wv); const unsigned h2 = f2bf(wv - bf2f(h1)); WR[i] = (bf16_t)h1; WR[32 * DM + i] = (bf16_t)h2; } }
        {
            LAS float* sv = (LAS float*)L;
            LAS float* red = (LAS float*)(L + 32768);
            mod_prepare(kp->c, kp->c_ctx, sv, tid);
            for (int it = bx; it < 384; it += G) mod_item(it, kp->w_mod, kp->b_mod, MOD, sv, red, tid, lane, wave);
        }
        {
            LAS float* scr = (LAS float*)(L + wave * 16384);
            constexpr int I_QKV = (DM / 64) * (QKVD / 32), I_O = (DM / 64) * (DM / 32), I_P = (512 / 64) * (512 / 32), I_G = (DM / 64) * (DE / 32), I_D = (DE / 64) * (DM / 32);
            constexpr int NITEMS = I_QKV + I_O + 4 * I_P;
            (void)I_G; (void)I_D;
            auto decode = [&](int it) { TItem d; int r = it;
                if (r < I_QKV) { d.W = kp->w_qkv; d.WT = WSP(bf16_t, WS_WQKV); d.K = DM; d.N = QKVD; d.kind = 0; }
                else if ((r -= I_QKV) < I_O) { d.W = kp->w_o; d.WT = WSP(bf16_t, WS_WO); d.K = DM; d.N = DM; d.kind = 0; }
                else { r -= I_O; const int g = r / I_P; r -= g * I_P; d.W = kp->w_pool + (size_t)g * 512 * 512; d.WT = WSP(bf16_t, WS_WPOOL) + (size_t)g * 512 * 512; d.K = 512; d.N = 512; d.kind = 0; }
                const int nblk = d.N / 32; d.k0 = 64 * (r / nblk); d.n0 = 32 * (r % nblk); return d; };
            for (int it = gw; it < NITEMS; it += 2 * NGW) {
                const TItem d0 = decode(it); f32x4 ra[8], rb[8]; t_load(d0, ra, lane);
                const bool two = it + NGW < NITEMS; TItem d1 = d0; if (two) { d1 = decode(it + NGW); t_load(d1, rb, lane); }
                t_store(d0, ra, scr, lane); if (two) t_store(d1, rb, scr, lane);
            }
        }
        __syncthreads();
    }
    SEAM(0);

    if (IN(1)) _Pragma("unroll 1") for (int rep_ = 0; rep_ < NREP(1); ++rep_) {
        CParams* kp = kparams(); TIDS;
        const float* MOD = WSP(float, WS_MOD); bf16_t* U = WSP(bf16_t, WS_U); const float* xl = kp->x; const float* xc = kp->ctx;
        const int R = (MT + NGW - 1) / NGW, r0 = gw * R, r1 = (r0 + R) < MT ? (r0 + R) : MT;
        f32x4 sa[8], sb[8], xv[8]; int cur = -1;
#define P1_LOAD(row_) do { const float* xr_ = ((row_) < NCTX) ? xc + (size_t)(row_) * DM : xl + (size_t)((row_) - NCTX) * DM; _Pragma("unroll") for (int j = 0; j < 8; ++j) xv[j] = *(const f32x4*)(xr_ + (j * 64 + lane) * 4); } while (0)
        if (r0 < r1) P1_LOAD(r0); else P1_LOAD(0);
        for (int row = r0; row < r1; ++row) { const int cd = row_cond(row);
            if (cd != cur) { const float* sh = MOD + (size_t)cd * 12288; const float* sc = sh + DM;
#pragma unroll
                for (int j = 0; j < 8; ++j) { const int c = (j * 64 + lane) * 4; sa[j] = *(const f32x4*)(sc + c) + 1.0f; sb[j] = *(const f32x4*)(sh + c); }
                cur = cd; }
            f32x4 o[8];
#pragma unroll
            for (int j = 0; j < 8; ++j) o[j] = xv[j] * sa[j] + sb[j];
            if (row + 1 < r1) P1_LOAD(row + 1);
#pragma unroll
            for (int j = 0; j < 8; ++j) { const int c = (j * 64 + lane) * 4; v2u w; w.x = pk2(o[j][0], o[j][1]); w.y = pk2(o[j][2], o[j][3]); *(v2u*)(U + (size_t)row * DM + c) = w; } }
#undef P1_LOAD
    }
    SEAM(1);

    if (IN(2)) _Pragma("unroll 1") for (int rep_ = 0; rep_ < NREP(2); ++rep_) {
        CParams* kp = kparams();
        typedef pg8::SchedSplit<256u * DM * 2u, 256u * DM * 2u, DM / 64, QKVD / 256> Sch;
        pg8::Gemm g{DM, DM, DM}; Sch S; S.init(ogrid(), obid()); S.A = WSP(const char, WS_U); S.B = WSP(const char, WS_WQKV);
        pg8::EpiQkv E{WSP(bf16_t, WS_QKVR), QKVD, WSP(float, WS_PQ), WSP(bf16_t, WS_V)};
        pg8::gemm_phase<pg8::EpiQkv, Sch, true, false>(L, g, S, E);
    }
    SEAM(2);

    if (IN(3)) _Pragma("unroll 1") for (int rep_ = 0; rep_ < NREP(3); ++rep_) {
        CParams* kp = kparams(); TIDS;
        const float* ROPE = WSP(float, WS_ROPE); const bf16_t* QKVR = WSP(bf16_t, WS_QKVR); bf16_t* Qb = WSP(bf16_t, WS_Q); bf16_t* Kb = WSP(bf16_t, WS_K); bf16_t* Vb = WSP(bf16_t, WS_V);
        const int sub = lane >> 4, l16 = lane & 15, d0 = l16 * 8, ax = l16 >> 3, hh = (l16 >> 2) & 1, p0 = (l16 & 3) * 8;
        const bool split3 = ((64 * (QKVD / 256)) % G == 0) && (2 * (QKVD / 256) * 8 <= G);
        const float* PQ = WSP(float, WS_PQ);
        float qg[8], kg[8];
        { const float* qgn = kp->q_gain; const float* kgn = kp->k_gain;
#pragma unroll
          for (int i = 0; i < 8; ++i) { qg[i] = qgn[d0 + i]; kg[i] = kgn[d0 + i]; } }
        v4u rw[6];
#define P3_LOAD(row_) do { const bf16_t* s_ = QKVR + (size_t)(row_) * QKVD + sub * 128 + d0; const bool all_ = (row_) < NCTX; _Pragma("unroll") for (int it = 0; it < 6; ++it) if (it == 4 || all_) rw[it] = *(const v4u*)(s_ + it * 512); } while (0)
        for (int r4 = NCTX + gw * 4; r4 < MT; r4 += NGW * 4) {
            v4u kr[4]; f32x4 c0[4], c1[4], s0[4], s1[4];
#pragma unroll
            for (int q = 0; q < 4; ++q) { const int row = r4 + q, t = (row - NCTX) & 8191; kr[q] = *(const v4u*)(QKVR + (size_t)row * QKVD + 2048 + sub * 128 + d0);
                const int pos = ax ? (t & 63) : (t >> 6); const float* cp_ = ROPE + pos * 32 + p0; c0[q] = *(const f32x4*)cp_; c1[q] = *(const f32x4*)(cp_ + 4); s0[q] = *(const f32x4*)(cp_ + 4096); s1[q] = *(const f32x4*)(cp_ + 4100); }
#pragma unroll
            for (int q = 0; q < 4; ++q) { const int row = r4 + q, lr = row - NCTX, b = lr >> 13, kpos = CTXL + (lr & 8191); const v4u raw = kr[q];
                float f[8], cs[8], sn[8];
#pragma unroll
                for (int i = 0; i < 4; ++i) { f[2 * i] = bf2f(raw[i] & 0xffffu); f[2 * i + 1] = bf2f(raw[i] >> 16); cs[i] = c0[q][i]; cs[4 + i] = c1[q][i]; sn[i] = hh ? s0[q][i] : -s0[q][i]; sn[4 + i] = hh ? s1[q][i] : -s1[q][i]; }
                float ss = 0.f;
#pragma unroll
                for (int i = 0; i < 8; ++i) ss += f[i] * f[i];
                ss += __shfl_xor(ss, 1); ss += __shfl_xor(ss, 2); ss += __shfl_xor(ss, 4); ss += __shfl_xor(ss, 8);
                const float r = 1.0f / sqrtf(ss * (1.0f / 128.0f) + RMS_EPS);
                float o[8];
#pragma unroll
                for (int i = 0; i < 8; ++i) { const float y = f[i] * r * kg[i]; const float pr = __shfl_xor(y, 4); o[i] = y * cs[i] + pr * sn[i]; }
                v4u w; w.x = pk2(o[0], o[1]); w.y = pk2(o[2], o[3]); w.z = pk2(o[4], o[5]); w.w = pk2(o[6], o[7]);
                *(v4u*)(Kb + (((size_t)b * NKV + sub) * SKV + kpos) * HD + d0) = w; }
        }
        P3_LOAD(gw < NCTX ? gw : 0);
        for (int row = gw; row < NCTX; row += NGW) {
            const bool lat = row >= NCTX; const int lr = row - NCTX; const int b = lat ? (lr >> 13) : (row >> 8); const int t = lat ? (lr & 8191) : 0;
            const int kpos = lat ? (CTXL + t) : (row & 255);
            v4u cur[6];
#pragma unroll
            for (int it = 0; it < 6; ++it) cur[it] = rw[it];
            if (row + NGW < NCTX) P3_LOAD(row + NGW);
            float cs[8], sn[8];
#pragma unroll
            for (int i = 0; i < 8; ++i) { cs[i] = 1.f; sn[i] = 0.f; }
            if (lat) { const int pos = ax ? (t & 63) : (t >> 6); const float* cp_ = ROPE + pos * 32 + p0;
                const f32x4 c0 = *(const f32x4*)cp_, c1 = *(const f32x4*)(cp_ + 4), s0 = *(const f32x4*)(cp_ + 4096), s1 = *(const f32x4*)(cp_ + 4100);
#pragma unroll
                for (int i = 0; i < 4; ++i) { cs[i] = c0[i]; cs[4 + i] = c1[i]; sn[i] = hh ? s0[i] : -s0[i]; sn[4 + i] = hh ? s1[i] : -s1[i]; } }
#pragma unroll
            for (int it = 0; it < 6; ++it) { const int h = it * 4 + sub;
                if (lat && it != 4) continue;
                if (it == 5 && !split3) continue;
                float f[8]; v4u raw;
                if (!lat && split3) {
                    f32x4 q0[8]; const float* pp_ = PQ + (size_t)row * QKVD + h * 128 + d0;
#pragma unroll
                    for (int ks = 0; ks < 8; ++ks) q0[ks] = *(const f32x4*)(pp_ + (size_t)ks * 512 * QKVD);
                    f32x4 a0 = q0[0];
#pragma unroll
                    for (int ks = 1; ks < 8; ++ks) a0 += q0[ks];
#pragma unroll
                    for (int ks = 0; ks < 8; ++ks) q0[ks] = *(const f32x4*)(pp_ + (size_t)ks * 512 * QKVD + 4);
                    f32x4 a1 = q0[0];
#pragma unroll
                    for (int ks = 1; ks < 8; ++ks) a1 += q0[ks];
#pragma unroll
                    for (int i = 0; i < 4; ++i) { f[i] = a0[i]; f[4 + i] = a1[i]; }
                    raw.x = pk2(f[0], f[1]); raw.y = pk2(f[2], f[3]); raw.z = pk2(f[4], f[5]); raw.w = pk2(f[6], f[7]);
#pragma unroll
                    for (int i = 0; i < 4; ++i) { f[2 * i] = bf2f(raw[i] & 0xffffu); f[2 * i + 1] = bf2f(raw[i] >> 16); }
                } else { raw = cur[it];
#pragma unroll
                    for (int i = 0; i < 4; ++i) { f[2 * i] = bf2f(raw[i] & 0xffffu); f[2 * i + 1] = bf2f(raw[i] >> 16); } }
                if (it == 5) { *(v4u*)(Vb + (((size_t)b * NKV + (h - 20)) * SKV + kpos) * HD + d0) = raw; continue; }
                float ss = 0.f;
#pragma unroll
                for (int i = 0; i < 8; ++i) ss += f[i] * f[i];
                ss += __shfl_xor(ss, 1); ss += __shfl_xor(ss, 2); ss += __shfl_xor(ss, 4); ss += __shfl_xor(ss, 8);
                const float r = 1.0f / sqrtf(ss * (1.0f / 128.0f) + RMS_EPS);
                float o[8];
#pragma unroll
                for (int i = 0; i < 8; ++i) { const float y = f[i] * r * (it < 4 ? qg[i] : kg[i]); const float pr = __shfl_xor(y, 4); o[i] = y * cs[i] + pr * sn[i]; }
                v4u w; w.x = pk2(o[0], o[1]); w.y = pk2(o[2], o[3]); w.z = pk2(o[4], o[5]); w.w = pk2(o[6], o[7]);
                bf16_t* d = (it < 4) ? Qb + (size_t)row * DM + h * 128 + d0 : Kb + (((size_t)b * NKV + (h - 16)) * SKV + kpos) * HD + d0;
                *(v4u*)d = w; }
        }
#undef P3_LOAD
    }
    SEAM(3);

    if (IN(4)) _Pragma("unroll 1") for (int rep_ = 0; rep_ < NREP(4); ++rep_) {
        CParams* kp = kparams();
        const bf16_t* Qb = WSP(bf16_t, WS_Q); const bf16_t* Kb = WSP(bf16_t, WS_K); const bf16_t* Vb = WSP(bf16_t, WS_V); bf16_t* Ob = WSP(bf16_t, WS_O);
        const bf16_t* QKVR = WSP(bf16_t, WS_QKVR); const float* ROPE = WSP(float, WS_ROPE); const float* qgn = kp->q_gain;
        const int G = ogrid(), bx = obid(); const bool fast = (G % 8) == 0;
        const int NR = fast ? (G >> 3) : G, rank = fast ? (bx >> 3) : bx, tot = fast ? 132 : 1056;
        const bool split = fast && NR == 32; const int NA = split ? 26 : NR;
        if (rank < NA) for (int i = 0;; ++i) {
            int w = rank + NA * i;
            if (split && i == 5) w = rank >= 24 ? rank + 106 : tot;
            if (w >= tot) break;
            const int combo = fast ? (bx & 7) : (w / 132), ww = fast ? w : (w % 132), b = combo >> 2, kvh = combo & 3;
            const bool isl = ww < 128; const int rbk = ww >> 2; const int h = kvh * 4 + (isl ? (ww & 3) : (ww - 128));
            const size_t row0 = isl ? ((size_t)NCTX + (size_t)b * SEQ + (size_t)rbk * 256) : ((size_t)b * CTXL);
            if (isl) att::attn_dma_body(QKVR + row0 * QKVD + h * HD, QKVD, rbk * 256, ROPE, qgn, Kb + (size_t)combo * SKV * HD, Vb + (size_t)combo * SKV * HD, Ob + row0 * DM + h * HD, SKV, (char*)lds);
            else att::attn_dma_body(Qb + row0 * DM + h * HD, DM, -1, ROPE, qgn, Kb + (size_t)combo * SKV * HD, Vb + (size_t)combo * SKV * HD, Ob + row0 * DM + h * HD, CTXL, (char*)lds);
            if (otid() == 0) { asm volatile("s_waitcnt vmcnt(0)" ::: "memory");
                (void)xb_add(WSP(unsigned, WS_CTL) + CW_DONE + 32 * (isl ? (b * 32 + rbk) : (64 + b)), 1u); }
        }
        {
            const int tid = otid(), lane = tid & 63, wave = __builtin_amdgcn_readfirstlane(tid >> 6);
            unsigned* mq = WSP(unsigned, WS_CTL) + CW_MQ; bool prepared = false;
            for (;;) {
                if (tid == 0) MISC[34] = xb_add(mq, 1u);
                __syncthreads();
                const unsigned t = MISC[34];
                __syncthreads();
                if (t >= 384u) break;
                if (!prepared) { mod_prepare(kp->c, kp->c_ctx, (LAS float*)L, tid); prepared = true; }
                mod_item(384 + (int)t, kp->w_mod, kp->b_mod, WSP(float, WS_MOD), (const LAS float*)L, (LAS float*)(L + 32768), tid, lane, wave);
            }
        }
        {
            const int tid = otid(), lane = tid & 63, wave = __builtin_amdgcn_readfirstlane(tid >> 6);
            LAS float* scr = (LAS float*)(L + wave * 16384);
            unsigned* qc = WSP(unsigned, WS_CTL) + CW_Q;
            constexpr int I_G = (DM / 64) * (DE / 32), I_D = (DE / 64) * (DM / 32), PER = 2 * I_G + I_D; constexpr unsigned NTICK = 64u * PER / 2u;
            auto decode = [&](int it) { TItem d; const int le = it / PER; int r = it - le * PER;
                if (r < I_G) { d.W = kp->w_gate + (size_t)le * DM * DE; d.WT = WSP(bf16_t, WS_WGU) + (size_t)le * 2048 * DM; d.K = DM; d.N = DE; d.kind = 1; }
                else if ((r -= I_G) < I_G) { d.W = kp->w_up + (size_t)le * DM * DE; d.WT = WSP(bf16_t, WS_WGU) + (size_t)le * 2048 * DM; d.K = DM; d.N = DE; d.kind = 2; }
                else { r -= I_G; d.W = kp->w_down + (size_t)le * DE * DM; d.WT = WSP(bf16_t, WS_WD) + (size_t)le * DM * DE; d.K = DE; d.N = DM; d.kind = 0; }
                const int nblk = d.N / 32; d.k0 = 64 * (r / nblk); d.n0 = 32 * (r % nblk); return d; };
            auto grab = [&]() { unsigned t = 0; if (lane == 0) t = __hip_atomic_fetch_add(qc, 1u, __ATOMIC_RELAXED, __HIP_MEMORY_SCOPE_AGENT); return (unsigned)__builtin_amdgcn_readfirstlane((int)t); };
            unsigned tk = grab();
            while (tk < NTICK) {
                const unsigned nx = grab();
                const TItem d0 = decode((int)(2u * tk)); TItem d1 = d0; d1.n0 += 32;
                f32x4 ra[8], rb[8]; t_load(d0, ra, lane); t_load(d1, rb, lane);
                t_store(d0, ra, scr, lane); t_store(d1, rb, scr, lane);
                tk = nx;
            }
        }
        __syncthreads();
        {
            unsigned* wq = WSP(unsigned, WS_CTL) + CW_WQ; unsigned* done = WSP(unsigned, WS_CTL) + CW_DONE; unsigned* yd = WSP(unsigned, WS_CTL) + CW_YD; unsigned* bw = WSP(unsigned, WS_CTL) + CW_BAR;
            const char* Oc = WSP(const char, WS_O); const char* Wc = WSP(const char, WS_WO);
            pg8::Gemm g{DM, DM, DM}; pg8::EpiBf16W E{WSP(bf16_t, WS_Y), DM};
            int tail = obid(); bool queue = true;
            for (;;) {
                if (otid() == 0) { int pm = -1, pn = 0, fl = 0;
                    if (queue) { const unsigned t = xb_add(wq, 1u);
                        if (t < 416u) { const int rbk = (int)t >> 4, b = ((int)t >> 3) & 1; pn = (int)t & 7; pm = 2 + b * 32 + rbk; fl = b * 32 + rbk; }
                        else if (t < 432u) { const int c = (int)t - 416; pm = c >> 3; pn = c & 7; fl = 64 + pm; } }
                    else if (tail < 96) { const int rbk = 26 + (tail >> 4), b = (tail >> 3) & 1; pn = tail & 7; pm = 2 + b * 32 + rbk; fl = b * 32 + rbk; }
                    if (pm >= 0) { XB_SPIN(xb_ld(&done[32 * fl]) < 16u, bw);
                        __builtin_amdgcn_fence(__ATOMIC_ACQUIRE, "agent"); asm volatile("s_waitcnt vmcnt(0)" ::: "memory"); }
                    MISC[32] = (unsigned)pm; MISC[33] = (unsigned)pn; }
                __syncthreads();
                const int pm = (int)MISC[32], pn = (int)MISC[33];
                __syncthreads();
                if (pm < 0) { if (!queue) break; queue = false; continue; }
                pg8::SchedOne S; S.u.A = Oc + (size_t)((unsigned)pm * (256u * DM * 2u)); S.u.B = Wc + (size_t)((unsigned)pn * (256u * DM * 2u)); S.u.pm = pm; S.u.pn = pn; S.u.aux = 0; S.u.kt = DM / 64; S.u.rb = 0; S.u.cn = 0; S.u.ui = 0;
                pg8::gemm_phase<pg8::EpiBf16W, pg8::SchedOne, true, false>(L, g, S, E);
                if (otid() == 0) (void)xb_add(&yd[32 * pm], 1u);
                if (!queue) tail += ogrid();
            }
        }
    }


    layer_half<0>(lo, hi, bar, L, tcnt, tbase, texp);
    layer_half<1>(lo, hi, bar, L, tcnt, tbase, texp);
#undef IN
#undef SEAM
#undef TIDS
}

extern "C" void kernel_launch(void* const* d_in, const int* in_sizes, int n_in, void* d_out, int out_size, void* d_ws, size_t ws_size, hipStream_t stream) {
    static int grid = 0;
    if (grid == 0) {
        if (n_in != 19 || in_sizes[0] != NLAT * DM || out_size != NLAT * DM || ws_size < WS_END) {
            fprintf(stderr, "kernel_launch: shape mismatch: n_in %d in0 %d out %d ws %zu (need %zu); nothing launched\n", n_in, n_in > 0 ? in_sizes[0] : -1, out_size, ws_size, (size_t)WS_END); grid = -1; return; }
        int dev = 0, cus = 0, per_cu = 0;
        if (hipGetDevice(&dev) != hipSuccess || hipDeviceGetAttribute(&cus, hipDeviceAttributeMultiprocessorCount, dev) != hipSuccess) { fprintf(stderr, "kernel_launch: device query failed\n"); grid = -1; return; }
        if (hipFuncSetAttribute((const void*)mk_fwd, hipFuncAttributeMaxDynamicSharedMemorySize, LDS_BYTES) != hipSuccess) { fprintf(stderr, "kernel_launch: hipFuncSetAttribute failed\n"); grid = -1; return; }
        if (hipOccupancyMaxActiveBlocksPerMultiprocessor(&per_cu, (const void*)mk_fwd, 512, LDS_BYTES) != hipSuccess || per_cu < 1)
            fprintf(stderr, "kernel_launch: note: occupancy query reports %d workgroups per CU\n", per_cu);
        (void)hipGetLastError();
        if (cus * (pg8::RT_UNITS / 2) < MAXT * 8) { fprintf(stderr, "kernel_launch: %d CUs: the MoE phases' per-workgroup LDS row tables are sized for >= %d workgroups; nothing launched\n", cus, (MAXT * 8 + pg8::RT_UNITS / 2 - 1) / (pg8::RT_UNITS / 2)); grid = -1; return; }
        grid = cus;
    }
    if (grid < 0) return;
    if (hipMemsetAsync((char*)d_ws + WS_CTL, 0, CTL_ZERO_BYTES, stream) != hipSuccess) { fprintf(stderr, "kernel_launch: memset failed\n"); return; }
    Params p{};
    p.x = (const float*)d_in[0]; p.c = (const float*)d_in[1]; p.ctx = (const float*)d_in[2]; p.c_ctx = (const float*)d_in[3]; p.w_mod = (const float*)d_in[4]; p.b_mod = (const float*)d_in[5];
    p.ln_g = (const float*)d_in[6]; p.ln_b = (const float*)d_in[7]; p.w_qkv = (const float*)d_in[8]; p.q_gain = (const float*)d_in[9]; p.k_gain = (const float*)d_in[10]; p.w_o = (const float*)d_in[11];
    p.w_pool = (const float*)d_in[12]; p.pool_scale = (const float*)d_in[13]; p.w_router = (const float*)d_in[14]; p.router_bias = (const float*)d_in[15];
    p.w_gate = (const float*)d_in[16]; p.w_up = (const float*)d_in[17]; p.w_down = (const float*)d_in[18];
    p.out = (float*)d_out; p.ws = (unsigned char*)d_ws;
#if MK_PER_PHASE
    for (int k = 0; k < NPHASE; ++k) { p.ph_lo = k; p.ph_hi = k + 1;
        hipLaunchKernelGGL(mk_fwd, dim3(grid), dim3(512), LDS_BYTES, stream, p);
        const hipError_t le = hipPeekAtLastError(); if (le != hipSuccess) { fprintf(stderr, "kernel_launch: launch %d failed: %s\n", k, hipGetErrorName(le)); break; } }
#else
    p.ph_lo = 0; p.ph_hi = NPHASE;
    hipLaunchKernelGGL(mk_fwd, dim3(grid), dim3(512), LDS_BYTES, stream, p);
    const hipError_t le = hipPeekAtLastError(); if (le != hipSuccess) fprintf(stderr, "kernel_launch: launch failed: %s\n", hipGetErrorName(le));
#endif
}
```

```cpp
#include <hip/hip_runtime.h>
#include <cstdio>
#include <cstdint>

#ifndef REP_MASK
#define REP_MASK 0
#endif
#ifndef MK_PER_PHASE
#define MK_PER_PHASE 0
#endif

constexpr int DM = 2048, NB = 2, SEQ = 8192, CTXL = 256;
constexpr int NCTX = NB * CTXL, NLAT = NB * SEQ, MT = NCTX + NLAT;
constexpr int NH = 16, NKV = 4, HD = 128, KVD = NKV * HD, QKVD = DM + 2 * KVD;
constexpr int SKV = CTXL + SEQ;
constexpr int NE = 32, DE = 1024;
constexpr int MAXT = 164, NSLOT = MAXT * 256;
constexpr float ALPHA = 1.41421356237309515f;
constexpr float LN_EPS = 1e-6f, RMS_EPS = 1e-6f;
constexpr int NPHASE = 18;

constexpr size_t MiB = 1u << 20;
constexpr size_t WS_CTL = 0, CTL_ZERO_BYTES = 1 * MiB;
constexpr size_t WS_MOD = 1 * MiB;
constexpr size_t WS_ROPE = WS_MOD + 512 * 1024;
constexpr size_t WS_WR = WS_MOD + 768 * 1024;
constexpr size_t WS_WQKV = 2 * MiB;
constexpr size_t WS_WO = 14 * MiB;
constexpr size_t WS_WPOOL = 22 * MiB;
constexpr size_t WS_WGU = 24 * MiB;
constexpr size_t WS_WD = 536 * MiB;
constexpr size_t WS_Y = 792 * MiB;
constexpr size_t WS_X1 = 924 * MiB;
constexpr size_t WS_X2 = 1056 * MiB;
constexpr size_t WS_H = 1188 * MiB;
constexpr size_t WS_LIST = 1254 * MiB;
constexpr size_t WS_SLOT = 1259 * MiB;
constexpr size_t WS_SH = 1260 * MiB;
constexpr size_t WS_U = WS_SH;
constexpr size_t WS_QKVR = WS_SH + 66 * MiB;
constexpr size_t WS_Q = WS_SH + 165 * MiB;
constexpr size_t WS_K = WS_SH + 231 * MiB;
constexpr size_t WS_V = WS_SH + 248 * MiB;
constexpr size_t WS_O = WS_SH + 265 * MiB;
constexpr size_t WS_HS = WS_SH;
constexpr size_t WS_ACT = WS_SH + 164 * MiB;
constexpr size_t WS_FB = WS_SH + 246 * MiB;
constexpr size_t WS_DP = WS_SH;
constexpr size_t WS_PQ = WS_SH + 510 * MiB;
constexpr size_t WS_PO = WS_PQ + 48 * MiB;
constexpr size_t WS_END = WS_PO + 32 * MiB;
static_assert((size_t)MT * DM * 4 <= 132 * MiB && (size_t)NSLOT * 2048 * 2 <= 164 * MiB && (size_t)2 * MT * DM * 4 <= 264 * MiB, "ws map");
static_assert((size_t)32 * MT * 8 <= 5 * MiB && (size_t)NSLOT * 8 <= 1 * MiB, "ws map 2");
constexpr int CW_CNT = 64;
constexpr int CW_Q = 3072;
constexpr int CW_MQ = 3136;
constexpr int CW_WQ = 3104;
constexpr int CW_DONE = 8192;
constexpr int CW_GUD = 16384;
constexpr int CW_YD = 40960;
constexpr int CW_P6Q = 3168;
constexpr int CW_BAR = 4096;

constexpr int RING_BYTES = 131072;
constexpr int MISC_OFF = RING_BYTES;
constexpr int TAB_OFF = MISC_OFF + 256;
constexpr int LDS_BYTES = 147456;

#define GAS __attribute__((address_space(1)))
#define LAS __attribute__((address_space(3)))
typedef unsigned short bf16_t;
typedef unsigned v4u __attribute__((ext_vector_type(4)));
typedef unsigned v2u __attribute__((ext_vector_type(2)));
typedef float f32x4 __attribute__((ext_vector_type(4)));
typedef float f32x2 __attribute__((ext_vector_type(2)));
typedef short bf16x8 __attribute__((ext_vector_type(8)));
typedef short s16x4 __attribute__((ext_vector_type(4)));
typedef float f32x16 __attribute__((ext_vector_type(16)));
typedef GAS unsigned gu32;
#define RLX_AGENT __ATOMIC_RELAXED, __HIP_MEMORY_SCOPE_AGENT
#define LDS_WAIT() asm volatile("s_waitcnt lgkmcnt(0)" ::: "memory")
#define VM_WAIT() asm volatile("s_waitcnt vmcnt(0)" ::: "memory")
__device__ __forceinline__ unsigned f2bf(float f) { unsigned u = __builtin_bit_cast(unsigned, f); return (u + 0x7fffu + ((u >> 16) & 1u)) >> 16; }
__device__ __forceinline__ unsigned pk2(float lo, float hi) { unsigned r; asm("v_cvt_pk_bf16_f32 %0, %1, %2" : "=v"(r) : "v"(lo), "v"(hi)); return r; }
__device__ __forceinline__ float bf2f(unsigned b) { return __builtin_bit_cast(float, b << 16); }
__device__ __forceinline__ unsigned cvt_pk_bf16(float lo, float hi) { unsigned r; asm volatile("v_cvt_pk_bf16_f32 %0, %1, %2" : "=v"(r) : "v"(lo), "v"(hi)); return r; }
__device__ __forceinline__ f32x4 bf4(v2u q) { return (f32x4){bf2f(q.x & 0xffffu), bf2f(q.x >> 16), bf2f(q.y & 0xffffu), bf2f(q.y >> 16)}; }
template <int CTRL> __device__ __forceinline__ float dppf(float v) { return __builtin_bit_cast(float, __builtin_amdgcn_update_dpp(0, __builtin_bit_cast(int, v), CTRL, 0xF, 0xF, true)); }
template <int CTRL> __device__ __forceinline__ int dppi(int v) { return __builtin_amdgcn_update_dpp(0, v, CTRL, 0xF, 0xF, true); }
__device__ __forceinline__ float wave_sum(float v) {
    v += dppf<0xB1>(v); v += dppf<0x4E>(v); v += dppf<0x141>(v); v += dppf<0x140>(v);
    { const auto r = __builtin_amdgcn_permlane16_swap(__float_as_uint(v), __float_as_uint(v), false, false); v = __uint_as_float(r[0]) + __uint_as_float(r[1]); }
    { const auto r = __builtin_amdgcn_permlane32_swap(__float_as_uint(v), __float_as_uint(v), false, false); v = __uint_as_float(r[0]) + __uint_as_float(r[1]); }
    return v;
}
__device__ __forceinline__ float silu_f(float x) { return x / (1.0f + __expf(-x)); }
__device__ __forceinline__ int row_cond(int row) { return row < NCTX ? 2 : ((row - NCTX) >> 13); }
__device__ __forceinline__ int otid() { int t = threadIdx.x; asm volatile("" : "+v"(t)); return t; }
__device__ __forceinline__ int obid() { int t = blockIdx.x; asm volatile("" : "+s"(t)); return t; }
__device__ __forceinline__ int ogrid() { int t = gridDim.x; asm volatile("" : "+s"(t)); return t; }

#define XB_TMO      128
#define XB_XCNT(j)  (256  + 64 * (j))
#define XB_XSUB(j)  (1280 + 64 * (j))
#define XB_XGEN(j)  (2304 + 64 * (j))
#define XB_TOP      3328
#define XB_TOPGEN   3392
#define XCD_BAR_WORDS 3456
#define XB_SPIN_CAP (1u << 20)
__device__ __forceinline__ unsigned xb_ld(unsigned* p)              { return __hip_atomic_load(p, __ATOMIC_RELAXED, __HIP_MEMORY_SCOPE_AGENT); }
__device__ __forceinline__ unsigned xb_add(unsigned* p, unsigned v) { return __hip_atomic_fetch_add(p, v, __ATOMIC_RELAXED, __HIP_MEMORY_SCOPE_AGENT); }
__device__ __forceinline__ unsigned xb_xcc_id() { return (unsigned)__builtin_amdgcn_s_getreg((3 << 11) | 20) & 0xFu; }
#define XB_SPIN(cond, bar) do { unsigned _sp = 0; while (cond) { __builtin_amdgcn_s_sleep(1); \
    if ((++_sp & 255u) == 0u) { if (xb_ld(&(bar)[XB_TMO])) break; if (_sp > XB_SPIN_CAP) { atomicAdd(&(bar)[XB_TMO], 1u); break; } } } } while (0)
struct XcdBarrier { unsigned* bar; unsigned x; volatile LAS unsigned* st; };
__device__ __forceinline__ XcdBarrier xcd_barrier_post(unsigned* bar, volatile LAS unsigned* st) {
    XcdBarrier b; b.bar = bar; b.x = xb_xcc_id(); b.st = st;
    if (threadIdx.x == 0) (void)xb_add(&bar[XB_XCNT(b.x)], 1u);
    return b;
}
__device__ __forceinline__ void xcd_barrier_complete(unsigned* bar, unsigned x, unsigned& nloc, unsigned& nx) {
    const unsigned G = gridDim.x * gridDim.y * gridDim.z;
    unsigned sum, cnt, mine, sp = 0u;
    for (;;) {
        sum = 0u; cnt = 0u; mine = 0u;
#pragma unroll 1
        for (unsigned j = 0; j < 16; ++j) { const unsigned c = xb_ld(&bar[XB_XCNT(j)]); sum += c; cnt += (c > 0u) ? 1u : 0u; }
        if (sum == G) break;
        __builtin_amdgcn_s_sleep(1);
        if ((++sp & 255u) == 0u) { if (xb_ld(&bar[XB_TMO])) break; if (sp > XB_SPIN_CAP) { atomicAdd(&bar[XB_TMO], 1u); break; } }
    }
    mine = xb_ld(&bar[XB_XCNT(x)]);
    nloc = mine > 0u ? mine : 1u; nx = cnt > 0u ? cnt : 1u;
}
__device__ __forceinline__ void xcd_barrier(const XcdBarrier& b) {
    asm volatile("s_waitcnt vmcnt(0)" ::: "memory");
    __syncthreads();
    if (threadIdx.x == 0) {
        unsigned* bar = b.bar;
        __builtin_amdgcn_s_waitcnt(0);
        unsigned nloc = b.st[0], nx = b.st[1];
        if (nloc == 0u) { xcd_barrier_complete(bar, b.x, nloc, nx); b.st[0] = nloc; b.st[1] = nx; }
        const unsigned old = xb_add(&bar[XB_XSUB(b.x)], 1u);
        const unsigned gen = old / nloc;
        if (old + 1u == (gen + 1u) * nloc) {
            __builtin_amdgcn_fence(__ATOMIC_RELEASE, "agent");
            asm volatile("s_waitcnt vmcnt(0)" ::: "memory");
            const unsigned og = xb_add(&bar[XB_TOP], 1u);
            const unsigned tg = og / nx;
            if (og + 1u == (tg + 1u) * nx) xb_add(&bar[XB_TOPGEN], 1u);
            else XB_SPIN(xb_ld(&bar[XB_TOPGEN]) == tg, bar);
            __builtin_amdgcn_fence(__ATOMIC_ACQUIRE, "agent");
            xb_add(&bar[XB_XGEN(b.x)], 1u);
            asm volatile("s_waitcnt vmcnt(0)" ::: "memory");
        } else {
            XB_SPIN(xb_ld(&bar[XB_XGEN(b.x)]) == gen, bar);
            __builtin_amdgcn_fence(__ATOMIC_ACQUIRE, "agent");
            asm volatile("s_waitcnt vmcnt(0)" ::: "memory");
        }
    }
    __syncthreads();
}

namespace pg8 {
#define PG8_LAS __attribute__((address_space(3)))
constexpr int BM = 256, BK = 64, HALF = 128, HTB = HALF * BK * 2, STAGE_BYTES = 8 * HTB, NXCD = 8, WGM = 8;
__host__ __device__ __forceinline__ int lds_byte(int r, int c) { const int st = (r >> 4) * 2 + (c >> 5), rr = r & 15, cc = c & 31, ob = rr * 64 + cc * 2; return st * 1024 + (ob ^ (((ob >> 9) & 1) << 5)); }
__host__ __device__ __forceinline__ void stage_rc(int b, int& R, int& C) { const int st = b / 1024, sb = b % 1024, swz = sb ^ (((sb >> 9) & 1) << 5); R = (st >> 1) * 16 + swz / 64; C = (st & 1) * 32 + (swz % 64) / 2; }
__host__ __device__ __forceinline__ int perm32(int rho) { const int n = rho >> 4, i = rho & 15; return 8 * (i >> 2) + 4 * n + (i & 3); }

struct Unit { const char* A; const char* B; int pm, pn, aux, kt, rb, cn, ui; };
struct Gemm { int lda, ldb, K; };

struct TileOrder {
    int nM, nN, nwg, G, c, rot = 0;
    __device__ __forceinline__ void init(int nM_, int nN_, int G_, int c_) { nM = nM_; nN = nN_; nwg = nM * nN; G = G_; c = c_; }
    __device__ __forceinline__ bool get(int i, int& pm, int& pn) const { return map((long)i * G + c, pm, pn); }
    __device__ __forceinline__ bool map(long L, int& pm, int& pn) const {
        if (L >= nwg) return false;
        const int nig = WGM * nN;
        int wgid = (int)L; { const int q = nwg / NXCD, r = nwg % NXCD, xcd = wgid % NXCD; int off = wgid / NXCD; const int cs = (xcd < r ? xcd * (q + 1) : r * (q + 1) + (xcd - r) * q), len = q + (xcd < r ? 1 : 0);
            if (rot) { const int lead = (nig - cs % nig) % nig; if (lead < len) { off += lead; if (off >= len) off -= len; } }
            wgid = cs + off; }
        const int gid = wgid / nig, fm = gid * WGM, gsz = (nM - fm) < WGM ? (nM - fm) : WGM;
        pm = fm + ((wgid % nig) % gsz); pn = (wgid % nig) / gsz; return true;
    }
};

template <class Epi, class Sched, bool ALIGN_EPI, bool GATHER = false>
__device__ __forceinline__ void gemm_phase(PG8_LAS unsigned char* lds, const Gemm g, const Sched& S, const Epi& E) {
    const int tid = otid(), wid = __builtin_amdgcn_readfirstlane(tid >> 6), lane = tid & 63, wr = wid >> 2, wc = wid & 3, fr = lane & 15, fq = lane >> 4;
    unsigned vc[2][2], vn[2][2], voffB[2]; int Rr[2], Cc = 0;
#pragma unroll
    for (int i = 0; i < 2; ++i) { int R, C; stage_rc(tid * 16 + i * 8192, R, C); const int Rb = Epi::PERM ? ((R & ~31) + perm32(R & 31)) : R; Rr[i] = R; Cc = C;
        vc[0][i] = (unsigned)(R * g.lda + C) * 2u; vc[1][i] = vc[0][i] + (unsigned)(HALF * g.lda) * 2u; voffB[i] = (unsigned)(Rb * g.ldb + C) * 2u; }
#define PG8_ROWS(ui_, v) do { _Pragma("unroll") for (int _h = 0; _h < 2; ++_h) _Pragma("unroll") for (int _i = 0; _i < 2; ++_i) \
        v[_h][_i] = (unsigned)S.rowtok((ui_), Rr[_i] + HALF * _h) * (unsigned)(g.lda * 2) + (unsigned)Cc * 2u; } while (0)
    const size_t kstep = (size_t)(BK * 2);
    const size_t hsB = (size_t)HALF * g.ldb * 2;
    const unsigned ldsw = (unsigned)wid * 1024u;
    const int aoff = lds_byte(wr * 64 + fr, fq * 8), boff = lds_byte(wc * 32 + fr, fq * 8);
#define PG8_SA(b, h) (((b) * 2 + (h)) * HTB)
#define PG8_SB(b, h) ((4 + (b) * 2 + (h)) * HTB)
#define PG8_STAGE(bufoff, gbase, voff) do { _Pragma("unroll") for (int _i = 0; _i < 2; ++_i) \
        __builtin_amdgcn_global_load_lds((const unsigned*)((const char*)(gbase) + (voff)[_i]), (PG8_LAS unsigned*)(lds + (bufoff) + ldsw + _i * 8192), 16, 0, 0); } while (0)
#define PG8_LDA(dst, b, h) do { _Pragma("unroll") for (int m = 0; m < 4; ++m) _Pragma("unroll") for (int k = 0; k < 2; ++k) dst[m][k] = *(const PG8_LAS bf16x8*)(lds + PG8_SA(b, h) + aoff + m * 2048 + k * 1024); } while (0)
#define PG8_LDB(dst, b, h) do { _Pragma("unroll") for (int n = 0; n < 2; ++n) _Pragma("unroll") for (int k = 0; k < 2; ++k) dst[n][k] = *(const PG8_LAS bf16x8*)(lds + PG8_SB(b, h) + boff + n * 2048 + k * 1024); } while (0)
#define PG8_MMA(ai, bj, At, Bt) do { __builtin_amdgcn_s_setprio(1); _Pragma("unroll") for (int m = 0; m < 4; ++m) _Pragma("unroll") for (int n = 0; n < 2; ++n) _Pragma("unroll") for (int k = 0; k < 2; ++k) \
        acc[ai][bj][m][n] = __builtin_amdgcn_mfma_f32_16x16x32_bf16(Bt[n][k], At[m][k], acc[ai][bj][m][n], 0, 0, 0); __builtin_amdgcn_s_setprio(0); } while (0)
#define PG8_WAIT_V(n) asm volatile("s_waitcnt vmcnt(" #n ")" ::: "memory")
#define PG8_WAIT_L(n) asm volatile("s_waitcnt lgkmcnt(" #n ")" ::: "memory")
#define PG8_BAR __builtin_amdgcn_s_barrier()
#define PG8_SCHED __builtin_amdgcn_sched_barrier(0)
    Unit cur, nxt; int ui = 0; int pend = -1, pend2 = -1, wst = 0; unsigned pv = 8u; (void)pend; (void)pend2; (void)wst; (void)pv;
    if (!S.next(0, cur)) return;
    if constexpr (Sched::WAITS) S.wait_ready(cur);
    if constexpr (GATHER) PG8_ROWS(0, vc);
    f32x4 acc[2][2][4][2];
#pragma unroll
    for (int a = 0; a < 2; ++a)
#pragma unroll
        for (int b = 0; b < 2; ++b)
#pragma unroll
            for (int m = 0; m < 4; ++m)
#pragma unroll
                for (int n = 0; n < 2; ++n) acc[a][b][m][n] = (f32x4){0.f, 0.f, 0.f, 0.f};
    bf16x8 At[4][2], B0[2][2], B1[2][2];
    const char* cA = cur.A; const char* cB = cur.B;
    PG8_STAGE(PG8_SB(0, 0), cB, voffB); PG8_STAGE(PG8_SB(0, 1), cB + hsB, voffB); PG8_STAGE(PG8_SA(0, 0), cA, vc[0]); PG8_STAGE(PG8_SA(0, 1), cA, vc[1]);
    if (wr == 1) PG8_BAR;
    PG8_WAIT_V(2); PG8_BAR;
    PG8_STAGE(PG8_SB(1, 0), cB + kstep, voffB); PG8_STAGE(PG8_SA(1, 0), cA + kstep, vc[0]); PG8_STAGE(PG8_SB(1, 1), cB + hsB + kstep, voffB);
    PG8_WAIT_V(6); PG8_BAR;
    for (;;) {
        const bool has_next = S.next(ui + 1, nxt);
        if constexpr (Sched::WAITS) wst = has_next ? 1 : 0;
        const char* nA = has_next ? nxt.A : cA; const char* nB = has_next ? nxt.B : cB;
        if constexpr (GATHER) { if (has_next) PG8_ROWS(ui + 1, vn); else {
#pragma unroll
            for (int h = 0; h < 2; ++h) { vn[h][0] = vc[h][0]; vn[h][1] = vc[h][1]; } } }
        const int nt = cur.kt;
        for (int t = 0; t < nt; t += 2) {
            const bool last = (t == nt - 2);
            const char* a1 = cA + (size_t)(t + 1) * kstep;
            const char* a2 = last ? nA : cA + (size_t)(t + 2) * kstep; const char* b2 = last ? nB : cB + (size_t)(t + 2) * kstep;
            const char* a3 = a2 + kstep; const char* b3 = b2 + kstep;
            unsigned o0[2], o1[2];
#pragma unroll
            for (int i = 0; i < 2; ++i) { o0[i] = (GATHER && last) ? vn[0][i] : vc[0][i]; o1[i] = (GATHER && last) ? vn[1][i] : vc[1][i]; }
            PG8_LDB(B0, 0, 0); PG8_LDB(B1, 0, 1); PG8_SCHED; PG8_LDA(At, 0, 0); PG8_STAGE(PG8_SA(1, 1), a1, vc[1]);
            PG8_WAIT_V(8); PG8_WAIT_L(0); PG8_BAR; PG8_MMA(0, 0, At, B0); PG8_MMA(0, 1, At, B1); PG8_BAR; PG8_SCHED;
            PG8_LDA(At, 0, 1); PG8_STAGE(PG8_SB(0, 0), b2, voffB); PG8_STAGE(PG8_SB(0, 1), b2 + hsB, voffB); PG8_STAGE(PG8_SA(0, 0), a2, o0);
            PG8_WAIT_V(8); PG8_WAIT_L(0); PG8_BAR; PG8_MMA(1, 0, At, B0); PG8_MMA(1, 1, At, B1); PG8_BAR; PG8_SCHED;
            PG8_LDB(B0, 1, 0); PG8_LDB(B1, 1, 1); PG8_SCHED; PG8_LDA(At, 1, 0); PG8_STAGE(PG8_SA(0, 1), a2, o1);
            PG8_WAIT_V(8); PG8_WAIT_L(0); PG8_BAR; PG8_MMA(0, 0, At, B0); PG8_MMA(0, 1, At, B1); PG8_BAR; PG8_SCHED;
            PG8_LDA(At, 1, 1); PG8_STAGE(PG8_SB(1, 0), b3, voffB); PG8_STAGE(PG8_SB(1, 1), b3 + hsB, voffB); PG8_STAGE(PG8_SA(1, 0), a3, o0);
            PG8_WAIT_V(8); PG8_WAIT_L(0); PG8_BAR; PG8_MMA(1, 0, At, B0); PG8_MMA(1, 1, At, B1); PG8_BAR; PG8_SCHED;
            if constexpr (Sched::SIGNALS) { if (pend >= 0) { pend2 = pend; pend = -1; } else if (pend2 >= 0) { S.signal(pend2, lane, wid); pend2 = -1; } }
            if constexpr (Sched::WAITS) { if (wst == 1) { pv = S.poll(nxt); wst = 2; } else if (wst == 2) { wst = 0; if (pv < 8u) S.spin(nxt); } }
        }
        if constexpr (ALIGN_EPI) { if (wr == 0) PG8_BAR; }
        E(acc, cur, wr, wc, fr, fq);
        if constexpr (Sched::SIGNALS) pend = cur.pm;
        if (!has_next) break;
#pragma unroll
        for (int a = 0; a < 2; ++a)
#pragma unroll
            for (int b = 0; b < 2; ++b)
#pragma unroll
                for (int m = 0; m < 4; ++m)
#pragma unroll
                    for (int n = 0; n < 2; ++n) acc[a][b][m][n] = (f32x4){0.f, 0.f, 0.f, 0.f};
        cur = nxt; cA = nA; cB = nB; ++ui;
        if constexpr (GATHER) {
#pragma unroll
            for (int h = 0; h < 2; ++h) { vc[h][0] = vn[h][0]; vc[h][1] = vn[h][1]; } }
        if constexpr (ALIGN_EPI) { if (wr == 1) PG8_BAR; }
    }
    PG8_WAIT_V(0);
    if constexpr (!ALIGN_EPI) { if (wr == 0) PG8_BAR; }
    PG8_BAR;
    if constexpr (Sched::SIGNALS) { if (pend >= 0) S.signal(pend, lane, wid); }
#undef PG8_ROWS
#undef PG8_SA
#undef PG8_SB
#undef PG8_STAGE
#undef PG8_LDA
#undef PG8_LDB
#undef PG8_MMA
#undef PG8_WAIT_V
#undef PG8_WAIT_L
#undef PG8_BAR
#undef PG8_SCHED
}

template <unsigned AT, unsigned BT, int KT>
struct SchedDense {
    static constexpr bool SIGNALS = false, WAITS = false;
    TileOrder o; const char* A; const char* B; int pm0;
    __device__ __forceinline__ int rowtok(int, int) const { return 0; }
    __device__ __forceinline__ bool next(int i, Unit& u) const { int pm, pn; if (!o.get(i, pm, pn)) return false;
        u.rb = 0; u.cn = 0; u.pm = pm0 + pm; u.pn = pn; u.aux = 0; u.kt = KT; u.A = A + (size_t)((unsigned)u.pm * AT); u.B = B + (size_t)((unsigned)pn * BT); return true; }
};
template <unsigned AT, unsigned BT, int KT, int NN>
struct SchedSplit {
    static constexpr bool SIGNALS = false, WAITS = false;
    TileOrder o; const char* A; const char* B; int G, c; bool split;
    __device__ __forceinline__ int rowtok(int, int) const { return 0; }
    __device__ __forceinline__ void init(int G_, int c_) { G = G_; c = c_; split = ((64 * NN) % G_ == 0) && (2 * NN * 8 <= G_); if (split) o.init(64, NN, G_, c_); else o.init(66, NN, G_, c_); }
    __device__ __forceinline__ bool next(int i, Unit& u) const { u.rb = 0; u.cn = 0;
        if (!split) { int pm, pn; if (!o.get(i, pm, pn)) return false; u.pm = pm; u.pn = pn; u.aux = 0; u.kt = KT; u.A = A + (size_t)((unsigned)pm * AT); u.B = B + (size_t)((unsigned)pn * BT); return true; }
        const int fr = (64 * NN) / G;
        if (i < fr) { int pm, pn; o.get(i, pm, pn); u.pm = 2 + pm; u.pn = pn; u.aux = 0; u.kt = KT; u.A = A + (size_t)((unsigned)u.pm * AT); u.B = B + (size_t)((unsigned)pn * BT); return true; }
        if (i > fr || c >= 2 * NN * 8) return false;
        const int ks = c & 7, t = c >> 3; u.pm = t / NN; u.pn = t % NN; u.aux = ks + 1; u.kt = KT / 8;
        u.A = A + (size_t)((unsigned)u.pm * AT + (unsigned)ks * (KT / 8) * 128u); u.B = B + (size_t)((unsigned)u.pn * BT + (unsigned)ks * (KT / 8) * 128u); return true; }
};
struct SchedPool {
    static constexpr bool SIGNALS = false, WAITS = false;
    TileOrder o; const char* A; const char* B;
    __device__ __forceinline__ int rowtok(int, int) const { return 0; }
    __device__ __forceinline__ bool next(int i, Unit& u) const { int pm, pn; if (!o.get(i, pm, pn)) return false;
        u.rb = 0; u.cn = 0; u.pm = 2 + pm; u.pn = pn; u.aux = 0; u.kt = 8; const int g = pn >> 1;
        u.A = A + (size_t)((unsigned)u.pm * (256u * DM * 2u) + (unsigned)g * 1024u); u.B = B + (size_t)((unsigned)g * (512u * 512u * 2u) + (unsigned)(pn & 1) * (256u * 512u * 2u)); return true; }
};
struct SchedOne {
    static constexpr bool SIGNALS = false, WAITS = false;
    Unit u;
    __device__ __forceinline__ int rowtok(int, int) const { return 0; }
    __device__ __forceinline__ bool next(int i, Unit& o) const { if (i != 0) return false; o = u; return true; }
};
constexpr int RT_UNITS = 14;
template <unsigned AT, unsigned BT, unsigned BE, int KT, bool GATHER>
struct SchedMoe {
    static constexpr bool SIGNALS = GATHER, WAITS = !GATHER;
    unsigned* ctr;
    __device__ __forceinline__ void signal(int pm, int lane, int wid) const { if (wid == 0 && lane == 0) (void)xb_add(ctr + 32 * pm, 1u); }
    __device__ __forceinline__ void wait_ready(const Unit& u) const { while (xb_ld(ctr + 32 * u.pm) < 8u) __builtin_amdgcn_s_sleep(2); asm volatile("" ::: "memory"); }
    __device__ __forceinline__ unsigned poll(const Unit& u) const { return xb_ld(ctr + 32 * u.pm); }
    __device__ __forceinline__ void spin(const Unit& u) const { while (xb_ld(ctr + 32 * u.pm) < 8u) __builtin_amdgcn_s_sleep(2); }
    __device__ __forceinline__ void acquire_async() const { asm volatile("buffer_inv sc1" ::: "memory"); }
    TileOrder o; const char* A; const char* B; const PG8_LAS int* texp; const PG8_LAS int* tbase; const PG8_LAS int* tcnt; const PG8_LAS int* rt; const int* list;
    int rem = 0, nl = 0;
    __device__ __forceinline__ bool next(int i, Unit& u) const { int pm, pn;
        if (GATHER) { if (!o.get(i, pm, pn)) return false; }
        else { const bool light = o.c >= rem; const long L = (light && i < 2) ? (long)i * nl + (o.c - rem) : 2L * nl + (long)(light ? i - 2 : i) * o.G + o.c; if (!o.map(L, pm, pn)) return false; }
        const int e = __builtin_amdgcn_readfirstlane(texp[pm]);
        u.pm = pm; u.pn = pn; u.aux = e; u.kt = KT; u.ui = i; u.rb = (pm - __builtin_amdgcn_readfirstlane(tbase[e])) * 256; u.cn = __builtin_amdgcn_readfirstlane(tcnt[e]);
        u.A = GATHER ? A : A + (size_t)((unsigned)pm * AT); u.B = B + (size_t)((unsigned)e * BE + (unsigned)pn * BT); return true; }
    __device__ __forceinline__ int tok_of(const Unit& u, int row) const { const int pos = u.rb + row; return pos < u.cn ? (list[(size_t)u.aux * MT + pos] >> 1) : 0; }
    __device__ __forceinline__ int rowtok(int ui, int row) const { if (ui < RT_UNITS) return rt[ui * 256 + row]; Unit u; next(ui, u); return tok_of(u, row); }
    __device__ __forceinline__ void fill_dst(PG8_LAS int* rtw, const float* listg, int tid) const {
        int dv[RT_UNITS / 2]; float gv[RT_UNITS / 2]; bool ok[RT_UNITS / 2];
#pragma unroll
        for (int i = 0; i < RT_UNITS / 2; ++i) { Unit u; ok[i] = next(i, u); dv[i] = -1; gv[i] = 0.f;
            if (ok[i] && tid < 256) { const int pos = u.rb + tid; if (pos < u.cn) { const size_t li = (size_t)u.aux * MT + pos; dv[i] = list[li]; gv[i] = listg[li]; } } }
#pragma unroll
        for (int i = 0; i < RT_UNITS / 2; ++i) if (ok[i] && tid < 256) { rtw[i * 512 + tid] = dv[i]; rtw[i * 512 + 256 + tid] = (int)__float_as_uint(gv[i]); }
        __syncthreads(); }
    __device__ __forceinline__ void fill_rows(PG8_LAS int* rtw, int tid) const {
#pragma unroll
        for (int h = 0; h < 2; ++h) { int tk[RT_UNITS / 2]; bool ok[RT_UNITS / 2];
#pragma unroll
            for (int q = 0; q < RT_UNITS / 2; ++q) { Unit u; ok[q] = next(h * (RT_UNITS / 2) + q, u); tk[q] = 0; if (ok[q] && tid < 256) tk[q] = tok_of(u, tid); }
#pragma unroll
            for (int q = 0; q < RT_UNITS / 2; ++q) if (ok[q] && tid < 256) rtw[(h * (RT_UNITS / 2) + q) * 256 + tid] = tk[q]; }
        __syncthreads(); }
};

struct EpiBf16 {
    static constexpr bool PERM = true;
    bf16_t* O; int ldc; float* P;
    __device__ __forceinline__ void operator()(const f32x4 (&acc)[2][2][4][2], const Unit& u, int wr, int wc, int fr, int fq) const {
        const int row0 = u.pm * BM + wr * 64 + fr, col0 = u.pn * BM + wc * 32 + 8 * fq;
        if (u.aux == 0) {
#pragma unroll
            for (int ai = 0; ai < 2; ++ai)
#pragma unroll
                for (int m = 0; m < 4; ++m) { bf16_t* rowp = O + (size_t)(row0 + ai * HALF + m * 16) * ldc + col0;
#pragma unroll
                    for (int bj = 0; bj < 2; ++bj) { const f32x4 v0 = acc[ai][bj][m][0], v1 = acc[ai][bj][m][1];
                        v4u w; w.x = cvt_pk_bf16(v0[0], v0[1]); w.y = cvt_pk_bf16(v0[2], v0[3]); w.z = cvt_pk_bf16(v1[0], v1[1]); w.w = cvt_pk_bf16(v1[2], v1[3]);
                        *(v4u*)(rowp + bj * HALF) = w; } }
        } else {
            float* pb = P + (size_t)(u.aux - 1) * 512 * ldc;
#pragma unroll
            for (int ai = 0; ai < 2; ++ai)
#pragma unroll
                for (int m = 0; m < 4; ++m) { float* rowp = pb + (size_t)(row0 + ai * HALF + m * 16) * ldc + col0;
#pragma unroll
                    for (int bj = 0; bj < 2; ++bj) { *(f32x4*)(rowp + bj * HALF) = acc[ai][bj][m][0]; *(f32x4*)(rowp + bj * HALF + 4) = acc[ai][bj][m][1]; } }
        }
    }
};
struct EpiBf16W {
    static constexpr bool PERM = true;
    bf16_t* O; int ldc;
    __device__ __forceinline__ void operator()(const f32x4 (&acc)[2][2][4][2], const Unit& u, int wr, int wc, int fr, int fq) const {
        const int row0 = u.pm * BM + wr * 64 + fr, col0 = u.pn * BM + wc * 32 + 8 * fq;
#pragma unroll
        for (int ai = 0; ai < 2; ++ai)
#pragma unroll
            for (int m = 0; m < 4; ++m) { bf16_t* rowp = O + (size_t)(row0 + ai * HALF + m * 16) * ldc + col0;
#pragma unroll
                for (int bj = 0; bj < 2; ++bj) { const f32x4 v0 = acc[ai][bj][m][0], v1 = acc[ai][bj][m][1];
                    v4u w; w.x = cvt_pk_bf16(v0[0], v0[1]); w.y = cvt_pk_bf16(v0[2], v0[3]); w.z = cvt_pk_bf16(v1[0], v1[1]); w.w = cvt_pk_bf16(v1[2], v1[3]);
                    const bf16_t* gp = rowp + bj * HALF;
                    asm volatile("global_store_dwordx4 %0, %1, off sc1\n\ts_nop 1" :: "v"(gp), "v"(w) : "memory"); } }
    }
};
struct EpiQkv {
    static constexpr bool PERM = true;
    bf16_t* O; int ldc; float* P; bf16_t* V;
    __device__ __forceinline__ void operator()(const f32x4 (&acc)[2][2][4][2], const Unit& u, int wr, int wc, int fr, int fq) const {
        const int row0 = u.pm * BM + wr * 64 + fr, col0 = u.pn * BM + wc * 32 + 8 * fq;
        if (u.aux == 0) {
            const bool isV = u.pn >= (DM + KVD) / BM;
#pragma unroll
            for (int ai = 0; ai < 2; ++ai)
#pragma unroll
                for (int m = 0; m < 4; ++m) { const int row = row0 + ai * HALF + m * 16; bf16_t* rowp = O + (size_t)row * ldc + col0; size_t vstep = HALF;
                    if (isV) { const bool lat = row >= NCTX; const int lr = row - NCTX, b = lat ? (lr >> 13) : (row >> 8), kpos = lat ? (CTXL + (lr & 8191)) : (row & 255);
                        rowp = V + (((size_t)b * NKV + (size_t)(u.pn - (DM + KVD) / BM) * 2) * SKV + kpos) * HD + wc * 32 + 8 * fq; vstep = (size_t)SKV * HD; }
#pragma unroll
                    for (int bj = 0; bj < 2; ++bj) { const f32x4 v0 = acc[ai][bj][m][0], v1 = acc[ai][bj][m][1];
                        v4u w; w.x = cvt_pk_bf16(v0[0], v0[1]); w.y = cvt_pk_bf16(v0[2], v0[3]); w.z = cvt_pk_bf16(v1[0], v1[1]); w.w = cvt_pk_bf16(v1[2], v1[3]);
                        *(v4u*)(rowp + bj * vstep) = w; } }
        } else {
            float* pb = P + (size_t)(u.aux - 1) * 512 * ldc;
#pragma unroll
            for (int ai = 0; ai < 2; ++ai)
#pragma unroll
                for (int m = 0; m < 4; ++m) { float* rowp = pb + (size_t)(row0 + ai * HALF + m * 16) * ldc + col0;
#pragma unroll
                    for (int bj = 0; bj < 2; ++bj) { *(f32x4*)(rowp + bj * HALF) = acc[ai][bj][m][0]; *(f32x4*)(rowp + bj * HALF + 4) = acc[ai][bj][m][1]; } }
        }
    }
};
struct EpiGateUp {
    static constexpr bool PERM = true;
    bf16_t* ACT;
    __device__ __forceinline__ void operator()(const f32x4 (&acc)[2][2][4][2], const Unit& u, int wr, int wc, int fr, int fq) const {
        const int row0 = u.pm * BM + wr * 64 + fr, col0 = u.pn * HALF + wc * 32 + 8 * fq;
#pragma unroll
        for (int ai = 0; ai < 2; ++ai)
#pragma unroll
            for (int m = 0; m < 4; ++m) { bf16_t* rowp = ACT + (size_t)(row0 + ai * HALF + m * 16) * DE + col0;
                float v[8];
#pragma unroll
                for (int n = 0; n < 2; ++n)
#pragma unroll
                    for (int j = 0; j < 4; ++j) v[n * 4 + j] = silu_f(acc[ai][0][m][n][j]) * acc[ai][1][m][n][j];
                v4u w; w.x = cvt_pk_bf16(v[0], v[1]); w.y = cvt_pk_bf16(v[2], v[3]); w.z = cvt_pk_bf16(v[4], v[5]); w.w = cvt_pk_bf16(v[6], v[7]);
                asm volatile("global_store_dwordx4 %0, %1, off sc1\n\ts_nop 1" :: "v"(rowp), "v"(w) : "memory"); }
    }
};
struct EpiDown {
    static constexpr bool PERM = true;
    bf16_t* FB; const PG8_LAS int* rt;
    __device__ __forceinline__ void operator()(const f32x4 (&acc)[2][2][4][2], const Unit& u, int wr, int wc, int fr, int fq) const {
        const int r0 = wr * 64 + fr, col0 = u.pn * BM + wc * 32 + 8 * fq; const PG8_LAS int* tb = rt + u.ui * 512 + r0;
#pragma unroll
        for (int ai = 0; ai < 2; ++ai)
#pragma unroll
            for (int m = 0; m < 4; ++m) { const int d_ = tb[ai * HALF + m * 16]; const float g_ = __uint_as_float((unsigned)tb[256 + ai * HALF + m * 16]);
                if (d_ >= 0) { bf16_t* fr_ = FB + (size_t)d_ * DM + col0;
#pragma unroll
                    for (int bj = 0; bj < 2; ++bj) { const f32x4 v0 = acc[ai][bj][m][0] * g_, v1 = acc[ai][bj][m][1] * g_;
                        v4u w; w.x = cvt_pk_bf16(v0[0], v0[1]); w.y = cvt_pk_bf16(v0[2], v0[3]); w.z = cvt_pk_bf16(v1[0], v1[1]); w.w = cvt_pk_bf16(v1[2], v1[3]);
                        *(v4u*)(fr_ + bj * HALF) = w; } } }
    }
};
}

namespace att {
constexpr int D = 128, NW = 8, QBLK = 32, KVBLK = 64;
constexpr float SCALE = 0.088388347648318440f;
constexpr float THR = 8.f;
#ifndef ATT_SDEPTH
#define ATT_SDEPTH 1
#endif
constexpr int SDEPTH = ATT_SDEPTH;
constexpr int LDQ = DM, LDK = HD, LDO = DM;
constexpr size_t SHM_V = KVBLK * D * 2, SHM_K = KVBLK * D * 2, SHM_ATTN = 2 * SHM_V + 2 * SHM_K + NW * 64 * 4;
typedef unsigned u32x4 __attribute__((ext_vector_type(4)));
#define KSWZ(row, colB) ((row) * 256 + ((colB) ^ (((row) & 7) << 4)))
#define SBAR() __builtin_amdgcn_sched_barrier(0)
__device__ __forceinline__ int crow(int r, int hi) { return (r & 3) + 8 * (r >> 2) + 4 * hi; }
__device__ __forceinline__ unsigned cvtpk(float lo, float hi) { unsigned r; asm volatile("v_cvt_pk_bf16_f32 %0, %1, %2" : "=v"(r) : "v"(lo), "v"(hi)); return r; }
__device__ __forceinline__ bf16x8 ld8(const bf16_t* p) { return *reinterpret_cast<const bf16x8*>(p); }

__device__ __forceinline__ void partialSM(f32x16& p0, f32x16& p1, float& m_reg, float& mn, float& alpha) {
  constexpr float C = SCALE * 1.4426950408889634f;
  float pmax = p0[0]; for (int r = 1; r < 16; ++r) pmax = fmaxf(pmax, p0[r]); for (int r = 0; r < 16; ++r) pmax = fmaxf(pmax, p1[r]);
  { auto rr = __builtin_amdgcn_permlane32_swap(__float_as_uint(pmax), __float_as_uint(pmax), false, false);
    pmax = fmaxf(__uint_as_float(rr[0]), __uint_as_float(rr[1])); }
  if (__builtin_expect(__all(pmax - m_reg <= THR / SCALE), 1)) { mn = m_reg; alpha = 1.f; }
  else { mn = fmaxf(m_reg, pmax); alpha = __builtin_amdgcn_exp2f((m_reg - mn) * C); m_reg = mn; }
  float mnC = -mn * C;
  for (int r = 0; r < 16; ++r) p0[r] = fmaf(p0[r], C, mnC); for (int r = 0; r < 16; ++r) p1[r] = fmaf(p1[r], C, mnC);
  for (int r = 0; r < 16; ++r) p0[r] = __builtin_amdgcn_exp2f(p0[r]);
}
__device__ __forceinline__ void finishSM(f32x16& p0, f32x16& p1, float alpha, float& l_reg, bf16x8& pa0, bf16x8& pa1, bf16x8& pa2, bf16x8& pa3) {
  for (int r = 0; r < 16; ++r) p1[r] = __builtin_amdgcn_exp2f(p1[r]);
  float ps = 0; for (int r = 0; r < 16; ++r) ps += p0[r]; for (int r = 0; r < 16; ++r) ps += p1[r];
  { auto rr = __builtin_amdgcn_permlane32_swap(__float_as_uint(ps), __float_as_uint(ps), false, false);
    ps = __uint_as_float(rr[0]) + __uint_as_float(rr[1]); }
  l_reg = l_reg * alpha + ps;
#define PK4(P, BASE, OUT) do { unsigned a0 = cvtpk(P[BASE + 0], P[BASE + 1]), a1 = cvtpk(P[BASE + 2], P[BASE + 3]);   \
    unsigned b0 = cvtpk(P[BASE + 4], P[BASE + 5]), b1 = cvtpk(P[BASE + 6], P[BASE + 7]);                              \
    auto r0 = __builtin_amdgcn_permlane32_swap(a0, b0, false, false); auto r1 = __builtin_amdgcn_permlane32_swap(a1, b1, false, false); \
    u32x4 w = {r0[0], r1[0], r0[1], r1[1]}; OUT = *reinterpret_cast<bf16x8*>(&w); } while (0)
  PK4(p0, 0, pa0); PK4(p0, 8, pa1); PK4(p1, 0, pa2); PK4(p1, 8, pa3);
#undef PK4
}
__device__ __forceinline__ void qkt(f32x16& p0, f32x16& p1, const bf16_t* Ks, const bf16x8* qr, int r32, int hi) {
  p0 = f32x16{}; p1 = f32x16{};
  for (int d0 = 0; d0 < 8; ++d0) { int cb = (d0 * 16 + hi * 8) * 2;
    bf16x8 b0 = *reinterpret_cast<const bf16x8*>((const char*)Ks + KSWZ(r32, cb));
    bf16x8 b1 = *reinterpret_cast<const bf16x8*>((const char*)Ks + KSWZ(32 + r32, cb));
    p0 = __builtin_amdgcn_mfma_f32_32x32x16_bf16(b0, qr[d0], p0, 0, 0, 0);
    p1 = __builtin_amdgcn_mfma_f32_32x32x16_bf16(b1, qr[d0], p1, 0, 0, 0); }
}
__device__ __forceinline__ int v_st(int k, int c) { const int kk = (k & ~0xC) | ((k & 4) << 1) | ((k & 8) >> 1); return ((kk >> 3) * 4 + (c >> 5)) * 512 + ((kk & 7) * 32 + (c & 31)) * 2; }
__device__ __forceinline__ int v_rd_base(int lane) { return ((lane & 3) << 3) | (((lane >> 2) & 3) << 6) | (((lane >> 4) & 1) << 5) | (((lane >> 5) & 1) << 8); }
constexpr int v_rd_off(int d0, int ks, int half) { return d0 * 512 + ks * 4096 + half * 2048; }
template <int OFF> __device__ __forceinline__ s16x4 tr_read(int vb) {
  s16x4 r; asm volatile("ds_read_b64_tr_b16 %0, %1 offset:%2" : "=&v"(r) : "v"(vb), "i"(OFF) : "memory"); return r;
}
template <int D0> __device__ __forceinline__ void pv_one(f32x16& od, int vb, bf16x8 pa0, bf16x8 pa1, bf16x8 pa2, bf16x8 pa3) {
  const s16x4 l0 = tr_read<v_rd_off(D0, 0, 0)>(vb), h0 = tr_read<v_rd_off(D0, 0, 1)>(vb), l1 = tr_read<v_rd_off(D0, 1, 0)>(vb), h1 = tr_read<v_rd_off(D0, 1, 1)>(vb);
  const s16x4 l2 = tr_read<v_rd_off(D0, 2, 0)>(vb), h2 = tr_read<v_rd_off(D0, 2, 1)>(vb), l3 = tr_read<v_rd_off(D0, 3, 0)>(vb), h3 = tr_read<v_rd_off(D0, 3, 1)>(vb);
  asm volatile("s_waitcnt lgkmcnt(0)" ::: "memory"); SBAR();
#define PK(L, H) (bf16x8){L[0], L[1], L[2], L[3], H[0], H[1], H[2], H[3]}
  od = __builtin_amdgcn_mfma_f32_32x32x16_bf16(pa0, PK(l0, h0), od, 0, 0, 0);
  od = __builtin_amdgcn_mfma_f32_32x32x16_bf16(pa1, PK(l1, h1), od, 0, 0, 0);
  od = __builtin_amdgcn_mfma_f32_32x32x16_bf16(pa2, PK(l2, h2), od, 0, 0, 0);
  od = __builtin_amdgcn_mfma_f32_32x32x16_bf16(pa3, PK(l3, h3), od, 0, 0, 0);
#undef PK
}
__device__ __forceinline__ void pv_d0(f32x16* o, int vb, bf16x8 pa0, bf16x8 pa1, bf16x8 pa2, bf16x8 pa3) {
  pv_one<0>(o[0], vb, pa0, pa1, pa2, pa3); pv_one<1>(o[1], vb, pa0, pa1, pa2, pa3); pv_one<2>(o[2], vb, pa0, pa1, pa2, pa3); pv_one<3>(o[3], vb, pa0, pa1, pa2, pa3);
}
__device__ __forceinline__ void attn_dense_body(const bf16_t* __restrict__ Qb, const bf16_t* __restrict__ Kh, const bf16_t* __restrict__ Vh,
                                                bf16_t* __restrict__ Ob, int seq, char* lds) {
  const int tid = otid(), wid = tid >> 6, lane = tid & 63, r32 = lane & 31, hi = lane >> 5;
  bf16_t* V_lds = (bf16_t*)lds; bf16_t* K_lds = (bf16_t*)(lds + 2 * SHM_V);
  float* ws = (float*)(lds + 2 * SHM_V + 2 * SHM_K) + wid * 64; float* li_l = ws; float* al_l = ws + 32;
  float m_reg = -1e30f, l_reg = 0; f32x16 o[4] = {}; bf16x8 qr[8];
  const bf16_t* Qw = Qb + (long)(wid * QBLK + r32) * LDQ + hi * 8;
#pragma unroll
  for (int d0 = 0; d0 < 8; ++d0) qr[d0] = ld8(Qw + d0 * 16);
  const int sr = tid >> 4, sc = (tid & 15) * 8, vst0 = v_st(sr, sc), vst1 = v_st(32 + sr, sc);
  const int vb0 = (int)(uintptr_t)V_lds + v_rd_base(lane);
  struct { bf16x8 vs0, vs1, ks0, ks1; } sr_[SDEPTH];
#define SLOAD(i, k0) do { sr_[i].vs0 = ld8(&Vh[(long)((k0) + sr) * LDK + sc]); sr_[i].vs1 = ld8(&Vh[(long)((k0) + 32 + sr) * LDK + sc]); \
    sr_[i].ks0 = ld8(&Kh[(long)((k0) + sr) * LDK + sc]); sr_[i].ks1 = ld8(&Kh[(long)((k0) + 32 + sr) * LDK + sc]); } while (0)
#define SWRITE(b, i) do { *(bf16x8*)((char*)V_lds + (b) * SHM_V + vst0) = sr_[i].vs0;          \
    *(bf16x8*)((char*)V_lds + (b) * SHM_V + vst1) = sr_[i].vs1; int kc = sc * 2;               \
    *(bf16x8*)((char*)K_lds + (b) * SHM_K + KSWZ(sr, kc)) = sr_[i].ks0;                       \
    *(bf16x8*)((char*)K_lds + (b) * SHM_K + KSWZ(32 + sr, kc)) = sr_[i].ks1; } while (0)
#define SWAIT() do { if constexpr (SDEPTH == 2) asm volatile("s_waitcnt vmcnt(4)" ::: "memory"); else asm volatile("s_waitcnt vmcnt(0)" ::: "memory"); } while (0)
#define RESC(a) do { if (__any((a) < 1.f)) { if (hi == 0) al_l[r32] = (a); asm volatile("s_waitcnt lgkmcnt(0)" ::: "memory"); \
    for (int d = 0; d < 4; ++d) for (int r = 0; r < 16; ++r) o[d][r] *= al_l[crow(r, hi)]; } } while (0)
  f32x16 pA0, pA1, pB0, pB1; float mnA, mnB, alA, alB; bf16x8 pa0, pa1, pa2, pa3; const int NT = seq / KVBLK;
  constexpr int SE = 0, SO = SDEPTH - 1;
  SLOAD(SE, 0); asm volatile("s_waitcnt vmcnt(0)" ::: "memory"); SWRITE(0, SE); __syncthreads();
  qkt(pA0, pA1, K_lds, qr, r32, hi); partialSM(pA0, pA1, m_reg, mnA, alA);
  SLOAD(SO, KVBLK); if constexpr (SDEPTH == 2) { if (2 < NT) SLOAD(SE, 2 * KVBLK); }
  SWAIT(); SWRITE(1, SO); __syncthreads();
  for (int j = 1; j + 1 < NT; j += 2) {
    SBAR(); qkt(pB0, pB1, (bf16_t*)((char*)K_lds + SHM_K), qr, r32, hi);
    finishSM(pA0, pA1, alA, l_reg, pa0, pa1, pa2, pa3); SBAR();
    SLOAD(SO, (j + SDEPTH) * KVBLK); SBAR();
    pv_d0(o, vb0, pa0, pa1, pa2, pa3); partialSM(pB0, pB1, m_reg, mnB, alB);
    __syncthreads(); SWAIT(); SWRITE(0, SE);
    RESC(alB); __syncthreads();
    SBAR(); qkt(pA0, pA1, K_lds, qr, r32, hi);
    finishSM(pB0, pB1, alB, l_reg, pa0, pa1, pa2, pa3); SBAR();
    if (SDEPTH == 1 || j + 3 < NT) SLOAD(SE, (j + 1 + SDEPTH) * KVBLK); SBAR();
    pv_d0(o, vb0 + (int)SHM_V, pa0, pa1, pa2, pa3); partialSM(pA0, pA1, m_reg, mnA, alA);
    __syncthreads(); SWAIT(); SWRITE(1, SO);
    RESC(alA); __syncthreads();
  }
  SBAR(); qkt(pB0, pB1, (bf16_t*)((char*)K_lds + SHM_K), qr, r32, hi);
  finishSM(pA0, pA1, alA, l_reg, pa0, pa1, pa2, pa3); SBAR();
  pv_d0(o, vb0, pa0, pa1, pa2, pa3); partialSM(pB0, pB1, m_reg, mnB, alB);
  __syncthreads(); RESC(alB);
  finishSM(pB0, pB1, alB, l_reg, pa0, pa1, pa2, pa3); SBAR();
  pv_d0(o, vb0 + (int)SHM_V, pa0, pa1, pa2, pa3);
  if (hi == 0) li_l[r32] = l_reg; asm volatile("s_waitcnt lgkmcnt(0)" ::: "memory");
  float rli[16];
#pragma unroll
  for (int r = 0; r < 16; ++r) rli[r] = __builtin_amdgcn_rcpf(li_l[crow(r, hi)]);
  bf16_t* Ow = Ob + (long)(wid * QBLK) * LDO;
#pragma unroll
  for (int r = 0; r < 16; ++r) { int orow = crow(r, hi);
    for (int d0 = 0; d0 < 4; ++d0) Ow[(long)orow * LDO + d0 * 32 + r32] = (bf16_t)f2bf(o[d0][r] * rli[r]); }
  asm volatile("s_waitcnt vmcnt(0) lgkmcnt(0)" ::: "memory");
  __syncthreads();
#undef SLOAD
#undef SWRITE
#undef SWAIT
#undef RESC
}
constexpr size_t SHM_SLOT = 32768, SHM_DMA = 4 * SHM_SLOT;
static_assert(4 * SHM_SLOT <= RING_BYTES && TAB_OFF + 1024 + NW * 64 * 4 <= LDS_BYTES, "attention LDS map");
#define ATT_WAIT_BAR() asm volatile("s_waitcnt vmcnt(0) lgkmcnt(0)\n\ts_barrier" ::: "memory")
__device__ __forceinline__ void attn_dma_body(const bf16_t* __restrict__ Qb, int ldq, int tpos0, const float* __restrict__ rope, const float* __restrict__ qgain,
                                              const bf16_t* __restrict__ Kh, const bf16_t* __restrict__ Vh, bf16_t* __restrict__ Ob, int seq, char* lds) {
  const int tid = otid(), wid = tid >> 6, lane = tid & 63, r32 = lane & 31, hi = lane >> 5;
  float* ws = (float*)(lds + TAB_OFF + 1024) + wid * 64; float* li_l = ws; float* al_l = ws + 32;
  float m_reg = -1e30f, l_reg = 0; f32x16 o[4] = {}; bf16x8 qr[8];
  const bf16_t* Qw = Qb + (long)(wid * QBLK + r32) * ldq + hi * 8;
  unsigned koff[2], voff[2];
#pragma unroll
  for (int c = 0; c < 2; ++c) { const int g = c * 512 + tid;
    { const int row = g >> 4, ch = (g & 15) ^ (row & 7); koff[c] = (unsigned)(row * 128 + ch * 8) * 2u; }
    { const int sub = g >> 5, kk = (sub >> 2) * 8 + ((g >> 2) & 7), k = (kk & ~0xC) | ((kk & 4) << 1) | ((kk & 8) >> 1), col = (sub & 3) * 32 + (g & 3) * 8; voff[c] = (unsigned)(k * 128 + col) * 2u; } }
  const unsigned wbase = (unsigned)__builtin_amdgcn_readfirstlane(wid) * 1024u;
  typedef __attribute__((address_space(3))) unsigned lds_u32;
  lds_u32* ldsl = (lds_u32*)(__attribute__((address_space(3))) char*)lds;
#define ATT_DMA(t, slot) do { const char* kt_ = (const char*)Kh + (size_t)(t) * (KVBLK * D * 2); const char* vt_ = (const char*)Vh + (size_t)(t) * (KVBLK * D * 2); \
    _Pragma("unroll") for (int c_ = 0; c_ < 2; ++c_) { \
      __builtin_amdgcn_global_load_lds((const unsigned*)(kt_ + koff[c_]), (lds_u32*)((__attribute__((address_space(3))) char*)ldsl + (slot) * SHM_SLOT + c_ * 8192 + wbase), 16, 0, 0); \
      __builtin_amdgcn_global_load_lds((const unsigned*)(vt_ + voff[c_]), (lds_u32*)((__attribute__((address_space(3))) char*)ldsl + (slot) * SHM_SLOT + 16384 + c_ * 8192 + wbase), 16, 0, 0); } } while (0)
#define RESC(a) do { if (__any((a) < 1.f)) { if (hi == 0) al_l[r32] = (a); asm volatile("s_waitcnt lgkmcnt(0)" ::: "memory"); \
    for (int d = 0; d < 4; ++d) for (int r = 0; r < 16; ++r) o[d][r] *= al_l[crow(r, hi)]; } } while (0)
  const int NT = seq / KVBLK;
  ATT_DMA(0, 0); ATT_DMA(1, 1);
#pragma unroll
  for (int d0 = 0; d0 < 8; ++d0) qr[d0] = ld8(Qw + d0 * 16);
  if (tpos0 >= 0) {
    float ss = 0.f;
#pragma unroll
    for (int d0 = 0; d0 < 8; ++d0)
#pragma unroll
      for (int i = 0; i < 8; ++i) { const float x = bf2f((unsigned)(unsigned short)qr[d0][i]); ss += x * x; }
    { auto rr = __builtin_amdgcn_permlane32_swap(__float_as_uint(ss), __float_as_uint(ss), false, false); ss = __uint_as_float(rr[0]) + __uint_as_float(rr[1]); }
    const float rinv = 1.0f / sqrtf(ss * (1.0f / 128.0f) + RMS_EPS);
    const int t = tpos0 + wid * QBLK + r32;
#pragma unroll
    for (int ax = 0; ax < 2; ++ax) { const int pos = ax ? (t & 63) : (t >> 6);
#pragma unroll
      for (int q = 0; q < 2; ++q) { const int dl = 4 * ax + q, dh = dl + 2, p0 = q * 16 + 8 * hi;
        const float* cp_ = rope + pos * 32 + p0; const float* gl = qgain + dl * 16 + 8 * hi; const float* gh = qgain + dh * 16 + 8 * hi;
        float cs[8], sn[8], lo[8], hv[8];
#pragma unroll
        for (int i = 0; i < 8; ++i) { cs[i] = cp_[i]; sn[i] = cp_[4096 + i];
          lo[i] = bf2f((unsigned)(unsigned short)qr[dl][i]) * rinv * gl[i]; hv[i] = bf2f((unsigned)(unsigned short)qr[dh][i]) * rinv * gh[i]; }
        u32x4 wl, wh;
#pragma unroll
        for (int i = 0; i < 4; ++i) { const float l0 = lo[2 * i] * cs[2 * i] - hv[2 * i] * sn[2 * i], l1 = lo[2 * i + 1] * cs[2 * i + 1] - hv[2 * i + 1] * sn[2 * i + 1];
          const float h0 = hv[2 * i] * cs[2 * i] + lo[2 * i] * sn[2 * i], h1 = hv[2 * i + 1] * cs[2 * i + 1] + lo[2 * i + 1] * sn[2 * i + 1];
          wl[i] = pk2(l0, l1); wh[i] = pk2(h0, h1); }
        qr[dl] = *reinterpret_cast<bf16x8*>(&wl); qr[dh] = *reinterpret_cast<bf16x8*>(&wh); } } }
#pragma unroll
  for (int d0 = 0; d0 < 8; ++d0) asm volatile("" : "+v"(qr[d0]));
  ATT_WAIT_BAR();
  if (2 < NT) ATT_DMA(2, 2);
  const int vb0 = (int)(uintptr_t)lds + 16384 + v_rd_base(lane);
  f32x16 pA0, pA1, pB0, pB1; float mnA, mnB, alA, alB; bf16x8 pa0, pa1, pa2, pa3;
  qkt(pA0, pA1, (const bf16_t*)lds, qr, r32, hi); partialSM(pA0, pA1, m_reg, mnA, alA);
  const bool lead = __builtin_amdgcn_readfirstlane(wid) < 4;
#define ATT_SYNC(jn) do { ATT_WAIT_BAR(); if ((jn) < NT) ATT_DMA((jn), (jn) & 3); } while (0)
  for (int j = 1; j + 1 < NT; j += 2) {
    { SBAR(); qkt(pB0, pB1, (const bf16_t*)(lds + (j & 3) * SHM_SLOT), qr, r32, hi);
      finishSM(pA0, pA1, alA, l_reg, pa0, pa1, pa2, pa3); SBAR();
      if (!lead) ATT_SYNC(j + 2);
      pv_d0(o, vb0 + ((j - 1) & 3) * (int)SHM_SLOT, pa0, pa1, pa2, pa3); partialSM(pB0, pB1, m_reg, mnB, alB);
      if (lead) ATT_SYNC(j + 2);
      RESC(alB); }
    { SBAR(); qkt(pA0, pA1, (const bf16_t*)(lds + ((j + 1) & 3) * SHM_SLOT), qr, r32, hi);
      finishSM(pB0, pB1, alB, l_reg, pa0, pa1, pa2, pa3); SBAR();
      if (!lead) ATT_SYNC(j + 3);
      pv_d0(o, vb0 + (j & 3) * (int)SHM_SLOT, pa0, pa1, pa2, pa3); partialSM(pA0, pA1, m_reg, mnA, alA);
      if (lead) ATT_SYNC(j + 3);
      RESC(alA); }
  }
#undef ATT_SYNC
  { SBAR(); qkt(pB0, pB1, (const bf16_t*)(lds + ((NT - 1) & 3) * SHM_SLOT), qr, r32, hi);
    finishSM(pA0, pA1, alA, l_reg, pa0, pa1, pa2, pa3); SBAR();
    pv_d0(o, vb0 + ((NT - 2) & 3) * (int)SHM_SLOT, pa0, pa1, pa2, pa3); partialSM(pB0, pB1, m_reg, mnB, alB);
    RESC(alB);
    finishSM(pB0, pB1, alB, l_reg, pa0, pa1, pa2, pa3); SBAR();
    pv_d0(o, vb0 + ((NT - 1) & 3) * (int)SHM_SLOT, pa0, pa1, pa2, pa3); }
  if (hi == 0) li_l[r32] = l_reg; asm volatile("s_waitcnt lgkmcnt(0)" ::: "memory");
  float rli[16];
#pragma unroll
  for (int r = 0; r < 16; ++r) rli[r] = __builtin_amdgcn_rcpf(li_l[crow(r, hi)]);
  bf16_t* Ow = Ob + (long)(wid * QBLK) * LDO;
  asm volatile("s_waitcnt lgkmcnt(0)\n\ts_barrier" ::: "memory");
  { char* st = lds + wid * 8704;
#pragma unroll
    for (int r = 0; r < 16; ++r) { const int orow = crow(r, hi);
#pragma unroll
      for (int d0 = 0; d0 < 4; ++d0) *(bf16_t*)(st + orow * 272 + (d0 * 32 + r32) * 2) = (bf16_t)f2bf(o[d0][r] * rli[r]); }
    asm volatile("s_waitcnt lgkmcnt(0)" ::: "memory");
#pragma unroll
    for (int i = 0; i < 8; ++i) { const int c = i * 64 + lane, row = c >> 4, cc = c & 15; const u32x4 v = *(const u32x4*)(st + row * 272 + cc * 16);
      const bf16_t* gp = Ow + (long)row * LDO + cc * 8;
      asm volatile("global_store_dwordx4 %0, %1, off sc1\n\ts_nop 1" :: "v"(gp), "v"(v) : "memory"); } }
  ATT_WAIT_BAR();
#undef ATT_DMA
#undef RESC
}
#undef KSWZ
}

struct Params {
    const float *x, *c, *ctx, *c_ctx, *w_mod, *b_mod, *ln_g, *ln_b, *w_qkv, *q_gain, *k_gain, *w_o, *w_pool, *pool_scale, *w_router, *router_bias, *w_gate, *w_up, *w_down;
    float* out; unsigned char* ws; int ph_lo, ph_hi;
};

struct TItem { const float* W; bf16_t* WT; int K, N, kind, k0, n0; };
__device__ __forceinline__ int t_drow(int kind, int n) { return kind == 0 ? n : ((n >> 7) * 256 + (kind == 2 ? 128 : 0) + (n & 127)); }
__device__ __forceinline__ void t_load(const TItem& d, f32x4 (&r)[8], int lane) {
    const float* p = d.W + (size_t)(d.k0 + (lane >> 3)) * d.N + d.n0 + (lane & 7) * 4;
#pragma unroll
    for (int i = 0; i < 8; ++i) r[i] = __builtin_nontemporal_load((const f32x4*)(p + (size_t)(8 * i) * d.N));
}
__device__ __forceinline__ void t_store(const TItem& d, const f32x4 (&r)[8], LAS float* scr, int lane) {
#pragma unroll
    for (int i = 0; i < 8; ++i) *(LAS f32x4*)(scr + (8 * i + (lane >> 3)) * 32 + (((lane & 7) * 4 + 8 * i) & 31)) = r[i];
    LDS_WAIT(); asm volatile("" ::: "memory");
    const int c = lane >> 3, nl = lane & 7;
#pragma unroll
    for (int j = 0; j < 4; ++j) { const int n = nl + 8 * j; const LAS float* s = scr + (8 * c) * 32 + ((n + 8 * c) & 31);
        v4u o; o.x = pk2(s[0 * 32], s[1 * 32]); o.y = pk2(s[2 * 32], s[3 * 32]); o.z = pk2(s[4 * 32], s[5 * 32]); o.w = pk2(s[6 * 32], s[7 * 32]);
        __builtin_nontemporal_store(o, (GAS v4u*)(d.WT + (size_t)t_drow(d.kind, d.n0 + n) * d.K + d.k0 + 8 * c)); }
    LDS_WAIT(); asm volatile("" ::: "memory");
}

__device__ __forceinline__ void mod_prepare(const float* cl, const float* cc, LAS float* sv, int tid) {
    for (int i = tid; i < 3 * DM; i += 512) { const int cd = i >> 11, k = i & 2047; const float v = (cd < 2) ? cl[cd * DM + k] : cc[k]; sv[i] = v / (1.0f + expf(-v)); }
    __syncthreads();
}
__device__ __forceinline__ void mod_item(int it, const float* wm, const float* bm, float* MOD, const LAS float* sv, LAS float* red, int tid, int lane, int wave) {
    const int c4 = lane & 7, kr = (lane >> 3) + 8 * wave;
    const int l = it / 384, nb = it % 384; const float* W = wm + (size_t)l * DM * 12288 + nb * 32 + c4 * 4;
    f32x4 a0 = {0, 0, 0, 0}, a1 = a0, a2 = a0;
#pragma unroll 16
    for (int s = 0; s < 32; ++s) { const int k = s * 64 + kr; const f32x4 w = *(const f32x4*)(W + (size_t)k * 12288);
        a0 += w * sv[k]; a1 += w * sv[DM + k]; a2 += w * sv[2 * DM + k]; }
    *(LAS f32x4*)(red + (kr * 3 + 0) * 32 + c4 * 4) = a0; *(LAS f32x4*)(red + (kr * 3 + 1) * 32 + c4 * 4) = a1; *(LAS f32x4*)(red + (kr * 3 + 2) * 32 + c4 * 4) = a2;
    __syncthreads();
    if (tid < 96) { const int cd = tid >> 5, n = tid & 31; float s = 0.f; for (int r = 0; r < 64; ++r) s += red[(r * 3 + cd) * 32 + n];
        MOD[((size_t)l * 3 + cd) * 12288 + nb * 32 + n] = s + bm[l * 12288 + nb * 32 + n]; }
    __syncthreads();
}

typedef const __attribute__((address_space(4))) Params CParams;
__device__ __forceinline__ CParams* kparams() { CParams* k = (CParams*)__builtin_amdgcn_kernarg_segment_ptr(); asm volatile("" : "+s"(k)); return k; }
#define WSP(T, off) ((T*)(kp->ws + (off)))


#define IN(k) (lo <= (k) && (k) < hi)
#define NREP(k) (1 + ((REP_MASK >> (k)) & 1))
#define SEAM(k) do { if (IN(k) && IN((k) + 1)) xcd_barrier(bar); } while (0)
#define TIDS const int tid = otid(), lane = tid & 63, wave = __builtin_amdgcn_readfirstlane(tid >> 6), G = ogrid(), bx = obid(), gw = bx * 8 + wave, NGW = G * 8; (void)lane; (void)gw; (void)NGW


template <int layer>
__device__ __forceinline__ void layer_half(const int lo, const int hi, const XcdBarrier& bar, LAS unsigned char* L, LAS int* tcnt, LAS int* tbase, LAS int* texp) {
        const int P6 = 6 + 7 * layer;
        if (IN(P6)) _Pragma("unroll 1") for (int rep_ = 0; rep_ < NREP(6); ++rep_) {
            CParams* kp = kparams(); TIDS;
            const int row_lo = layer == 0 ? 0 : NCTX;
            const float* modl = WSP(float, WS_MOD) + (size_t)layer * 3 * 12288;
            unsigned* cnt = WSP(unsigned, WS_CTL) + CW_CNT + layer * 1024;
            const bf16_t* Y = WSP(bf16_t, WS_Y); float* X1 = WSP(float, WS_X1); bf16_t* Hb = WSP(bf16_t, WS_H);
            const float* xlat = kp->x; const float* xctx = kp->ctx; const bf16_t* X2b = WSP(bf16_t, WS_X2);
            const float* pscale = kp->pool_scale;
            int* LIST = WSP(int, WS_LIST); float* LISTG = WSP(float, WS_LIST) + (size_t)32 * MT;
            const float rb_e = kp->router_bias[lane & 31];
            LAS bf16_t* hp = (LAS bf16_t*)L;
            LAS float* part = (LAS float*)(L + 65536);
            LAS int* lcnt = (LAS int*)(L + 65536 + 8192); LAS int* lbase = lcnt + 32;
            LAS int* asg = (LAS int*)(L + 65536 + 8192 + 256);
            LAS float* vG1 = (LAS float*)(L + 82176); LAS float* vLG = vG1 + DM; LAS float* vLB = vLG + DM; LAS float* vSC = vLB + DM; LAS float* vSH = vSC + DM;
            const float* lg = kp->ln_g + (size_t)(layer * 2 + 0) * DM; const float* lb = kp->ln_b + (size_t)(layer * 2 + 0) * DM;
            const int ngrp = (MT - row_lo) / 8;
            const bool agg = ((ngrp + G - 1) / G) * 16 <= 512;
            if (tid < 32) lcnt[tid] = 0;
            const int ti = lane & 31, hi = lane >> 5;
            const bf16_t* w1p = WSP(bf16_t, WS_WR) + ((size_t)(wave * 16) * 64 + lane) * 8; const bf16_t* w2p = w1p + 32 * DM;
            const LAS bf16_t* a1p = hp + (ti & 7) * DM + wave * 256 + 8 * hi; const LAS bf16_t* a2p = a1p + 8 * DM;
            f32x4 xv[8]; v2u xb[8], yv[8];
#define P6_LOAD(grp_) do { const int row_ = row_lo + (grp_) * 8 + wave; const float* xr_ = (row_ < NCTX) ? xctx + (size_t)row_ * DM : xlat + (size_t)(row_ - NCTX) * DM; const bf16_t* yr_ = Y + (size_t)row_ * DM; const bf16_t* xb_ = X2b + (size_t)row_ * DM; \
                _Pragma("unroll") for (int j = 0; j < 8; ++j) { if (layer == 0) xv[j] = *(const f32x4*)(xr_ + (j * 64 + lane) * 4); else xb[j] = *(const v2u*)(xb_ + (j * 64 + lane) * 4); yv[j] = *(const v2u*)(yr_ + (j * 64 + lane) * 4); } } while (0)
            LAS int* rdy = (LAS int*)(L + 124928); unsigned* yd = WSP(unsigned, WS_CTL) + CW_YD; volatile LAS unsigned* MISC = (volatile LAS unsigned*)(L + MISC_OFF);
            const bool dyn = (layer == 0) && (G % 2 == 0); const int pcls = bx & 1; unsigned* q6 = WSP(unsigned, WS_CTL) + CW_P6Q + 32 * pcls;
            auto gmap = [&](unsigned pos) -> int { return pos >= 1056u ? -1 : (pos < 32u ? pcls * 32 + (int)pos : 64 + pcls * 1024 + ((int)pos - 32)); };
            auto seq = [&](int k) -> int { const int g_ = bx + k * G; return g_ < ngrp ? g_ : -1; };
            auto ensure = [&](int g_) { if (layer == 0) { const int pm_ = g_ < 64 ? (g_ >> 5) : 2 + ((g_ - 64) >> 5); if (!rdy[pm_]) { while (xb_ld(yd + 32 * pm_) < 8u) __builtin_amdgcn_s_sleep(4); asm volatile("" ::: "memory"); } } };
            if (layer == 0) { if (tid < 66) rdy[tid] = xb_ld(yd + 32 * tid) >= 8u ? 1 : 0;
                if (tid == 0) { __builtin_amdgcn_fence(__ATOMIC_ACQUIRE, "agent"); asm volatile("s_waitcnt vmcnt(0)" ::: "memory");
                    if (dyn) { MISC[36] = xb_add(q6, 1u); MISC[37] = xb_add(q6, 1u); } }
                __syncthreads(); }
            int grp = dyn ? gmap(MISC[36]) : seq(0), nxt_ = dyn ? gmap(MISC[37]) : seq(1);
            if (grp >= 0) ensure(grp);
            P6_LOAD(grp >= 0 ? grp : 0);
            int it_ = 0, cur_cd = -1;
            for (; grp >= 0; ++it_) {
                const int pf_ = nxt_ >= 0 ? nxt_ : grp; if (nxt_ >= 0) ensure(nxt_);
                unsigned tk2 = 0xffffffffu;
                if (dyn && tid == 0 && nxt_ >= 0 && it_ + 2 < 32) tk2 = xb_add(q6, 1u);
                const int row = row_lo + grp * 8 + wave; const int cd = row_cond(row_lo + grp * 8);
                if (cd != cur_cd) {
                    const float* g1 = modl + (size_t)cd * 12288 + 2 * DM;
                    float t0[4], t1[4], t2[4], t3[4], t4[4], t5[4];
                    __syncthreads();
#pragma unroll
                    for (int q = 0; q < 4; ++q) { const int i = tid + q * 512; t0[q] = g1[i]; t1[q] = (layer == 1) ? pscale[i] : 1.0f; t2[q] = lg[i]; t3[q] = lb[i]; t4[q] = g1[DM + i]; t5[q] = g1[2 * DM + i]; }
#pragma unroll
                    for (int q = 0; q < 4; ++q) { const int i = tid + q * 512; vG1[i] = t0[q] * t1[q]; vLG[i] = t2[q]; vLB[i] = t3[q]; vSH[i] = t4[q]; vSC[i] = t5[q] + 1.0f; }
                    cur_cd = cd; __syncthreads(); }
                f32x4 v[8]; float s = 0.f;
#pragma unroll
                for (int j = 0; j < 8; ++j) { const int c = (j * 64 + lane) * 4; const f32x4 gv = *(const LAS f32x4*)(vG1 + c);
                    const f32x4 yf = {bf2f(yv[j].x & 0xffffu), bf2f(yv[j].x >> 16), bf2f(yv[j].y & 0xffffu), bf2f(yv[j].y >> 16)};
                    const f32x4 xf = (layer == 0) ? xv[j] : bf4(xb[j]);
                    v[j] = xf * ALPHA + gv * yf; s += (v[j][0] + v[j][1]) + (v[j][2] + v[j][3]); }
                const float mean = wave_sum(s) * (1.0f / DM); float s2 = 0.f;
#pragma unroll
                for (int j = 0; j < 8; ++j) { v[j] = v[j] - mean; s2 += (v[j][0] * v[j][0] + v[j][1] * v[j][1]) + (v[j][2] * v[j][2] + v[j][3] * v[j][3]); }
                const float rstd = 1.0f / sqrtf(wave_sum(s2) * (1.0f / DM) + LN_EPS);
#pragma unroll
                for (int j = 0; j < 8; ++j) { const int c = (j * 64 + lane) * 4;
                    const f32x4 x1 = v[j] * rstd * *(const LAS f32x4*)(vLG + c) + *(const LAS f32x4*)(vLB + c);
                    { v2u xw; xw.x = pk2(x1[0], x1[1]); xw.y = pk2(x1[2], x1[3]); *(v2u*)((bf16_t*)X1 + (size_t)row * DM + c) = xw; }
                    const f32x4 hv = x1 * *(const LAS f32x4*)(vSC + c) + *(const LAS f32x4*)(vSH + c);
                    v2u w; w.x = pk2(hv[0], hv[1]); w.y = pk2(hv[2], hv[3]); *(v2u*)(Hb + (size_t)row * DM + c) = w;
                    v2u w2; w2.x = pk2(hv[0] - bf2f(w.x & 0xffffu), hv[1] - bf2f(w.x >> 16)); w2.y = pk2(hv[2] - bf2f(w.y & 0xffffu), hv[3] - bf2f(w.y >> 16));
                    *(LAS v2u*)(hp + wave * DM + c) = w; *(LAS v2u*)(hp + (8 + wave) * DM + c) = w2; }
                const bf16_t* w1q = w1p; asm volatile("" : "+v"(w1q));
                const bf16_t* w2q = w1q + 32 * DM;
                bf16x8 wA1[4], wA2[4], wB1[4], wB2[4];
#define P6_WLOAD(d1, d2, q0) do { _Pragma("unroll") for (int q_ = 0; q_ < 4; ++q_) { d1[q_] = *(const GAS bf16x8*)(w1q + ((q0) + q_) * 512); d2[q_] = *(const GAS bf16x8*)(w2q + ((q0) + q_) * 512); } } while (0)
#define P6_MMA(s1, s2, q0) do { _Pragma("unroll") for (int q_ = 0; q_ < 4; ++q_) { const bf16x8 a1 = *(const LAS bf16x8*)(a1p + ((q0) + q_) * 16), a2 = *(const LAS bf16x8*)(a2p + ((q0) + q_) * 16); \
                    acc = __builtin_amdgcn_mfma_f32_32x32x16_bf16(a1, s1[q_], acc, 0, 0, 0); acc = __builtin_amdgcn_mfma_f32_32x32x16_bf16(a1, s2[q_], acc, 0, 0, 0); acc = __builtin_amdgcn_mfma_f32_32x32x16_bf16(a2, s1[q_], acc, 0, 0, 0); } } while (0)
                P6_WLOAD(wA1, wA2, 0); P6_WLOAD(wB1, wB2, 4);
                __syncthreads();
                {
                    f32x16 acc = {};
                    __builtin_amdgcn_sched_barrier(0); P6_MMA(wA1, wA2, 0); __builtin_amdgcn_sched_barrier(0);
                    P6_WLOAD(wA1, wA2, 8); __builtin_amdgcn_sched_barrier(0); P6_MMA(wB1, wB2, 4); __builtin_amdgcn_sched_barrier(0);
                    P6_WLOAD(wB1, wB2, 12); __builtin_amdgcn_sched_barrier(0);
                    P6_LOAD(pf_);
                    __builtin_amdgcn_sched_barrier(0); P6_MMA(wA1, wA2, 8); __builtin_amdgcn_sched_barrier(0);
                    P6_MMA(wB1, wB2, 12);
#pragma unroll
                    for (int r = 0; r < 4; ++r) part[(wave * 8 + r + 4 * hi) * 32 + ti] = acc[r];
                }
                if (dyn && tid == 0) MISC[38] = tk2;
                __syncthreads();
                {
                    const int rr = row_lo + grp * 8 + wave, e = lane & 31; float lgt = 0.f;
#pragma unroll
                    for (int k = 0; k < 8; ++k) lgt += part[(k * 8 + wave) * 32 + e];
                    const float aff = 1.0f / (1.0f + expf(-lgt)); const float sel = aff + rb_e;
                    const float o1 = dppf<0xB1>(sel), mx1 = fmaxf(sel, o1), mn1 = fminf(sel, o1);
                    const float mx2 = dppf<0x4E>(mx1), mn2 = dppf<0x4E>(mn1);
                    float gs = fmaxf(mx1, mx2) + fmaxf(fminf(mx1, mx2), fmaxf(mn1, mn2)); int bg = e >> 2;
                    { const float og = dppf<0x141>(gs); const int ob = dppi<0x141>(bg); if (og > gs || (og == gs && ob < bg)) { gs = og; bg = ob; } }
                    { const float og = dppf<0x140>(gs); const int ob = dppi<0x140>(bg); if (og > gs || (og == gs && ob < bg)) { gs = og; bg = ob; } }
                    { const auto rg = __builtin_amdgcn_permlane16_swap(__float_as_uint(gs), __float_as_uint(gs), false, false); const auto rb = __builtin_amdgcn_permlane16_swap((unsigned)bg, (unsigned)bg, false, false);
                      const bool odd = (lane & 16) != 0; const float og = __uint_as_float(odd ? rg[0] : rg[1]); const int ob = (int)(odd ? rb[0] : rb[1]); if (og > gs || (og == gs && ob < bg)) { gs = og; bg = ob; } }
                    const int bgs = __builtin_amdgcn_readfirstlane(bg);
                    float s4[4], a4[4];
#pragma unroll
                    for (int j = 0; j < 4; ++j) { s4[j] = __uint_as_float((unsigned)__builtin_amdgcn_readlane((int)__float_as_uint(sel), bgs * 4 + j)); a4[j] = __uint_as_float((unsigned)__builtin_amdgcn_readlane((int)__float_as_uint(aff), bgs * 4 + j)); }
                    int i0 = 0; float m0 = s4[0], g0 = a4[0];
#pragma unroll
                    for (int j = 1; j < 4; ++j) if (s4[j] > m0) { m0 = s4[j]; i0 = j; g0 = a4[j]; }
                    int i1 = -1; float m1 = -1e30f, g1_ = 0.f;
#pragma unroll
                    for (int j = 0; j < 4; ++j) if (j != i0 && s4[j] > m1) { m1 = s4[j]; i1 = j; g1_ = a4[j]; }
                    const int e0 = __builtin_amdgcn_readfirstlane(bg * 4 + i0), e1 = __builtin_amdgcn_readfirstlane(bg * 4 + i1);
                    const float inv = 1.0f / (g0 + g1_);
                    if (lane == 0 && rep_ == 0) {
                        if (agg) { const int q0 = __hip_atomic_fetch_add(&lcnt[e0], 1, __ATOMIC_RELAXED, __HIP_MEMORY_SCOPE_WORKGROUP), q1 = __hip_atomic_fetch_add(&lcnt[e1], 1, __ATOMIC_RELAXED, __HIP_MEMORY_SCOPE_WORKGROUP);
                            LAS int* ap = asg + (it_ * 8 + wave) * 8;
                            ap[0] = e0; ap[1] = q0; ap[2] = rr * 2; ap[3] = (int)__float_as_uint(g0 * inv); ap[4] = e1; ap[5] = q1; ap[6] = rr * 2 + 1; ap[7] = (int)__float_as_uint(g1_ * inv);
                        } else {
                            const unsigned p0 = __hip_atomic_fetch_add(&cnt[e0 * 32], 1u, RLX_AGENT), p1 = __hip_atomic_fetch_add(&cnt[e1 * 32], 1u, RLX_AGENT);
                            LIST[(size_t)e0 * MT + p0] = rr * 2; LISTG[(size_t)e0 * MT + p0] = g0 * inv;
                            LIST[(size_t)e1 * MT + p1] = rr * 2 + 1; LISTG[(size_t)e1 * MT + p1] = g1_ * inv; } }
                }
                grp = nxt_; nxt_ = dyn ? gmap(MISC[38]) : seq(it_ + 2);
            }
#undef P6_LOAD
#undef P6_WLOAD
#undef P6_MMA
            __syncthreads();
            if (agg && rep_ == 0) {
                if (tid < 32) lbase[tid] = (int)__hip_atomic_fetch_add(&cnt[tid * 32], (unsigned)lcnt[tid], RLX_AGENT);
                __syncthreads();
                for (int i = tid; i < it_ * 16; i += 512) { const int e = asg[i * 4], q = asg[i * 4 + 1], src = asg[i * 4 + 2]; const float gt = __uint_as_float((unsigned)asg[i * 4 + 3]);
                    const size_t o = (size_t)e * MT + (size_t)(lbase[e] + q); LIST[o] = src; LISTG[o] = gt; }
            }
            __syncthreads();
        }
        SEAM(P6);
        int NT = 0;
        if (IN(P6 + 1) || IN(P6 + 2) || IN(P6 + 3)) {
            CParams* kp = kparams(); unsigned* cnt = WSP(unsigned, WS_CTL) + CW_CNT + layer * 1024;
            const int ttid = otid();
            if (ttid < 64) { const int ln = ttid, e = ln & 31; const int c = (int)__hip_atomic_load(&cnt[e * 32], RLX_AGENT); const int nt_ = (c + 255) >> 8; int inc = nt_;
#pragma unroll
                for (int o = 1; o < 32; o <<= 1) { const int t_ = __shfl_up(inc, o); if ((ln & 31) >= o) inc += t_; }
                if (ln < 32) { tcnt[e] = c; tbase[e] = inc - nt_; if (e == 31) tbase[32] = inc; for (int t_ = inc - nt_; t_ < inc; ++t_) texp[t_] = e; } }
            __syncthreads();
            NT = __builtin_amdgcn_readfirstlane(tbase[32]);
        }
        if (IN(P6 + 2)) _Pragma("unroll 1") for (int rep_ = 0; rep_ < NREP(8); ++rep_) {
            CParams* kp = kparams();
            typedef pg8::SchedMoe<256u * DM * 2u, 256u * DM * 2u, 2048u * DM * 2u, DM / 64, true> Sch;
            LAS int* rt = (LAS int*)(L + TAB_OFF + 1024);
            pg8::Gemm g{DM, DM, DM}; Sch S; S.o.init(NT, 8, ogrid(), obid()); S.A = WSP(const char, WS_H); S.B = WSP(const char, WS_WGU) + (size_t)layer * 32 * 2048 * DM * 2;
            S.texp = texp; S.tbase = tbase; S.tcnt = tcnt; S.rt = rt; S.list = WSP(int, WS_LIST); S.ctr = WSP(unsigned, WS_CTL) + CW_GUD + layer * 8192;
            S.fill_rows(rt, otid());
            pg8::EpiGateUp E{WSP(bf16_t, WS_ACT)};
            pg8::gemm_phase<pg8::EpiGateUp, Sch, true, true>(L, g, S, E);
        }
        if (IN(P6 + 2)) _Pragma("unroll 1") for (int rep_ = 0; rep_ < NREP(9); ++rep_) {
            CParams* kp = kparams();
            typedef pg8::SchedMoe<256u * DE * 2u, 256u * DE * 2u, (unsigned)DM * DE * 2u, DE / 64, false> Sch;
            pg8::Gemm g{DE, DE, DE}; Sch S; S.o.init(NT, 8, ogrid(), obid()); S.o.rot = 1; S.rem = (NT * 8) % ogrid(); S.nl = ogrid() - S.rem; S.A = WSP(const char, WS_ACT); S.B = WSP(const char, WS_WD) + (size_t)layer * 32 * DM * DE * 2;
            LAS int* rt = (LAS int*)(L + TAB_OFF + 1024);
            S.texp = texp; S.tbase = tbase; S.tcnt = tcnt; S.rt = nullptr; S.list = WSP(int, WS_LIST); S.ctr = WSP(unsigned, WS_CTL) + CW_GUD + layer * 8192;
            if (otid() == 0) { __builtin_amdgcn_fence(__ATOMIC_ACQUIRE, "agent"); asm volatile("s_waitcnt vmcnt(0)" ::: "memory"); }
            S.fill_dst(rt, WSP(float, WS_LIST) + (size_t)32 * MT, otid());
            pg8::EpiDown E{WSP(bf16_t, WS_FB), rt};
            pg8::gemm_phase<pg8::EpiDown, Sch, true, false>(L, g, S, E);
        }
        SEAM(P6 + 3);
        if (IN(P6 + 4)) _Pragma("unroll 1") for (int rep_ = 0; rep_ < NREP(10); ++rep_) {
            CParams* kp = kparams(); TIDS;
            const int row_lo = layer == 0 ? 0 : NCTX;
            const float* modl = WSP(float, WS_MOD) + (size_t)layer * 3 * 12288; const float* X1 = WSP(float, WS_X1); const bf16_t* FB = WSP(bf16_t, WS_FB);
            float* dstb = kp->out - (size_t)NCTX * DM; bf16_t* X2b = WSP(bf16_t, WS_X2);
            LAS float* vG2 = (LAS float*)L; LAS float* vLG = vG2 + 3 * DM; LAS float* vLB = vLG + DM;
            { const float* lg = kp->ln_g + (size_t)(layer * 2 + 1) * DM; const float* lb = kp->ln_b + (size_t)(layer * 2 + 1) * DM;
              float t0[12], t1[4], t2[4];
#pragma unroll
              for (int q = 0; q < 12; ++q) { const int i = tid + q * 512; t0[q] = modl[(size_t)(i >> 11) * 12288 + 5 * DM + (i & 2047)]; }
#pragma unroll
              for (int q = 0; q < 4; ++q) { const int i = tid + q * 512; t1[q] = lg[i]; t2[q] = lb[i]; }
#pragma unroll
              for (int q = 0; q < 12; ++q) vG2[tid + q * 512] = t0[q];
#pragma unroll
              for (int q = 0; q < 4; ++q) { vLG[tid + q * 512] = t1[q]; vLB[tid + q * 512] = t2[q]; } }
            __syncthreads();
            f32x4 xa[8]; v2u fa[8], fb[8];
#define P10_LOAD(row_) do { const float* xr_ = X1 + (size_t)(row_) * DM; const bf16_t* xb_ = (const bf16_t*)X1 + (size_t)(row_) * DM; const bf16_t* f0_ = FB + (size_t)((row_) * 2) * DM; \
                _Pragma("unroll") for (int j = 0; j < 8; ++j) { const int c = (j * 64 + lane) * 4; \
                    { const v2u q_ = *(const v2u*)(xb_ + c); xa[j] = (f32x4){bf2f(q_.x & 0xffffu), bf2f(q_.x >> 16), bf2f(q_.y & 0xffffu), bf2f(q_.y >> 16)}; } \
                    fa[j] = *(const v2u*)(f0_ + c); fb[j] = *(const v2u*)(f0_ + DM + c); } } while (0)
            { const int r0 = row_lo + gw; P10_LOAD(r0 < MT ? r0 : row_lo); }
            for (int row = row_lo + gw; row < MT; row += NGW) { const int cd = row_cond(row);
                f32x4 v[8]; float s = 0.f;
#pragma unroll
                for (int j = 0; j < 8; ++j) { const int c = (j * 64 + lane) * 4;
                    const f32x4 fs = {bf2f(fa[j].x & 0xffffu) + bf2f(fb[j].x & 0xffffu), bf2f(fa[j].x >> 16) + bf2f(fb[j].x >> 16), bf2f(fa[j].y & 0xffffu) + bf2f(fb[j].y & 0xffffu), bf2f(fa[j].y >> 16) + bf2f(fb[j].y >> 16)};
                    v[j] = xa[j] * ALPHA + *(const LAS f32x4*)(vG2 + cd * DM + c) * fs; s += (v[j][0] + v[j][1]) + (v[j][2] + v[j][3]); }
                if (row + NGW < MT) P10_LOAD(row + NGW);
                const float mean = wave_sum(s) * (1.0f / DM); float s2 = 0.f;
#pragma unroll
                for (int j = 0; j < 8; ++j) { v[j] = v[j] - mean; s2 += (v[j][0] * v[j][0] + v[j][1] * v[j][1]) + (v[j][2] * v[j][2] + v[j][3] * v[j][3]); }
                const float rstd = 1.0f / sqrtf(wave_sum(s2) * (1.0f / DM) + LN_EPS);
                float* dst = dstb + (size_t)row * DM;
#pragma unroll
                for (int j = 0; j < 8; ++j) { const int c = (j * 64 + lane) * 4; const f32x4 r_ = v[j] * rstd * *(const LAS f32x4*)(vLG + c) + *(const LAS f32x4*)(vLB + c);
                    if (layer == 0) { v2u w; w.x = pk2(r_[0], r_[1]); w.y = pk2(r_[2], r_[3]); *(v2u*)(X2b + (size_t)row * DM + c) = w; } else *(f32x4*)(dst + c) = r_; } }
#undef P10_LOAD
            __syncthreads();
        }
        if constexpr (layer == 0) {
            SEAM(10);
            if (IN(11)) _Pragma("unroll 1") for (int rep_ = 0; rep_ < NREP(11); ++rep_) {
                CParams* kp = kparams(); TIDS;
                const bf16_t* X2 = WSP(bf16_t, WS_X2); bf16_t* DP = WSP(bf16_t, WS_DP);
                const float* sc1 = WSP(float, WS_MOD) + (size_t)3 * 12288 + DM;
                const int c = tid * 4, gch = c >> 9, hw = 1 << gch;
                for (int chunk = bx; chunk < NLAT / 64; chunk += G) { const int b = chunk >> 7, t0 = (chunk & 127) * 64;
                    const bf16_t* base = X2 + ((size_t)NCTX + (size_t)b * SEQ) * DM + c; bf16_t* dbase = DP + ((size_t)NCTX + (size_t)b * SEQ) * DM + c;
                    const f32x4 a1 = *(const f32x4*)(sc1 + (size_t)b * 12288 + c) + 1.0f;
                    f32x4 s = {0, 0, 0, 0};
                    { v2u wv[16];
#pragma unroll
                      for (int q = 0; q < 16; ++q) { const int p_ = t0 - 8 + q; wv[q] = *(const v2u*)(base + (size_t)(p_ < 0 ? 0 : p_) * DM); }
#pragma unroll
                      for (int q = 0; q < 16; ++q) { const int p_ = t0 - 8 + q; const bool in_ = p_ >= 0 && p_ >= t0 - hw && p_ < t0 + hw; s += bf4(wv[q]) * (in_ ? 1.0f : 0.0f); } }
#pragma unroll 8
                    for (int i = 0; i < 64; ++i) { const int t = t0 + i; const int tn = t + hw, to = t - hw;
                        const f32x4 xc = bf4(*(const v2u*)(base + (size_t)t * DM));
                        const f32x4 xn = bf4(*(const v2u*)(base + (size_t)(tn < SEQ ? tn : SEQ - 1) * DM)), xo = bf4(*(const v2u*)(base + (size_t)(to >= 0 ? to : 0) * DM));
                        const int lo_ = to < 0 ? 0 : to, hi_ = tn > SEQ ? SEQ : tn;
                        const f32x4 d = a1 * (s * (1.0f / (float)(hi_ - lo_)) - xc);
                        v2u w; w.x = pk2(d[0], d[1]); w.y = pk2(d[2], d[3]); *(v2u*)(dbase + (size_t)t * DM) = w;
                        s = s + xn * (tn < SEQ ? 1.0f : 0.0f) - xo * (to >= 0 ? 1.0f : 0.0f); }
                }
            }
            SEAM(11);
            if (IN(12)) _Pragma("unroll 1") for (int rep_ = 0; rep_ < NREP(12); ++rep_) {
                CParams* kp = kparams();
                pg8::Gemm g{DM, 512, 512}; pg8::SchedPool S; S.o.init(NLAT / 256, 8, ogrid(), obid()); S.A = WSP(const char, WS_DP); S.B = WSP(const char, WS_WPOOL);
                pg8::EpiBf16 E{WSP(bf16_t, WS_Y), DM, nullptr};
                pg8::gemm_phase<pg8::EpiBf16, pg8::SchedPool, true, false>(L, g, S, E);
            }
            SEAM(12);
        }
    }

__global__ void __launch_bounds__(512, 2) mk_fwd(Params p_unused) {
    extern __shared__ __attribute__((aligned(16))) unsigned char lds[];
    LAS unsigned char* L = (LAS unsigned char*)lds;
    volatile LAS unsigned* MISC = (volatile LAS unsigned*)(L + MISC_OFF);
    LAS int* tcnt = (LAS int*)(L + TAB_OFF); LAS int* tbase = tcnt + 32; LAS int* texp = tcnt + 80;
    if (threadIdx.x < 64) MISC[threadIdx.x] = 0u;
    __syncthreads();
    int lo, hi; XcdBarrier bar;
    { CParams* kp = kparams(); lo = kp->ph_lo; hi = kp->ph_hi; unsigned* bw = (unsigned*)(kp->ws + WS_CTL) + CW_BAR;
      bar.bar = bw; bar.x = 0; bar.st = nullptr; if (hi - lo > 1) bar = xcd_barrier_post(bw, MISC + 8); }
    if (IN(0)) _Pragma("unroll 1") for (int rep_ = 0; rep_ < NREP(0); ++rep_) {
        CParams* kp = kparams(); TIDS;
        float* MOD = WSP(float, WS_MOD); float* ROPE = WSP(float, WS_ROPE);
        for (int i = bx * 512 + tid; i < 4096; i += G * 512) { const int pos = i >> 5, pp = i & 31;
            const float inv = exp2f(-(float)pp * (13.287712379549449f / 32.0f)); const float ang = (float)pos * inv;
            float sn, cs; sincosf(ang, &sn, &cs); ROPE[i] = cs; ROPE[4096 + i] = sn; }
        { const float* wrt = kp->w_router; bf16_t* WR = WSP(bf16_t, WS_WR);
          for (int i = bx * 512 + tid; i < 32 * DM; i += G * 512) { const int ii = i & 7, ln = (i >> 3) & 63, kq = (i >> 9) & 15, w = i >> 13; const int e = ln & 31, k = w * 256 + kq * 16 + 8 * (ln >> 5) + ii;
              const float wv = wrt[k * 32 + e]; const unsigned h1 = f2bf(wv); const unsigned h2 = f2bf(wv - bf2f(h1)); WR[i] = (bf16_t)h1; WR[32 * DM + i] = (bf16_t)h2; } }
        {
            LAS float* sv = (LAS float*)L;
            LAS float* red = (LAS float*)(L + 32768);
            mod_prepare(kp->c, kp->c_ctx, sv, tid);
            for (int it = bx; it < 384; it += G) mod_item(it, kp->w_mod, kp->b_mod, MOD, sv, red, tid, lane, wave);
        }
        {
            LAS float* scr = (LAS float*)(L + wave * 16384);
            constexpr int I_QKV = (DM / 64) * (QKVD / 32), I_O = (DM / 64) * (DM / 32), I_P = (512 / 64) * (512 / 32), I_G = (DM / 64) * (DE / 32), I_D = (DE / 64) * (DM / 32);
            constexpr int NITEMS = I_QKV + I_O + 4 * I_P;
            (void)I_G; (void)I_D;
            auto decode = [&](int it) { TItem d; int r = it;
                if (r < I_QKV) { d.W = kp->w_qkv; d.WT = WSP(bf16_t, WS_WQKV); d.K = DM; d.N = QKVD; d.kind = 0; }
                else if ((r -= I_QKV) < I_O) { d.W = kp->w_o; d.WT = WSP(bf16_t, WS_WO); d.K = DM; d.N = DM; d.kind = 0; }
                else { r -= I_O; const int g = r / I_P; r -= g * I_P; d.W = kp->w_pool + (size_t)g * 512 * 512; d.WT = WSP(bf16_t, WS_WPOOL) + (size_t)g * 512 * 512; d.K = 512; d.N = 512; d.kind = 0; }
                const int nblk = d.N / 32; d.k0 = 64 * (r / nblk); d.n0 = 32 * (r % nblk); return d; };
            for (int it = gw; it < NITEMS; it += 2 * NGW) {
                const TItem d0 = decode(it); f32x4 ra[8], rb[8]; t_load(d0, ra, lane);
                const bool two = it + NGW < NITEMS; TItem d1 = d0; if (two) { d1 = decode(it + NGW); t_load(d1, rb, lane); }
                t_store(d0, ra, scr, lane); if (two) t_store(d1, rb, scr, lane);
            }
        }
        __syncthreads();
    }
    SEAM(0);

    if (IN(1)) _Pragma("unroll 1") for (int rep_ = 0; rep_ < NREP(1); ++rep_) {
        CParams* kp = kparams(); TIDS;
        const float* MOD = WSP(float, WS_MOD); bf16_t* U = WSP(bf16_t, WS_U); const float* xl = kp->x; const float* xc = kp->ctx;
        const int R = (MT + NGW - 1) / NGW, r0 = gw * R, r1 = (r0 + R) < MT ? (r0 + R) : MT;
        f32x4 sa[8], sb[8], xv[8]; int cur = -1;
#define P1_LOAD(row_) do { const float* xr_ = ((row_) < NCTX) ? xc + (size_t)(row_) * DM : xl + (size_t)((row_) - NCTX) * DM; _Pragma("unroll") for (int j = 0; j < 8; ++j) xv[j] = *(const f32x4*)(xr_ + (j * 64 + lane) * 4); } while (0)
        if (r0 < r1) P1_LOAD(r0); else P1_LOAD(0);
        for (int row = r0; row < r1; ++row) { const int cd = row_cond(row);
            if (cd != cur) { const float* sh = MOD + (size_t)cd * 12288; const float* sc = sh + DM;
#pragma unroll
                for (int j = 0; j < 8; ++j) { const int c = (j * 64 + lane) * 4; sa[j] = *(const f32x4*)(sc + c) + 1.0f; sb[j] = *(const f32x4*)(sh + c); }
                cur = cd; }
            f32x4 o[8];
#pragma unroll
            for (int j = 0; j < 8; ++j) o[j] = xv[j] * sa[j] + sb[j];
            if (row + 1 < r1) P1_LOAD(row + 1);
#pragma unroll
            for (int j = 0; j < 8; ++j) { const int c = (j * 64 + lane) * 4; v2u w; w.x = pk2(o[j][0], o[j][1]); w.y = pk2(o[j][2], o[j][3]); *(v2u*)(U + (size_t)row * DM + c) = w; } }
#undef P1_LOAD
    }
    SEAM(1);

    if (IN(2)) _Pragma("unroll 1") for (int rep_ = 0; rep_ < NREP(2); ++rep_) {
        CParams* kp = kparams();
        typedef pg8::SchedSplit<256u * DM * 2u, 256u * DM * 2u, DM / 64, QKVD / 256> Sch;
        pg8::Gemm g{DM, DM, DM}; Sch S; S.init(ogrid(), obid()); S.A = WSP(const char, WS_U); S.B = WSP(const char, WS_WQKV);
        pg8::EpiQkv E{WSP(bf16_t, WS_QKVR), QKVD, WSP(float, WS_PQ), WSP(bf16_t, WS_V)};
        pg8::gemm_phase<pg8::EpiQkv, Sch, true, false>(L, g, S, E);
    }
    SEAM(2);

    if (IN(3)) _Pragma("unroll 1") for (int rep_ = 0; rep_ < NREP(3); ++rep_) {
        CParams* kp = kparams(); TIDS;
        const float* ROPE = WSP(float, WS_ROPE); const bf16_t* QKVR = WSP(bf16_t, WS_QKVR); bf16_t* Qb = WSP(bf16_t, WS_Q); bf16_t* Kb = WSP(bf16_t, WS_K); bf16_t* Vb = WSP(bf16_t, WS_V);
        const int sub = lane >> 4, l16 = lane & 15, d0 = l16 * 8, ax = l16 >> 3, hh = (l16 >> 2) & 1, p0 = (l16 & 3) * 8;
        const bool split3 = ((64 * (QKVD / 256)) % G == 0) && (2 * (QKVD / 256) * 8 <= G);
        const float* PQ = WSP(float, WS_PQ);
        float qg[8], kg[8];
        { const float* qgn = kp->q_gain; const float* kgn = kp->k_gain;
#pragma unroll
          for (int i = 0; i < 8; ++i) { qg[i] = qgn[d0 + i]; kg[i] = kgn[d0 + i]; } }
        v4u rw[6];
#define P3_LOAD(row_) do { const bf16_t* s_ = QKVR + (size_t)(row_) * QKVD + sub * 128 + d0; const bool all_ = (row_) < NCTX; _Pragma("unroll") for (int it = 0; it < 6; ++it) if (it == 4 || all_) rw[it] = *(const v4u*)(s_ + it * 512); } while (0)
        for (int r4 = NCTX + gw * 4; r4 < MT; r4 += NGW * 4) {
            v4u kr[4]; f32x4 c0[4], c1[4], s0[4], s1[4];
#pragma unroll
            for (int q = 0; q < 4; ++q) { const int row = r4 + q, t = (row - NCTX) & 8191; kr[q] = *(const v4u*)(QKVR + (size_t)row * QKVD + 2048 + sub * 128 + d0);
                const int pos = ax ? (t & 63) : (t >> 6); const float* cp_ = ROPE + pos * 32 + p0; c0[q] = *(const f32x4*)cp_; c1[q] = *(const f32x4*)(cp_ + 4); s0[q] = *(const f32x4*)(cp_ + 4096); s1[q] = *(const f32x4*)(cp_ + 4100); }
#pragma unroll
            for (int q = 0; q < 4; ++q) { const int row = r4 + q, lr = row - NCTX, b = lr >> 13, kpos = CTXL + (lr & 8191); const v4u raw = kr[q];
                float f[8], cs[8], sn[8];
#pragma unroll
                for (int i = 0; i < 4; ++i) { f[2 * i] = bf2f(raw[i] & 0xffffu); f[2 * i + 1] = bf2f(raw[i] >> 16); cs[i] = c0[q][i]; cs[4 + i] = c1[q][i]; sn[i] = hh ? s0[q][i] : -s0[q][i]; sn[4 + i] = hh ? s1[q][i] : -s1[q][i]; }
                float ss = 0.f;
#pragma unroll
                for (int i = 0; i < 8; ++i) ss += f[i] * f[i];
                ss += __shfl_xor(ss, 1); ss += __shfl_xor(ss, 2); ss += __shfl_xor(ss, 4); ss += __shfl_xor(ss, 8);
                const float r = 1.0f / sqrtf(ss * (1.0f / 128.0f) + RMS_EPS);
                float o[8];
#pragma unroll
                for (int i = 0; i < 8; ++i) { const float y = f[i] * r * kg[i]; const float pr = __shfl_xor(y, 4); o[i] = y * cs[i] + pr * sn[i]; }
                v4u w; w.x = pk2(o[0], o[1]); w.y = pk2(o[2], o[3]); w.z = pk2(o[4], o[5]); w.w = pk2(o[6], o[7]);
                *(v4u*)(Kb + (((size_t)b * NKV + sub) * SKV + kpos) * HD + d0) = w; }
        }
        P3_LOAD(gw < NCTX ? gw : 0);
        for (int row = gw; row < NCTX; row += NGW) {
            const bool lat = row >= NCTX; const int lr = row - NCTX; const int b = lat ? (lr >> 13) : (row >> 8); const int t = lat ? (lr & 8191) : 0;
            const int kpos = lat ? (CTXL + t) : (row & 255);
            v4u cur[6];
#pragma unroll
            for (int it = 0; it < 6; ++it) cur[it] = rw[it];
            if (row + NGW < NCTX) P3_LOAD(row + NGW);
            float cs[8], sn[8];
#pragma unroll
            for (int i = 0; i < 8; ++i) { cs[i] = 1.f; sn[i] = 0.f; }
            if (lat) { const int pos = ax ? (t & 63) : (t >> 6); const float* cp_ = ROPE + pos * 32 + p0;
                const f32x4 c0 = *(const f32x4*)cp_, c1 = *(const f32x4*)(cp_ + 4), s0 = *(const f32x4*)(cp_ + 4096), s1 = *(const f32x4*)(cp_ + 4100);
#pragma unroll
                for (int i = 0; i < 4; ++i) { cs[i] = c0[i]; cs[4 + i] = c1[i]; sn[i] = hh ? s0[i] : -s0[i]; sn[4 + i] = hh ? s1[i] : -s1[i]; } }
#pragma unroll
            for (int it = 0; it < 6; ++it) { const int h = it * 4 + sub;
                if (lat && it != 4) continue;
                if (it == 5 && !split3) continue;
                float f[8]; v4u raw;
                if (!lat && split3) {
                    f32x4 q0[8]; const float* pp_ = PQ + (size_t)row * QKVD + h * 128 + d0;
#pragma unroll
                    for (int ks = 0; ks < 8; ++ks) q0[ks] = *(const f32x4*)(pp_ + (size_t)ks * 512 * QKVD);
                    f32x4 a0 = q0[0];
#pragma unroll
                    for (int ks = 1; ks < 8; ++ks) a0 += q0[ks];
#pragma unroll
                    for (int ks = 0; ks < 8; ++ks) q0[ks] = *(const f32x4*)(pp_ + (size_t)ks * 512 * QKVD + 4);
                    f32x4 a1 = q0[0];
#pragma unroll
                    for (int ks = 1; ks < 8; ++ks) a1 += q0[ks];
#pragma unroll
                    for (int i = 0; i < 4; ++i) { f[i] = a0[i]; f[4 + i] = a1[i]; }
                    raw.x = pk2(f[0], f[1]); raw.y = pk2(f[2], f[3]); raw.z = pk2(f[4], f[5]); raw.w = pk2(f[6], f[7]);
#pragma unroll
                    for (int i = 0; i < 4; ++i) { f[2 * i] = bf2f(raw[i] & 0xffffu); f[2 * i + 1] = bf2f(raw[i] >> 16); }
                } else { raw = cur[it];
#pragma unroll
                    for (int i = 0; i < 4; ++i) { f[2 * i] = bf2f(raw[i] & 0xffffu); f[2 * i + 1] = bf2f(raw[i] >> 16); } }
                if (it == 5) { *(v4u*)(Vb + (((size_t)b * NKV + (h - 20)) * SKV + kpos) * HD + d0) = raw; continue; }
                float ss = 0.f;
#pragma unroll
                for (int i = 0; i < 8; ++i) ss += f[i] * f[i];
                ss += __shfl_xor(ss, 1); ss += __shfl_xor(ss, 2); ss += __shfl_xor(ss, 4); ss += __shfl_xor(ss, 8);
                const float r = 1.0f / sqrtf(ss * (1.0f / 128.0f) + RMS_EPS);
                float o[8];
#pragma unroll
                for (int i = 0; i < 8; ++i) { const float y = f[i] * r * (it < 4 ? qg[i] : kg[i]); const float pr = __shfl_xor(y, 4); o[i] = y * cs[i] + pr * sn[i]; }
                v4u w; w.x = pk2(o[0], o[1]); w.y = pk2(o[2], o[3]); w.z = pk2(o[4], o[5]); w.w = pk2(o[6], o[7]);
                bf16_t* d = (it < 4) ? Qb + (size_t)row * DM + h * 128 + d0 : Kb + (((size_t)b * NKV + (h - 16)) * SKV + kpos) * HD + d0;
                *(v4u*)d = w; }
        }
#undef P3_LOAD
    }
    SEAM(3);

    if (IN(4)) _Pragma("unroll 1") for (int rep_ = 0; rep_ < NREP(4); ++rep_) {
        CParams* kp = kparams();
        const bf16_t* Qb = WSP(bf16_t, WS_Q); const bf16_t* Kb = WSP(bf16_t, WS_K); const bf16_t* Vb = WSP(bf16_t, WS_V); bf16_t* Ob = WSP(bf16_t, WS_O);
        const bf16_t* QKVR = WSP(bf16_t, WS_QKVR); const float* ROPE = WSP(float, WS_ROPE); const float* qgn = kp->q_gain;
        const int G = ogrid(), bx = obid(); const bool fast = (G % 8) == 0;
        const int NR = fast ? (G >> 3) : G, rank = fast ? (bx >> 3) : bx, tot = fast ? 132 : 1056;
        const bool split = fast && NR == 32; const int NA = split ? 26 : NR;
        if (rank < NA) for (int i = 0;; ++i) {
            int w = rank + NA * i;
            if (split && i == 5) w = rank >= 24 ? rank + 106 : tot;
            if (w >= tot) break;
            const int combo = fast ? (bx & 7) : (w / 132), ww = fast ? w : (w % 132), b = combo >> 2, kvh = combo & 3;
            const bool isl = ww < 128; const int rbk = ww >> 2; const int h = kvh * 4 + (isl ? (ww & 3) : (ww - 128));
            const size_t row0 = isl ? ((size_t)NCTX + (size_t)b * SEQ + (size_t)rbk * 256) : ((size_t)b * CTXL);
            if (isl) att::attn_dma_body(QKVR + row0 * QKVD + h * HD, QKVD, rbk * 256, ROPE, qgn, Kb + (size_t)combo * SKV * HD, Vb + (size_t)combo * SKV * HD, Ob + row0 * DM + h * HD, SKV, (char*)lds);
            else att::attn_dma_body(Qb + row0 * DM + h * HD, DM, -1, ROPE, qgn, Kb + (size_t)combo * SKV * HD, Vb + (size_t)combo * SKV * HD, Ob + row0 * DM + h * HD, CTXL, (char*)lds);
            if (otid() == 0) { asm volatile("s_waitcnt vmcnt(0)" ::: "memory");
                (void)xb_add(WSP(unsigned, WS_CTL) + CW_DONE + 32 * (isl ? (b * 32 + rbk) : (64 + b)), 1u); }
        }
        {
            const int tid = otid(), lane = tid & 63, wave = __builtin_amdgcn_readfirstlane(tid >> 6);
            unsigned* mq = WSP(unsigned, WS_CTL) + CW_MQ; bool prepared = false;
            for (;;) {
                if (tid == 0) MISC[34] = xb_add(mq, 1u);
                __syncthreads();
                const unsigned t = MISC[34];
                __syncthreads();
                if (t >= 384u) break;
                if (!prepared) { mod_prepare(kp->c, kp->c_ctx, (LAS float*)L, tid); prepared = true; }
                mod_item(384 + (int)t, kp->w_mod, kp->b_mod, WSP(float, WS_MOD), (const LAS float*)L, (LAS float*)(L + 32768), tid, lane, wave);
            }
        }
        {
            const int tid = otid(), lane = tid & 63, wave = __builtin_amdgcn_readfirstlane(tid >> 6);
            LAS float* scr = (LAS float*)(L + wave * 16384);
            unsigned* qc = WSP(unsigned, WS_CTL) + CW_Q;
            constexpr int I_G = (DM / 64) * (DE / 32), I_D = (DE / 64) * (DM / 32), PER = 2 * I_G + I_D; constexpr unsigned NTICK = 64u * PER / 2u;
            auto decode = [&](int it) { TItem d; const int le = it / PER; int r = it - le * PER;
                if (r < I_G) { d.W = kp->w_gate + (size_t)le * DM * DE; d.WT = WSP(bf16_t, WS_WGU) + (size_t)le * 2048 * DM; d.K = DM; d.N = DE; d.kind = 1; }
                else if ((r -= I_G) < I_G) { d.W = kp->w_up + (size_t)le * DM * DE; d.WT = WSP(bf16_t, WS_WGU) + (size_t)le * 2048 * DM; d.K = DM; d.N = DE; d.kind = 2; }
                else { r -= I_G; d.W = kp->w_down + (size_t)le * DE * DM; d.WT = WSP(bf16_t, WS_WD) + (size_t)le * DM * DE; d.K = DE; d.N = DM; d.kind = 0; }
                const int nblk = d.N / 32; d.k0 = 64 * (r / nblk); d.n0 = 32 * (r % nblk); return d; };
            static_assert(NTICK % 8u == 0u, "ticket chunks");
            auto grab = [&]() { unsigned t = 0; if (lane == 0) t = __hip_atomic_fetch_add(qc, 8u, __ATOMIC_RELAXED, __HIP_MEMORY_SCOPE_AGENT); return (unsigned)__builtin_amdgcn_readfirstlane((int)t); };
            for (unsigned tb = grab(); tb < NTICK; tb = grab()) {
                _Pragma("unroll 1") for (unsigned tk = tb; tk < tb + 8u; ++tk) {
                    const TItem d0 = decode((int)(2u * tk)); TItem d1 = d0; d1.n0 += 32;
                    f32x4 ra[8], rb[8]; t_load(d0, ra, lane); t_load(d1, rb, lane);
                    t_store(d0, ra, scr, lane); t_store(d1, rb, scr, lane);
                }
            }
        }
        __syncthreads();
        {
            unsigned* wq = WSP(unsigned, WS_CTL) + CW_WQ; unsigned* done = WSP(unsigned, WS_CTL) + CW_DONE; unsigned* yd = WSP(unsigned, WS_CTL) + CW_YD; unsigned* bw = WSP(unsigned, WS_CTL) + CW_BAR;
            const char* Oc = WSP(const char, WS_O); const char* Wc = WSP(const char, WS_WO);
            pg8::Gemm g{DM, DM, DM}; pg8::EpiBf16W E{WSP(bf16_t, WS_Y), DM};
            int tail = obid(); bool queue = true;
            for (;;) {
                if (otid() == 0) { int pm = -1, pn = 0, fl = 0;
                    if (queue) { const unsigned t = xb_add(wq, 1u);
                        if (t < 416u) { const int rbk = (int)t >> 4, b = ((int)t >> 3) & 1; pn = (int)t & 7; pm = 2 + b * 32 + rbk; fl = b * 32 + rbk; }
                        else if (t < 432u) { const int c = (int)t - 416; pm = c >> 3; pn = c & 7; fl = 64 + pm; } }
                    else if (tail < 96) { const int rbk = 26 + (tail >> 4), b = (tail >> 3) & 1; pn = tail & 7; pm = 2 + b * 32 + rbk; fl = b * 32 + rbk; }
                    if (pm >= 0) { XB_SPIN(xb_ld(&done[32 * fl]) < 16u, bw);
                        __builtin_amdgcn_fence(__ATOMIC_ACQUIRE, "agent"); asm volatile("s_waitcnt vmcnt(0)" ::: "memory"); }
                    MISC[32] = (unsigned)pm; MISC[33] = (unsigned)pn; }
                __syncthreads();
                const int pm = (int)MISC[32], pn = (int)MISC[33];
                __syncthreads();
                if (pm < 0) { if (!queue) break; queue = false; continue; }
                pg8::SchedOne S; S.u.A = Oc + (size_t)((unsigned)pm * (256u * DM * 2u)); S.u.B = Wc + (size_t)((unsigned)pn * (256u * DM * 2u)); S.u.pm = pm; S.u.pn = pn; S.u.aux = 0; S.u.kt = DM / 64; S.u.rb = 0; S.u.cn = 0; S.u.ui = 0;
                pg8::gemm_phase<pg8::EpiBf16W, pg8::SchedOne, true, false>(L, g, S, E);
                if (otid() == 0) (void)xb_add(&yd[32 * pm], 1u);
                if (!queue) tail += ogrid();
            }
        }
    }


    layer_half<0>(lo, hi, bar, L, tcnt, tbase, texp);
    layer_half<1>(lo, hi, bar, L, tcnt, tbase, texp);
#undef IN
#undef SEAM
#undef TIDS
}

extern "C" void kernel_launch(void* const* d_in, const int* in_sizes, int n_in, void* d_out, int out_size, void* d_ws, size_t ws_size, hipStream_t stream) {
    static int grid = 0;
    if (grid == 0) {
        if (n_in != 19 || in_sizes[0] != NLAT * DM || out_size != NLAT * DM || ws_size < WS_END) {
            fprintf(stderr, "kernel_launch: shape mismatch: n_in %d in0 %d out %d ws %zu (need %zu); nothing launched\n", n_in, n_in > 0 ? in_sizes[0] : -1, out_size, ws_size, (size_t)WS_END); grid = -1; return; }
        int dev = 0, cus = 0, per_cu = 0;
        if (hipGetDevice(&dev) != hipSuccess || hipDeviceGetAttribute(&cus, hipDeviceAttributeMultiprocessorCount, dev) != hipSuccess) { fprintf(stderr, "kernel_launch: device query failed\n"); grid = -1; return; }
        if (hipFuncSetAttribute((const void*)mk_fwd, hipFuncAttributeMaxDynamicSharedMemorySize, LDS_BYTES) != hipSuccess) { fprintf(stderr, "kernel_launch: hipFuncSetAttribute failed\n"); grid = -1; return; }
        if (hipOccupancyMaxActiveBlocksPerMultiprocessor(&per_cu, (const void*)mk_fwd, 512, LDS_BYTES) != hipSuccess || per_cu < 1)
            fprintf(stderr, "kernel_launch: note: occupancy query reports %d workgroups per CU\n", per_cu);
        (void)hipGetLastError();
        if (cus * (pg8::RT_UNITS / 2) < MAXT * 8) { fprintf(stderr, "kernel_launch: %d CUs: the MoE phases' per-workgroup LDS row tables are sized for >= %d workgroups; nothing launched\n", cus, (MAXT * 8 + pg8::RT_UNITS / 2 - 1) / (pg8::RT_UNITS / 2)); grid = -1; return; }
        grid = cus;
    }
    if (grid < 0) return;
    if (hipMemsetAsync((char*)d_ws + WS_CTL, 0, CTL_ZERO_BYTES, stream) != hipSuccess) { fprintf(stderr, "kernel_launch: memset failed\n"); return; }
    Params p{};
    p.x = (const float*)d_in[0]; p.c = (const float*)d_in[1]; p.ctx = (const float*)d_in[2]; p.c_ctx = (const float*)d_in[3]; p.w_mod = (const float*)d_in[4]; p.b_mod = (const float*)d_in[5];
    p.ln_g = (const float*)d_in[6]; p.ln_b = (const float*)d_in[7]; p.w_qkv = (const float*)d_in[8]; p.q_gain = (const float*)d_in[9]; p.k_gain = (const float*)d_in[10]; p.w_o = (const float*)d_in[11];
    p.w_pool = (const float*)d_in[12]; p.pool_scale = (const float*)d_in[13]; p.w_router = (const float*)d_in[14]; p.router_bias = (const float*)d_in[15];
    p.w_gate = (const float*)d_in[16]; p.w_up = (const float*)d_in[17]; p.w_down = (const float*)d_in[18];
    p.out = (float*)d_out; p.ws = (unsigned char*)d_ws;
#if MK_PER_PHASE
    for (int k = 0; k < NPHASE; ++k) { p.ph_lo = k; p.ph_hi = k + 1;
        hipLaunchKernelGGL(mk_fwd, dim3(grid), dim3(512), LDS_BYTES, stream, p);
        const hipError_t le = hipPeekAtLastError(); if (le != hipSuccess) { fprintf(stderr, "kernel_launch: launch %d failed: %s\n", k, hipGetErrorName(le)); break; } }
#else
    p.ph_lo = 0; p.ph_hi = NPHASE;
    hipLaunchKernelGGL(mk_fwd, dim3(grid), dim3(512), LDS_BYTES, stream, p);
    const hipError_t le = hipPeekAtLastError(); if (le != hipSuccess) fprintf(stderr, "kernel_launch: launch failed: %s\n", hipGetErrorName(le));
#endif
}
```

```cpp
#include <hip/hip_runtime.h>
#include <cstdio>
#include <cstdint>

#ifndef REP_MASK
#define REP_MASK 0
#endif
#ifndef MK_PER_PHASE
#define MK_PER_PHASE 0
#endif

constexpr int DM = 2048, NB = 2, SEQ = 8192, CTXL = 256;
constexpr int NCTX = NB * CTXL, NLAT = NB * SEQ, MT = NCTX + NLAT;
constexpr int NH = 16, NKV = 4, HD = 128, KVD = NKV * HD, QKVD = DM + 2 * KVD;
constexpr int SKV = CTXL + SEQ;
constexpr int NE = 32, DE = 1024;
constexpr int MAXT = 164, NSLOT = MAXT * 256;
constexpr float ALPHA = 1.41421356237309515f;
constexpr float LN_EPS = 1e-6f, RMS_EPS = 1e-6f;
constexpr int NPHASE = 18;

constexpr size_t MiB = 1u << 20;
constexpr size_t WS_CTL = 0, CTL_ZERO_BYTES = 1 * MiB;
constexpr size_t WS_MOD = 1 * MiB;
constexpr size_t WS_ROPE = WS_MOD + 512 * 1024;
constexpr size_t WS_WR = WS_MOD + 768 * 1024;
constexpr size_t WS_WQKV = 2 * MiB;
constexpr size_t WS_WO = 14 * MiB;
constexpr size_t WS_WPOOL = 22 * MiB;
constexpr size_t WS_WGU = 24 * MiB;
constexpr size_t WS_WD = 536 * MiB;
constexpr size_t WS_Y = 792 * MiB;
constexpr size_t WS_X1 = 924 * MiB;
constexpr size_t WS_X2 = 1056 * MiB;
constexpr size_t WS_H = 1188 * MiB;
constexpr size_t WS_LIST = 1254 * MiB;
constexpr size_t WS_SLOT = 1259 * MiB;
constexpr size_t WS_SH = 1260 * MiB;
constexpr size_t WS_U = WS_SH;
constexpr size_t WS_QKVR = WS_SH + 66 * MiB;
constexpr size_t WS_Q = WS_SH + 165 * MiB;
constexpr size_t WS_K = WS_SH + 231 * MiB;
constexpr size_t WS_V = WS_SH + 248 * MiB;
constexpr size_t WS_O = WS_SH + 265 * MiB;
constexpr size_t WS_HS = WS_SH;
constexpr size_t WS_ACT = WS_SH + 164 * MiB;
constexpr size_t WS_FB = WS_SH + 246 * MiB;
constexpr size_t WS_DP = WS_SH;
constexpr size_t WS_PQ = WS_SH + 510 * MiB;
constexpr size_t WS_PO = WS_PQ + 48 * MiB;
constexpr size_t WS_END = WS_PO + 32 * MiB;
static_assert((size_t)MT * DM * 4 <= 132 * MiB && (size_t)NSLOT * 2048 * 2 <= 164 * MiB && (size_t)2 * MT * DM * 4 <= 264 * MiB, "ws map");
static_assert((size_t)32 * MT * 8 <= 5 * MiB && (size_t)NSLOT * 8 <= 1 * MiB, "ws map 2");
constexpr int CW_CNT = 64;
constexpr int CW_Q = 3072;
constexpr int CW_MQ = 3136;
constexpr int CW_WQ = 3104;
constexpr int CW_DONE = 8192;
constexpr int CW_GUD = 16384;
constexpr int CW_YD = 40960;
constexpr int CW_P6Q = 3168;
constexpr int CW_BAR = 4096;

constexpr int RING_BYTES = 131072;
constexpr int MISC_OFF = RING_BYTES;
constexpr int TAB_OFF = MISC_OFF + 256;
constexpr int LDS_BYTES = 147456;

#define GAS __attribute__((address_space(1)))
#define LAS __attribute__((address_space(3)))
typedef unsigned short bf16_t;
typedef unsigned v4u __attribute__((ext_vector_type(4)));
typedef unsigned v2u __attribute__((ext_vector_type(2)));
typedef float f32x4 __attribute__((ext_vector_type(4)));
typedef float f32x2 __attribute__((ext_vector_type(2)));
typedef short bf16x8 __attribute__((ext_vector_type(8)));
typedef short s16x4 __attribute__((ext_vector_type(4)));
typedef float f32x16 __attribute__((ext_vector_type(16)));
typedef GAS unsigned gu32;
#define RLX_AGENT __ATOMIC_RELAXED, __HIP_MEMORY_SCOPE_AGENT
#define LDS_WAIT() asm volatile("s_waitcnt lgkmcnt(0)" ::: "memory")
#define VM_WAIT() asm volatile("s_waitcnt vmcnt(0)" ::: "memory")
__device__ __forceinline__ unsigned f2bf(float f) { unsigned u = __builtin_bit_cast(unsigned, f); return (u + 0x7fffu + ((u >> 16) & 1u)) >> 16; }
__device__ __forceinline__ unsigned pk2(float lo, float hi) { unsigned r; asm("v_cvt_pk_bf16_f32 %0, %1, %2" : "=v"(r) : "v"(lo), "v"(hi)); return r; }
__device__ __forceinline__ float bf2f(unsigned b) { return __builtin_bit_cast(float, b << 16); }
__device__ __forceinline__ unsigned cvt_pk_bf16(float lo, float hi) { unsigned r; asm volatile("v_cvt_pk_bf16_f32 %0, %1, %2" : "=v"(r) : "v"(lo), "v"(hi)); return r; }
__device__ __forceinline__ f32x4 bf4(v2u q) { return (f32x4){bf2f(q.x & 0xffffu), bf2f(q.x >> 16), bf2f(q.y & 0xffffu), bf2f(q.y >> 16)}; }
template <int CTRL> __device__ __forceinline__ float dppf(float v) { return __builtin_bit_cast(float, __builtin_amdgcn_update_dpp(0, __builtin_bit_cast(int, v), CTRL, 0xF, 0xF, true)); }
template <int CTRL> __device__ __forceinline__ int dppi(int v) { return __builtin_amdgcn_update_dpp(0, v, CTRL, 0xF, 0xF, true); }
__device__ __forceinline__ float wave_sum(float v) {
    v += dppf<0xB1>(v); v += dppf<0x4E>(v); v += dppf<0x141>(v); v += dppf<0x140>(v);
    { const auto r = __builtin_amdgcn_permlane16_swap(__float_as_uint(v), __float_as_uint(v), false, false); v = __uint_as_float(r[0]) + __uint_as_float(r[1]); }
    { const auto r = __builtin_amdgcn_permlane32_swap(__float_as_uint(v), __float_as_uint(v), false, false); v = __uint_as_float(r[0]) + __uint_as_float(r[1]); }
    return v;
}
__device__ __forceinline__ float silu_f(float x) { return x / (1.0f + __expf(-x)); }
__device__ __forceinline__ int row_cond(int row) { return row < NCTX ? 2 : ((row - NCTX) >> 13); }
__device__ __forceinline__ int otid() { int t = threadIdx.x; asm volatile("" : "+v"(t)); return t; }
__device__ __forceinline__ int obid() { int t = blockIdx.x; asm volatile("" : "+s"(t)); return t; }
__device__ __forceinline__ int ogrid() { int t = gridDim.x; asm volatile("" : "+s"(t)); return t; }

#define XB_TMO      128
#define XB_XCNT(j)  (256  + 64 * (j))
#define XB_XSUB(j)  (1280 + 64 * (j))
#define XB_XGEN(j)  (2304 + 64 * (j))
#define XB_TOP      3328
#define XB_TOPGEN   3392
#define XCD_BAR_WORDS 3456
#define XB_SPIN_CAP (1u << 20)
__device__ __forceinline__ unsigned xb_ld(unsigned* p)              { return __hip_atomic_load(p, __ATOMIC_RELAXED, __HIP_MEMORY_SCOPE_AGENT); }
__device__ __forceinline__ unsigned xb_add(unsigned* p, unsigned v) { return __hip_atomic_fetch_add(p, v, __ATOMIC_RELAXED, __HIP_MEMORY_SCOPE_AGENT); }
__device__ __forceinline__ unsigned xb_xcc_id() { return (unsigned)__builtin_amdgcn_s_getreg((3 << 11) | 20) & 0xFu; }
#define XB_SPIN(cond, bar) do { unsigned _sp = 0; while (cond) { __builtin_amdgcn_s_sleep(1); \
    if ((++_sp & 255u) == 0u) { if (xb_ld(&(bar)[XB_TMO])) break; if (_sp > XB_SPIN_CAP) { atomicAdd(&(bar)[XB_TMO], 1u); break; } } } } while (0)
struct XcdBarrier { unsigned* bar; unsigned x; volatile LAS unsigned* st; };
__device__ __forceinline__ XcdBarrier xcd_barrier_post(unsigned* bar, volatile LAS unsigned* st) {
    XcdBarrier b; b.bar = bar; b.x = xb_xcc_id(); b.st = st;
    if (threadIdx.x == 0) (void)xb_add(&bar[XB_XCNT(b.x)], 1u);
    return b;
}
__device__ __forceinline__ void xcd_barrier_complete(unsigned* bar, unsigned x, unsigned& nloc, unsigned& nx) {
    const unsigned G = gridDim.x * gridDim.y * gridDim.z;
    unsigned sum, cnt, mine, sp = 0u;
    for (;;) {
        sum = 0u; cnt = 0u; mine = 0u;
#pragma unroll 1
        for (unsigned j = 0; j < 16; ++j) { const unsigned c = xb_ld(&bar[XB_XCNT(j)]); sum += c; cnt += (c > 0u) ? 1u : 0u; }
        if (sum == G) break;
        __builtin_amdgcn_s_sleep(1);
        if ((++sp & 255u) == 0u) { if (xb_ld(&bar[XB_TMO])) break; if (sp > XB_SPIN_CAP) { atomicAdd(&bar[XB_TMO], 1u); break; } }
    }
    mine = xb_ld(&bar[XB_XCNT(x)]);
    nloc = mine > 0u ? mine : 1u; nx = cnt > 0u ? cnt : 1u;
}
__device__ __forceinline__ void xcd_barrier(const XcdBarrier& b) {
    asm volatile("s_waitcnt vmcnt(0)" ::: "memory");
    __syncthreads();
    if (threadIdx.x == 0) {
        unsigned* bar = b.bar;
        __builtin_amdgcn_s_waitcnt(0);
        unsigned nloc = b.st[0], nx = b.st[1];
        if (nloc == 0u) { xcd_barrier_complete(bar, b.x, nloc, nx); b.st[0] = nloc; b.st[1] = nx; }
        const unsigned old = xb_add(&bar[XB_XSUB(b.x)], 1u);
        const unsigned gen = old / nloc;
        if (old + 1u == (gen + 1u) * nloc) {
            __builtin_amdgcn_fence(__ATOMIC_RELEASE, "agent");
            asm volatile("s_waitcnt vmcnt(0)" ::: "memory");
            const unsigned og = xb_add(&bar[XB_TOP], 1u);
            const unsigned tg = og / nx;
            if (og + 1u == (tg + 1u) * nx) xb_add(&bar[XB_TOPGEN], 1u);
            else XB_SPIN(xb_ld(&bar[XB_TOPGEN]) == tg, bar);
            __builtin_amdgcn_fence(__ATOMIC_ACQUIRE, "agent");
            xb_add(&bar[XB_XGEN(b.x)], 1u);
            asm volatile("s_waitcnt vmcnt(0)" ::: "memory");
        } else {
            XB_SPIN(xb_ld(&bar[XB_XGEN(b.x)]) == gen, bar);
            __builtin_amdgcn_fence(__ATOMIC_ACQUIRE, "agent");
            asm volatile("s_waitcnt vmcnt(0)" ::: "memory");
        }
    }
    __syncthreads();
}

namespace pg8 {
#define PG8_LAS __attribute__((address_space(3)))
constexpr int BM = 256, BK = 64, HALF = 128, HTB = HALF * BK * 2, STAGE_BYTES = 8 * HTB, NXCD = 8, WGM = 8;
__host__ __device__ __forceinline__ int lds_byte(int r, int c) { const int st = (r >> 4) * 2 + (c >> 5), rr = r & 15, cc = c & 31, ob = rr * 64 + cc * 2; return st * 1024 + (ob ^ (((ob >> 9) & 1) << 5)); }
__host__ __device__ __forceinline__ void stage_rc(int b, int& R, int& C) { const int st = b / 1024, sb = b % 1024, swz = sb ^ (((sb >> 9) & 1) << 5); R = (st >> 1) * 16 + swz / 64; C = (st & 1) * 32 + (swz % 64) / 2; }
__host__ __device__ __forceinline__ int perm32(int rho) { const int n = rho >> 4, i = rho & 15; return 8 * (i >> 2) + 4 * n + (i & 3); }

struct Unit { const char* A; const char* B; int pm, pn, aux, kt, rb, cn, ui; };
struct Gemm { int lda, ldb, K; };

struct TileOrder {
    int nM, nN, nwg, G, c, rot = 0;
    __device__ __forceinline__ void init(int nM_, int nN_, int G_, int c_) { nM = nM_; nN = nN_; nwg = nM * nN; G = G_; c = c_; }
    __device__ __forceinline__ bool get(int i, int& pm, int& pn) const { return map((long)i * G + c, pm, pn); }
    __device__ __forceinline__ bool map(long L, int& pm, int& pn) const {
        if (L >= nwg) return false;
        const int nig = WGM * nN;
        int wgid = (int)L; { const int q = nwg / NXCD, r = nwg % NXCD, xcd = wgid % NXCD; int off = wgid / NXCD; const int cs = (xcd < r ? xcd * (q + 1) : r * (q + 1) + (xcd - r) * q), len = q + (xcd < r ? 1 : 0);
            if (rot) { const int lead = (nig - cs % nig) % nig; if (lead < len) { off += lead; if (off >= len) off -= len; } }
            wgid = cs + off; }
        const int gid = wgid / nig, fm = gid * WGM, gsz = (nM - fm) < WGM ? (nM - fm) : WGM;
        pm = fm + ((wgid % nig) % gsz); pn = (wgid % nig) / gsz; return true;
    }
};

template <class Epi, class Sched, bool ALIGN_EPI, bool GATHER = false>
__device__ __forceinline__ void gemm_phase(PG8_LAS unsigned char* lds, const Gemm g, const Sched& S, const Epi& E) {
    const int tid = otid(), wid = __builtin_amdgcn_readfirstlane(tid >> 6), lane = tid & 63, wr = wid >> 2, wc = wid & 3, fr = lane & 15, fq = lane >> 4;
    unsigned vc[2][2], vn[2][2], voffB[2]; int Rr[2], Cc = 0;
#pragma unroll
    for (int i = 0; i < 2; ++i) { int R, C; stage_rc(tid * 16 + i * 8192, R, C); const int Rb = Epi::PERM ? ((R & ~31) + perm32(R & 31)) : R; Rr[i] = R; Cc = C;
        vc[0][i] = (unsigned)(R * g.lda + C) * 2u; vc[1][i] = vc[0][i] + (unsigned)(HALF * g.lda) * 2u; voffB[i] = (unsigned)(Rb * g.ldb + C) * 2u; }
#define PG8_ROWS(ui_, v) do { _Pragma("unroll") for (int _h = 0; _h < 2; ++_h) _Pragma("unroll") for (int _i = 0; _i < 2; ++_i) \
        v[_h][_i] = (unsigned)S.rowtok((ui_), Rr[_i] + HALF * _h) * (unsigned)(g.lda * 2) + (unsigned)Cc * 2u; } while (0)
    const size_t kstep = (size_t)(BK * 2);
    const size_t hsB = (size_t)HALF * g.ldb * 2;
    const unsigned ldsw = (unsigned)wid * 1024u;
    const int aoff = lds_byte(wr * 64 + fr, fq * 8), boff = lds_byte(wc * 32 + fr, fq * 8);
#define PG8_SA(b, h) (((b) * 2 + (h)) * HTB)
#define PG8_SB(b, h) ((4 + (b) * 2 + (h)) * HTB)
#define PG8_STAGE(bufoff, gbase, voff) do { _Pragma("unroll") for (int _i = 0; _i < 2; ++_i) \
        __builtin_amdgcn_global_load_lds((const unsigned*)((const char*)(gbase) + (voff)[_i]), (PG8_LAS unsigned*)(lds + (bufoff) + ldsw + _i * 8192), 16, 0, 0); } while (0)
#define PG8_LDA(dst, b, h) do { _Pragma("unroll") for (int m = 0; m < 4; ++m) _Pragma("unroll") for (int k = 0; k < 2; ++k) dst[m][k] = *(const PG8_LAS bf16x8*)(lds + PG8_SA(b, h) + aoff + m * 2048 + k * 1024); } while (0)
#define PG8_LDB(dst, b, h) do { _Pragma("unroll") for (int n = 0; n < 2; ++n) _Pragma("unroll") for (int k = 0; k < 2; ++k) dst[n][k] = *(const PG8_LAS bf16x8*)(lds + PG8_SB(b, h) + boff + n * 2048 + k * 1024); } while (0)
#define PG8_MMA(ai, bj, At, Bt) do { __builtin_amdgcn_s_setprio(1); _Pragma("unroll") for (int m = 0; m < 4; ++m) _Pragma("unroll") for (int n = 0; n < 2; ++n) _Pragma("unroll") for (int k = 0; k < 2; ++k) \
        acc[ai][bj][m][n] = __builtin_amdgcn_mfma_f32_16x16x32_bf16(Bt[n][k], At[m][k], acc[ai][bj][m][n], 0, 0, 0); __builtin_amdgcn_s_setprio(0); } while (0)
#define PG8_WAIT_V(n) asm volatile("s_waitcnt vmcnt(" #n ")" ::: "memory")
#define PG8_WAIT_L(n) asm volatile("s_waitcnt lgkmcnt(" #n ")" ::: "memory")
#define PG8_BAR __builtin_amdgcn_s_barrier()
#define PG8_SCHED __builtin_amdgcn_sched_barrier(0)
    Unit cur, nxt; int ui = 0; int pend = -1, pend2 = -1, wst = 0; unsigned pv = 8u; (void)pend; (void)pend2; (void)wst; (void)pv;
    if (!S.next(0, cur)) return;
    if constexpr (Sched::WAITS) S.wait_ready(cur);
    if constexpr (GATHER) PG8_ROWS(0, vc);
    f32x4 acc[2][2][4][2];
#pragma unroll
    for (int a = 0; a < 2; ++a)
#pragma unroll
        for (int b = 0; b < 2; ++b)
#pragma unroll
            for (int m = 0; m < 4; ++m)
#pragma unroll
                for (int n = 0; n < 2; ++n) acc[a][b][m][n] = (f32x4){0.f, 0.f, 0.f, 0.f};
    bf16x8 At[4][2], B0[2][2], B1[2][2];
    const char* cA = cur.A; const char* cB = cur.B;
    PG8_STAGE(PG8_SB(0, 0), cB, voffB); PG8_STAGE(PG8_SB(0, 1), cB + hsB, voffB); PG8_STAGE(PG8_SA(0, 0), cA, vc[0]); PG8_STAGE(PG8_SA(0, 1), cA, vc[1]);
    if (wr == 1) PG8_BAR;
    PG8_WAIT_V(2); PG8_BAR;
    PG8_STAGE(PG8_SB(1, 0), cB + kstep, voffB); PG8_STAGE(PG8_SA(1, 0), cA + kstep, vc[0]); PG8_STAGE(PG8_SB(1, 1), cB + hsB + kstep, voffB);
    PG8_WAIT_V(6); PG8_BAR;
    for (;;) {
        const bool has_next = S.next(ui + 1, nxt);
        if constexpr (Sched::WAITS) wst = has_next ? 1 : 0;
        const char* nA = has_next ? nxt.A : cA; const char* nB = has_next ? nxt.B : cB;
        if constexpr (GATHER) { if (has_next) PG8_ROWS(ui + 1, vn); else {
#pragma unroll
            for (int h = 0; h < 2; ++h) { vn[h][0] = vc[h][0]; vn[h][1] = vc[h][1]; } } }
        const int nt = cur.kt;
        for (int t = 0; t < nt; t += 2) {
            const bool last = (t == nt - 2);
            const char* a1 = cA + (size_t)(t + 1) * kstep;
            const char* a2 = last ? nA : cA + (size_t)(t + 2) * kstep; const char* b2 = last ? nB : cB + (size_t)(t + 2) * kstep;
            const char* a3 = a2 + kstep; const char* b3 = b2 + kstep;
            unsigned o0[2], o1[2];
#pragma unroll
            for (int i = 0; i < 2; ++i) { o0[i] = (GATHER && last) ? vn[0][i] : vc[0][i]; o1[i] = (GATHER && last) ? vn[1][i] : vc[1][i]; }
            PG8_LDB(B0, 0, 0); PG8_LDB(B1, 0, 1); PG8_SCHED; PG8_LDA(At, 0, 0); PG8_STAGE(PG8_SA(1, 1), a1, vc[1]);
            PG8_WAIT_V(8); PG8_WAIT_L(0); PG8_BAR; PG8_MMA(0, 0, At, B0); PG8_MMA(0, 1, At, B1); PG8_BAR; PG8_SCHED;
            PG8_LDA(At, 0, 1); PG8_STAGE(PG8_SB(0, 0), b2, voffB); PG8_STAGE(PG8_SB(0, 1), b2 + hsB, voffB); PG8_STAGE(PG8_SA(0, 0), a2, o0);
            PG8_WAIT_V(8); PG8_WAIT_L(0); PG8_BAR; PG8_MMA(1, 0, At, B0); PG8_MMA(1, 1, At, B1); PG8_BAR; PG8_SCHED;
            PG8_LDB(B0, 1, 0); PG8_LDB(B1, 1, 1); PG8_SCHED; PG8_LDA(At, 1, 0); PG8_STAGE(PG8_SA(0, 1), a2, o1);
            PG8_WAIT_V(8); PG8_WAIT_L(0); PG8_BAR; PG8_MMA(0, 0, At, B0); PG8_MMA(0, 1, At, B1); PG8_BAR; PG8_SCHED;
            PG8_LDA(At, 1, 1); PG8_STAGE(PG8_SB(1, 0), b3, voffB); PG8_STAGE(PG8_SB(1, 1), b3 + hsB, voffB); PG8_STAGE(PG8_SA(1, 0), a3, o0);
            PG8_WAIT_V(8); PG8_WAIT_L(0); PG8_BAR; PG8_MMA(1, 0, At, B0); PG8_MMA(1, 1, At, B1); PG8_BAR; PG8_SCHED;
            if constexpr (Sched::SIGNALS) { if (pend >= 0) { pend2 = pend; pend = -1; } else if (pend2 >= 0) { S.signal(pend2, lane, wid); pend2 = -1; } }
            if constexpr (Sched::WAITS) { if (wst == 1) { pv = S.poll(nxt); wst = 2; } else if (wst == 2) { wst = 0; if (pv < 8u) S.spin(nxt); } }
        }
        if constexpr (ALIGN_EPI) { if (wr == 0) PG8_BAR; }
        E(acc, cur, wr, wc, fr, fq);
        if constexpr (Sched::SIGNALS) pend = cur.pm;
        if (!has_next) break;
#pragma unroll
        for (int a = 0; a < 2; ++a)
#pragma unroll
            for (int b = 0; b < 2; ++b)
#pragma unroll
                for (int m = 0; m < 4; ++m)
#pragma unroll
                    for (int n = 0; n < 2; ++n) acc[a][b][m][n] = (f32x4){0.f, 0.f, 0.f, 0.f};
        cur = nxt; cA = nA; cB = nB; ++ui;
        if constexpr (GATHER) {
#pragma unroll
            for (int h = 0; h < 2; ++h) { vc[h][0] = vn[h][0]; vc[h][1] = vn[h][1]; } }
        if constexpr (ALIGN_EPI) { if (wr == 1) PG8_BAR; }
    }
    PG8_WAIT_V(0);
    if constexpr (!ALIGN_EPI) { if (wr == 0) PG8_BAR; }
    PG8_BAR;
    if constexpr (Sched::SIGNALS) { if (pend >= 0) S.signal(pend, lane, wid); }
#undef PG8_ROWS
#undef PG8_SA
#undef PG8_SB
#undef PG8_STAGE
#undef PG8_LDA
#undef PG8_LDB
#undef PG8_MMA
#undef PG8_WAIT_V
#undef PG8_WAIT_L
#undef PG8_BAR
#undef PG8_SCHED
}

template <unsigned AT, unsigned BT, int KT>
struct SchedDense {
    static constexpr bool SIGNALS = false, WAITS = false;
    TileOrder o; const char* A; const char* B; int pm0;
    __device__ __forceinline__ int rowtok(int, int) const { return 0; }
    __device__ __forceinline__ bool next(int i, Unit& u) const { int pm, pn; if (!o.get(i, pm, pn)) return false;
        u.rb = 0; u.cn = 0; u.pm = pm0 + pm; u.pn = pn; u.aux = 0; u.kt = KT; u.A = A + (size_t)((unsigned)u.pm * AT); u.B = B + (size_t)((unsigned)pn * BT); return true; }
};
template <unsigned AT, unsigned BT, int KT, int NN>
struct SchedSplit {
    static constexpr bool SIGNALS = false, WAITS = false;
    TileOrder o; const char* A; const char* B; int G, c; bool split;
    __device__ __forceinline__ int rowtok(int, int) const { return 0; }
    __device__ __forceinline__ void init(int G_, int c_) { G = G_; c = c_; split = ((64 * NN) % G_ == 0) && (2 * NN * 8 <= G_); if (split) o.init(64, NN, G_, c_); else o.init(66, NN, G_, c_); }
    __device__ __forceinline__ bool next(int i, Unit& u) const { u.rb = 0; u.cn = 0;
        if (!split) { int pm, pn; if (!o.get(i, pm, pn)) return false; u.pm = pm; u.pn = pn; u.aux = 0; u.kt = KT; u.A = A + (size_t)((unsigned)pm * AT); u.B = B + (size_t)((unsigned)pn * BT); return true; }
        const int fr = (64 * NN) / G;
        if (i < fr) { int pm, pn; o.get(i, pm, pn); u.pm = 2 + pm; u.pn = pn; u.aux = 0; u.kt = KT; u.A = A + (size_t)((unsigned)u.pm * AT); u.B = B + (size_t)((unsigned)pn * BT); return true; }
        if (i > fr || c >= 2 * NN * 8) return false;
        const int ks = c & 7, t = c >> 3; u.pm = t / NN; u.pn = t % NN; u.aux = ks + 1; u.kt = KT / 8;
        u.A = A + (size_t)((unsigned)u.pm * AT + (unsigned)ks * (KT / 8) * 128u); u.B = B + (size_t)((unsigned)u.pn * BT + (unsigned)ks * (KT / 8) * 128u); return true; }
};
struct SchedPool {
    static constexpr bool SIGNALS = false, WAITS = false;
    TileOrder o; const char* A; const char* B;
    __device__ __forceinline__ int rowtok(int, int) const { return 0; }
    __device__ __forceinline__ bool next(int i, Unit& u) const { int pm, pn; if (!o.get(i, pm, pn)) return false;
        u.rb = 0; u.cn = 0; u.pm = 2 + pm; u.pn = pn; u.aux = 0; u.kt = 8; const int g = pn >> 1;
        u.A = A + (size_t)((unsigned)u.pm * (256u * DM * 2u) + (unsigned)g * 1024u); u.B = B + (size_t)((unsigned)g * (512u * 512u * 2u) + (unsigned)(pn & 1) * (256u * 512u * 2u)); return true; }
};
struct SchedOne {
    static constexpr bool SIGNALS = false, WAITS = false;
    Unit u;
    __device__ __forceinline__ int rowtok(int, int) const { return 0; }
    __device__ __forceinline__ bool next(int i, Unit& o) const { if (i != 0) return false; o = u; return true; }
};
constexpr int RT_UNITS = 14;
template <unsigned AT, unsigned BT, unsigned BE, int KT, bool GATHER>
struct SchedMoe {
    static constexpr bool SIGNALS = GATHER, WAITS = !GATHER;
    unsigned* ctr;
    __device__ __forceinline__ void signal(int pm, int lane, int wid) const { if (wid == 0 && lane == 0) (void)xb_add(ctr + 32 * pm, 1u); }
    __device__ __forceinline__ void wait_ready(const Unit& u) const { while (xb_ld(ctr + 32 * u.pm) < 8u) __builtin_amdgcn_s_sleep(2); asm volatile("" ::: "memory"); }
    __device__ __forceinline__ unsigned poll(const Unit& u) const { return xb_ld(ctr + 32 * u.pm); }
    __device__ __forceinline__ void spin(const Unit& u) const { while (xb_ld(ctr + 32 * u.pm) < 8u) __builtin_amdgcn_s_sleep(2); }
    __device__ __forceinline__ void acquire_async() const { asm volatile("buffer_inv sc1" ::: "memory"); }
    TileOrder o; const char* A; const char* B; const PG8_LAS int* texp; const PG8_LAS int* tbase; const PG8_LAS int* tcnt; const PG8_LAS int* rt; const int* list;
    int rem = 0, nl = 0;
    __device__ __forceinline__ bool next(int i, Unit& u) const { int pm, pn;
        if (GATHER) { if (!o.get(i, pm, pn)) return false; }
        else { const bool light = o.c >= rem; const long L = (light && i < 2) ? (long)i * nl + (o.c - rem) : 2L * nl + (long)(light ? i - 2 : i) * o.G + o.c; if (!o.map(L, pm, pn)) return false; }
        const int e = __builtin_amdgcn_readfirstlane(texp[pm]);
        u.pm = pm; u.pn = pn; u.aux = e; u.kt = KT; u.ui = i; u.rb = (pm - __builtin_amdgcn_readfirstlane(tbase[e])) * 256; u.cn = __builtin_amdgcn_readfirstlane(tcnt[e]);
        u.A = GATHER ? A : A + (size_t)((unsigned)pm * AT); u.B = B + (size_t)((unsigned)e * BE + (unsigned)pn * BT); return true; }
    __device__ __forceinline__ int tok_of(const Unit& u, int row) const { const int pos = u.rb + row; return pos < u.cn ? (list[(size_t)u.aux * MT + pos] >> 1) : 0; }
    __device__ __forceinline__ int rowtok(int ui, int row) const { if (ui < RT_UNITS) return rt[ui * 256 + row]; Unit u; next(ui, u); return tok_of(u, row); }
    __device__ __forceinline__ void fill_dst(PG8_LAS int* rtw, const float* listg, int tid) const {
        int dv[RT_UNITS / 2]; float gv[RT_UNITS / 2]; bool ok[RT_UNITS / 2];
#pragma unroll
        for (int i = 0; i < RT_UNITS / 2; ++i) { Unit u; ok[i] = next(i, u); dv[i] = -1; gv[i] = 0.f;
            if (ok[i] && tid < 256) { const int pos = u.rb + tid; if (pos < u.cn) { const size_t li = (size_t)u.aux * MT + pos; dv[i] = list[li]; gv[i] = listg[li]; } } }
#pragma unroll
        for (int i = 0; i < RT_UNITS / 2; ++i) if (ok[i] && tid < 256) { rtw[i * 512 + tid] = dv[i]; rtw[i * 512 + 256 + tid] = (int)__float_as_uint(gv[i]); }
        __syncthreads(); }
    __device__ __forceinline__ void fill_rows(PG8_LAS int* rtw, int tid) const {
#pragma unroll
        for (int h = 0; h < 2; ++h) { int tk[RT_UNITS / 2]; bool ok[RT_UNITS / 2];
#pragma unroll
            for (int q = 0; q < RT_UNITS / 2; ++q) { Unit u; ok[q] = next(h * (RT_UNITS / 2) + q, u); tk[q] = 0; if (ok[q] && tid < 256) tk[q] = tok_of(u, tid); }
#pragma unroll
            for (int q = 0; q < RT_UNITS / 2; ++q) if (ok[q] && tid < 256) rtw[(h * (RT_UNITS / 2) + q) * 256 + tid] = tk[q]; }
        __syncthreads(); }
};

struct EpiBf16 {
    static constexpr bool PERM = true;
    bf16_t* O; int ldc; float* P;
    __device__ __forceinline__ void operator()(const f32x4 (&acc)[2][2][4][2], const Unit& u, int wr, int wc, int fr, int fq) const {
        const int row0 = u.pm * BM + wr * 64 + fr, col0 = u.pn * BM + wc * 32 + 8 * fq;
        if (u.aux == 0) {
#pragma unroll
            for (int ai = 0; ai < 2; ++ai)
#pragma unroll
                for (int m = 0; m < 4; ++m) { bf16_t* rowp = O + (size_t)(row0 + ai * HALF + m * 16) * ldc + col0;
#pragma unroll
                    for (int bj = 0; bj < 2; ++bj) { const f32x4 v0 = acc[ai][bj][m][0], v1 = acc[ai][bj][m][1];
                        v4u w; w.x = cvt_pk_bf16(v0[0], v0[1]); w.y = cvt_pk_bf16(v0[2], v0[3]); w.z = cvt_pk_bf16(v1[0], v1[1]); w.w = cvt_pk_bf16(v1[2], v1[3]);
                        *(v4u*)(rowp + bj * HALF) = w; } }
        } else {
            float* pb = P + (size_t)(u.aux - 1) * 512 * ldc;
#pragma unroll
            for (int ai = 0; ai < 2; ++ai)
#pragma unroll
                for (int m = 0; m < 4; ++m) { float* rowp = pb + (size_t)(row0 + ai * HALF + m * 16) * ldc + col0;
#pragma unroll
                    for (int bj = 0; bj < 2; ++bj) { *(f32x4*)(rowp + bj * HALF) = acc[ai][bj][m][0]; *(f32x4*)(rowp + bj * HALF + 4) = acc[ai][bj][m][1]; } }
        }
    }
};
struct EpiBf16W {
    static constexpr bool PERM = true;
    bf16_t* O; int ldc;
    __device__ __forceinline__ void operator()(const f32x4 (&acc)[2][2][4][2], const Unit& u, int wr, int wc, int fr, int fq) const {
        const int row0 = u.pm * BM + wr * 64 + fr, col0 = u.pn * BM + wc * 32 + 8 * fq;
#pragma unroll
        for (int ai = 0; ai < 2; ++ai)
#pragma unroll
            for (int m = 0; m < 4; ++m) { bf16_t* rowp = O + (size_t)(row0 + ai * HALF + m * 16) * ldc + col0;
#pragma unroll
                for (int bj = 0; bj < 2; ++bj) { const f32x4 v0 = acc[ai][bj][m][0], v1 = acc[ai][bj][m][1];
                    v4u w; w.x = cvt_pk_bf16(v0[0], v0[1]); w.y = cvt_pk_bf16(v0[2], v0[3]); w.z = cvt_pk_bf16(v1[0], v1[1]); w.w = cvt_pk_bf16(v1[2], v1[3]);
                    const bf16_t* gp = rowp + bj * HALF;
                    asm volatile("global_store_dwordx4 %0, %1, off sc1\n\ts_nop 1" :: "v"(gp), "v"(w) : "memory"); } }
    }
};
struct EpiQkv {
    static constexpr bool PERM = true;
    bf16_t* O; int ldc; float* P; bf16_t* V;
    __device__ __forceinline__ void operator()(const f32x4 (&acc)[2][2][4][2], const Unit& u, int wr, int wc, int fr, int fq) const {
        const int row0 = u.pm * BM + wr * 64 + fr, col0 = u.pn * BM + wc * 32 + 8 * fq;
        if (u.aux == 0) {
            const bool isV = u.pn >= (DM + KVD) / BM;
#pragma unroll
            for (int ai = 0; ai < 2; ++ai)
#pragma unroll
                for (int m = 0; m < 4; ++m) { const int row = row0 + ai * HALF + m * 16; bf16_t* rowp = O + (size_t)row * ldc + col0; size_t vstep = HALF;
                    if (isV) { const bool lat = row >= NCTX; const int lr = row - NCTX, b = lat ? (lr >> 13) : (row >> 8), kpos = lat ? (CTXL + (lr & 8191)) : (row & 255);
                        rowp = V + (((size_t)b * NKV + (size_t)(u.pn - (DM + KVD) / BM) * 2) * SKV + kpos) * HD + wc * 32 + 8 * fq; vstep = (size_t)SKV * HD; }
#pragma unroll
                    for (int bj = 0; bj < 2; ++bj) { const f32x4 v0 = acc[ai][bj][m][0], v1 = acc[ai][bj][m][1];
                        v4u w; w.x = cvt_pk_bf16(v0[0], v0[1]); w.y = cvt_pk_bf16(v0[2], v0[3]); w.z = cvt_pk_bf16(v1[0], v1[1]); w.w = cvt_pk_bf16(v1[2], v1[3]);
                        *(v4u*)(rowp + bj * vstep) = w; } }
        } else {
            float* pb = P + (size_t)(u.aux - 1) * 512 * ldc;
#pragma unroll
            for (int ai = 0; ai < 2; ++ai)
#pragma unroll
                for (int m = 0; m < 4; ++m) { float* rowp = pb + (size_t)(row0 + ai * HALF + m * 16) * ldc + col0;
#pragma unroll
                    for (int bj = 0; bj < 2; ++bj) { *(f32x4*)(rowp + bj * HALF) = acc[ai][bj][m][0]; *(f32x4*)(rowp + bj * HALF + 4) = acc[ai][bj][m][1]; } }
        }
    }
};
struct EpiGateUp {
    static constexpr bool PERM = true;
    bf16_t* ACT;
    __device__ __forceinline__ void operator()(const f32x4 (&acc)[2][2][4][2], const Unit& u, int wr, int wc, int fr, int fq) const {
        const int row0 = u.pm * BM + wr * 64 + fr, col0 = u.pn * HALF + wc * 32 + 8 * fq;
#pragma unroll
        for (int ai = 0; ai < 2; ++ai)
#pragma unroll
            for (int m = 0; m < 4; ++m) { bf16_t* rowp = ACT + (size_t)(row0 + ai * HALF + m * 16) * DE + col0;
                float v[8];
#pragma unroll
                for (int n = 0; n < 2; ++n)
#pragma unroll
                    for (int j = 0; j < 4; ++j) v[n * 4 + j] = silu_f(acc[ai][0][m][n][j]) * acc[ai][1][m][n][j];
                v4u w; w.x = cvt_pk_bf16(v[0], v[1]); w.y = cvt_pk_bf16(v[2], v[3]); w.z = cvt_pk_bf16(v[4], v[5]); w.w = cvt_pk_bf16(v[6], v[7]);
                asm volatile("global_store_dwordx4 %0, %1, off sc1\n\ts_nop 1" :: "v"(rowp), "v"(w) : "memory"); }
    }
};
struct EpiDown {
    static constexpr bool PERM = true;
    bf16_t* FB; const PG8_LAS int* rt;
    __device__ __forceinline__ void operator()(const f32x4 (&acc)[2][2][4][2], const Unit& u, int wr, int wc, int fr, int fq) const {
        const int r0 = wr * 64 + fr, col0 = u.pn * BM + wc * 32 + 8 * fq; const PG8_LAS int* tb = rt + u.ui * 512 + r0;
#pragma unroll
        for (int ai = 0; ai < 2; ++ai)
#pragma unroll
            for (int m = 0; m < 4; ++m) { const int d_ = tb[ai * HALF + m * 16]; const float g_ = __uint_as_float((unsigned)tb[256 + ai * HALF + m * 16]);
                if (d_ >= 0) { bf16_t* fr_ = FB + (size_t)d_ * DM + col0;
#pragma unroll
                    for (int bj = 0; bj < 2; ++bj) { const f32x4 v0 = acc[ai][bj][m][0] * g_, v1 = acc[ai][bj][m][1] * g_;
                        v4u w; w.x = cvt_pk_bf16(v0[0], v0[1]); w.y = cvt_pk_bf16(v0[2], v0[3]); w.z = cvt_pk_bf16(v1[0], v1[1]); w.w = cvt_pk_bf16(v1[2], v1[3]);
                        *(v4u*)(fr_ + bj * HALF) = w; } } }
    }
};
}

namespace att {
constexpr int D = 128, NW = 8, QBLK = 32, KVBLK = 64;
constexpr float SCALE = 0.088388347648318440f;
constexpr float THR = 8.f;
#ifndef ATT_SDEPTH
#define ATT_SDEPTH 1
#endif
constexpr int SDEPTH = ATT_SDEPTH;
constexpr int LDQ = DM, LDK = HD, LDO = DM;
constexpr size_t SHM_V = KVBLK * D * 2, SHM_K = KVBLK * D * 2, SHM_ATTN = 2 * SHM_V + 2 * SHM_K + NW * 64 * 4;
typedef unsigned u32x4 __attribute__((ext_vector_type(4)));
#define KSWZ(row, colB) ((row) * 256 + ((colB) ^ (((row) & 7) << 4)))
#define SBAR() __builtin_amdgcn_sched_barrier(0)
__device__ __forceinline__ int crow(int r, int hi) { return (r & 3) + 8 * (r >> 2) + 4 * hi; }
__device__ __forceinline__ unsigned cvtpk(float lo, float hi) { unsigned r; asm volatile("v_cvt_pk_bf16_f32 %0, %1, %2" : "=v"(r) : "v"(lo), "v"(hi)); return r; }
__device__ __forceinline__ bf16x8 ld8(const bf16_t* p) { return *reinterpret_cast<const bf16x8*>(p); }

__device__ __forceinline__ void partialSM(f32x16& p0, f32x16& p1, float& m_reg, float& mn, float& alpha) {
  constexpr float C = SCALE * 1.4426950408889634f;
  float pmax = p0[0]; for (int r = 1; r < 16; ++r) pmax = fmaxf(pmax, p0[r]); for (int r = 0; r < 16; ++r) pmax = fmaxf(pmax, p1[r]);
  { auto rr = __builtin_amdgcn_permlane32_swap(__float_as_uint(pmax), __float_as_uint(pmax), false, false);
    pmax = fmaxf(__uint_as_float(rr[0]), __uint_as_float(rr[1])); }
  if (__builtin_expect(__all(pmax - m_reg <= THR / SCALE), 1)) { mn = m_reg; alpha = 1.f; }
  else { mn = fmaxf(m_reg, pmax); alpha = __builtin_amdgcn_exp2f((m_reg - mn) * C); m_reg = mn; }
  float mnC = -mn * C;
  for (int r = 0; r < 16; ++r) p0[r] = fmaf(p0[r], C, mnC); for (int r = 0; r < 16; ++r) p1[r] = fmaf(p1[r], C, mnC);
  for (int r = 0; r < 16; ++r) p0[r] = __builtin_amdgcn_exp2f(p0[r]);
}
__device__ __forceinline__ void finishSM(f32x16& p0, f32x16& p1, float alpha, float& l_reg, bf16x8& pa0, bf16x8& pa1, bf16x8& pa2, bf16x8& pa3) {
  for (int r = 0; r < 16; ++r) p1[r] = __builtin_amdgcn_exp2f(p1[r]);
  float ps = 0; for (int r = 0; r < 16; ++r) ps += p0[r]; for (int r = 0; r < 16; ++r) ps += p1[r];
  { auto rr = __builtin_amdgcn_permlane32_swap(__float_as_uint(ps), __float_as_uint(ps), false, false);
    ps = __uint_as_float(rr[0]) + __uint_as_float(rr[1]); }
  l_reg = l_reg * alpha + ps;
#define PK4(P, BASE, OUT) do { unsigned a0 = cvtpk(P[BASE + 0], P[BASE + 1]), a1 = cvtpk(P[BASE + 2], P[BASE + 3]);   \
    unsigned b0 = cvtpk(P[BASE + 4], P[BASE + 5]), b1 = cvtpk(P[BASE + 6], P[BASE + 7]);                              \
    auto r0 = __builtin_amdgcn_permlane32_swap(a0, b0, false, false); auto r1 = __builtin_amdgcn_permlane32_swap(a1, b1, false, false); \
    u32x4 w = {r0[0], r1[0], r0[1], r1[1]}; OUT = *reinterpret_cast<bf16x8*>(&w); } while (0)
  PK4(p0, 0, pa0); PK4(p0, 8, pa1); PK4(p1, 0, pa2); PK4(p1, 8, pa3);
#undef PK4
}
__device__ __forceinline__ void qkt(f32x16& p0, f32x16& p1, const bf16_t* Ks, const bf16x8* qr, int r32, int hi) {
  p0 = f32x16{}; p1 = f32x16{};
  for (int d0 = 0; d0 < 8; ++d0) { int cb = (d0 * 16 + hi * 8) * 2;
    bf16x8 b0 = *reinterpret_cast<const bf16x8*>((const char*)Ks + KSWZ(r32, cb));
    bf16x8 b1 = *reinterpret_cast<const bf16x8*>((const char*)Ks + KSWZ(32 + r32, cb));
    p0 = __builtin_amdgcn_mfma_f32_32x32x16_bf16(b0, qr[d0], p0, 0, 0, 0);
    p1 = __builtin_amdgcn_mfma_f32_32x32x16_bf16(b1, qr[d0], p1, 0, 0, 0); }
}
__device__ __forceinline__ int v_st(int k, int c) { const int kk = (k & ~0xC) | ((k & 4) << 1) | ((k & 8) >> 1); return ((kk >> 3) * 4 + (c >> 5)) * 512 + ((kk & 7) * 32 + (c & 31)) * 2; }
__device__ __forceinline__ int v_rd_base(int lane) { return ((lane & 3) << 3) | (((lane >> 2) & 3) << 6) | (((lane >> 4) & 1) << 5) | (((lane >> 5) & 1) << 8); }
constexpr int v_rd_off(int d0, int ks, int half) { return d0 * 512 + ks * 4096 + half * 2048; }
template <int OFF> __device__ __forceinline__ s16x4 tr_read(int vb) {
  s16x4 r; asm volatile("ds_read_b64_tr_b16 %0, %1 offset:%2" : "=&v"(r) : "v"(vb), "i"(OFF) : "memory"); return r;
}
template <int D0> __device__ __forceinline__ void pv_one(f32x16& od, int vb, bf16x8 pa0, bf16x8 pa1, bf16x8 pa2, bf16x8 pa3) {
  const s16x4 l0 = tr_read<v_rd_off(D0, 0, 0)>(vb), h0 = tr_read<v_rd_off(D0, 0, 1)>(vb), l1 = tr_read<v_rd_off(D0, 1, 0)>(vb), h1 = tr_read<v_rd_off(D0, 1, 1)>(vb);
  const s16x4 l2 = tr_read<v_rd_off(D0, 2, 0)>(vb), h2 = tr_read<v_rd_off(D0, 2, 1)>(vb), l3 = tr_read<v_rd_off(D0, 3, 0)>(vb), h3 = tr_read<v_rd_off(D0, 3, 1)>(vb);
  asm volatile("s_waitcnt lgkmcnt(0)" ::: "memory"); SBAR();
#define PK(L, H) (bf16x8){L[0], L[1], L[2], L[3], H[0], H[1], H[2], H[3]}
  od = __builtin_amdgcn_mfma_f32_32x32x16_bf16(pa0, PK(l0, h0), od, 0, 0, 0);
  od = __builtin_amdgcn_mfma_f32_32x32x16_bf16(pa1, PK(l1, h1), od, 0, 0, 0);
  od = __builtin_amdgcn_mfma_f32_32x32x16_bf16(pa2, PK(l2, h2), od, 0, 0, 0);
  od = __builtin_amdgcn_mfma_f32_32x32x16_bf16(pa3, PK(l3, h3), od, 0, 0, 0);
#undef PK
}
template <int D0> __device__ __forceinline__ void pv_rd(s16x4 (&r)[8], int vb) {
  r[0] = tr_read<v_rd_off(D0, 0, 0)>(vb); r[1] = tr_read<v_rd_off(D0, 0, 1)>(vb); r[2] = tr_read<v_rd_off(D0, 1, 0)>(vb); r[3] = tr_read<v_rd_off(D0, 1, 1)>(vb);
  r[4] = tr_read<v_rd_off(D0, 2, 0)>(vb); r[5] = tr_read<v_rd_off(D0, 2, 1)>(vb); r[6] = tr_read<v_rd_off(D0, 3, 0)>(vb); r[7] = tr_read<v_rd_off(D0, 3, 1)>(vb);
}
__device__ __forceinline__ void pv_mm(f32x16& od, const s16x4 (&r)[8], bf16x8 pa0, bf16x8 pa1, bf16x8 pa2, bf16x8 pa3) {
#define PK(L, H) (bf16x8){L[0], L[1], L[2], L[3], H[0], H[1], H[2], H[3]}
  od = __builtin_amdgcn_mfma_f32_32x32x16_bf16(pa0, PK(r[0], r[1]), od, 0, 0, 0);
  od = __builtin_amdgcn_mfma_f32_32x32x16_bf16(pa1, PK(r[2], r[3]), od, 0, 0, 0);
  od = __builtin_amdgcn_mfma_f32_32x32x16_bf16(pa2, PK(r[4], r[5]), od, 0, 0, 0);
  od = __builtin_amdgcn_mfma_f32_32x32x16_bf16(pa3, PK(r[6], r[7]), od, 0, 0, 0);
#undef PK
}
__device__ __forceinline__ void pv_d0(f32x16* o, int vb, bf16x8 pa0, bf16x8 pa1, bf16x8 pa2, bf16x8 pa3) {
  s16x4 ra[8], rb[8];
  pv_rd<0>(ra, vb); pv_rd<1>(rb, vb);
  asm volatile("s_waitcnt lgkmcnt(8)" ::: "memory"); SBAR(); pv_mm(o[0], ra, pa0, pa1, pa2, pa3); pv_rd<2>(ra, vb);
  asm volatile("s_waitcnt lgkmcnt(8)" ::: "memory"); SBAR(); pv_mm(o[1], rb, pa0, pa1, pa2, pa3); pv_rd<3>(rb, vb);
  asm volatile("s_waitcnt lgkmcnt(8)" ::: "memory"); SBAR(); pv_mm(o[2], ra, pa0, pa1, pa2, pa3);
  asm volatile("s_waitcnt lgkmcnt(0)" ::: "memory"); SBAR(); pv_mm(o[3], rb, pa0, pa1, pa2, pa3);
}
__device__ __forceinline__ void attn_dense_body(const bf16_t* __restrict__ Qb, const bf16_t* __restrict__ Kh, const bf16_t* __restrict__ Vh,
                                                bf16_t* __restrict__ Ob, int seq, char* lds) {
  const int tid = otid(), wid = tid >> 6, lane = tid & 63, r32 = lane & 31, hi = lane >> 5;
  bf16_t* V_lds = (bf16_t*)lds; bf16_t* K_lds = (bf16_t*)(lds + 2 * SHM_V);
  float* ws = (float*)(lds + 2 * SHM_V + 2 * SHM_K) + wid * 64; float* li_l = ws; float* al_l = ws + 32;
  float m_reg = -1e30f, l_reg = 0; f32x16 o[4] = {}; bf16x8 qr[8];
  const bf16_t* Qw = Qb + (long)(wid * QBLK + r32) * LDQ + hi * 8;
#pragma unroll
  for (int d0 = 0; d0 < 8; ++d0) qr[d0] = ld8(Qw + d0 * 16);
  const int sr = tid >> 4, sc = (tid & 15) * 8, vst0 = v_st(sr, sc), vst1 = v_st(32 + sr, sc);
  const int vb0 = (int)(uintptr_t)V_lds + v_rd_base(lane);
  struct { bf16x8 vs0, vs1, ks0, ks1; } sr_[SDEPTH];
#define SLOAD(i, k0) do { sr_[i].vs0 = ld8(&Vh[(long)((k0) + sr) * LDK + sc]); sr_[i].vs1 = ld8(&Vh[(long)((k0) + 32 + sr) * LDK + sc]); \
    sr_[i].ks0 = ld8(&Kh[(long)((k0) + sr) * LDK + sc]); sr_[i].ks1 = ld8(&Kh[(long)((k0) + 32 + sr) * LDK + sc]); } while (0)
#define SWRITE(b, i) do { *(bf16x8*)((char*)V_lds + (b) * SHM_V + vst0) = sr_[i].vs0;          \
    *(bf16x8*)((char*)V_lds + (b) * SHM_V + vst1) = sr_[i].vs1; int kc = sc * 2;               \
    *(bf16x8*)((char*)K_lds + (b) * SHM_K + KSWZ(sr, kc)) = sr_[i].ks0;                       \
    *(bf16x8*)((char*)K_lds + (b) * SHM_K + KSWZ(32 + sr, kc)) = sr_[i].ks1; } while (0)
#define SWAIT() do { if constexpr (SDEPTH == 2) asm volatile("s_waitcnt vmcnt(4)" ::: "memory"); else asm volatile("s_waitcnt vmcnt(0)" ::: "memory"); } while (0)
#define RESC(a) do { if (__any((a) < 1.f)) { if (hi == 0) al_l[r32] = (a); asm volatile("s_waitcnt lgkmcnt(0)" ::: "memory"); \
    for (int d = 0; d < 4; ++d) for (int r = 0; r < 16; ++r) o[d][r] *= al_l[crow(r, hi)]; } } while (0)
  f32x16 pA0, pA1, pB0, pB1; float mnA, mnB, alA, alB; bf16x8 pa0, pa1, pa2, pa3; const int NT = seq / KVBLK;
  constexpr int SE = 0, SO = SDEPTH - 1;
  SLOAD(SE, 0); asm volatile("s_waitcnt vmcnt(0)" ::: "memory"); SWRITE(0, SE); __syncthreads();
  qkt(pA0, pA1, K_lds, qr, r32, hi); partialSM(pA0, pA1, m_reg, mnA, alA);
  SLOAD(SO, KVBLK); if constexpr (SDEPTH == 2) { if (2 < NT) SLOAD(SE, 2 * KVBLK); }
  SWAIT(); SWRITE(1, SO); __syncthreads();
  for (int j = 1; j + 1 < NT; j += 2) {
    SBAR(); qkt(pB0, pB1, (bf16_t*)((char*)K_lds + SHM_K), qr, r32, hi);
    finishSM(pA0, pA1, alA, l_reg, pa0, pa1, pa2, pa3); SBAR();
    SLOAD(SO, (j + SDEPTH) * KVBLK); SBAR();
    pv_d0(o, vb0, pa0, pa1, pa2, pa3); partialSM(pB0, pB1, m_reg, mnB, alB);
    __syncthreads(); SWAIT(); SWRITE(0, SE);
    RESC(alB); __syncthreads();
    SBAR(); qkt(pA0, pA1, K_lds, qr, r32, hi);
    finishSM(pB0, pB1, alB, l_reg, pa0, pa1, pa2, pa3); SBAR();
    if (SDEPTH == 1 || j + 3 < NT) SLOAD(SE, (j + 1 + SDEPTH) * KVBLK); SBAR();
    pv_d0(o, vb0 + (int)SHM_V, pa0, pa1, pa2, pa3); partialSM(pA0, pA1, m_reg, mnA, alA);
    __syncthreads(); SWAIT(); SWRITE(1, SO);
    RESC(alA); __syncthreads();
  }
  SBAR(); qkt(pB0, pB1, (bf16_t*)((char*)K_lds + SHM_K), qr, r32, hi);
  finishSM(pA0, pA1, alA, l_reg, pa0, pa1, pa2, pa3); SBAR();
  pv_d0(o, vb0, pa0, pa1, pa2, pa3); partialSM(pB0, pB1, m_reg, mnB, alB);
  __syncthreads(); RESC(alB);
  finishSM(pB0, pB1, alB, l_reg, pa0, pa1, pa2, pa3); SBAR();
  pv_d0(o, vb0 + (int)SHM_V, pa0, pa1, pa2, pa3);
  if (hi == 0) li_l[r32] = l_reg; asm volatile("s_waitcnt lgkmcnt(0)" ::: "memory");
  float rli[16];
#pragma unroll
  for (int r = 0; r < 16; ++r) rli[r] = __builtin_amdgcn_rcpf(li_l[crow(r, hi)]);
  bf16_t* Ow = Ob + (long)(wid * QBLK) * LDO;
#pragma unroll
  for (int r = 0; r < 16; ++r) { int orow = crow(r, hi);
    for (int d0 = 0; d0 < 4; ++d0) Ow[(long)orow * LDO + d0 * 32 + r32] = (bf16_t)f2bf(o[d0][r] * rli[r]); }
  asm volatile("s_waitcnt vmcnt(0) lgkmcnt(0)" ::: "memory");
  __syncthreads();
#undef SLOAD
#undef SWRITE
#undef SWAIT
#undef RESC
}
constexpr size_t SHM_SLOT = 32768, SHM_DMA = 4 * SHM_SLOT;
static_assert(4 * SHM_SLOT <= RING_BYTES && TAB_OFF + 1024 + NW * 64 * 4 <= LDS_BYTES, "attention LDS map");
#define ATT_WAIT_BAR() asm volatile("s_waitcnt vmcnt(0) lgkmcnt(0)\n\ts_barrier" ::: "memory")
__device__ __forceinline__ void attn_dma_body(const bf16_t* __restrict__ Qb, int ldq, int tpos0, const float* __restrict__ rope, const float* __restrict__ qgain,
                                              const bf16_t* __restrict__ Kh, const bf16_t* __restrict__ Vh, bf16_t* __restrict__ Ob, int seq, char* lds) {
  const int tid = otid(), wid = tid >> 6, lane = tid & 63, r32 = lane & 31, hi = lane >> 5;
  float* ws = (float*)(lds + TAB_OFF + 1024) + wid * 64; float* li_l = ws; float* al_l = ws + 32;
  float m_reg = -1e30f, l_reg = 0; f32x16 o[4] = {}; bf16x8 qr[8];
  const bf16_t* Qw = Qb + (long)(wid * QBLK + r32) * ldq + hi * 8;
  unsigned koff[2], voff[2];
#pragma unroll
  for (int c = 0; c < 2; ++c) { const int g = c * 512 + tid;
    { const int row = g >> 4, ch = (g & 15) ^ (row & 7); koff[c] = (unsigned)(row * 128 + ch * 8) * 2u; }
    { const int sub = g >> 5, kk = (sub >> 2) * 8 + ((g >> 2) & 7), k = (kk & ~0xC) | ((kk & 4) << 1) | ((kk & 8) >> 1), col = (sub & 3) * 32 + (g & 3) * 8; voff[c] = (unsigned)(k * 128 + col) * 2u; } }
  const unsigned wbase = (unsigned)__builtin_amdgcn_readfirstlane(wid) * 1024u;
  typedef __attribute__((address_space(3))) unsigned lds_u32;
  lds_u32* ldsl = (lds_u32*)(__attribute__((address_space(3))) char*)lds;
#define ATT_DMA(t, slot) do { const char* kt_ = (const char*)Kh + (size_t)(t) * (KVBLK * D * 2); const char* vt_ = (const char*)Vh + (size_t)(t) * (KVBLK * D * 2); \
    _Pragma("unroll") for (int c_ = 0; c_ < 2; ++c_) { \
      __builtin_amdgcn_global_load_lds((const unsigned*)(kt_ + koff[c_]), (lds_u32*)((__attribute__((address_space(3))) char*)ldsl + (slot) * SHM_SLOT + c_ * 8192 + wbase), 16, 0, 0); \
      __builtin_amdgcn_global_load_lds((const unsigned*)(vt_ + voff[c_]), (lds_u32*)((__attribute__((address_space(3))) char*)ldsl + (slot) * SHM_SLOT + 16384 + c_ * 8192 + wbase), 16, 0, 0); } } while (0)
#define RESC(a) do { if (__any((a) < 1.f)) { if (hi == 0) al_l[r32] = (a); asm volatile("s_waitcnt lgkmcnt(0)" ::: "memory"); \
    for (int d = 0; d < 4; ++d) for (int r = 0; r < 16; ++r) o[d][r] *= al_l[crow(r, hi)]; } } while (0)
  const int NT = seq / KVBLK;
  ATT_DMA(0, 0); ATT_DMA(1, 1);
#pragma unroll
  for (int d0 = 0; d0 < 8; ++d0) qr[d0] = ld8(Qw + d0 * 16);
  if (tpos0 >= 0) {
    float ss = 0.f;
#pragma unroll
    for (int d0 = 0; d0 < 8; ++d0)
#pragma unroll
      for (int i = 0; i < 8; ++i) { const float x = bf2f((unsigned)(unsigned short)qr[d0][i]); ss += x * x; }
    { auto rr = __builtin_amdgcn_permlane32_swap(__float_as_uint(ss), __float_as_uint(ss), false, false); ss = __uint_as_float(rr[0]) + __uint_as_float(rr[1]); }
    const float rinv = 1.0f / sqrtf(ss * (1.0f / 128.0f) + RMS_EPS);
    const int t = tpos0 + wid * QBLK + r32;
#pragma unroll
    for (int ax = 0; ax < 2; ++ax) { const int pos = ax ? (t & 63) : (t >> 6);
#pragma unroll
      for (int q = 0; q < 2; ++q) { const int dl = 4 * ax + q, dh = dl + 2, p0 = q * 16 + 8 * hi;
        const float* cp_ = rope + pos * 32 + p0; const float* gl = qgain + dl * 16 + 8 * hi; const float* gh = qgain + dh * 16 + 8 * hi;
        float cs[8], sn[8], lo[8], hv[8];
#pragma unroll
        for (int i = 0; i < 8; ++i) { cs[i] = cp_[i]; sn[i] = cp_[4096 + i];
          lo[i] = bf2f((unsigned)(unsigned short)qr[dl][i]) * rinv * gl[i]; hv[i] = bf2f((unsigned)(unsigned short)qr[dh][i]) * rinv * gh[i]; }
        u32x4 wl, wh;
#pragma unroll
        for (int i = 0; i < 4; ++i) { const float l0 = lo[2 * i] * cs[2 * i] - hv[2 * i] * sn[2 * i], l1 = lo[2 * i + 1] * cs[2 * i + 1] - hv[2 * i + 1] * sn[2 * i + 1];
          const float h0 = hv[2 * i] * cs[2 * i] + lo[2 * i] * sn[2 * i], h1 = hv[2 * i + 1] * cs[2 * i + 1] + lo[2 * i + 1] * sn[2 * i + 1];
          wl[i] = pk2(l0, l1); wh[i] = pk2(h0, h1); }
        qr[dl] = *reinterpret_cast<bf16x8*>(&wl); qr[dh] = *reinterpret_cast<bf16x8*>(&wh); } } }
#pragma unroll
  for (int d0 = 0; d0 < 8; ++d0) asm volatile("" : "+v"(qr[d0]));
  ATT_WAIT_BAR();
  if (2 < NT) ATT_DMA(2, 2);
  const int vb0 = (int)(uintptr_t)lds + 16384 + v_rd_base(lane);
  f32x16 pA0, pA1, pB0, pB1; float mnA, mnB, alA, alB; bf16x8 pa0, pa1, pa2, pa3;
  qkt(pA0, pA1, (const bf16_t*)lds, qr, r32, hi); partialSM(pA0, pA1, m_reg, mnA, alA);
  const bool lead = __builtin_amdgcn_readfirstlane(wid) < 4;
#define ATT_SYNC(jn) do { ATT_WAIT_BAR(); if ((jn) < NT) ATT_DMA((jn), (jn) & 3); } while (0)
  for (int j = 1; j + 1 < NT; j += 2) {
    { SBAR(); qkt(pB0, pB1, (const bf16_t*)(lds + (j & 3) * SHM_SLOT), qr, r32, hi);
      finishSM(pA0, pA1, alA, l_reg, pa0, pa1, pa2, pa3); SBAR();
      if (!lead) ATT_SYNC(j + 2);
      pv_d0(o, vb0 + ((j - 1) & 3) * (int)SHM_SLOT, pa0, pa1, pa2, pa3); partialSM(pB0, pB1, m_reg, mnB, alB);
      if (lead) ATT_SYNC(j + 2);
      RESC(alB); }
    { SBAR(); qkt(pA0, pA1, (const bf16_t*)(lds + ((j + 1) & 3) * SHM_SLOT), qr, r32, hi);
      finishSM(pB0, pB1, alB, l_reg, pa0, pa1, pa2, pa3); SBAR();
      if (!lead) ATT_SYNC(j + 3);
      pv_d0(o, vb0 + (j & 3) * (int)SHM_SLOT, pa0, pa1, pa2, pa3); partialSM(pA0, pA1, m_reg, mnA, alA);
      if (lead) ATT_SYNC(j + 3);
      RESC(alA); }
  }
#undef ATT_SYNC
  { SBAR(); qkt(pB0, pB1, (const bf16_t*)(lds + ((NT - 1) & 3) * SHM_SLOT), qr, r32, hi);
    finishSM(pA0, pA1, alA, l_reg, pa0, pa1, pa2, pa3); SBAR();
    pv_d0(o, vb0 + ((NT - 2) & 3) * (int)SHM_SLOT, pa0, pa1, pa2, pa3); partialSM(pB0, pB1, m_reg, mnB, alB);
    RESC(alB);
    finishSM(pB0, pB1, alB, l_reg, pa0, pa1, pa2, pa3); SBAR();
    pv_d0(o, vb0 + ((NT - 1) & 3) * (int)SHM_SLOT, pa0, pa1, pa2, pa3); }
  if (hi == 0) li_l[r32] = l_reg; asm volatile("s_waitcnt lgkmcnt(0)" ::: "memory");
  float rli[16];
#pragma unroll
  for (int r = 0; r < 16; ++r) rli[r] = __builtin_amdgcn_rcpf(li_l[crow(r, hi)]);
  bf16_t* Ow = Ob + (long)(wid * QBLK) * LDO;
  asm volatile("s_waitcnt lgkmcnt(0)\n\ts_barrier" ::: "memory");
  { char* st = lds + wid * 8704;
#pragma unroll
    for (int r = 0; r < 16; ++r) { const int orow = crow(r, hi);
#pragma unroll
      for (int d0 = 0; d0 < 4; ++d0) *(bf16_t*)(st + orow * 272 + (d0 * 32 + r32) * 2) = (bf16_t)f2bf(o[d0][r] * rli[r]); }
    asm volatile("s_waitcnt lgkmcnt(0)" ::: "memory");
#pragma unroll
    for (int i = 0; i < 8; ++i) { const int c = i * 64 + lane, row = c >> 4, cc = c & 15; const u32x4 v = *(const u32x4*)(st + row * 272 + cc * 16);
      const bf16_t* gp = Ow + (long)row * LDO + cc * 8;
      asm volatile("global_store_dwordx4 %0, %1, off sc1\n\ts_nop 1" :: "v"(gp), "v"(v) : "memory"); } }
  ATT_WAIT_BAR();
#undef ATT_DMA
#undef RESC
}
#undef KSWZ
}

struct Params {
    const float *x, *c, *ctx, *c_ctx, *w_mod, *b_mod, *ln_g, *ln_b, *w_qkv, *q_gain, *k_gain, *w_o, *w_pool, *pool_scale, *w_router, *router_bias, *w_gate, *w_up, *w_down;
    float* out; unsigned char* ws; int ph_lo, ph_hi;
};

struct TItem { const float* W; bf16_t* WT; int K, N, kind, k0, n0; };
__device__ __forceinline__ int t_drow(int kind, int n) { return kind == 0 ? n : ((n >> 7) * 256 + (kind == 2 ? 128 : 0) + (n & 127)); }
__device__ __forceinline__ void t_load(const TItem& d, f32x4 (&r)[8], int lane) {
    const float* p = d.W + (size_t)(d.k0 + (lane >> 3)) * d.N + d.n0 + (lane & 7) * 4;
#pragma unroll
    for (int i = 0; i < 8; ++i) r[i] = __builtin_nontemporal_load((const f32x4*)(p + (size_t)(8 * i) * d.N));
}
__device__ __forceinline__ void t_store(const TItem& d, const f32x4 (&r)[8], LAS float* scr, int lane) {
#pragma unroll
    for (int i = 0; i < 8; ++i) *(LAS f32x4*)(scr + (8 * i + (lane >> 3)) * 32 + (((lane & 7) * 4 + 8 * i) & 31)) = r[i];
    LDS_WAIT(); asm volatile("" ::: "memory");
    const int c = lane >> 3, nl = lane & 7;
#pragma unroll
    for (int j = 0; j < 4; ++j) { const int n = nl + 8 * j; const LAS float* s = scr + (8 * c) * 32 + ((n + 8 * c) & 31);
        v4u o; o.x = pk2(s[0 * 32], s[1 * 32]); o.y = pk2(s[2 * 32], s[3 * 32]); o.z = pk2(s[4 * 32], s[5 * 32]); o.w = pk2(s[6 * 32], s[7 * 32]);
        __builtin_nontemporal_store(o, (GAS v4u*)(d.WT + (size_t)t_drow(d.kind, d.n0 + n) * d.K + d.k0 + 8 * c)); }
    LDS_WAIT(); asm volatile("" ::: "memory");
}

__device__ __forceinline__ void mod_prepare(const float* cl, const float* cc, LAS float* sv, int tid) {
    for (int i = tid; i < 3 * DM; i += 512) { const int cd = i >> 11, k = i & 2047; const float v = (cd < 2) ? cl[cd * DM + k] : cc[k]; sv[i] = v / (1.0f + expf(-v)); }
    __syncthreads();
}
__device__ __forceinline__ void mod_item(int it, const float* wm, const float* bm, float* MOD, const LAS float* sv, LAS float* red, int tid, int lane, int wave) {
    const int c4 = lane & 7, kr = (lane >> 3) + 8 * wave;
    const int l = it / 384, nb = it % 384; const float* W = wm + (size_t)l * DM * 12288 + nb * 32 + c4 * 4;
    f32x4 a0 = {0, 0, 0, 0}, a1 = a0, a2 = a0;
#pragma unroll 16
    for (int s = 0; s < 32; ++s) { const int k = s * 64 + kr; const f32x4 w = *(const f32x4*)(W + (size_t)k * 12288);
        a0 += w * sv[k]; a1 += w * sv[DM + k]; a2 += w * sv[2 * DM + k]; }
    *(LAS f32x4*)(red + (kr * 3 + 0) * 32 + c4 * 4) = a0; *(LAS f32x4*)(red + (kr * 3 + 1) * 32 + c4 * 4) = a1; *(LAS f32x4*)(red + (kr * 3 + 2) * 32 + c4 * 4) = a2;
    __syncthreads();
    if (tid < 96) { const int cd = tid >> 5, n = tid & 31; float s = 0.f; for (int r = 0; r < 64; ++r) s += red[(r * 3 + cd) * 32 + n];
        MOD[((size_t)l * 3 + cd) * 12288 + nb * 32 + n] = s + bm[l * 12288 + nb * 32 + n]; }
    __syncthreads();
}

typedef const __attribute__((address_space(4))) Params CParams;
__device__ __forceinline__ CParams* kparams() { CParams* k = (CParams*)__builtin_amdgcn_kernarg_segment_ptr(); asm volatile("" : "+s"(k)); return k; }
#define WSP(T, off) ((T*)(kp->ws + (off)))


#define IN(k) (lo <= (k) && (k) < hi)
#define NREP(k) (1 + ((REP_MASK >> (k)) & 1))
#define SEAM(k) do { if (IN(k) && IN((k) + 1)) xcd_barrier(bar); } while (0)
#define TIDS const int tid = otid(), lane = tid & 63, wave = __builtin_amdgcn_readfirstlane(tid >> 6), G = ogrid(), bx = obid(), gw = bx * 8 + wave, NGW = G * 8; (void)lane; (void)gw; (void)NGW


template <int layer>
__device__ __forceinline__ void layer_half(const int lo, const int hi, const XcdBarrier& bar, LAS unsigned char* L, LAS int* tcnt, LAS int* tbase, LAS int* texp) {
        const int P6 = 6 + 7 * layer;
        if (IN(P6)) _Pragma("unroll 1") for (int rep_ = 0; rep_ < NREP(6); ++rep_) {
            CParams* kp = kparams(); TIDS;
            const int row_lo = layer == 0 ? 0 : NCTX;
            const float* modl = WSP(float, WS_MOD) + (size_t)layer * 3 * 12288;
            unsigned* cnt = WSP(unsigned, WS_CTL) + CW_CNT + layer * 1024;
            const bf16_t* Y = WSP(bf16_t, WS_Y); float* X1 = WSP(float, WS_X1); bf16_t* Hb = WSP(bf16_t, WS_H);
            const float* xlat = kp->x; const float* xctx = kp->ctx; const bf16_t* X2b = WSP(bf16_t, WS_X2);
            const float* pscale = kp->pool_scale;
            int* LIST = WSP(int, WS_LIST); float* LISTG = WSP(float, WS_LIST) + (size_t)32 * MT;
            const float rb_e = kp->router_bias[lane & 31];
            LAS bf16_t* hp = (LAS bf16_t*)L;
            LAS float* part = (LAS float*)(L + 65536);
            LAS int* lcnt = (LAS int*)(L + 65536 + 8192); LAS int* lbase = lcnt + 32;
            LAS int* asg = (LAS int*)(L + 65536 + 8192 + 256);
            LAS float* vG1 = (LAS float*)(L + 82176); LAS float* vLG = vG1 + DM; LAS float* vLB = vLG + DM; LAS float* vSC = vLB + DM; LAS float* vSH = vSC + DM;
            const float* lg = kp->ln_g + (size_t)(layer * 2 + 0) * DM; const float* lb = kp->ln_b + (size_t)(layer * 2 + 0) * DM;
            const int ngrp = (MT - row_lo) / 8;
            const bool agg = ((ngrp + G - 1) / G) * 16 <= 512;
            if (tid < 32) lcnt[tid] = 0;
            const int ti = lane & 31, hi = lane >> 5;
            const bf16_t* w1p = WSP(bf16_t, WS_WR) + ((size_t)(wave * 16) * 64 + lane) * 8; const bf16_t* w2p = w1p + 32 * DM;
            const LAS bf16_t* a1p = hp + (ti & 7) * DM + wave * 256 + 8 * hi; const LAS bf16_t* a2p = a1p + 8 * DM;
            f32x4 xv[8]; v2u xb[8], yv[8];
#define P6_LOAD(grp_) do { const int row_ = row_lo + (grp_) * 8 + wave; const float* xr_ = (row_ < NCTX) ? xctx + (size_t)row_ * DM : xlat + (size_t)(row_ - NCTX) * DM; const bf16_t* yr_ = Y + (size_t)row_ * DM; const bf16_t* xb_ = X2b + (size_t)row_ * DM; \
                _Pragma("unroll") for (int j = 0; j < 8; ++j) { if (layer == 0) xv[j] = *(const f32x4*)(xr_ + (j * 64 + lane) * 4); else xb[j] = *(const v2u*)(xb_ + (j * 64 + lane) * 4); yv[j] = *(const v2u*)(yr_ + (j * 64 + lane) * 4); } } while (0)
            LAS int* rdy = (LAS int*)(L + 124928); unsigned* yd = WSP(unsigned, WS_CTL) + CW_YD; volatile LAS unsigned* MISC = (volatile LAS unsigned*)(L + MISC_OFF);
            const bool dyn = (layer == 0) && (G % 2 == 0); const int pcls = bx & 1; unsigned* q6 = WSP(unsigned, WS_CTL) + CW_P6Q + 32 * pcls;
            auto gmap = [&](unsigned pos) -> int { return pos >= 1056u ? -1 : (pos < 32u ? pcls * 32 + (int)pos : 64 + pcls * 1024 + ((int)pos - 32)); };
            auto seq = [&](int k) -> int { const int g_ = bx + k * G; return g_ < ngrp ? g_ : -1; };
            auto ensure = [&](int g_) { if (layer == 0) { const int pm_ = g_ < 64 ? (g_ >> 5) : 2 + ((g_ - 64) >> 5); if (!rdy[pm_]) { while (xb_ld(yd + 32 * pm_) < 8u) __builtin_amdgcn_s_sleep(4); asm volatile("" ::: "memory"); } } };
            if (layer == 0) { if (tid < 66) rdy[tid] = xb_ld(yd + 32 * tid) >= 8u ? 1 : 0;
                if (tid == 0) { __builtin_amdgcn_fence(__ATOMIC_ACQUIRE, "agent"); asm volatile("s_waitcnt vmcnt(0)" ::: "memory");
                    if (dyn) { MISC[36] = xb_add(q6, 1u); MISC[37] = xb_add(q6, 1u); } }
                __syncthreads(); }
            int grp = dyn ? gmap(MISC[36]) : seq(0), nxt_ = dyn ? gmap(MISC[37]) : seq(1);
            if (grp >= 0) ensure(grp);
            P6_LOAD(grp >= 0 ? grp : 0);
            int it_ = 0, cur_cd = -1;
            for (; grp >= 0; ++it_) {
                const int pf_ = nxt_ >= 0 ? nxt_ : grp; if (nxt_ >= 0) ensure(nxt_);
                unsigned tk2 = 0xffffffffu;
                if (dyn && tid == 0 && nxt_ >= 0 && it_ + 2 < 32) tk2 = xb_add(q6, 1u);
                const int row = row_lo + grp * 8 + wave; const int cd = row_cond(row_lo + grp * 8);
                if (cd != cur_cd) {
                    const float* g1 = modl + (size_t)cd * 12288 + 2 * DM;
                    float t0[4], t1[4], t2[4], t3[4], t4[4], t5[4];
                    __syncthreads();
#pragma unroll
                    for (int q = 0; q < 4; ++q) { const int i = tid + q * 512; t0[q] = g1[i]; t1[q] = (layer == 1) ? pscale[i] : 1.0f; t2[q] = lg[i]; t3[q] = lb[i]; t4[q] = g1[DM + i]; t5[q] = g1[2 * DM + i]; }
#pragma unroll
                    for (int q = 0; q < 4; ++q) { const int i = tid + q * 512; vG1[i] = t0[q] * t1[q]; vLG[i] = t2[q]; vLB[i] = t3[q]; vSH[i] = t4[q]; vSC[i] = t5[q] + 1.0f; }
                    cur_cd = cd; __syncthreads(); }
                f32x4 v[8]; float s = 0.f;
#pragma unroll
                for (int j = 0; j < 8; ++j) { const int c = (j * 64 + lane) * 4; const f32x4 gv = *(const LAS f32x4*)(vG1 + c);
                    const f32x4 yf = {bf2f(yv[j].x & 0xffffu), bf2f(yv[j].x >> 16), bf2f(yv[j].y & 0xffffu), bf2f(yv[j].y >> 16)};
                    const f32x4 xf = (layer == 0) ? xv[j] : bf4(xb[j]);
                    v[j] = xf * ALPHA + gv * yf; s += (v[j][0] + v[j][1]) + (v[j][2] + v[j][3]); }
                const float mean = wave_sum(s) * (1.0f / DM); float s2 = 0.f;
#pragma unroll
                for (int j = 0; j < 8; ++j) { v[j] = v[j] - mean; s2 += (v[j][0] * v[j][0] + v[j][1] * v[j][1]) + (v[j][2] * v[j][2] + v[j][3] * v[j][3]); }
                const float rstd = 1.0f / sqrtf(wave_sum(s2) * (1.0f / DM) + LN_EPS);
#pragma unroll
                for (int j = 0; j < 8; ++j) { const int c = (j * 64 + lane) * 4;
                    const f32x4 x1 = v[j] * rstd * *(const LAS f32x4*)(vLG + c) + *(const LAS f32x4*)(vLB + c);
                    { v2u xw; xw.x = pk2(x1[0], x1[1]); xw.y = pk2(x1[2], x1[3]); *(v2u*)((bf16_t*)X1 + (size_t)row * DM + c) = xw; }
                    const f32x4 hv = x1 * *(const LAS f32x4*)(vSC + c) + *(const LAS f32x4*)(vSH + c);
                    v2u w; w.x = pk2(hv[0], hv[1]); w.y = pk2(hv[2], hv[3]); *(v2u*)(Hb + (size_t)row * DM + c) = w;
                    v2u w2; w2.x = pk2(hv[0] - bf2f(w.x & 0xffffu), hv[1] - bf2f(w.x >> 16)); w2.y = pk2(hv[2] - bf2f(w.y & 0xffffu), hv[3] - bf2f(w.y >> 16));
                    *(LAS v2u*)(hp + wave * DM + c) = w; *(LAS v2u*)(hp + (8 + wave) * DM + c) = w2; }
                const bf16_t* w1q = w1p; asm volatile("" : "+v"(w1q));
                const bf16_t* w2q = w1q + 32 * DM;
                bf16x8 wA1[4], wA2[4], wB1[4], wB2[4];
#define P6_WLOAD(d1, d2, q0) do { _Pragma("unroll") for (int q_ = 0; q_ < 4; ++q_) { d1[q_] = *(const GAS bf16x8*)(w1q + ((q0) + q_) * 512); d2[q_] = *(const GAS bf16x8*)(w2q + ((q0) + q_) * 512); } } while (0)
#define P6_MMA(s1, s2, q0) do { _Pragma("unroll") for (int q_ = 0; q_ < 4; ++q_) { const bf16x8 a1 = *(const LAS bf16x8*)(a1p + ((q0) + q_) * 16), a2 = *(const LAS bf16x8*)(a2p + ((q0) + q_) * 16); \
                    acc = __builtin_amdgcn_mfma_f32_32x32x16_bf16(a1, s1[q_], acc, 0, 0, 0); acc = __builtin_amdgcn_mfma_f32_32x32x16_bf16(a1, s2[q_], acc, 0, 0, 0); acc = __builtin_amdgcn_mfma_f32_32x32x16_bf16(a2, s1[q_], acc, 0, 0, 0); } } while (0)
                P6_WLOAD(wA1, wA2, 0); P6_WLOAD(wB1, wB2, 4);
                __syncthreads();
                {
                    f32x16 acc = {};
                    __builtin_amdgcn_sched_barrier(0); P6_MMA(wA1, wA2, 0); __builtin_amdgcn_sched_barrier(0);
                    P6_WLOAD(wA1, wA2, 8); __builtin_amdgcn_sched_barrier(0); P6_MMA(wB1, wB2, 4); __builtin_amdgcn_sched_barrier(0);
                    P6_WLOAD(wB1, wB2, 12); __builtin_amdgcn_sched_barrier(0);
                    P6_LOAD(pf_);
                    __builtin_amdgcn_sched_barrier(0); P6_MMA(wA1, wA2, 8); __builtin_amdgcn_sched_barrier(0);
                    P6_MMA(wB1, wB2, 12);
#pragma unroll
                    for (int r = 0; r < 4; ++r) part[(wave * 8 + r + 4 * hi) * 32 + ti] = acc[r];
                }
                if (dyn && tid == 0) MISC[38] = tk2;
                __syncthreads();
                {
                    const int rr = row_lo + grp * 8 + wave, e = lane & 31; float lgt = 0.f;
#pragma unroll
                    for (int k = 0; k < 8; ++k) lgt += part[(k * 8 + wave) * 32 + e];
                    const float aff = 1.0f / (1.0f + expf(-lgt)); const float sel = aff + rb_e;
                    const float o1 = dppf<0xB1>(sel), mx1 = fmaxf(sel, o1), mn1 = fminf(sel, o1);
                    const float mx2 = dppf<0x4E>(mx1), mn2 = dppf<0x4E>(mn1);
                    float gs = fmaxf(mx1, mx2) + fmaxf(fminf(mx1, mx2), fmaxf(mn1, mn2)); int bg = e >> 2;
                    { const float og = dppf<0x141>(gs); const int ob = dppi<0x141>(bg); if (og > gs || (og == gs && ob < bg)) { gs = og; bg = ob; } }
                    { const float og = dppf<0x140>(gs); const int ob = dppi<0x140>(bg); if (og > gs || (og == gs && ob < bg)) { gs = og; bg = ob; } }
                    { const auto rg = __builtin_amdgcn_permlane16_swap(__float_as_uint(gs), __float_as_uint(gs), false, false); const auto rb = __builtin_amdgcn_permlane16_swap((unsigned)bg, (unsigned)bg, false, false);
                      const bool odd = (lane & 16) != 0; const float og = __uint_as_float(odd ? rg[0] : rg[1]); const int ob = (int)(odd ? rb[0] : rb[1]); if (og > gs || (og == gs && ob < bg)) { gs = og; bg = ob; } }
                    const int bgs = __builtin_amdgcn_readfirstlane(bg);
                    float s4[4], a4[4];
#pragma unroll
                    for (int j = 0; j < 4; ++j) { s4[j] = __uint_as_float((unsigned)__builtin_amdgcn_readlane((int)__float_as_uint(sel), bgs * 4 + j)); a4[j] = __uint_as_float((unsigned)__builtin_amdgcn_readlane((int)__float_as_uint(aff), bgs * 4 + j)); }
                    int i0 = 0; float m0 = s4[0], g0 = a4[0];
#pragma unroll
                    for (int j = 1; j < 4; ++j) if (s4[j] > m0) { m0 = s4[j]; i0 = j; g0 = a4[j]; }
                    int i1 = -1; float m1 = -1e30f, g1_ = 0.f;
#pragma unroll
                    for (int j = 0; j < 4; ++j) if (j != i0 && s4[j] > m1) { m1 = s4[j]; i1 = j; g1_ = a4[j]; }
                    const int e0 = __builtin_amdgcn_readfirstlane(bg * 4 + i0), e1 = __builtin_amdgcn_readfirstlane(bg * 4 + i1);
                    const float inv = 1.0f / (g0 + g1_);
                    if (lane == 0 && rep_ == 0) {
                        if (agg) { const int q0 = __hip_atomic_fetch_add(&lcnt[e0], 1, __ATOMIC_RELAXED, __HIP_MEMORY_SCOPE_WORKGROUP), q1 = __hip_atomic_fetch_add(&lcnt[e1], 1, __ATOMIC_RELAXED, __HIP_MEMORY_SCOPE_WORKGROUP);
                            LAS int* ap = asg + (it_ * 8 + wave) * 8;
                            ap[0] = e0; ap[1] = q0; ap[2] = rr * 2; ap[3] = (int)__float_as_uint(g0 * inv); ap[4] = e1; ap[5] = q1; ap[6] = rr * 2 + 1; ap[7] = (int)__float_as_uint(g1_ * inv);
                        } else {
                            const unsigned p0 = __hip_atomic_fetch_add(&cnt[e0 * 32], 1u, RLX_AGENT), p1 = __hip_atomic_fetch_add(&cnt[e1 * 32], 1u, RLX_AGENT);
                            LIST[(size_t)e0 * MT + p0] = rr * 2; LISTG[(size_t)e0 * MT + p0] = g0 * inv;
                            LIST[(size_t)e1 * MT + p1] = rr * 2 + 1; LISTG[(size_t)e1 * MT + p1] = g1_ * inv; } }
                }
                grp = nxt_; nxt_ = dyn ? gmap(MISC[38]) : seq(it_ + 2);
            }
#undef P6_LOAD
#undef P6_WLOAD
#undef P6_MMA
            __syncthreads();
            if (agg && rep_ == 0) {
                if (tid < 32) lbase[tid] = (int)__hip_atomic_fetch_add(&cnt[tid * 32], (unsigned)lcnt[tid], RLX_AGENT);
                __syncthreads();
                for (int i = tid; i < it_ * 16; i += 512) { const int e = asg[i * 4], q = asg[i * 4 + 1], src = asg[i * 4 + 2]; const float gt = __uint_as_float((unsigned)asg[i * 4 + 3]);
                    const size_t o = (size_t)e * MT + (size_t)(lbase[e] + q); LIST[o] = src; LISTG[o] = gt; }
            }
            __syncthreads();
        }
        SEAM(P6);
        int NT = 0;
        if (IN(P6 + 1) || IN(P6 + 2) || IN(P6 + 3)) {
            CParams* kp = kparams(); unsigned* cnt = WSP(unsigned, WS_CTL) + CW_CNT + layer * 1024;
            const int ttid = otid();
            if (ttid < 64) { const int ln = ttid, e = ln & 31; const int c = (int)__hip_atomic_load(&cnt[e * 32], RLX_AGENT); const int nt_ = (c + 255) >> 8; int inc = nt_;
#pragma unroll
                for (int o = 1; o < 32; o <<= 1) { const int t_ = __shfl_up(inc, o); if ((ln & 31) >= o) inc += t_; }
                if (ln < 32) { tcnt[e] = c; tbase[e] = inc - nt_; if (e == 31) tbase[32] = inc; for (int t_ = inc - nt_; t_ < inc; ++t_) texp[t_] = e; } }
            __syncthreads();
            NT = __builtin_amdgcn_readfirstlane(tbase[32]);
        }
        if (IN(P6 + 2)) _Pragma("unroll 1") for (int rep_ = 0; rep_ < NREP(8); ++rep_) {
            CParams* kp = kparams();
            typedef pg8::SchedMoe<256u * DM * 2u, 256u * DM * 2u, 2048u * DM * 2u, DM / 64, true> Sch;
            LAS int* rt = (LAS int*)(L + TAB_OFF + 1024);
            pg8::Gemm g{DM, DM, DM}; Sch S; S.o.init(NT, 8, ogrid(), obid()); S.A = WSP(const char, WS_H); S.B = WSP(const char, WS_WGU) + (size_t)layer * 32 * 2048 * DM * 2;
            S.texp = texp; S.tbase = tbase; S.tcnt = tcnt; S.rt = rt; S.list = WSP(int, WS_LIST); S.ctr = WSP(unsigned, WS_CTL) + CW_GUD + layer * 8192;
            S.fill_rows(rt, otid());
            pg8::EpiGateUp E{WSP(bf16_t, WS_ACT)};
            pg8::gemm_phase<pg8::EpiGateUp, Sch, true, true>(L, g, S, E);
        }
        if (IN(P6 + 2)) _Pragma("unroll 1") for (int rep_ = 0; rep_ < NREP(9); ++rep_) {
            CParams* kp = kparams();
            typedef pg8::SchedMoe<256u * DE * 2u, 256u * DE * 2u, (unsigned)DM * DE * 2u, DE / 64, false> Sch;
            pg8::Gemm g{DE, DE, DE}; Sch S; S.o.init(NT, 8, ogrid(), obid()); S.o.rot = 1; S.rem = (NT * 8) % ogrid(); S.nl = ogrid() - S.rem; S.A = WSP(const char, WS_ACT); S.B = WSP(const char, WS_WD) + (size_t)layer * 32 * DM * DE * 2;
            LAS int* rt = (LAS int*)(L + TAB_OFF + 1024);
            S.texp = texp; S.tbase = tbase; S.tcnt = tcnt; S.rt = nullptr; S.list = WSP(int, WS_LIST); S.ctr = WSP(unsigned, WS_CTL) + CW_GUD + layer * 8192;
            if (otid() == 0) { __builtin_amdgcn_fence(__ATOMIC_ACQUIRE, "agent"); asm volatile("s_waitcnt vmcnt(0)" ::: "memory"); }
            S.fill_dst(rt, WSP(float, WS_LIST) + (size_t)32 * MT, otid());
            pg8::EpiDown E{WSP(bf16_t, WS_FB), rt};
            pg8::gemm_phase<pg8::EpiDown, Sch, true, false>(L, g, S, E);
        }
        SEAM(P6 + 3);
        if (IN(P6 + 4)) _Pragma("unroll 1") for (int rep_ = 0; rep_ < NREP(10); ++rep_) {
            CParams* kp = kparams(); TIDS;
            const int row_lo = layer == 0 ? 0 : NCTX;
            const float* modl = WSP(float, WS_MOD) + (size_t)layer * 3 * 12288; const float* X1 = WSP(float, WS_X1); const bf16_t* FB = WSP(bf16_t, WS_FB);
            float* dstb = kp->out - (size_t)NCTX * DM; bf16_t* X2b = WSP(bf16_t, WS_X2);
            LAS float* vG2 = (LAS float*)L; LAS float* vLG = vG2 + 3 * DM; LAS float* vLB = vLG + DM;
            { const float* lg = kp->ln_g + (size_t)(layer * 2 + 1) * DM; const float* lb = kp->ln_b + (size_t)(layer * 2 + 1) * DM;
              float t0[12], t1[4], t2[4];
#pragma unroll
              for (int q = 0; q < 12; ++q) { const int i = tid + q * 512; t0[q] = modl[(size_t)(i >> 11) * 12288 + 5 * DM + (i & 2047)]; }
#pragma unroll
              for (int q = 0; q < 4; ++q) { const int i = tid + q * 512; t1[q] = lg[i]; t2[q] = lb[i]; }
#pragma unroll
              for (int q = 0; q < 12; ++q) vG2[tid + q * 512] = t0[q];
#pragma unroll
              for (int q = 0; q < 4; ++q) { vLG[tid + q * 512] = t1[q]; vLB[tid + q * 512] = t2[q]; } }
            __syncthreads();
            f32x4 xa[8]; v2u fa[8], fb[8];
#define P10_LOAD(row_) do { const float* xr_ = X1 + (size_t)(row_) * DM; const bf16_t* xb_ = (const bf16_t*)X1 + (size_t)(row_) * DM; const bf16_t* f0_ = FB + (size_t)((row_) * 2) * DM; \
                _Pragma("unroll") for (int j = 0; j < 8; ++j) { const int c = (j * 64 + lane) * 4; \
                    { const v2u q_ = *(const v2u*)(xb_ + c); xa[j] = (f32x4){bf2f(q_.x & 0xffffu), bf2f(q_.x >> 16), bf2f(q_.y & 0xffffu), bf2f(q_.y >> 16)}; } \
                    fa[j] = *(const v2u*)(f0_ + c); fb[j] = *(const v2u*)(f0_ + DM + c); } } while (0)
            { const int r0 = row_lo + gw; P10_LOAD(r0 < MT ? r0 : row_lo); }
            for (int row = row_lo + gw; row < MT; row += NGW) { const int cd = row_cond(row);
                f32x4 v[8]; float s = 0.f;
#pragma unroll
                for (int j = 0; j < 8; ++j) { const int c = (j * 64 + lane) * 4;
                    const f32x4 fs = {bf2f(fa[j].x & 0xffffu) + bf2f(fb[j].x & 0xffffu), bf2f(fa[j].x >> 16) + bf2f(fb[j].x >> 16), bf2f(fa[j].y & 0xffffu) + bf2f(fb[j].y & 0xffffu), bf2f(fa[j].y >> 16) + bf2f(fb[j].y >> 16)};
                    v[j] = xa[j] * ALPHA + *(const LAS f32x4*)(vG2 + cd * DM + c) * fs; s += (v[j][0] + v[j][1]) + (v[j][2] + v[j][3]); }
                if (row + NGW < MT) P10_LOAD(row + NGW);
                const float mean = wave_sum(s) * (1.0f / DM); float s2 = 0.f;
#pragma unroll
                for (int j = 0; j < 8; ++j) { v[j] = v[j] - mean; s2 += (v[j][0] * v[j][0] + v[j][1] * v[j][1]) + (v[j][2] * v[j][2] + v[j][3] * v[j][3]); }
                const float rstd = 1.0f / sqrtf(wave_sum(s2) * (1.0f / DM) + LN_EPS);
                float* dst = dstb + (size_t)row * DM;
#pragma unroll
                for (int j = 0; j < 8; ++j) { const int c = (j * 64 + lane) * 4; const f32x4 r_ = v[j] * rstd * *(const LAS f32x4*)(vLG + c) + *(const LAS f32x4*)(vLB + c);
                    if (layer == 0) { v2u w; w.x = pk2(r_[0], r_[1]); w.y = pk2(r_[2], r_[3]); *(v2u*)(X2b + (size_t)row * DM + c) = w; } else *(f32x4*)(dst + c) = r_; } }
#undef P10_LOAD
            __syncthreads();
        }
        if constexpr (layer == 0) {
            SEAM(10);
            if (IN(11)) _Pragma("unroll 1") for (int rep_ = 0; rep_ < NREP(11); ++rep_) {
                CParams* kp = kparams(); TIDS;
                const bf16_t* X2 = WSP(bf16_t, WS_X2); bf16_t* DP = WSP(bf16_t, WS_DP);
                const float* sc1 = WSP(float, WS_MOD) + (size_t)3 * 12288 + DM;
                const int c = tid * 4, gch = c >> 9, hw = 1 << gch;
                for (int chunk = bx; chunk < NLAT / 64; chunk += G) { const int b = chunk >> 7, t0 = (chunk & 127) * 64;
                    const bf16_t* base = X2 + ((size_t)NCTX + (size_t)b * SEQ) * DM + c; bf16_t* dbase = DP + ((size_t)NCTX + (size_t)b * SEQ) * DM + c;
                    const f32x4 a1 = *(const f32x4*)(sc1 + (size_t)b * 12288 + c) + 1.0f;
                    f32x4 s = {0, 0, 0, 0};
                    { v2u wv[16];
#pragma unroll
                      for (int q = 0; q < 16; ++q) { const int p_ = t0 - 8 + q; wv[q] = *(const v2u*)(base + (size_t)(p_ < 0 ? 0 : p_) * DM); }
#pragma unroll
                      for (int q = 0; q < 16; ++q) { const int p_ = t0 - 8 + q; const bool in_ = p_ >= 0 && p_ >= t0 - hw && p_ < t0 + hw; s += bf4(wv[q]) * (in_ ? 1.0f : 0.0f); } }
#pragma unroll 8
                    for (int i = 0; i < 64; ++i) { const int t = t0 + i; const int tn = t + hw, to = t - hw;
                        const f32x4 xc = bf4(*(const v2u*)(base + (size_t)t * DM));
                        const f32x4 xn = bf4(*(const v2u*)(base + (size_t)(tn < SEQ ? tn : SEQ - 1) * DM)), xo = bf4(*(const v2u*)(base + (size_t)(to >= 0 ? to : 0) * DM));
                        const int lo_ = to < 0 ? 0 : to, hi_ = tn > SEQ ? SEQ : tn;
                        const f32x4 d = a1 * (s * (1.0f / (float)(hi_ - lo_)) - xc);
                        v2u w; w.x = pk2(d[0], d[1]); w.y = pk2(d[2], d[3]); *(v2u*)(dbase + (size_t)t * DM) = w;
                        s = s + xn * (tn < SEQ ? 1.0f : 0.0f) - xo * (to >= 0 ? 1.0f : 0.0f); }
                }
            }
            SEAM(11);
            if (IN(12)) _Pragma("unroll 1") for (int rep_ = 0; rep_ < NREP(12); ++rep_) {
                CParams* kp = kparams();
                pg8::Gemm g{DM, 512, 512}; pg8::SchedPool S; S.o.init(NLAT / 256, 8, ogrid(), obid()); S.A = WSP(const char, WS_DP); S.B = WSP(const char, WS_WPOOL);
                pg8::EpiBf16 E{WSP(bf16_t, WS_Y), DM, nullptr};
                pg8::gemm_phase<pg8::EpiBf16, pg8::SchedPool, true, false>(L, g, S, E);
            }
            SEAM(12);
        }
    }

__global__ void __launch_bounds__(512, 2) mk_fwd(Params p_unused) {
    extern __shared__ __attribute__((aligned(16))) unsigned char lds[];
    LAS unsigned char* L = (LAS unsigned char*)lds;
    volatile LAS unsigned* MISC = (volatile LAS unsigned*)(L + MISC_OFF);
    LAS int* tcnt = (LAS int*)(L + TAB_OFF); LAS int* tbase = tcnt + 32; LAS int* texp = tcnt + 80;
    if (threadIdx.x < 64) MISC[threadIdx.x] = 0u;
    __syncthreads();
    int lo, hi; XcdBarrier bar;
    { CParams* kp = kparams(); lo = kp->ph_lo; hi = kp->ph_hi; unsigned* bw = (unsigned*)(kp->ws + WS_CTL) + CW_BAR;
      bar.bar = bw; bar.x = 0; bar.st = nullptr; if (hi - lo > 1) bar = xcd_barrier_post(bw, MISC + 8); }
    if (IN(0)) _Pragma("unroll 1") for (int rep_ = 0; rep_ < NREP(0); ++rep_) {
        CParams* kp = kparams(); TIDS;
        float* MOD = WSP(float, WS_MOD); float* ROPE = WSP(float, WS_ROPE);
        for (int i = bx * 512 + tid; i < 4096; i += G * 512) { const int pos = i >> 5, pp = i & 31;
            const float inv = exp2f(-(float)pp * (13.287712379549449f / 32.0f)); const float ang = (float)pos * inv;
            float sn, cs; sincosf(ang, &sn, &cs); ROPE[i] = cs; ROPE[4096 + i] = sn; }
        { const float* wrt = kp->w_router; bf16_t* WR = WSP(bf16_t, WS_WR);
          for (int i = bx * 512 + tid; i < 32 * DM; i += G * 512) { const int ii = i & 7, ln = (i >> 3) & 63, kq = (i >> 9) & 15, w = i >> 13; const int e = ln & 31, k = w * 256 + kq * 16 + 8 * (ln >> 5) + ii;
              const float wv = wrt[k * 32 + e]; const unsigned h1 = f2bf(wv); const unsigned h2 = f2bf(wv - bf2f(h1)); WR[i] = (bf16_t)h1; WR[32 * DM + i] = (bf16_t)h2; } }
        {
            LAS float* sv = (LAS float*)L;
            LAS float* red = (LAS float*)(L + 32768);
            mod_prepare(kp->c, kp->c_ctx, sv, tid);
            for (int it = bx; it < 384; it += G) mod_item(it, kp->w_mod, kp->b_mod, MOD, sv, red, tid, lane, wave);
        }
        {
            LAS float* scr = (LAS float*)(L + wave * 16384);
            constexpr int I_QKV = (DM / 64) * (QKVD / 32), I_O = (DM / 64) * (DM / 32), I_P = (512 / 64) * (512 / 32), I_G = (DM / 64) * (DE / 32), I_D = (DE / 64) * (DM / 32);
            constexpr int NITEMS = I_QKV + I_O + 4 * I_P;
            (void)I_G; (void)I_D;
            auto decode = [&](int it) { TItem d; int r = it;
                if (r < I_QKV) { d.W = kp->w_qkv; d.WT = WSP(bf16_t, WS_WQKV); d.K = DM; d.N = QKVD; d.kind = 0; }
                else if ((r -= I_QKV) < I_O) { d.W = kp->w_o; d.WT = WSP(bf16_t, WS_WO); d.K = DM; d.N = DM; d.kind = 0; }
                else { r -= I_O; const int g = r / I_P; r -= g * I_P; d.W = kp->w_pool + (size_t)g * 512 * 512; d.WT = WSP(bf16_t, WS_WPOOL) + (size_t)g * 512 * 512; d.K = 512; d.N = 512; d.kind = 0; }
                const int nblk = d.N / 32; d.k0 = 64 * (r / nblk); d.n0 = 32 * (r % nblk); return d; };
            for (int it = gw; it < NITEMS; it += 2 * NGW) {
                const TItem d0 = decode(it); f32x4 ra[8], rb[8]; t_load(d0, ra, lane);
                const bool two = it + NGW < NITEMS; TItem d1 = d0; if (two) { d1 = decode(it + NGW); t_load(d1, rb, lane); }
                t_store(d0, ra, scr, lane); if (two) t_store(d1, rb, scr, lane);
            }
        }
        __syncthreads();
    }
    SEAM(0);

    if (IN(1)) _Pragma("unroll 1") for (int rep_ = 0; rep_ < NREP(1); ++rep_) {
        CParams* kp = kparams(); TIDS;
        const float* MOD = WSP(float, WS_MOD); bf16_t* U = WSP(bf16_t, WS_U); const float* xl = kp->x; const float* xc = kp->ctx;
        const int R = (MT + NGW - 1) / NGW, r0 = gw * R, r1 = (r0 + R) < MT ? (r0 + R) : MT;
        f32x4 sa[8], sb[8], xv[8]; int cur = -1;
#define P1_LOAD(row_) do { const float* xr_ = ((row_) < NCTX) ? xc + (size_t)(row_) * DM : xl + (size_t)((row_) - NCTX) * DM; _Pragma("unroll") for (int j = 0; j < 8; ++j) xv[j] = *(const f32x4*)(xr_ + (j * 64 + lane) * 4); } while (0)
        if (r0 < r1) P1_LOAD(r0); else P1_LOAD(0);
        for (int row = r0; row < r1; ++row) { const int cd = row_cond(row);
            if (cd != cur) { const float* sh = MOD + (size_t)cd * 12288; const float* sc = sh + DM;
#pragma unroll
                for (int j = 0; j < 8; ++j) { const int c = (j * 64 + lane) * 4; sa[j] = *(const f32x4*)(sc + c) + 1.0f; sb[j] = *(const f32x4*)(sh + c); }
                cur = cd; }
            f32x4 o[8];
#pragma unroll
            for (int j = 0; j < 8; ++j) o[j] = xv[j] * sa[j] + sb[j];
            if (row + 1 < r1) P1_LOAD(row + 1);
#pragma unroll
            for (int j = 0; j < 8; ++j) { const int c = (j * 64 + lane) * 4; v2u w; w.x = pk2(o[j][0], o[j][1]); w.y = pk2(o[j][2], o[j][3]); *(v2u*)(U + (size_t)row * DM + c) = w; } }
#undef P1_LOAD
    }
    SEAM(1);

    if (IN(2)) _Pragma("unroll 1") for (int rep_ = 0; rep_ < NREP(2); ++rep_) {
        CParams* kp = kparams();
        typedef pg8::SchedSplit<256u * DM * 2u, 256u * DM * 2u, DM / 64, QKVD / 256> Sch;
        pg8::Gemm g{DM, DM, DM}; Sch S; S.init(ogrid(), obid()); S.A = WSP(const char, WS_U); S.B = WSP(const char, WS_WQKV);
        pg8::EpiQkv E{WSP(bf16_t, WS_QKVR), QKVD, WSP(float, WS_PQ), WSP(bf16_t, WS_V)};
        pg8::gemm_phase<pg8::EpiQkv, Sch, true, false>(L, g, S, E);
    }
    SEAM(2);

    if (IN(3)) _Pragma("unroll 1") for (int rep_ = 0; rep_ < NREP(3); ++rep_) {
        CParams* kp = kparams(); TIDS;
        const float* ROPE = WSP(float, WS_ROPE); const bf16_t* QKVR = WSP(bf16_t, WS_QKVR); bf16_t* Qb = WSP(bf16_t, WS_Q); bf16_t* Kb = WSP(bf16_t, WS_K); bf16_t* Vb = WSP(bf16_t, WS_V);
        const int sub = lane >> 4, l16 = lane & 15, d0 = l16 * 8, ax = l16 >> 3, hh = (l16 >> 2) & 1, p0 = (l16 & 3) * 8;
        const bool split3 = ((64 * (QKVD / 256)) % G == 0) && (2 * (QKVD / 256) * 8 <= G);
        const float* PQ = WSP(float, WS_PQ);
        float qg[8], kg[8];
        { const float* qgn = kp->q_gain; const float* kgn = kp->k_gain;
#pragma unroll
          for (int i = 0; i < 8; ++i) { qg[i] = qgn[d0 + i]; kg[i] = kgn[d0 + i]; } }
        v4u rw[6];
#define P3_LOAD(row_) do { const bf16_t* s_ = QKVR + (size_t)(row_) * QKVD + sub * 128 + d0; const bool all_ = (row_) < NCTX; _Pragma("unroll") for (int it = 0; it < 6; ++it) if (it == 4 || all_) rw[it] = *(const v4u*)(s_ + it * 512); } while (0)
        for (int r4 = NCTX + gw * 4; r4 < MT; r4 += NGW * 4) {
            v4u kr[4]; f32x4 c0[4], c1[4], s0[4], s1[4];
#pragma unroll
            for (int q = 0; q < 4; ++q) { const int row = r4 + q, t = (row - NCTX) & 8191; kr[q] = *(const v4u*)(QKVR + (size_t)row * QKVD + 2048 + sub * 128 + d0);
                const int pos = ax ? (t & 63) : (t >> 6); const float* cp_ = ROPE + pos * 32 + p0; c0[q] = *(const f32x4*)cp_; c1[q] = *(const f32x4*)(cp_ + 4); s0[q] = *(const f32x4*)(cp_ + 4096); s1[q] = *(const f32x4*)(cp_ + 4100); }
#pragma unroll
            for (int q = 0; q < 4; ++q) { const int row = r4 + q, lr = row - NCTX, b = lr >> 13, kpos = CTXL + (lr & 8191); const v4u raw = kr[q];
                float f[8], cs[8], sn[8];
#pragma unroll
                for (int i = 0; i < 4; ++i) { f[2 * i] = bf2f(raw[i] & 0xffffu); f[2 * i + 1] = bf2f(raw[i] >> 16); cs[i] = c0[q][i]; cs[4 + i] = c1[q][i]; sn[i] = hh ? s0[q][i] : -s0[q][i]; sn[4 + i] = hh ? s1[q][i] : -s1[q][i]; }
                float ss = 0.f;
#pragma unroll
                for (int i = 0; i < 8; ++i) ss += f[i] * f[i];
                ss += __shfl_xor(ss, 1); ss += __shfl_xor(ss, 2); ss += __shfl_xor(ss, 4); ss += __shfl_xor(ss, 8);
                const float r = 1.0f / sqrtf(ss * (1.0f / 128.0f) + RMS_EPS);
                float o[8];
#pragma unroll
                for (int i = 0; i < 8; ++i) { const float y = f[i] * r * kg[i]; const float pr = __shfl_xor(y, 4); o[i] = y * cs[i] + pr * sn[i]; }
                v4u w; w.x = pk2(o[0], o[1]); w.y = pk2(o[2], o[3]); w.z = pk2(o[4], o[5]); w.w = pk2(o[6], o[7]);
                *(v4u*)(Kb + (((size_t)b * NKV + sub) * SKV + kpos) * HD + d0) = w; }
        }
        P3_LOAD(gw < NCTX ? gw : 0);
        for (int row = gw; row < NCTX; row += NGW) {
            const bool lat = row >= NCTX; const int lr = row - NCTX; const int b = lat ? (lr >> 13) : (row >> 8); const int t = lat ? (lr & 8191) : 0;
            const int kpos = lat ? (CTXL + t) : (row & 255);
            v4u cur[6];
#pragma unroll
            for (int it = 0; it < 6; ++it) cur[it] = rw[it];
            if (row + NGW < NCTX) P3_LOAD(row + NGW);
            float cs[8], sn[8];
#pragma unroll
            for (int i = 0; i < 8; ++i) { cs[i] = 1.f; sn[i] = 0.f; }
            if (lat) { const int pos = ax ? (t & 63) : (t >> 6); const float* cp_ = ROPE + pos * 32 + p0;
                const f32x4 c0 = *(const f32x4*)cp_, c1 = *(const f32x4*)(cp_ + 4), s0 = *(const f32x4*)(cp_ + 4096), s1 = *(const f32x4*)(cp_ + 4100);
#pragma unroll
                for (int i = 0; i < 4; ++i) { cs[i] = c0[i]; cs[4 + i] = c1[i]; sn[i] = hh ? s0[i] : -s0[i]; sn[4 + i] = hh ? s1[i] : -s1[i]; } }
#pragma unroll
            for (int it = 0; it < 6; ++it) { const int h = it * 4 + sub;
                if (lat && it != 4) continue;
                if (it == 5 && !split3) continue;
                float f[8]; v4u raw;
                if (!lat && split3) {
                    f32x4 q0[8]; const float* pp_ = PQ + (size_t)row * QKVD + h * 128 + d0;
#pragma unroll
                    for (int ks = 0; ks < 8; ++ks) q0[ks] = *(const f32x4*)(pp_ + (size_t)ks * 512 * QKVD);
                    f32x4 a0 = q0[0];
#pragma unroll
                    for (int ks = 1; ks < 8; ++ks) a0 += q0[ks];
#pragma unroll
                    for (int ks = 0; ks < 8; ++ks) q0[ks] = *(const f32x4*)(pp_ + (size_t)ks * 512 * QKVD + 4);
                    f32x4 a1 = q0[0];
#pragma unroll
                    for (int ks = 1; ks < 8; ++ks) a1 += q0[ks];
#pragma unroll
                    for (int i = 0; i < 4; ++i) { f[i] = a0[i]; f[4 + i] = a1[i]; }
                    raw.x = pk2(f[0], f[1]); raw.y = pk2(f[2], f[3]); raw.z = pk2(f[4], f[5]); raw.w = pk2(f[6], f[7]);
#pragma unroll
                    for (int i = 0; i < 4; ++i) { f[2 * i] = bf2f(raw[i] & 0xffffu); f[2 * i + 1] = bf2f(raw[i] >> 16); }
                } else { raw = cur[it];
#pragma unroll
                    for (int i = 0; i < 4; ++i) { f[2 * i] = bf2f(raw[i] & 0xffffu); f[2 * i + 1] = bf2f(raw[i] >> 16); } }
                if (it == 5) { *(v4u*)(Vb + (((size_t)b * NKV + (h - 20)) * SKV + kpos) * HD + d0) = raw; continue; }
                float ss = 0.f;
#pragma unroll
                for (int i = 0; i < 8; ++i) ss += f[i] * f[i];
                ss += __shfl_xor(ss, 1); ss += __shfl_xor(ss, 2); ss += __shfl_xor(ss, 4); ss += __shfl_xor(ss, 8);
                const float r = 1.0f / sqrtf(ss * (1.0f / 128.0f) + RMS_EPS);
                float o[8];
#pragma unroll
                for (int i = 0; i < 8; ++i) { const float y = f[i] * r * (it < 4 ? qg[i] : kg[i]); const float pr = __shfl_xor(y, 4); o[i] = y * cs[i] + pr * sn[i]; }
                v4u w; w.x = pk2(o[0], o[1]); w.y = pk2(o[2], o[3]); w.z = pk2(o[4], o[5]); w.w = pk2(o[6], o[7]);
                bf16_t* d = (it < 4) ? Qb + (size_t)row * DM + h * 128 + d0 : Kb + (((size_t)b * NKV + (h - 16)) * SKV + kpos) * HD + d0;
                *(v4u*)d = w; }
        }
#undef P3_LOAD
    }
    SEAM(3);

    if (IN(4)) _Pragma("unroll 1") for (int rep_ = 0; rep_ < NREP(4); ++rep_) {
        CParams* kp = kparams();
        const bf16_t* Qb = WSP(bf16_t, WS_Q); const bf16_t* Kb = WSP(bf16_t, WS_K); const bf16_t* Vb = WSP(bf16_t, WS_V); bf16_t* Ob = WSP(bf16_t, WS_O);
        const bf16_t* QKVR = WSP(bf16_t, WS_QKVR); const float* ROPE = WSP(float, WS_ROPE); const float* qgn = kp->q_gain;
        const int G = ogrid(), bx = obid(); const bool fast = (G % 8) == 0;
        const int NR = fast ? (G >> 3) : G, rank = fast ? (bx >> 3) : bx, tot = fast ? 132 : 1056;
        const bool split = fast && NR == 32; const int NA = split ? 26 : NR;
        if (rank < NA) for (int i = 0;; ++i) {
            int w = rank + NA * i;
            if (split && i == 5) w = rank >= 24 ? rank + 106 : tot;
            if (w >= tot) break;
            const int combo = fast ? (bx & 7) : (w / 132), ww = fast ? w : (w % 132), b = combo >> 2, kvh = combo & 3;
            const bool isl = ww < 128; const int rbk = ww >> 2; const int h = kvh * 4 + (isl ? (ww & 3) : (ww - 128));
            const size_t row0 = isl ? ((size_t)NCTX + (size_t)b * SEQ + (size_t)rbk * 256) : ((size_t)b * CTXL);
            if (isl) att::attn_dma_body(QKVR + row0 * QKVD + h * HD, QKVD, rbk * 256, ROPE, qgn, Kb + (size_t)combo * SKV * HD, Vb + (size_t)combo * SKV * HD, Ob + row0 * DM + h * HD, SKV, (char*)lds);
            else att::attn_dma_body(Qb + row0 * DM + h * HD, DM, -1, ROPE, qgn, Kb + (size_t)combo * SKV * HD, Vb + (size_t)combo * SKV * HD, Ob + row0 * DM + h * HD, CTXL, (char*)lds);
            if (otid() == 0) { asm volatile("s_waitcnt vmcnt(0)" ::: "memory");
                (void)xb_add(WSP(unsigned, WS_CTL) + CW_DONE + 32 * (isl ? (b * 32 + rbk) : (64 + b)), 1u); }
        }
        {
            const int tid = otid(), lane = tid & 63, wave = __builtin_amdgcn_readfirstlane(tid >> 6);
            unsigned* mq = WSP(unsigned, WS_CTL) + CW_MQ; bool prepared = false;
            for (;;) {
                if (tid == 0) MISC[34] = xb_add(mq, 1u);
                __syncthreads();
                const unsigned t = MISC[34];
                __syncthreads();
                if (t >= 384u) break;
                if (!prepared) { mod_prepare(kp->c, kp->c_ctx, (LAS float*)L, tid); prepared = true; }
                mod_item(384 + (int)t, kp->w_mod, kp->b_mod, WSP(float, WS_MOD), (const LAS float*)L, (LAS float*)(L + 32768), tid, lane, wave);
            }
        }
        {
            const int tid = otid(), lane = tid & 63, wave = __builtin_amdgcn_readfirstlane(tid >> 6);
            LAS float* scr = (LAS float*)(L + wave * 16384);
            unsigned* qc = WSP(unsigned, WS_CTL) + CW_Q;
            constexpr int I_G = (DM / 64) * (DE / 32), I_D = (DE / 64) * (DM / 32), PER = 2 * I_G + I_D; constexpr unsigned NTICK = 64u * PER / 2u;
            auto decode = [&](int it) { TItem d; const int le = it / PER; int r = it - le * PER;
                if (r < I_G) { d.W = kp->w_gate + (size_t)le * DM * DE; d.WT = WSP(bf16_t, WS_WGU) + (size_t)le * 2048 * DM; d.K = DM; d.N = DE; d.kind = 1; }
                else if ((r -= I_G) < I_G) { d.W = kp->w_up + (size_t)le * DM * DE; d.WT = WSP(bf16_t, WS_WGU) + (size_t)le * 2048 * DM; d.K = DM; d.N = DE; d.kind = 2; }
                else { r -= I_G; d.W = kp->w_down + (size_t)le * DE * DM; d.WT = WSP(bf16_t, WS_WD) + (size_t)le * DM * DE; d.K = DE; d.N = DM; d.kind = 0; }
                const int nblk = d.N / 32; d.k0 = 64 * (r / nblk); d.n0 = 32 * (r % nblk); return d; };
            static_assert(NTICK % 8u == 0u, "ticket chunks");
            auto grab = [&]() { unsigned t = 0; if (lane == 0) t = __hip_atomic_fetch_add(qc, 8u, __ATOMIC_RELAXED, __HIP_MEMORY_SCOPE_AGENT); return (unsigned)__builtin_amdgcn_readfirstlane((int)t); };
            for (unsigned tb = grab(); tb < NTICK; tb = grab()) {
                _Pragma("unroll 1") for (unsigned tk = tb; tk < tb + 8u; ++tk) {
                    const TItem d0 = decode((int)(2u * tk)); TItem d1 = d0; d1.n0 += 32;
                    f32x4 ra[8], rb[8]; t_load(d0, ra, lane); t_load(d1, rb, lane);
                    t_store(d0, ra, scr, lane); t_store(d1, rb, scr, lane);
                }
            }
        }
        __syncthreads();
        {
            unsigned* wq = WSP(unsigned, WS_CTL) + CW_WQ; unsigned* done = WSP(unsigned, WS_CTL) + CW_DONE; unsigned* yd = WSP(unsigned, WS_CTL) + CW_YD; unsigned* bw = WSP(unsigned, WS_CTL) + CW_BAR;
            const char* Oc = WSP(const char, WS_O); const char* Wc = WSP(const char, WS_WO);
            pg8::Gemm g{DM, DM, DM}; pg8::EpiBf16W E{WSP(bf16_t, WS_Y), DM};
            int tail = obid(); bool queue = true;
            for (;;) {
                if (otid() == 0) { int pm = -1, pn = 0, fl = 0;
                    if (queue) { const unsigned t = xb_add(wq, 1u);
                        if (t < 416u) { const int rbk = (int)t >> 4, b = ((int)t >> 3) & 1; pn = (int)t & 7; pm = 2 + b * 32 + rbk; fl = b * 32 + rbk; }
                        else if (t < 432u) { const int c = (int)t - 416; pm = c >> 3; pn = c & 7; fl = 64 + pm; } }
                    else if (tail < 96) { const int rbk = 26 + (tail >> 4), b = (tail >> 3) & 1; pn = tail & 7; pm = 2 + b * 32 + rbk; fl = b * 32 + rbk; }
                    if (pm >= 0) { XB_SPIN(xb_ld(&done[32 * fl]) < 16u, bw);
                        __builtin_amdgcn_fence(__ATOMIC_ACQUIRE, "agent"); asm volatile("s_waitcnt vmcnt(0)" ::: "memory"); }
                    MISC[32] = (unsigned)pm; MISC[33] = (unsigned)pn; }
                __syncthreads();
                const int pm = (int)MISC[32], pn = (int)MISC[33];
                __syncthreads();
                if (pm < 0) { if (!queue) break; queue = false; continue; }
                pg8::SchedOne S; S.u.A = Oc + (size_t)((unsigned)pm * (256u * DM * 2u)); S.u.B = Wc + (size_t)((unsigned)pn * (256u * DM * 2u)); S.u.pm = pm; S.u.pn = pn; S.u.aux = 0; S.u.kt = DM / 64; S.u.rb = 0; S.u.cn = 0; S.u.ui = 0;
                pg8::gemm_phase<pg8::EpiBf16W, pg8::SchedOne, true, false>(L, g, S, E);
                if (otid() == 0) (void)xb_add(&yd[32 * pm], 1u);
                if (!queue) tail += ogrid();
            }
        }
    }


    layer_half<0>(lo, hi, bar, L, tcnt, tbase, texp);
    layer_half<1>(lo, hi, bar, L, tcnt, tbase, texp);
#undef IN
#undef SEAM
#undef TIDS
}

extern "C" void kernel_launch(void* const* d_in, const int* in_sizes, int n_in, void* d_out, int out_size, void* d_ws, size_t ws_size, hipStream_t stream) {
    static int grid = 0;
    if (grid == 0) {
        if (n_in != 19 || in_sizes[0] != NLAT * DM || out_size != NLAT * DM || ws_size < WS_END) {
            fprintf(stderr, "kernel_launch: shape mismatch: n_in %d in0 %d out %d ws %zu (need %zu); nothing launched\n", n_in, n_in > 0 ? in_sizes[0] : -1, out_size, ws_size, (size_t)WS_END); grid = -1; return; }
        int dev = 0, cus = 0, per_cu = 0;
        if (hipGetDevice(&dev) != hipSuccess || hipDeviceGetAttribute(&cus, hipDeviceAttributeMultiprocessorCount, dev) != hipSuccess) { fprintf(stderr, "kernel_launch: device query failed\n"); grid = -1; return; }
        if (hipFuncSetAttribute((const void*)mk_fwd, hipFuncAttributeMaxDynamicSharedMemorySize, LDS_BYTES) != hipSuccess) { fprintf(stderr, "kernel_launch: hipFuncSetAttribute failed\n"); grid = -1; return; }
        if (hipOccupancyMaxActiveBlocksPerMultiprocessor(&per_cu, (const void*)mk_fwd, 512, LDS_BYTES) != hipSuccess || per_cu < 1)
            fprintf(stderr, "kernel_launch: note: occupancy query reports %d workgroups per CU\n", per_cu);
        (void)hipGetLastError();
        if (cus * (pg8::RT_UNITS / 2) < MAXT * 8) { fprintf(stderr, "kernel_launch: %d CUs: the MoE phases' per-workgroup LDS row tables are sized for >= %d workgroups; nothing launched\n", cus, (MAXT * 8 + pg8::RT_UNITS / 2 - 1) / (pg8::RT_UNITS / 2)); grid = -1; return; }
        grid = cus;
    }
    if (grid < 0) return;
    if (hipMemsetAsync((char*)d_ws + WS_CTL, 0, CTL_ZERO_BYTES, stream) != hipSuccess) { fprintf(stderr, "kernel_launch: memset failed\n"); return; }
    Params p{};
    p.x = (const float*)d_in[0]; p.c = (const float*)d_in[1]; p.ctx = (const float*)d_in[2]; p.c_ctx = (const float*)d_in[3]; p.w_mod = (const float*)d_in[4]; p.b_mod = (const float*)d_in[5];
    p.ln_g = (const float*)d_in[6]; p.ln_b = (const float*)d_in[7]; p.w_qkv = (const float*)d_in[8]; p.q_gain = (const float*)d_in[9]; p.k_gain = (const float*)d_in[10]; p.w_o = (const float*)d_in[11];
    p.w_pool = (const float*)d_in[12]; p.pool_scale = (const float*)d_in[13]; p.w_router = (const float*)d_in[14]; p.router_bias = (const float*)d_in[15];
    p.w_gate = (const float*)d_in[16]; p.w_up = (const float*)d_in[17]; p.w_down = (const float*)d_in[18];
    p.out = (float*)d_out; p.ws = (unsigned char*)d_ws;
#if MK_PER_PHASE
    for (int k = 0; k < NPHASE; ++k) { p.ph_lo = k; p.ph_hi = k + 1;
        hipLaunchKernelGGL(mk_fwd, dim3(grid), dim3(512), LDS_BYTES, stream, p);
        const hipError_t le = hipPeekAtLastError(); if (le != hipSuccess) { fprintf(stderr, "kernel_launch: launch %d failed: %s\n", k, hipGetErrorName(le)); break; } }
#else
    p.ph_lo = 0; p.ph_hi = NPHASE;
    hipLaunchKernelGGL(mk_fwd, dim3(grid), dim3(512), LDS_BYTES, stream, p);
    const hipError_t le = hipPeekAtLastError(); if (le != hipSuccess) fprintf(stderr, "kernel_launch: launch failed: %s\n", hipGetErrorName(le));
#endif
}
```

```cpp
#include <hip/hip_runtime.h>
#include <cstdio>
#include <cstdint>

#ifndef REP_MASK
#define REP_MASK 0
#endif
#ifndef MK_PER_PHASE
#define MK_PER_PHASE 0
#endif

constexpr int DM = 2048, NB = 2, SEQ = 8192, CTXL = 256;
constexpr int NCTX = NB * CTXL, NLAT = NB * SEQ, MT = NCTX + NLAT;
constexpr int NH = 16, NKV = 4, HD = 128, KVD = NKV * HD, QKVD = DM + 2 * KVD;
constexpr int SKV = CTXL + SEQ;
constexpr int NE = 32, DE = 1024;
constexpr int MAXT = 164, NSLOT = MAXT * 256;
constexpr float ALPHA = 1.41421356237309515f;
constexpr float LN_EPS = 1e-6f, RMS_EPS = 1e-6f;
constexpr int NPHASE = 18;

constexpr size_t MiB = 1u << 20;
constexpr size_t WS_CTL = 0, CTL_ZERO_BYTES = 1 * MiB;
constexpr size_t WS_MOD = 1 * MiB;
constexpr size_t WS_ROPE = WS_MOD + 512 * 1024;
constexpr size_t WS_WR = WS_MOD + 768 * 1024;
constexpr size_t WS_WQKV = 2 * MiB;
constexpr size_t WS_WO = 14 * MiB;
constexpr size_t WS_WPOOL = 22 * MiB;
constexpr size_t WS_WGU = 24 * MiB;
constexpr size_t WS_WD = 536 * MiB;
constexpr size_t WS_Y = 792 * MiB;
constexpr size_t WS_X1 = 924 * MiB;
constexpr size_t WS_X2 = 1056 * MiB;
constexpr size_t WS_H = 1188 * MiB;
constexpr size_t WS_LIST = 1254 * MiB;
constexpr size_t WS_SLOT = 1259 * MiB;
constexpr size_t WS_SH = 1260 * MiB;
constexpr size_t WS_U = WS_SH;
constexpr size_t WS_QKVR = WS_SH + 66 * MiB;
constexpr size_t WS_Q = WS_SH + 165 * MiB;
constexpr size_t WS_K = WS_SH + 231 * MiB;
constexpr size_t WS_V = WS_SH + 248 * MiB;
constexpr size_t WS_O = WS_SH + 265 * MiB;
constexpr size_t WS_HS = WS_SH;
constexpr size_t WS_ACT = WS_SH + 164 * MiB;
constexpr size_t WS_FB = WS_SH + 246 * MiB;
constexpr size_t WS_DP = WS_SH;
constexpr size_t WS_PQ = WS_SH + 510 * MiB;
constexpr size_t WS_PO = WS_PQ + 48 * MiB;
constexpr size_t WS_END = WS_PO + 32 * MiB;
static_assert((size_t)MT * DM * 4 <= 132 * MiB && (size_t)NSLOT * 2048 * 2 <= 164 * MiB && (size_t)2 * MT * DM * 4 <= 264 * MiB, "ws map");
static_assert((size_t)32 * MT * 8 <= 5 * MiB && (size_t)NSLOT * 8 <= 1 * MiB, "ws map 2");
constexpr int CW_CNT = 64;
constexpr int CW_Q = 3072;
constexpr int CW_MQ = 3136;
constexpr int CW_WQ = 3104;
constexpr int CW_DONE = 8192;
constexpr int CW_GUD = 16384;
constexpr int CW_YD = 40960;
constexpr int CW_P6Q = 3168;
constexpr int CW_BAR = 4096;

constexpr int RING_BYTES = 131072;
constexpr int MISC_OFF = RING_BYTES;
constexpr int TAB_OFF = MISC_OFF + 256;
constexpr int LDS_BYTES = 147456;

#define GAS __attribute__((address_space(1)))
#define LAS __attribute__((address_space(3)))
typedef unsigned short bf16_t;
typedef unsigned v4u __attribute__((ext_vector_type(4)));
typedef unsigned v2u __attribute__((ext_vector_type(2)));
typedef float f32x4 __attribute__((ext_vector_type(4)));
typedef float f32x2 __attribute__((ext_vector_type(2)));
typedef short bf16x8 __attribute__((ext_vector_type(8)));
typedef short s16x4 __attribute__((ext_vector_type(4)));
typedef float f32x16 __attribute__((ext_vector_type(16)));
typedef GAS unsigned gu32;
#define RLX_AGENT __ATOMIC_RELAXED, __HIP_MEMORY_SCOPE_AGENT
#define LDS_WAIT() asm volatile("s_waitcnt lgkmcnt(0)" ::: "memory")
#define VM_WAIT() asm volatile("s_waitcnt vmcnt(0)" ::: "memory")
__device__ __forceinline__ unsigned f2bf(float f) { unsigned u = __builtin_bit_cast(unsigned, f); return (u + 0x7fffu + ((u >> 16) & 1u)) >> 16; }
__device__ __forceinline__ unsigned pk2(float lo, float hi) { unsigned r; asm("v_cvt_pk_bf16_f32 %0, %1, %2" : "=v"(r) : "v"(lo), "v"(hi)); return r; }
__device__ __forceinline__ float bf2f(unsigned b) { return __builtin_bit_cast(float, b << 16); }
__device__ __forceinline__ unsigned cvt_pk_bf16(float lo, float hi) { unsigned r; asm volatile("v_cvt_pk_bf16_f32 %0, %1, %2" : "=v"(r) : "v"(lo), "v"(hi)); return r; }
__device__ __forceinline__ f32x4 bf4(v2u q) { return (f32x4){bf2f(q.x & 0xffffu), bf2f(q.x >> 16), bf2f(q.y & 0xffffu), bf2f(q.y >> 16)}; }
template <int CTRL> __device__ __forceinline__ float dppf(float v) { return __builtin_bit_cast(float, __builtin_amdgcn_update_dpp(0, __builtin_bit_cast(int, v), CTRL, 0xF, 0xF, true)); }
template <int CTRL> __device__ __forceinline__ int dppi(int v) { return __builtin_amdgcn_update_dpp(0, v, CTRL, 0xF, 0xF, true); }
__device__ __forceinline__ float wave_sum(float v) {
    v += dppf<0xB1>(v); v += dppf<0x4E>(v); v += dppf<0x141>(v); v += dppf<0x140>(v);
    { const auto r = __builtin_amdgcn_permlane16_swap(__float_as_uint(v), __float_as_uint(v), false, false); v = __uint_as_float(r[0]) + __uint_as_float(r[1]); }
    { const auto r = __builtin_amdgcn_permlane32_swap(__float_as_uint(v), __float_as_uint(v), false, false); v = __uint_as_float(r[0]) + __uint_as_float(r[1]); }
    return v;
}
__device__ __forceinline__ float silu_f(float x) { return x / (1.0f + __expf(-x)); }
__device__ __forceinline__ int row_cond(int row) { return row < NCTX ? 2 : ((row - NCTX) >> 13); }
__device__ __forceinline__ int otid() { int t = threadIdx.x; asm volatile("" : "+v"(t)); return t; }
__device__ __forceinline__ int obid() { int t = blockIdx.x; asm volatile("" : "+s"(t)); return t; }
__device__ __forceinline__ int ogrid() { int t = gridDim.x; asm volatile("" : "+s"(t)); return t; }

#define XB_TMO      128
#define XB_XCNT(j)  (256  + 64 * (j))
#define XB_XSUB(j)  (1280 + 64 * (j))
#define XB_XGEN(j)  (2304 + 64 * (j))
#define XB_TOP      3328
#define XB_TOPGEN   3392
#define XCD_BAR_WORDS 3456
#define XB_SPIN_CAP (1u << 20)
__device__ __forceinline__ unsigned xb_ld(unsigned* p)              { return __hip_atomic_load(p, __ATOMIC_RELAXED, __HIP_MEMORY_SCOPE_AGENT); }
__device__ __forceinline__ unsigned xb_add(unsigned* p, unsigned v) { return __hip_atomic_fetch_add(p, v, __ATOMIC_RELAXED, __HIP_MEMORY_SCOPE_AGENT); }
__device__ __forceinline__ unsigned xb_xcc_id() { return (unsigned)__builtin_amdgcn_s_getreg((3 << 11) | 20) & 0xFu; }
#define XB_SPIN(cond, bar) do { unsigned _sp = 0; while (cond) { __builtin_amdgcn_s_sleep(1); \
    if ((++_sp & 255u) == 0u) { if (xb_ld(&(bar)[XB_TMO])) break; if (_sp > XB_SPIN_CAP) { atomicAdd(&(bar)[XB_TMO], 1u); break; } } } } while (0)
struct XcdBarrier { unsigned* bar; unsigned x; volatile LAS unsigned* st; };
__device__ __forceinline__ XcdBarrier xcd_barrier_post(unsigned* bar, volatile LAS unsigned* st) {
    XcdBarrier b; b.bar = bar; b.x = xb_xcc_id(); b.st = st;
    if (threadIdx.x == 0) (void)xb_add(&bar[XB_XCNT(b.x)], 1u);
    return b;
}
__device__ __forceinline__ void xcd_barrier_complete(unsigned* bar, unsigned x, unsigned& nloc, unsigned& nx) {
    const unsigned G = gridDim.x * gridDim.y * gridDim.z;
    unsigned sum, cnt, mine, sp = 0u;
    for (;;) {
        sum = 0u; cnt = 0u; mine = 0u;
#pragma unroll 1
        for (unsigned j = 0; j < 16; ++j) { const unsigned c = xb_ld(&bar[XB_XCNT(j)]); sum += c; cnt += (c > 0u) ? 1u : 0u; }
        if (sum == G) break;
        __builtin_amdgcn_s_sleep(1);
        if ((++sp & 255u) == 0u) { if (xb_ld(&bar[XB_TMO])) break; if (sp > XB_SPIN_CAP) { atomicAdd(&bar[XB_TMO], 1u); break; } }
    }
    mine = xb_ld(&bar[XB_XCNT(x)]);
    nloc = mine > 0u ? mine : 1u; nx = cnt > 0u ? cnt : 1u;
}
__device__ __forceinline__ void xcd_barrier(const XcdBarrier& b) {
    asm volatile("s_waitcnt vmcnt(0)" ::: "memory");
    __syncthreads();
    if (threadIdx.x == 0) {
        unsigned* bar = b.bar;
        __builtin_amdgcn_s_waitcnt(0);
        unsigned nloc = b.st[0], nx = b.st[1];
        if (nloc == 0u) { xcd_barrier_complete(bar, b.x, nloc, nx); b.st[0] = nloc; b.st[1] = nx; }
        const unsigned old = xb_add(&bar[XB_XSUB(b.x)], 1u);
        const unsigned gen = old / nloc;
        if (old + 1u == (gen + 1u) * nloc) {
            __builtin_amdgcn_fence(__ATOMIC_RELEASE, "agent");
            asm volatile("s_waitcnt vmcnt(0)" ::: "memory");
            const unsigned og = xb_add(&bar[XB_TOP], 1u);
            const unsigned tg = og / nx;
            if (og + 1u == (tg + 1u) * nx) xb_add(&bar[XB_TOPGEN], 1u);
            else XB_SPIN(xb_ld(&bar[XB_TOPGEN]) == tg, bar);
            __builtin_amdgcn_fence(__ATOMIC_ACQUIRE, "agent");
            xb_add(&bar[XB_XGEN(b.x)], 1u);
            asm volatile("s_waitcnt vmcnt(0)" ::: "memory");
        } else {
            XB_SPIN(xb_ld(&bar[XB_XGEN(b.x)]) == gen, bar);
            __builtin_amdgcn_fence(__ATOMIC_ACQUIRE, "agent");
            asm volatile("s_waitcnt vmcnt(0)" ::: "memory");
        }
    }
    __syncthreads();
}

namespace pg8 {
#define PG8_LAS __attribute__((address_space(3)))
constexpr int BM = 256, BK = 64, HALF = 128, HTB = HALF * BK * 2, STAGE_BYTES = 8 * HTB, NXCD = 8, WGM = 8;
__host__ __device__ __forceinline__ int lds_byte(int r, int c) { const int st = (r >> 4) * 2 + (c >> 5), rr = r & 15, cc = c & 31, ob = rr * 64 + cc * 2; return st * 1024 + (ob ^ (((ob >> 9) & 1) << 5)); }
__host__ __device__ __forceinline__ void stage_rc(int b, int& R, int& C) { const int st = b / 1024, sb = b % 1024, swz = sb ^ (((sb >> 9) & 1) << 5); R = (st >> 1) * 16 + swz / 64; C = (st & 1) * 32 + (swz % 64) / 2; }
__host__ __device__ __forceinline__ int perm32(int rho) { const int n = rho >> 4, i = rho & 15; return 8 * (i >> 2) + 4 * n + (i & 3); }

struct Unit { const char* A; const char* B; int pm, pn, aux, kt, rb, cn, ui; };
struct Gemm { int lda, ldb, K; };

struct TileOrder {
    int nM, nN, nwg, G, c, rot = 0;
    __device__ __forceinline__ void init(int nM_, int nN_, int G_, int c_) { nM = nM_; nN = nN_; nwg = nM * nN; G = G_; c = c_; }
    __device__ __forceinline__ bool get(int i, int& pm, int& pn) const { return map((long)i * G + c, pm, pn); }
    __device__ __forceinline__ bool map(long L, int& pm, int& pn) const {
        if (L >= nwg) return false;
        const int nig = WGM * nN;
        int wgid = (int)L; { const int q = nwg / NXCD, r = nwg % NXCD, xcd = wgid % NXCD; int off = wgid / NXCD; const int cs = (xcd < r ? xcd * (q + 1) : r * (q + 1) + (xcd - r) * q), len = q + (xcd < r ? 1 : 0);
            if (rot) { const int lead = (nig - cs % nig) % nig; if (lead < len) { off += lead; if (off >= len) off -= len; } }
            wgid = cs + off; }
        const int gid = wgid / nig, fm = gid * WGM, gsz = (nM - fm) < WGM ? (nM - fm) : WGM;
        pm = fm + ((wgid % nig) % gsz); pn = (wgid % nig) / gsz; return true;
    }
};

template <class Epi, class Sched, bool ALIGN_EPI, bool GATHER = false>
__device__ __forceinline__ void gemm_phase(PG8_LAS unsigned char* lds, const Gemm g, const Sched& S, const Epi& E) {
    const int tid = otid(), wid = __builtin_amdgcn_readfirstlane(tid >> 6), lane = tid & 63, wr = wid >> 2, wc = wid & 3, fr = lane & 15, fq = lane >> 4;
    unsigned vc[2][2], vn[2][2], voffB[2]; int Rr[2], Cc = 0;
#pragma unroll
    for (int i = 0; i < 2; ++i) { int R, C; stage_rc(tid * 16 + i * 8192, R, C); const int Rb = Epi::PERM ? ((R & ~31) + perm32(R & 31)) : R; Rr[i] = R; Cc = C;
        vc[0][i] = (unsigned)(R * g.lda + C) * 2u; vc[1][i] = vc[0][i] + (unsigned)(HALF * g.lda) * 2u; voffB[i] = (unsigned)(Rb * g.ldb + C) * 2u; }
#define PG8_ROWS(ui_, v) do { _Pragma("unroll") for (int _h = 0; _h < 2; ++_h) _Pragma("unroll") for (int _i = 0; _i < 2; ++_i) \
        v[_h][_i] = (unsigned)S.rowtok((ui_), Rr[_i] + HALF * _h) * (unsigned)(g.lda * 2) + (unsigned)Cc * 2u; } while (0)
    const size_t kstep = (size_t)(BK * 2);
    const size_t hsB = (size_t)HALF * g.ldb * 2;
    const unsigned ldsw = (unsigned)wid * 1024u;
    const int aoff = lds_byte(wr * 64 + fr, fq * 8), boff = lds_byte(wc * 32 + fr, fq * 8);
#define PG8_SA(b, h) (((b) * 2 + (h)) * HTB)
#define PG8_SB(b, h) ((4 + (b) * 2 + (h)) * HTB)
#define PG8_STAGE(bufoff, gbase, voff) do { _Pragma("unroll") for (int _i = 0; _i < 2; ++_i) \
        __builtin_amdgcn_global_load_lds((const unsigned*)((const char*)(gbase) + (voff)[_i]), (PG8_LAS unsigned*)(lds + (bufoff) + ldsw + _i * 8192), 16, 0, 0); } while (0)
#define PG8_LDA(dst, b, h) do { _Pragma("unroll") for (int m = 0; m < 4; ++m) _Pragma("unroll") for (int k = 0; k < 2; ++k) dst[m][k] = *(const PG8_LAS bf16x8*)(lds + PG8_SA(b, h) + aoff + m * 2048 + k * 1024); } while (0)
#define PG8_LDB(dst, b, h) do { _Pragma("unroll") for (int n = 0; n < 2; ++n) _Pragma("unroll") for (int k = 0; k < 2; ++k) dst[n][k] = *(const PG8_LAS bf16x8*)(lds + PG8_SB(b, h) + boff + n * 2048 + k * 1024); } while (0)
#define PG8_MMA(ai, bj, At, Bt) do { __builtin_amdgcn_s_setprio(1); _Pragma("unroll") for (int m = 0; m < 4; ++m) _Pragma("unroll") for (int n = 0; n < 2; ++n) _Pragma("unroll") for (int k = 0; k < 2; ++k) \
        acc[ai][bj][m][n] = __builtin_amdgcn_mfma_f32_16x16x32_bf16(Bt[n][k], At[m][k], acc[ai][bj][m][n], 0, 0, 0); __builtin_amdgcn_s_setprio(0); } while (0)
#define PG8_WAIT_V(n) asm volatile("s_waitcnt vmcnt(" #n ")" ::: "memory")
#define PG8_WAIT_L(n) asm volatile("s_waitcnt lgkmcnt(" #n ")" ::: "memory")
#define PG8_BAR __builtin_amdgcn_s_barrier()
#define PG8_SCHED __builtin_amdgcn_sched_barrier(0)
    Unit cur, nxt; int ui = 0; int pend = -1, pend2 = -1, wst = 0; unsigned pv = 8u; (void)pend; (void)pend2; (void)wst; (void)pv;
    if (!S.next(0, cur)) return;
    if constexpr (Sched::WAITS) S.wait_ready(cur);
    if constexpr (GATHER) PG8_ROWS(0, vc);
    f32x4 acc[2][2][4][2];
#pragma unroll
    for (int a = 0; a < 2; ++a)
#pragma unroll
        for (int b = 0; b < 2; ++b)
#pragma unroll
            for (int m = 0; m < 4; ++m)
#pragma unroll
                for (int n = 0; n < 2; ++n) acc[a][b][m][n] = (f32x4){0.f, 0.f, 0.f, 0.f};
    bf16x8 At[4][2], B0[2][2], B1[2][2];
    const char* cA = cur.A; const char* cB = cur.B;
    PG8_STAGE(PG8_SB(0, 0), cB, voffB); PG8_STAGE(PG8_SB(0, 1), cB + hsB, voffB); PG8_STAGE(PG8_SA(0, 0), cA, vc[0]); PG8_STAGE(PG8_SA(0, 1), cA, vc[1]);
    if (wr == 1) PG8_BAR;
    PG8_WAIT_V(2); PG8_BAR;
    PG8_STAGE(PG8_SB(1, 0), cB + kstep, voffB); PG8_STAGE(PG8_SA(1, 0), cA + kstep, vc[0]); PG8_STAGE(PG8_SB(1, 1), cB + hsB + kstep, voffB);
    PG8_WAIT_V(6); PG8_BAR;
    for (;;) {
        const bool has_next = S.next(ui + 1, nxt);
        if constexpr (Sched::WAITS) wst = has_next ? 1 : 0;
        const char* nA = has_next ? nxt.A : cA; const char* nB = has_next ? nxt.B : cB;
        if constexpr (GATHER) { if (has_next) PG8_ROWS(ui + 1, vn); else {
#pragma unroll
            for (int h = 0; h < 2; ++h) { vn[h][0] = vc[h][0]; vn[h][1] = vc[h][1]; } } }
        const int nt = cur.kt;
        for (int t = 0; t < nt; t += 2) {
            const bool last = (t == nt - 2);
            const char* a1 = cA + (size_t)(t + 1) * kstep;
            const char* a2 = last ? nA : cA + (size_t)(t + 2) * kstep; const char* b2 = last ? nB : cB + (size_t)(t + 2) * kstep;
            const char* a3 = a2 + kstep; const char* b3 = b2 + kstep;
            unsigned o0[2], o1[2];
#pragma unroll
            for (int i = 0; i < 2; ++i) { o0[i] = (GATHER && last) ? vn[0][i] : vc[0][i]; o1[i] = (GATHER && last) ? vn[1][i] : vc[1][i]; }
            PG8_LDB(B0, 0, 0); PG8_LDB(B1, 0, 1); PG8_SCHED; PG8_LDA(At, 0, 0); PG8_STAGE(PG8_SA(1, 1), a1, vc[1]);
            PG8_WAIT_V(8); PG8_WAIT_L(0); PG8_BAR; PG8_MMA(0, 0, At, B0); PG8_MMA(0, 1, At, B1); PG8_BAR; PG8_SCHED;
            PG8_LDA(At, 0, 1); PG8_STAGE(PG8_SB(0, 0), b2, voffB); PG8_STAGE(PG8_SB(0, 1), b2 + hsB, voffB); PG8_STAGE(PG8_SA(0, 0), a2, o0);
            PG8_WAIT_V(8); PG8_WAIT_L(0); PG8_BAR; PG8_MMA(1, 0, At, B0); PG8_MMA(1, 1, At, B1); PG8_BAR; PG8_SCHED;
            PG8_LDB(B0, 1, 0); PG8_LDB(B1, 1, 1); PG8_SCHED; PG8_LDA(At, 1, 0); PG8_STAGE(PG8_SA(0, 1), a2, o1);
            PG8_WAIT_V(8); PG8_WAIT_L(0); PG8_BAR; PG8_MMA(0, 0, At, B0); PG8_MMA(0, 1, At, B1); PG8_BAR; PG8_SCHED;
            PG8_LDA(At, 1, 1); PG8_STAGE(PG8_SB(1, 0), b3, voffB); PG8_STAGE(PG8_SB(1, 1), b3 + hsB, voffB); PG8_STAGE(PG8_SA(1, 0), a3, o0);
            PG8_WAIT_V(8); PG8_WAIT_L(0); PG8_BAR; PG8_MMA(1, 0, At, B0); PG8_MMA(1, 1, At, B1); PG8_BAR; PG8_SCHED;
            if constexpr (Sched::SIGNALS) { if (pend >= 0) { pend2 = pend; pend = -1; } else if (pend2 >= 0) { S.signal(pend2, lane, wid); pend2 = -1; } }
            if constexpr (Sched::WAITS) { if (wst == 1) { pv = S.poll(nxt); wst = 2; } else if (wst == 2) { wst = 0; if (pv < 8u) S.spin(nxt); } }
        }
        if constexpr (ALIGN_EPI) { if (wr == 0) PG8_BAR; }
        E(acc, cur, wr, wc, fr, fq);
        if constexpr (Sched::SIGNALS) pend = cur.pm;
        if (!has_next) break;
#pragma unroll
        for (int a = 0; a < 2; ++a)
#pragma unroll
            for (int b = 0; b < 2; ++b)
#pragma unroll
                for (int m = 0; m < 4; ++m)
#pragma unroll
                    for (int n = 0; n < 2; ++n) acc[a][b][m][n] = (f32x4){0.f, 0.f, 0.f, 0.f};
        cur = nxt; cA = nA; cB = nB; ++ui;
        if constexpr (GATHER) {
#pragma unroll
            for (int h = 0; h < 2; ++h) { vc[h][0] = vn[h][0]; vc[h][1] = vn[h][1]; } }
        if constexpr (ALIGN_EPI) { if (wr == 1) PG8_BAR; }
    }
    PG8_WAIT_V(0);
    if constexpr (!ALIGN_EPI) { if (wr == 0) PG8_BAR; }
    PG8_BAR;
    if constexpr (Sched::SIGNALS) { if (pend >= 0) S.signal(pend, lane, wid); }
#undef PG8_ROWS
#undef PG8_SA
#undef PG8_SB
#undef PG8_STAGE
#undef PG8_LDA
#undef PG8_LDB
#undef PG8_MMA
#undef PG8_WAIT_V
#undef PG8_WAIT_L
#undef PG8_BAR
#undef PG8_SCHED
}

template <unsigned AT, unsigned BT, int KT>
struct SchedDense {
    static constexpr bool SIGNALS = false, WAITS = false;
    TileOrder o; const char* A; const char* B; int pm0;
    __device__ __forceinline__ int rowtok(int, int) const { return 0; }
    __device__ __forceinline__ bool next(int i, Unit& u) const { int pm, pn; if (!o.get(i, pm, pn)) return false;
        u.rb = 0; u.cn = 0; u.pm = pm0 + pm; u.pn = pn; u.aux = 0; u.kt = KT; u.A = A + (size_t)((unsigned)u.pm * AT); u.B = B + (size_t)((unsigned)pn * BT); return true; }
};
template <unsigned AT, unsigned BT, int KT, int NN>
struct SchedSplit {
    static constexpr bool SIGNALS = false, WAITS = false;
    TileOrder o; const char* A; const char* B; int G, c; bool split;
    __device__ __forceinline__ int rowtok(int, int) const { return 0; }
    __device__ __forceinline__ void init(int G_, int c_) { G = G_; c = c_; split = ((64 * NN) % G_ == 0) && (2 * NN * 8 <= G_); if (split) o.init(64, NN, G_, c_); else o.init(66, NN, G_, c_); }
    __device__ __forceinline__ bool next(int i, Unit& u) const { u.rb = 0; u.cn = 0;
        if (!split) { int pm, pn; if (!o.get(i, pm, pn)) return false; u.pm = pm; u.pn = pn; u.aux = 0; u.kt = KT; u.A = A + (size_t)((unsigned)pm * AT); u.B = B + (size_t)((unsigned)pn * BT); return true; }
        const int fr = (64 * NN) / G;
        if (i < fr) { int pm, pn; o.get(i, pm, pn); u.pm = 2 + pm; u.pn = pn; u.aux = 0; u.kt = KT; u.A = A + (size_t)((unsigned)u.pm * AT); u.B = B + (size_t)((unsigned)pn * BT); return true; }
        if (i > fr || c >= 2 * NN * 8) return false;
        const int ks = c & 7, t = c >> 3; u.pm = t / NN; u.pn = t % NN; u.aux = ks + 1; u.kt = KT / 8;
        u.A = A + (size_t)((unsigned)u.pm * AT + (unsigned)ks * (KT / 8) * 128u); u.B = B + (size_t)((unsigned)u.pn * BT + (unsigned)ks * (KT / 8) * 128u); return true; }
};
struct SchedPool {
    static constexpr bool SIGNALS = false, WAITS = false;
    TileOrder o; const char* A; const char* B;
    __device__ __forceinline__ int rowtok(int, int) const { return 0; }
    __device__ __forceinline__ bool next(int i, Unit& u) const { int pm, pn; if (!o.get(i, pm, pn)) return false;
        u.rb = 0; u.cn = 0; u.pm = 2 + pm; u.pn = pn; u.aux = 0; u.kt = 8; const int g = pn >> 1;
        u.A = A + (size_t)((unsigned)u.pm * (256u * DM * 2u) + (unsigned)g * 1024u); u.B = B + (size_t)((unsigned)g * (512u * 512u * 2u) + (unsigned)(pn & 1) * (256u * 512u * 2u)); return true; }
};
struct SchedOne {
    static constexpr bool SIGNALS = false, WAITS = false;
    Unit u;
    __device__ __forceinline__ int rowtok(int, int) const { return 0; }
    __device__ __forceinline__ bool next(int i, Unit& o) const { if (i != 0) return false; o = u; return true; }
};
constexpr int RT_UNITS = 14;
template <unsigned AT, unsigned BT, unsigned BE, int KT, bool GATHER>
struct SchedMoe {
    static constexpr bool SIGNALS = GATHER, WAITS = !GATHER;
    unsigned* ctr;
    __device__ __forceinline__ void signal(int pm, int lane, int wid) const { if (wid == 0 && lane == 0) (void)xb_add(ctr + 32 * pm, 1u); }
    __device__ __forceinline__ void wait_ready(const Unit& u) const { while (xb_ld(ctr + 32 * u.pm) < 8u) __builtin_amdgcn_s_sleep(2); asm volatile("" ::: "memory"); }
    __device__ __forceinline__ unsigned poll(const Unit& u) const { return xb_ld(ctr + 32 * u.pm); }
    __device__ __forceinline__ void spin(const Unit& u) const { while (xb_ld(ctr + 32 * u.pm) < 8u) __builtin_amdgcn_s_sleep(2); }
    __device__ __forceinline__ void acquire_async() const { asm volatile("buffer_inv sc1" ::: "memory"); }
    TileOrder o; const char* A; const char* B; const PG8_LAS int* texp; const PG8_LAS int* tbase; const PG8_LAS int* tcnt; const PG8_LAS int* rt; const int* list;
    int rem = 0, nl = 0;
    __device__ __forceinline__ bool next(int i, Unit& u) const { int pm, pn;
        if (GATHER) { if (!o.get(i, pm, pn)) return false; }
        else { const bool light = o.c >= rem; const long L = (light && i < 2) ? (long)i * nl + (o.c - rem) : 2L * nl + (long)(light ? i - 2 : i) * o.G + o.c; if (!o.map(L, pm, pn)) return false; }
        const int e = __builtin_amdgcn_readfirstlane(texp[pm]);
        u.pm = pm; u.pn = pn; u.aux = e; u.kt = KT; u.ui = i; u.rb = (pm - __builtin_amdgcn_readfirstlane(tbase[e])) * 256; u.cn = __builtin_amdgcn_readfirstlane(tcnt[e]);
        u.A = GATHER ? A : A + (size_t)((unsigned)pm * AT); u.B = B + (size_t)((unsigned)e * BE + (unsigned)pn * BT); return true; }
    __device__ __forceinline__ int tok_of(const Unit& u, int row) const { const int pos = u.rb + row; return pos < u.cn ? (list[(size_t)u.aux * MT + pos] >> 1) : 0; }
    __device__ __forceinline__ int rowtok(int ui, int row) const { if (ui < RT_UNITS) return rt[ui * 256 + row]; Unit u; next(ui, u); return tok_of(u, row); }
    __device__ __forceinline__ void fill_dst(PG8_LAS int* rtw, const float* listg, int tid) const {
        int dv[RT_UNITS / 2]; float gv[RT_UNITS / 2]; bool ok[RT_UNITS / 2];
#pragma unroll
        for (int i = 0; i < RT_UNITS / 2; ++i) { Unit u; ok[i] = next(i, u); dv[i] = -1; gv[i] = 0.f;
            if (ok[i] && tid < 256) { const int pos = u.rb + tid; if (pos < u.cn) { const size_t li = (size_t)u.aux * MT + pos; dv[i] = list[li]; gv[i] = listg[li]; } } }
#pragma unroll
        for (int i = 0; i < RT_UNITS / 2; ++i) if (ok[i] && tid < 256) { rtw[i * 512 + tid] = dv[i]; rtw[i * 512 + 256 + tid] = (int)__float_as_uint(gv[i]); }
        __syncthreads(); }
    __device__ __forceinline__ void fill_rows(PG8_LAS int* rtw, int tid) const {
#pragma unroll
        for (int h = 0; h < 2; ++h) { int tk[RT_UNITS / 2]; bool ok[RT_UNITS / 2];
#pragma unroll
            for (int q = 0; q < RT_UNITS / 2; ++q) { Unit u; ok[q] = next(h * (RT_UNITS / 2) + q, u); tk[q] = 0; if (ok[q] && tid < 256) tk[q] = tok_of(u, tid); }
#pragma unroll
            for (int q = 0; q < RT_UNITS / 2; ++q) if (ok[q] && tid < 256) rtw[(h * (RT_UNITS / 2) + q) * 256 + tid] = tk[q]; }
        __syncthreads(); }
};

struct EpiBf16 {
    static constexpr bool PERM = true;
    bf16_t* O; int ldc; float* P;
    __device__ __forceinline__ void operator()(const f32x4 (&acc)[2][2][4][2], const Unit& u, int wr, int wc, int fr, int fq) const {
        const int row0 = u.pm * BM + wr * 64 + fr, col0 = u.pn * BM + wc * 32 + 8 * fq;
        if (u.aux == 0) {
#pragma unroll
            for (int ai = 0; ai < 2; ++ai)
#pragma unroll
                for (int m = 0; m < 4; ++m) { bf16_t* rowp = O + (size_t)(row0 + ai * HALF + m * 16) * ldc + col0;
#pragma unroll
                    for (int bj = 0; bj < 2; ++bj) { const f32x4 v0 = acc[ai][bj][m][0], v1 = acc[ai][bj][m][1];
                        v4u w; w.x = cvt_pk_bf16(v0[0], v0[1]); w.y = cvt_pk_bf16(v0[2], v0[3]); w.z = cvt_pk_bf16(v1[0], v1[1]); w.w = cvt_pk_bf16(v1[2], v1[3]);
                        *(v4u*)(rowp + bj * HALF) = w; } }
        } else {
            float* pb = P + (size_t)(u.aux - 1) * 512 * ldc;
#pragma unroll
            for (int ai = 0; ai < 2; ++ai)
#pragma unroll
                for (int m = 0; m < 4; ++m) { float* rowp = pb + (size_t)(row0 + ai * HALF + m * 16) * ldc + col0;
#pragma unroll
                    for (int bj = 0; bj < 2; ++bj) { *(f32x4*)(rowp + bj * HALF) = acc[ai][bj][m][0]; *(f32x4*)(rowp + bj * HALF + 4) = acc[ai][bj][m][1]; } }
        }
    }
};
struct EpiBf16W {
    static constexpr bool PERM = true;
    bf16_t* O; int ldc;
    __device__ __forceinline__ void operator()(const f32x4 (&acc)[2][2][4][2], const Unit& u, int wr, int wc, int fr, int fq) const {
        const int row0 = u.pm * BM + wr * 64 + fr, col0 = u.pn * BM + wc * 32 + 8 * fq;
#pragma unroll
        for (int ai = 0; ai < 2; ++ai)
#pragma unroll
            for (int m = 0; m < 4; ++m) { bf16_t* rowp = O + (size_t)(row0 + ai * HALF + m * 16) * ldc + col0;
#pragma unroll
                for (int bj = 0; bj < 2; ++bj) { const f32x4 v0 = acc[ai][bj][m][0], v1 = acc[ai][bj][m][1];
                    v4u w; w.x = cvt_pk_bf16(v0[0], v0[1]); w.y = cvt_pk_bf16(v0[2], v0[3]); w.z = cvt_pk_bf16(v1[0], v1[1]); w.w = cvt_pk_bf16(v1[2], v1[3]);
                    const bf16_t* gp = rowp + bj * HALF;
                    asm volatile("global_store_dwordx4 %0, %1, off sc1\n\ts_nop 1" :: "v"(gp), "v"(w) : "memory"); } }
    }
};
struct EpiQkv {
    static constexpr bool PERM = true;
    bf16_t* O; int ldc; float* P; bf16_t* V;
    __device__ __forceinline__ void operator()(const f32x4 (&acc)[2][2][4][2], const Unit& u, int wr, int wc, int fr, int fq) const {
        const int row0 = u.pm * BM + wr * 64 + fr, col0 = u.pn * BM + wc * 32 + 8 * fq;
        if (u.aux == 0) {
            const bool isV = u.pn >= (DM + KVD) / BM;
#pragma unroll
            for (int ai = 0; ai < 2; ++ai)
#pragma unroll
                for (int m = 0; m < 4; ++m) { const int row = row0 + ai * HALF + m * 16; bf16_t* rowp = O + (size_t)row * ldc + col0; size_t vstep = HALF;
                    if (isV) { const bool lat = row >= NCTX; const int lr = row - NCTX, b = lat ? (lr >> 13) : (row >> 8), kpos = lat ? (CTXL + (lr & 8191)) : (row & 255);
                        rowp = V + (((size_t)b * NKV + (size_t)(u.pn - (DM + KVD) / BM) * 2) * SKV + kpos) * HD + wc * 32 + 8 * fq; vstep = (size_t)SKV * HD; }
#pragma unroll
                    for (int bj = 0; bj < 2; ++bj) { const f32x4 v0 = acc[ai][bj][m][0], v1 = acc[ai][bj][m][1];
                        v4u w; w.x = cvt_pk_bf16(v0[0], v0[1]); w.y = cvt_pk_bf16(v0[2], v0[3]); w.z = cvt_pk_bf16(v1[0], v1[1]); w.w = cvt_pk_bf16(v1[2], v1[3]);
                        *(v4u*)(rowp + bj * vstep) = w; } }
        } else {
            float* pb = P + (size_t)(u.aux - 1) * 512 * ldc;
#pragma unroll
            for (int ai = 0; ai < 2; ++ai)
#pragma unroll
                for (int m = 0; m < 4; ++m) { float* rowp = pb + (size_t)(row0 + ai * HALF + m * 16) * ldc + col0;
#pragma unroll
                    for (int bj = 0; bj < 2; ++bj) { *(f32x4*)(rowp + bj * HALF) = acc[ai][bj][m][0]; *(f32x4*)(rowp + bj * HALF + 4) = acc[ai][bj][m][1]; } }
        }
    }
};
struct EpiGateUp {
    static constexpr bool PERM = true;
    bf16_t* ACT;
    __device__ __forceinline__ void operator()(const f32x4 (&acc)[2][2][4][2], const Unit& u, int wr, int wc, int fr, int fq) const {
        const int row0 = u.pm * BM + wr * 64 + fr, col0 = u.pn * HALF + wc * 32 + 8 * fq;
#pragma unroll
        for (int ai = 0; ai < 2; ++ai)
#pragma unroll
            for (int m = 0; m < 4; ++m) { bf16_t* rowp = ACT + (size_t)(row0 + ai * HALF + m * 16) * DE + col0;
                float v[8];
#pragma unroll
                for (int n = 0; n < 2; ++n)
#pragma unroll
                    for (int j = 0; j < 4; ++j) v[n * 4 + j] = silu_f(acc[ai][0][m][n][j]) * acc[ai][1][m][n][j];
                v4u w; w.x = cvt_pk_bf16(v[0], v[1]); w.y = cvt_pk_bf16(v[2], v[3]); w.z = cvt_pk_bf16(v[4], v[5]); w.w = cvt_pk_bf16(v[6], v[7]);
                asm volatile("global_store_dwordx4 %0, %1, off sc1\n\ts_nop 1" :: "v"(rowp), "v"(w) : "memory"); }
    }
};
struct EpiDown {
    static constexpr bool PERM = true;
    bf16_t* FB; const PG8_LAS int* rt;
    __device__ __forceinline__ void operator()(const f32x4 (&acc)[2][2][4][2], const Unit& u, int wr, int wc, int fr, int fq) const {
        const int r0 = wr * 64 + fr, col0 = u.pn * BM + wc * 32 + 8 * fq; const PG8_LAS int* tb = rt + u.ui * 512 + r0;
#pragma unroll
        for (int ai = 0; ai < 2; ++ai)
#pragma unroll
            for (int m = 0; m < 4; ++m) { const int d_ = tb[ai * HALF + m * 16]; const float g_ = __uint_as_float((unsigned)tb[256 + ai * HALF + m * 16]);
                if (d_ >= 0) { bf16_t* fr_ = FB + (size_t)d_ * DM + col0;
#pragma unroll
                    for (int bj = 0; bj < 2; ++bj) { const f32x4 v0 = acc[ai][bj][m][0] * g_, v1 = acc[ai][bj][m][1] * g_;
                        v4u w; w.x = cvt_pk_bf16(v0[0], v0[1]); w.y = cvt_pk_bf16(v0[2], v0[3]); w.z = cvt_pk_bf16(v1[0], v1[1]); w.w = cvt_pk_bf16(v1[2], v1[3]);
                        *(v4u*)(fr_ + bj * HALF) = w; } } }
    }
};
}

namespace att {
constexpr int D = 128, NW = 8, QBLK = 32, KVBLK = 64;
constexpr float SCALE = 0.088388347648318440f;
constexpr float THR = 8.f;
#ifndef ATT_SDEPTH
#define ATT_SDEPTH 1
#endif
constexpr int SDEPTH = ATT_SDEPTH;
constexpr int LDQ = DM, LDK = HD, LDO = DM;
constexpr size_t SHM_V = KVBLK * D * 2, SHM_K = KVBLK * D * 2, SHM_ATTN = 2 * SHM_V + 2 * SHM_K + NW * 64 * 4;
typedef unsigned u32x4 __attribute__((ext_vector_type(4)));
#define KSWZ(row, colB) ((row) * 256 + ((colB) ^ (((row) & 7) << 4)))
#define SBAR() __builtin_amdgcn_sched_barrier(0)
__device__ __forceinline__ int crow(int r, int hi) { return (r & 3) + 8 * (r >> 2) + 4 * hi; }
__device__ __forceinline__ unsigned cvtpk(float lo, float hi) { unsigned r; asm volatile("v_cvt_pk_bf16_f32 %0, %1, %2" : "=v"(r) : "v"(lo), "v"(hi)); return r; }
__device__ __forceinline__ bf16x8 ld8(const bf16_t* p) { return *reinterpret_cast<const bf16x8*>(p); }

__device__ __forceinline__ void partialSM(f32x16& p0, f32x16& p1, float& m_reg, float& mn, float& alpha) {
  constexpr float C = SCALE * 1.4426950408889634f;
  float pmax = p0[0]; for (int r = 1; r < 16; ++r) pmax = fmaxf(pmax, p0[r]); for (int r = 0; r < 16; ++r) pmax = fmaxf(pmax, p1[r]);
  { auto rr = __builtin_amdgcn_permlane32_swap(__float_as_uint(pmax), __float_as_uint(pmax), false, false);
    pmax = fmaxf(__uint_as_float(rr[0]), __uint_as_float(rr[1])); }
  if (__builtin_expect(__all(pmax - m_reg <= THR / SCALE), 1)) { mn = m_reg; alpha = 1.f; }
  else { mn = fmaxf(m_reg, pmax); alpha = __builtin_amdgcn_exp2f((m_reg - mn) * C); m_reg = mn; }
  float mnC = -mn * C;
  for (int r = 0; r < 16; ++r) p0[r] = fmaf(p0[r], C, mnC); for (int r = 0; r < 16; ++r) p1[r] = fmaf(p1[r], C, mnC);
  for (int r = 0; r < 16; ++r) p0[r] = __builtin_amdgcn_exp2f(p0[r]);
}
__device__ __forceinline__ void finishSM(f32x16& p0, f32x16& p1, float alpha, float& l_reg, bf16x8& pa0, bf16x8& pa1, bf16x8& pa2, bf16x8& pa3) {
  for (int r = 0; r < 16; ++r) p1[r] = __builtin_amdgcn_exp2f(p1[r]);
  float ps = 0; for (int r = 0; r < 16; ++r) ps += p0[r]; for (int r = 0; r < 16; ++r) ps += p1[r];
  { auto rr = __builtin_amdgcn_permlane32_swap(__float_as_uint(ps), __float_as_uint(ps), false, false);
    ps = __uint_as_float(rr[0]) + __uint_as_float(rr[1]); }
  l_reg = l_reg * alpha + ps;
#define PK4(P, BASE, OUT) do { unsigned a0 = cvtpk(P[BASE + 0], P[BASE + 1]), a1 = cvtpk(P[BASE + 2], P[BASE + 3]);   \
    unsigned b0 = cvtpk(P[BASE + 4], P[BASE + 5]), b1 = cvtpk(P[BASE + 6], P[BASE + 7]);                              \
    auto r0 = __builtin_amdgcn_permlane32_swap(a0, b0, false, false); auto r1 = __builtin_amdgcn_permlane32_swap(a1, b1, false, false); \
    u32x4 w = {r0[0], r1[0], r0[1], r1[1]}; OUT = *reinterpret_cast<bf16x8*>(&w); } while (0)
  PK4(p0, 0, pa0); PK4(p0, 8, pa1); PK4(p1, 0, pa2); PK4(p1, 8, pa3);
#undef PK4
}
__device__ __forceinline__ void qkt(f32x16& p0, f32x16& p1, const bf16_t* Ks, const bf16x8* qr, int r32, int hi) {
  p0 = f32x16{}; p1 = f32x16{};
  for (int d0 = 0; d0 < 8; ++d0) { int cb = (d0 * 16 + hi * 8) * 2;
    bf16x8 b0 = *reinterpret_cast<const bf16x8*>((const char*)Ks + KSWZ(r32, cb));
    bf16x8 b1 = *reinterpret_cast<const bf16x8*>((const char*)Ks + KSWZ(32 + r32, cb));
    p0 = __builtin_amdgcn_mfma_f32_32x32x16_bf16(b0, qr[d0], p0, 0, 0, 0);
    p1 = __builtin_amdgcn_mfma_f32_32x32x16_bf16(b1, qr[d0], p1, 0, 0, 0); }
}
__device__ __forceinline__ int v_st(int k, int c) { const int kk = (k & ~0xC) | ((k & 4) << 1) | ((k & 8) >> 1); return ((kk >> 3) * 4 + (c >> 5)) * 512 + ((kk & 7) * 32 + (c & 31)) * 2; }
__device__ __forceinline__ int v_rd_base(int lane) { return ((lane & 3) << 3) | (((lane >> 2) & 3) << 6) | (((lane >> 4) & 1) << 5) | (((lane >> 5) & 1) << 8); }
constexpr int v_rd_off(int d0, int ks, int half) { return d0 * 512 + ks * 4096 + half * 2048; }
template <int OFF> __device__ __forceinline__ s16x4 tr_read(int vb) {
  s16x4 r; asm volatile("ds_read_b64_tr_b16 %0, %1 offset:%2" : "=&v"(r) : "v"(vb), "i"(OFF) : "memory"); return r;
}
template <int D0> __device__ __forceinline__ void pv_one(f32x16& od, int vb, bf16x8 pa0, bf16x8 pa1, bf16x8 pa2, bf16x8 pa3) {
  const s16x4 l0 = tr_read<v_rd_off(D0, 0, 0)>(vb), h0 = tr_read<v_rd_off(D0, 0, 1)>(vb), l1 = tr_read<v_rd_off(D0, 1, 0)>(vb), h1 = tr_read<v_rd_off(D0, 1, 1)>(vb);
  const s16x4 l2 = tr_read<v_rd_off(D0, 2, 0)>(vb), h2 = tr_read<v_rd_off(D0, 2, 1)>(vb), l3 = tr_read<v_rd_off(D0, 3, 0)>(vb), h3 = tr_read<v_rd_off(D0, 3, 1)>(vb);
  asm volatile("s_waitcnt lgkmcnt(0)" ::: "memory"); SBAR();
#define PK(L, H) (bf16x8){L[0], L[1], L[2], L[3], H[0], H[1], H[2], H[3]}
  od = __builtin_amdgcn_mfma_f32_32x32x16_bf16(pa0, PK(l0, h0), od, 0, 0, 0);
  od = __builtin_amdgcn_mfma_f32_32x32x16_bf16(pa1, PK(l1, h1), od, 0, 0, 0);
  od = __builtin_amdgcn_mfma_f32_32x32x16_bf16(pa2, PK(l2, h2), od, 0, 0, 0);
  od = __builtin_amdgcn_mfma_f32_32x32x16_bf16(pa3, PK(l3, h3), od, 0, 0, 0);
#undef PK
}
template <int D0> __device__ __forceinline__ void pv_rd(s16x4 (&r)[8], int vb) {
  r[0] = tr_read<v_rd_off(D0, 0, 0)>(vb); r[1] = tr_read<v_rd_off(D0, 0, 1)>(vb); r[2] = tr_read<v_rd_off(D0, 1, 0)>(vb); r[3] = tr_read<v_rd_off(D0, 1, 1)>(vb);
  r[4] = tr_read<v_rd_off(D0, 2, 0)>(vb); r[5] = tr_read<v_rd_off(D0, 2, 1)>(vb); r[6] = tr_read<v_rd_off(D0, 3, 0)>(vb); r[7] = tr_read<v_rd_off(D0, 3, 1)>(vb);
}
__device__ __forceinline__ void pv_mm(f32x16& od, const s16x4 (&r)[8], bf16x8 pa0, bf16x8 pa1, bf16x8 pa2, bf16x8 pa3) {
#define PK(L, H) (bf16x8){L[0], L[1], L[2], L[3], H[0], H[1], H[2], H[3]}
  od = __builtin_amdgcn_mfma_f32_32x32x16_bf16(pa0, PK(r[0], r[1]), od, 0, 0, 0);
  od = __builtin_amdgcn_mfma_f32_32x32x16_bf16(pa1, PK(r[2], r[3]), od, 0, 0, 0);
  od = __builtin_amdgcn_mfma_f32_32x32x16_bf16(pa2, PK(r[4], r[5]), od, 0, 0, 0);
  od = __builtin_amdgcn_mfma_f32_32x32x16_bf16(pa3, PK(r[6], r[7]), od, 0, 0, 0);
#undef PK
}
__device__ __forceinline__ void pv_d0(f32x16* o, int vb, bf16x8 pa0, bf16x8 pa1, bf16x8 pa2, bf16x8 pa3) {
  s16x4 ra[8], rb[8];
  pv_rd<0>(ra, vb); pv_rd<1>(rb, vb);
  asm volatile("s_waitcnt lgkmcnt(8)" ::: "memory"); SBAR(); pv_mm(o[0], ra, pa0, pa1, pa2, pa3); pv_rd<2>(ra, vb);
  asm volatile("s_waitcnt lgkmcnt(8)" ::: "memory"); SBAR(); pv_mm(o[1], rb, pa0, pa1, pa2, pa3); pv_rd<3>(rb, vb);
  asm volatile("s_waitcnt lgkmcnt(8)" ::: "memory"); SBAR(); pv_mm(o[2], ra, pa0, pa1, pa2, pa3);
  asm volatile("s_waitcnt lgkmcnt(0)" ::: "memory"); SBAR(); pv_mm(o[3], rb, pa0, pa1, pa2, pa3);
}
__device__ __forceinline__ void pv_d0_pre(f32x16* o, int vb, s16x4 (&ra)[8], bf16x8 pa0, bf16x8 pa1, bf16x8 pa2, bf16x8 pa3) {
  s16x4 rb[8];
  pv_rd<1>(rb, vb);
  asm volatile("s_waitcnt lgkmcnt(8)" ::: "memory"); SBAR(); pv_mm(o[0], ra, pa0, pa1, pa2, pa3); pv_rd<2>(ra, vb);
  asm volatile("s_waitcnt lgkmcnt(8)" ::: "memory"); SBAR(); pv_mm(o[1], rb, pa0, pa1, pa2, pa3); pv_rd<3>(rb, vb);
  asm volatile("s_waitcnt lgkmcnt(8)" ::: "memory"); SBAR(); pv_mm(o[2], ra, pa0, pa1, pa2, pa3);
  asm volatile("s_waitcnt lgkmcnt(0)" ::: "memory"); SBAR(); pv_mm(o[3], rb, pa0, pa1, pa2, pa3);
}
__device__ __forceinline__ void attn_dense_body(const bf16_t* __restrict__ Qb, const bf16_t* __restrict__ Kh, const bf16_t* __restrict__ Vh,
                                                bf16_t* __restrict__ Ob, int seq, char* lds) {
  const int tid = otid(), wid = tid >> 6, lane = tid & 63, r32 = lane & 31, hi = lane >> 5;
  bf16_t* V_lds = (bf16_t*)lds; bf16_t* K_lds = (bf16_t*)(lds + 2 * SHM_V);
  float* ws = (float*)(lds + 2 * SHM_V + 2 * SHM_K) + wid * 64; float* li_l = ws; float* al_l = ws + 32;
  float m_reg = -1e30f, l_reg = 0; f32x16 o[4] = {}; bf16x8 qr[8];
  const bf16_t* Qw = Qb + (long)(wid * QBLK + r32) * LDQ + hi * 8;
#pragma unroll
  for (int d0 = 0; d0 < 8; ++d0) qr[d0] = ld8(Qw + d0 * 16);
  const int sr = tid >> 4, sc = (tid & 15) * 8, vst0 = v_st(sr, sc), vst1 = v_st(32 + sr, sc);
  const int vb0 = (int)(uintptr_t)V_lds + v_rd_base(lane);
  struct { bf16x8 vs0, vs1, ks0, ks1; } sr_[SDEPTH];
#define SLOAD(i, k0) do { sr_[i].vs0 = ld8(&Vh[(long)((k0) + sr) * LDK + sc]); sr_[i].vs1 = ld8(&Vh[(long)((k0) + 32 + sr) * LDK + sc]); \
    sr_[i].ks0 = ld8(&Kh[(long)((k0) + sr) * LDK + sc]); sr_[i].ks1 = ld8(&Kh[(long)((k0) + 32 + sr) * LDK + sc]); } while (0)
#define SWRITE(b, i) do { *(bf16x8*)((char*)V_lds + (b) * SHM_V + vst0) = sr_[i].vs0;          \
    *(bf16x8*)((char*)V_lds + (b) * SHM_V + vst1) = sr_[i].vs1; int kc = sc * 2;               \
    *(bf16x8*)((char*)K_lds + (b) * SHM_K + KSWZ(sr, kc)) = sr_[i].ks0;                       \
    *(bf16x8*)((char*)K_lds + (b) * SHM_K + KSWZ(32 + sr, kc)) = sr_[i].ks1; } while (0)
#define SWAIT() do { if constexpr (SDEPTH == 2) asm volatile("s_waitcnt vmcnt(4)" ::: "memory"); else asm volatile("s_waitcnt vmcnt(0)" ::: "memory"); } while (0)
#define RESC(a) do { if (__any((a) < 1.f)) { if (hi == 0) al_l[r32] = (a); asm volatile("s_waitcnt lgkmcnt(0)" ::: "memory"); \
    for (int d = 0; d < 4; ++d) for (int r = 0; r < 16; ++r) o[d][r] *= al_l[crow(r, hi)]; } } while (0)
  f32x16 pA0, pA1, pB0, pB1; float mnA, mnB, alA, alB; bf16x8 pa0, pa1, pa2, pa3; const int NT = seq / KVBLK;
  constexpr int SE = 0, SO = SDEPTH - 1;
  SLOAD(SE, 0); asm volatile("s_waitcnt vmcnt(0)" ::: "memory"); SWRITE(0, SE); __syncthreads();
  qkt(pA0, pA1, K_lds, qr, r32, hi); partialSM(pA0, pA1, m_reg, mnA, alA);
  SLOAD(SO, KVBLK); if constexpr (SDEPTH == 2) { if (2 < NT) SLOAD(SE, 2 * KVBLK); }
  SWAIT(); SWRITE(1, SO); __syncthreads();
  for (int j = 1; j + 1 < NT; j += 2) {
    SBAR(); qkt(pB0, pB1, (bf16_t*)((char*)K_lds + SHM_K), qr, r32, hi);
    finishSM(pA0, pA1, alA, l_reg, pa0, pa1, pa2, pa3); SBAR();
    SLOAD(SO, (j + SDEPTH) * KVBLK); SBAR();
    pv_d0(o, vb0, pa0, pa1, pa2, pa3); partialSM(pB0, pB1, m_reg, mnB, alB);
    __syncthreads(); SWAIT(); SWRITE(0, SE);
    RESC(alB); __syncthreads();
    SBAR(); qkt(pA0, pA1, K_lds, qr, r32, hi);
    finishSM(pB0, pB1, alB, l_reg, pa0, pa1, pa2, pa3); SBAR();
    if (SDEPTH == 1 || j + 3 < NT) SLOAD(SE, (j + 1 + SDEPTH) * KVBLK); SBAR();
    pv_d0(o, vb0 + (int)SHM_V, pa0, pa1, pa2, pa3); partialSM(pA0, pA1, m_reg, mnA, alA);
    __syncthreads(); SWAIT(); SWRITE(1, SO);
    RESC(alA); __syncthreads();
  }
  SBAR(); qkt(pB0, pB1, (bf16_t*)((char*)K_lds + SHM_K), qr, r32, hi);
  finishSM(pA0, pA1, alA, l_reg, pa0, pa1, pa2, pa3); SBAR();
  pv_d0(o, vb0, pa0, pa1, pa2, pa3); partialSM(pB0, pB1, m_reg, mnB, alB);
  __syncthreads(); RESC(alB);
  finishSM(pB0, pB1, alB, l_reg, pa0, pa1, pa2, pa3); SBAR();
  pv_d0(o, vb0 + (int)SHM_V, pa0, pa1, pa2, pa3);
  if (hi == 0) li_l[r32] = l_reg; asm volatile("s_waitcnt lgkmcnt(0)" ::: "memory");
  float rli[16];
#pragma unroll
  for (int r = 0; r < 16; ++r) rli[r] = __builtin_amdgcn_rcpf(li_l[crow(r, hi)]);
  bf16_t* Ow = Ob + (long)(wid * QBLK) * LDO;
#pragma unroll
  for (int r = 0; r < 16; ++r) { int orow = crow(r, hi);
    for (int d0 = 0; d0 < 4; ++d0) Ow[(long)orow * LDO + d0 * 32 + r32] = (bf16_t)f2bf(o[d0][r] * rli[r]); }
  asm volatile("s_waitcnt vmcnt(0) lgkmcnt(0)" ::: "memory");
  __syncthreads();
#undef SLOAD
#undef SWRITE
#undef SWAIT
#undef RESC
}
constexpr size_t SHM_SLOT = 32768, SHM_DMA = 4 * SHM_SLOT;
static_assert(4 * SHM_SLOT <= RING_BYTES && TAB_OFF + 1024 + NW * 64 * 4 <= LDS_BYTES, "attention LDS map");
#define ATT_WAIT_BAR() asm volatile("s_waitcnt vmcnt(0) lgkmcnt(0)\n\ts_barrier" ::: "memory")
__device__ __forceinline__ void attn_dma_body(const bf16_t* __restrict__ Qb, int ldq, int tpos0, const float* __restrict__ rope, const float* __restrict__ qgain,
                                              const bf16_t* __restrict__ Kh, const bf16_t* __restrict__ Vh, bf16_t* __restrict__ Ob, int seq, char* lds) {
  const int tid = otid(), wid = tid >> 6, lane = tid & 63, r32 = lane & 31, hi = lane >> 5;
  float* ws = (float*)(lds + TAB_OFF + 1024) + wid * 64; float* li_l = ws; float* al_l = ws + 32;
  float m_reg = -1e30f, l_reg = 0; f32x16 o[4] = {}; bf16x8 qr[8];
  const bf16_t* Qw = Qb + (long)(wid * QBLK + r32) * ldq + hi * 8;
  unsigned koff[2], voff[2];
#pragma unroll
  for (int c = 0; c < 2; ++c) { const int g = c * 512 + tid;
    { const int row = g >> 4, ch = (g & 15) ^ (row & 7); koff[c] = (unsigned)(row * 128 + ch * 8) * 2u; }
    { const int sub = g >> 5, kk = (sub >> 2) * 8 + ((g >> 2) & 7), k = (kk & ~0xC) | ((kk & 4) << 1) | ((kk & 8) >> 1), col = (sub & 3) * 32 + (g & 3) * 8; voff[c] = (unsigned)(k * 128 + col) * 2u; } }
  const unsigned wbase = (unsigned)__builtin_amdgcn_readfirstlane(wid) * 1024u;
  typedef __attribute__((address_space(3))) unsigned lds_u32;
  lds_u32* ldsl = (lds_u32*)(__attribute__((address_space(3))) char*)lds;
#define ATT_DMA(t, slot) do { const char* kt_ = (const char*)Kh + (size_t)(t) * (KVBLK * D * 2); const char* vt_ = (const char*)Vh + (size_t)(t) * (KVBLK * D * 2); \
    _Pragma("unroll") for (int c_ = 0; c_ < 2; ++c_) { \
      __builtin_amdgcn_global_load_lds((const unsigned*)(kt_ + koff[c_]), (lds_u32*)((__attribute__((address_space(3))) char*)ldsl + (slot) * SHM_SLOT + c_ * 8192 + wbase), 16, 0, 0); \
      __builtin_amdgcn_global_load_lds((const unsigned*)(vt_ + voff[c_]), (lds_u32*)((__attribute__((address_space(3))) char*)ldsl + (slot) * SHM_SLOT + 16384 + c_ * 8192 + wbase), 16, 0, 0); } } while (0)
#define RESC(a) do { if (__any((a) < 1.f)) { if (hi == 0) al_l[r32] = (a); asm volatile("s_waitcnt lgkmcnt(0)" ::: "memory"); \
    for (int d = 0; d < 4; ++d) for (int r = 0; r < 16; ++r) o[d][r] *= al_l[crow(r, hi)]; } } while (0)
  const int NT = seq / KVBLK;
  ATT_DMA(0, 0); ATT_DMA(1, 1);
#pragma unroll
  for (int d0 = 0; d0 < 8; ++d0) qr[d0] = ld8(Qw + d0 * 16);
  if (tpos0 >= 0) {
    float ss = 0.f;
#pragma unroll
    for (int d0 = 0; d0 < 8; ++d0)
#pragma unroll
      for (int i = 0; i < 8; ++i) { const float x = bf2f((unsigned)(unsigned short)qr[d0][i]); ss += x * x; }
    { auto rr = __builtin_amdgcn_permlane32_swap(__float_as_uint(ss), __float_as_uint(ss), false, false); ss = __uint_as_float(rr[0]) + __uint_as_float(rr[1]); }
    const float rinv = 1.0f / sqrtf(ss * (1.0f / 128.0f) + RMS_EPS);
    const int t = tpos0 + wid * QBLK + r32;
#pragma unroll
    for (int ax = 0; ax < 2; ++ax) { const int pos = ax ? (t & 63) : (t >> 6);
#pragma unroll
      for (int q = 0; q < 2; ++q) { const int dl = 4 * ax + q, dh = dl + 2, p0 = q * 16 + 8 * hi;
        const float* cp_ = rope + pos * 32 + p0; const float* gl = qgain + dl * 16 + 8 * hi; const float* gh = qgain + dh * 16 + 8 * hi;
        float cs[8], sn[8], lo[8], hv[8];
#pragma unroll
        for (int i = 0; i < 8; ++i) { cs[i] = cp_[i]; sn[i] = cp_[4096 + i];
          lo[i] = bf2f((unsigned)(unsigned short)qr[dl][i]) * rinv * gl[i]; hv[i] = bf2f((unsigned)(unsigned short)qr[dh][i]) * rinv * gh[i]; }
        u32x4 wl, wh;
#pragma unroll
        for (int i = 0; i < 4; ++i) { const float l0 = lo[2 * i] * cs[2 * i] - hv[2 * i] * sn[2 * i], l1 = lo[2 * i + 1] * cs[2 * i + 1] - hv[2 * i + 1] * sn[2 * i + 1];
          const float h0 = hv[2 * i] * cs[2 * i] + lo[2 * i] * sn[2 * i], h1 = hv[2 * i + 1] * cs[2 * i + 1] + lo[2 * i + 1] * sn[2 * i + 1];
          wl[i] = pk2(l0, l1); wh[i] = pk2(h0, h1); }
        qr[dl] = *reinterpret_cast<bf16x8*>(&wl); qr[dh] = *reinterpret_cast<bf16x8*>(&wh); } } }
#pragma unroll
  for (int d0 = 0; d0 < 8; ++d0) asm volatile("" : "+v"(qr[d0]));
  ATT_WAIT_BAR();
  if (2 < NT) ATT_DMA(2, 2);
  const int vb0 = (int)(uintptr_t)lds + 16384 + v_rd_base(lane);
  f32x16 pA0, pA1, pB0, pB1; float mnA, mnB, alA, alB; bf16x8 pa0, pa1, pa2, pa3;
  qkt(pA0, pA1, (const bf16_t*)lds, qr, r32, hi); partialSM(pA0, pA1, m_reg, mnA, alA);
  const bool lead = __builtin_amdgcn_readfirstlane(wid) < 4;
#define ATT_SYNC(jn) do { ATT_WAIT_BAR(); if ((jn) < NT) ATT_DMA((jn), (jn) & 3); } while (0)
  for (int j = 1; j + 1 < NT; j += 2) {
    { SBAR(); qkt(pB0, pB1, (const bf16_t*)(lds + (j & 3) * SHM_SLOT), qr, r32, hi);
      finishSM(pA0, pA1, alA, l_reg, pa0, pa1, pa2, pa3); s16x4 va[8]; pv_rd<0>(va, vb0 + ((j - 1) & 3) * (int)SHM_SLOT); SBAR();
      if (!lead) ATT_SYNC(j + 2);
      pv_d0_pre(o, vb0 + ((j - 1) & 3) * (int)SHM_SLOT, va, pa0, pa1, pa2, pa3); partialSM(pB0, pB1, m_reg, mnB, alB);
      if (lead) ATT_SYNC(j + 2);
      RESC(alB); }
    { SBAR(); qkt(pA0, pA1, (const bf16_t*)(lds + ((j + 1) & 3) * SHM_SLOT), qr, r32, hi);
      finishSM(pB0, pB1, alB, l_reg, pa0, pa1, pa2, pa3); s16x4 va[8]; pv_rd<0>(va, vb0 + (j & 3) * (int)SHM_SLOT); SBAR();
      if (!lead) ATT_SYNC(j + 3);
      pv_d0_pre(o, vb0 + (j & 3) * (int)SHM_SLOT, va, pa0, pa1, pa2, pa3); partialSM(pA0, pA1, m_reg, mnA, alA);
      if (lead) ATT_SYNC(j + 3);
      RESC(alA); }
  }
#undef ATT_SYNC
  { SBAR(); qkt(pB0, pB1, (const bf16_t*)(lds + ((NT - 1) & 3) * SHM_SLOT), qr, r32, hi);
    finishSM(pA0, pA1, alA, l_reg, pa0, pa1, pa2, pa3); SBAR();
    pv_d0(o, vb0 + ((NT - 2) & 3) * (int)SHM_SLOT, pa0, pa1, pa2, pa3); partialSM(pB0, pB1, m_reg, mnB, alB);
    RESC(alB);
    finishSM(pB0, pB1, alB, l_reg, pa0, pa1, pa2, pa3); SBAR();
    pv_d0(o, vb0 + ((NT - 1) & 3) * (int)SHM_SLOT, pa0, pa1, pa2, pa3); }
  if (hi == 0) li_l[r32] = l_reg; asm volatile("s_waitcnt lgkmcnt(0)" ::: "memory");
  float rli[16];
#pragma unroll
  for (int r = 0; r < 16; ++r) rli[r] = __builtin_amdgcn_rcpf(li_l[crow(r, hi)]);
  bf16_t* Ow = Ob + (long)(wid * QBLK) * LDO;
  asm volatile("s_waitcnt lgkmcnt(0)\n\ts_barrier" ::: "memory");
  { char* st = lds + wid * 8704;
#pragma unroll
    for (int r = 0; r < 16; ++r) { const int orow = crow(r, hi);
#pragma unroll
      for (int d0 = 0; d0 < 4; ++d0) *(bf16_t*)(st + orow * 272 + (d0 * 32 + r32) * 2) = (bf16_t)f2bf(o[d0][r] * rli[r]); }
    asm volatile("s_waitcnt lgkmcnt(0)" ::: "memory");
#pragma unroll
    for (int i = 0; i < 8; ++i) { const int c = i * 64 + lane, row = c >> 4, cc = c & 15; const u32x4 v = *(const u32x4*)(st + row * 272 + cc * 16);
      const bf16_t* gp = Ow + (long)row * LDO + cc * 8;
      asm volatile("global_store_dwordx4 %0, %1, off sc1\n\ts_nop 1" :: "v"(gp), "v"(v) : "memory"); } }
  ATT_WAIT_BAR();
#undef ATT_DMA
#undef RESC
}
#undef KSWZ
}

struct Params {
    const float *x, *c, *ctx, *c_ctx, *w_mod, *b_mod, *ln_g, *ln_b, *w_qkv, *q_gain, *k_gain, *w_o, *w_pool, *pool_scale, *w_router, *router_bias, *w_gate, *w_up, *w_down;
    float* out; unsigned char* ws; int ph_lo, ph_hi;
};

struct TItem { const float* W; bf16_t* WT; int K, N, kind, k0, n0; };
__device__ __forceinline__ int t_drow(int kind, int n) { return kind == 0 ? n : ((n >> 7) * 256 + (kind == 2 ? 128 : 0) + (n & 127)); }
__device__ __forceinline__ void t_load(const TItem& d, f32x4 (&r)[8], int lane) {
    const float* p = d.W + (size_t)(d.k0 + (lane >> 3)) * d.N + d.n0 + (lane & 7) * 4;
#pragma unroll
    for (int i = 0; i < 8; ++i) r[i] = __builtin_nontemporal_load((const f32x4*)(p + (size_t)(8 * i) * d.N));
}
__device__ __forceinline__ void t_store(const TItem& d, const f32x4 (&r)[8], LAS float* scr, int lane) {
#pragma unroll
    for (int i = 0; i < 8; ++i) *(LAS f32x4*)(scr + (8 * i + (lane >> 3)) * 32 + (((lane & 7) * 4 + 8 * i) & 31)) = r[i];
    LDS_WAIT(); asm volatile("" ::: "memory");
    const int c = lane >> 3, nl = lane & 7;
#pragma unroll
    for (int j = 0; j < 4; ++j) { const int n = nl + 8 * j; const LAS float* s = scr + (8 * c) * 32 + ((n + 8 * c) & 31);
        v4u o; o.x = pk2(s[0 * 32], s[1 * 32]); o.y = pk2(s[2 * 32], s[3 * 32]); o.z = pk2(s[4 * 32], s[5 * 32]); o.w = pk2(s[6 * 32], s[7 * 32]);
        __builtin_nontemporal_store(o, (GAS v4u*)(d.WT + (size_t)t_drow(d.kind, d.n0 + n) * d.K + d.k0 + 8 * c)); }
    LDS_WAIT(); asm volatile("" ::: "memory");
}

__device__ __forceinline__ void mod_prepare(const float* cl, const float* cc, LAS float* sv, int tid) {
    for (int i = tid; i < 3 * DM; i += 512) { const int cd = i >> 11, k = i & 2047; const float v = (cd < 2) ? cl[cd * DM + k] : cc[k]; sv[i] = v / (1.0f + expf(-v)); }
    __syncthreads();
}
__device__ __forceinline__ void mod_item(int it, const float* wm, const float* bm, float* MOD, const LAS float* sv, LAS float* red, int tid, int lane, int wave) {
    const int c4 = lane & 7, kr = (lane >> 3) + 8 * wave;
    const int l = it / 384, nb = it % 384; const float* W = wm + (size_t)l * DM * 12288 + nb * 32 + c4 * 4;
    f32x4 a0 = {0, 0, 0, 0}, a1 = a0, a2 = a0;
#pragma unroll 16
    for (int s = 0; s < 32; ++s) { const int k = s * 64 + kr; const f32x4 w = *(const f32x4*)(W + (size_t)k * 12288);
        a0 += w * sv[k]; a1 += w * sv[DM + k]; a2 += w * sv[2 * DM + k]; }
    *(LAS f32x4*)(red + (kr * 3 + 0) * 32 + c4 * 4) = a0; *(LAS f32x4*)(red + (kr * 3 + 1) * 32 + c4 * 4) = a1; *(LAS f32x4*)(red + (kr * 3 + 2) * 32 + c4 * 4) = a2;
    __syncthreads();
    if (tid < 96) { const int cd = tid >> 5, n = tid & 31; float s = 0.f; for (int r = 0; r < 64; ++r) s += red[(r * 3 + cd) * 32 + n];
        MOD[((size_t)l * 3 + cd) * 12288 + nb * 32 + n] = s + bm[l * 12288 + nb * 32 + n]; }
    __syncthreads();
}

typedef const __attribute__((address_space(4))) Params CParams;
__device__ __forceinline__ CParams* kparams() { CParams* k = (CParams*)__builtin_amdgcn_kernarg_segment_ptr(); asm volatile("" : "+s"(k)); return k; }
#define WSP(T, off) ((T*)(kp->ws + (off)))


#define IN(k) (lo <= (k) && (k) < hi)
#define NREP(k) (1 + ((REP_MASK >> (k)) & 1))
#define SEAM(k) do { if (IN(k) && IN((k) + 1)) xcd_barrier(bar); } while (0)
#define TIDS const int tid = otid(), lane = tid & 63, wave = __builtin_amdgcn_readfirstlane(tid >> 6), G = ogrid(), bx = obid(), gw = bx * 8 + wave, NGW = G * 8; (void)lane; (void)gw; (void)NGW


template <int layer>
__device__ __forceinline__ void layer_half(const int lo, const int hi, const XcdBarrier& bar, LAS unsigned char* L, LAS int* tcnt, LAS int* tbase, LAS int* texp) {
        const int P6 = 6 + 7 * layer;
        if (IN(P6)) _Pragma("unroll 1") for (int rep_ = 0; rep_ < NREP(6); ++rep_) {
            CParams* kp = kparams(); TIDS;
            const int row_lo = layer == 0 ? 0 : NCTX;
            const float* modl = WSP(float, WS_MOD) + (size_t)layer * 3 * 12288;
            unsigned* cnt = WSP(unsigned, WS_CTL) + CW_CNT + layer * 1024;
            const bf16_t* Y = WSP(bf16_t, WS_Y); float* X1 = WSP(float, WS_X1); bf16_t* Hb = WSP(bf16_t, WS_H);
            const float* xlat = kp->x; const float* xctx = kp->ctx; const bf16_t* X2b = WSP(bf16_t, WS_X2);
            const float* pscale = kp->pool_scale;
            int* LIST = WSP(int, WS_LIST); float* LISTG = WSP(float, WS_LIST) + (size_t)32 * MT;
            const float rb_e = kp->router_bias[lane & 31];
            LAS bf16_t* hp = (LAS bf16_t*)L;
            LAS float* part = (LAS float*)(L + 65536);
            LAS int* lcnt = (LAS int*)(L + 65536 + 8192); LAS int* lbase = lcnt + 32;
            LAS int* asg = (LAS int*)(L + 65536 + 8192 + 256);
            LAS float* vG1 = (LAS float*)(L + 82176); LAS float* vLG = vG1 + DM; LAS float* vLB = vLG + DM; LAS float* vSC = vLB + DM; LAS float* vSH = vSC + DM;
            const float* lg = kp->ln_g + (size_t)(layer * 2 + 0) * DM; const float* lb = kp->ln_b + (size_t)(layer * 2 + 0) * DM;
            const int ngrp = (MT - row_lo) / 8;
            const bool agg = ((ngrp + G - 1) / G) * 16 <= 512;
            if (tid < 32) lcnt[tid] = 0;
            const int ti = lane & 31, hi = lane >> 5;
            const bf16_t* w1p = WSP(bf16_t, WS_WR) + ((size_t)(wave * 16) * 64 + lane) * 8; const bf16_t* w2p = w1p + 32 * DM;
            const LAS bf16_t* a1p = hp + (ti & 7) * DM + wave * 256 + 8 * hi; const LAS bf16_t* a2p = a1p + 8 * DM;
            f32x4 xv[8]; v2u xb[8], yv[8];
#define P6_LOAD(grp_) do { const int row_ = row_lo + (grp_) * 8 + wave; const float* xr_ = (row_ < NCTX) ? xctx + (size_t)row_ * DM : xlat + (size_t)(row_ - NCTX) * DM; const bf16_t* yr_ = Y + (size_t)row_ * DM; const bf16_t* xb_ = X2b + (size_t)row_ * DM; \
                _Pragma("unroll") for (int j = 0; j < 8; ++j) { if (layer == 0) xv[j] = *(const f32x4*)(xr_ + (j * 64 + lane) * 4); else xb[j] = *(const v2u*)(xb_ + (j * 64 + lane) * 4); yv[j] = *(const v2u*)(yr_ + (j * 64 + lane) * 4); } } while (0)
            LAS int* rdy = (LAS int*)(L + 124928); unsigned* yd = WSP(unsigned, WS_CTL) + CW_YD; volatile LAS unsigned* MISC = (volatile LAS unsigned*)(L + MISC_OFF);
            const bool dyn = (layer == 0) && (G % 2 == 0); const int pcls = bx & 1; unsigned* q6 = WSP(unsigned, WS_CTL) + CW_P6Q + 32 * pcls;
            auto gmap = [&](unsigned pos) -> int { return pos >= 1056u ? -1 : (pos < 32u ? pcls * 32 + (int)pos : 64 + pcls * 1024 + ((int)pos - 32)); };
            auto seq = [&](int k) -> int { const int g_ = bx + k * G; return g_ < ngrp ? g_ : -1; };
            auto ensure = [&](int g_) { if (layer == 0) { const int pm_ = g_ < 64 ? (g_ >> 5) : 2 + ((g_ - 64) >> 5); if (!rdy[pm_]) { while (xb_ld(yd + 32 * pm_) < 8u) __builtin_amdgcn_s_sleep(4); asm volatile("" ::: "memory"); } } };
            if (layer == 0) { if (tid < 66) rdy[tid] = xb_ld(yd + 32 * tid) >= 8u ? 1 : 0;
                if (tid == 0) { __builtin_amdgcn_fence(__ATOMIC_ACQUIRE, "agent"); asm volatile("s_waitcnt vmcnt(0)" ::: "memory");
                    if (dyn) { MISC[36] = xb_add(q6, 1u); MISC[37] = xb_add(q6, 1u); } }
                __syncthreads(); }
            int grp = dyn ? gmap(MISC[36]) : seq(0), nxt_ = dyn ? gmap(MISC[37]) : seq(1);
            if (grp >= 0) ensure(grp);
            P6_LOAD(grp >= 0 ? grp : 0);
            int it_ = 0, cur_cd = -1;
            for (; grp >= 0; ++it_) {
                const int pf_ = nxt_ >= 0 ? nxt_ : grp; if (nxt_ >= 0) ensure(nxt_);
                unsigned tk2 = 0xffffffffu;
                if (dyn && tid == 0 && nxt_ >= 0 && it_ + 2 < 32) tk2 = xb_add(q6, 1u);
                const int row = row_lo + grp * 8 + wave; const int cd = row_cond(row_lo + grp * 8);
                if (cd != cur_cd) {
                    const float* g1 = modl + (size_t)cd * 12288 + 2 * DM;
                    float t0[4], t1[4], t2[4], t3[4], t4[4], t5[4];
                    __syncthreads();
#pragma unroll
                    for (int q = 0; q < 4; ++q) { const int i = tid + q * 512; t0[q] = g1[i]; t1[q] = (layer == 1) ? pscale[i] : 1.0f; t2[q] = lg[i]; t3[q] = lb[i]; t4[q] = g1[DM + i]; t5[q] = g1[2 * DM + i]; }
#pragma unroll
                    for (int q = 0; q < 4; ++q) { const int i = tid + q * 512; vG1[i] = t0[q] * t1[q]; vLG[i] = t2[q]; vLB[i] = t3[q]; vSH[i] = t4[q]; vSC[i] = t5[q] + 1.0f; }
                    cur_cd = cd; __syncthreads(); }
                f32x4 v[8]; float s = 0.f;
#pragma unroll
                for (int j = 0; j < 8; ++j) { const int c = (j * 64 + lane) * 4; const f32x4 gv = *(const LAS f32x4*)(vG1 + c);
                    const f32x4 yf = {bf2f(yv[j].x & 0xffffu), bf2f(yv[j].x >> 16), bf2f(yv[j].y & 0xffffu), bf2f(yv[j].y >> 16)};
                    const f32x4 xf = (layer == 0) ? xv[j] : bf4(xb[j]);
                    v[j] = xf * ALPHA + gv * yf; s += (v[j][0] + v[j][1]) + (v[j][2] + v[j][3]); }
                const float mean = wave_sum(s) * (1.0f / DM); float s2 = 0.f;
#pragma unroll
                for (int j = 0; j < 8; ++j) { v[j] = v[j] - mean; s2 += (v[j][0] * v[j][0] + v[j][1] * v[j][1]) + (v[j][2] * v[j][2] + v[j][3] * v[j][3]); }
                const float rstd = 1.0f / sqrtf(wave_sum(s2) * (1.0f / DM) + LN_EPS);
#pragma unroll
                for (int j = 0; j < 8; ++j) { const int c = (j * 64 + lane) * 4;
                    const f32x4 x1 = v[j] * rstd * *(const LAS f32x4*)(vLG + c) + *(const LAS f32x4*)(vLB + c);
                    { v2u xw; xw.x = pk2(x1[0], x1[1]); xw.y = pk2(x1[2], x1[3]); *(v2u*)((bf16_t*)X1 + (size_t)row * DM + c) = xw; }
                    const f32x4 hv = x1 * *(const LAS f32x4*)(vSC + c) + *(const LAS f32x4*)(vSH + c);
                    v2u w; w.x = pk2(hv[0], hv[1]); w.y = pk2(hv[2], hv[3]); *(v2u*)(Hb + (size_t)row * DM + c) = w;
                    v2u w2; w2.x = pk2(hv[0] - bf2f(w.x & 0xffffu), hv[1] - bf2f(w.x >> 16)); w2.y = pk2(hv[2] - bf2f(w.y & 0xffffu), hv[3] - bf2f(w.y >> 16));
                    *(LAS v2u*)(hp + wave * DM + c) = w; *(LAS v2u*)(hp + (8 + wave) * DM + c) = w2; }
                const bf16_t* w1q = w1p; asm volatile("" : "+v"(w1q));
                const bf16_t* w2q = w1q + 32 * DM;
                bf16x8 wA1[4], wA2[4], wB1[4], wB2[4];
#define P6_WLOAD(d1, d2, q0) do { _Pragma("unroll") for (int q_ = 0; q_ < 4; ++q_) { d1[q_] = *(const GAS bf16x8*)(w1q + ((q0) + q_) * 512); d2[q_] = *(const GAS bf16x8*)(w2q + ((q0) + q_) * 512); } } while (0)
#define P6_MMA(s1, s2, q0) do { _Pragma("unroll") for (int q_ = 0; q_ < 4; ++q_) { const bf16x8 a1 = *(const LAS bf16x8*)(a1p + ((q0) + q_) * 16), a2 = *(const LAS bf16x8*)(a2p + ((q0) + q_) * 16); \
                    acc = __builtin_amdgcn_mfma_f32_32x32x16_bf16(a1, s1[q_], acc, 0, 0, 0); acc = __builtin_amdgcn_mfma_f32_32x32x16_bf16(a1, s2[q_], acc, 0, 0, 0); acc = __builtin_amdgcn_mfma_f32_32x32x16_bf16(a2, s1[q_], acc, 0, 0, 0); } } while (0)
                P6_WLOAD(wA1, wA2, 0); P6_WLOAD(wB1, wB2, 4);
                __syncthreads();
                {
                    f32x16 acc = {};
                    __builtin_amdgcn_sched_barrier(0); P6_MMA(wA1, wA2, 0); __builtin_amdgcn_sched_barrier(0);
                    P6_WLOAD(wA1, wA2, 8); __builtin_amdgcn_sched_barrier(0); P6_MMA(wB1, wB2, 4); __builtin_amdgcn_sched_barrier(0);
                    P6_WLOAD(wB1, wB2, 12); __builtin_amdgcn_sched_barrier(0);
                    P6_LOAD(pf_);
                    __builtin_amdgcn_sched_barrier(0); P6_MMA(wA1, wA2, 8); __builtin_amdgcn_sched_barrier(0);
                    P6_MMA(wB1, wB2, 12);
#pragma unroll
                    for (int r = 0; r < 4; ++r) part[(wave * 8 + r + 4 * hi) * 32 + ti] = acc[r];
                }
                if (dyn && tid == 0) MISC[38] = tk2;
                __syncthreads();
                {
                    const int rr = row_lo + grp * 8 + wave, e = lane & 31; float lgt = 0.f;
#pragma unroll
                    for (int k = 0; k < 8; ++k) lgt += part[(k * 8 + wave) * 32 + e];
                    const float aff = 1.0f / (1.0f + expf(-lgt)); const float sel = aff + rb_e;
                    const float o1 = dppf<0xB1>(sel), mx1 = fmaxf(sel, o1), mn1 = fminf(sel, o1);
                    const float mx2 = dppf<0x4E>(mx1), mn2 = dppf<0x4E>(mn1);
                    float gs = fmaxf(mx1, mx2) + fmaxf(fminf(mx1, mx2), fmaxf(mn1, mn2)); int bg = e >> 2;
                    { const float og = dppf<0x141>(gs); const int ob = dppi<0x141>(bg); if (og > gs || (og == gs && ob < bg)) { gs = og; bg = ob; } }
                    { const float og = dppf<0x140>(gs); const int ob = dppi<0x140>(bg); if (og > gs || (og == gs && ob < bg)) { gs = og; bg = ob; } }
                    { const auto rg = __builtin_amdgcn_permlane16_swap(__float_as_uint(gs), __float_as_uint(gs), false, false); const auto rb = __builtin_amdgcn_permlane16_swap((unsigned)bg, (unsigned)bg, false, false);
                      const bool odd = (lane & 16) != 0; const float og = __uint_as_float(odd ? rg[0] : rg[1]); const int ob = (int)(odd ? rb[0] : rb[1]); if (og > gs || (og == gs && ob < bg)) { gs = og; bg = ob; } }
                    const int bgs = __builtin_amdgcn_readfirstlane(bg);
                    float s4[4], a4[4];
#pragma unroll
                    for (int j = 0; j < 4; ++j) { s4[j] = __uint_as_float((unsigned)__builtin_amdgcn_readlane((int)__float_as_uint(sel), bgs * 4 + j)); a4[j] = __uint_as_float((unsigned)__builtin_amdgcn_readlane((int)__float_as_uint(aff), bgs * 4 + j)); }
                    int i0 = 0; float m0 = s4[0], g0 = a4[0];
#pragma unroll
                    for (int j = 1; j < 4; ++j) if (s4[j] > m0) { m0 = s4[j]; i0 = j; g0 = a4[j]; }
                    int i1 = -1; float m1 = -1e30f, g1_ = 0.f;
#pragma unroll
                    for (int j = 0; j < 4; ++j) if (j != i0 && s4[j] > m1) { m1 = s4[j]; i1 = j; g1_ = a4[j]; }
                    const int e0 = __builtin_amdgcn_readfirstlane(bg * 4 + i0), e1 = __builtin_amdgcn_readfirstlane(bg * 4 + i1);
                    const float inv = 1.0f / (g0 + g1_);
                    if (lane == 0 && rep_ == 0) {
                        if (agg) { const int q0 = __hip_atomic_fetch_add(&lcnt[e0], 1, __ATOMIC_RELAXED, __HIP_MEMORY_SCOPE_WORKGROUP), q1 = __hip_atomic_fetch_add(&lcnt[e1], 1, __ATOMIC_RELAXED, __HIP_MEMORY_SCOPE_WORKGROUP);
                            LAS int* ap = asg + (it_ * 8 + wave) * 8;
                            ap[0] = e0; ap[1] = q0; ap[2] = rr * 2; ap[3] = (int)__float_as_uint(g0 * inv); ap[4] = e1; ap[5] = q1; ap[6] = rr * 2 + 1; ap[7] = (int)__float_as_uint(g1_ * inv);
                        } else {
                            const unsigned p0 = __hip_atomic_fetch_add(&cnt[e0 * 32], 1u, RLX_AGENT), p1 = __hip_atomic_fetch_add(&cnt[e1 * 32], 1u, RLX_AGENT);
                            LIST[(size_t)e0 * MT + p0] = rr * 2; LISTG[(size_t)e0 * MT + p0] = g0 * inv;
                            LIST[(size_t)e1 * MT + p1] = rr * 2 + 1; LISTG[(size_t)e1 * MT + p1] = g1_ * inv; } }
                }
                grp = nxt_; nxt_ = dyn ? gmap(MISC[38]) : seq(it_ + 2);
            }
#undef P6_LOAD
#undef P6_WLOAD
#undef P6_MMA
            __syncthreads();
            if (agg && rep_ == 0) {
                if (tid < 32) lbase[tid] = (int)__hip_atomic_fetch_add(&cnt[tid * 32], (unsigned)lcnt[tid], RLX_AGENT);
                __syncthreads();
                for (int i = tid; i < it_ * 16; i += 512) { const int e = asg[i * 4], q = asg[i * 4 + 1], src = asg[i * 4 + 2]; const float gt = __uint_as_float((unsigned)asg[i * 4 + 3]);
                    const size_t o = (size_t)e * MT + (size_t)(lbase[e] + q); LIST[o] = src; LISTG[o] = gt; }
            }
            __syncthreads();
        }
        SEAM(P6);
        int NT = 0;
        if (IN(P6 + 1) || IN(P6 + 2) || IN(P6 + 3)) {
            CParams* kp = kparams(); unsigned* cnt = WSP(unsigned, WS_CTL) + CW_CNT + layer * 1024;
            const int ttid = otid();
            if (ttid < 64) { const int ln = ttid, e = ln & 31; const int c = (int)__hip_atomic_load(&cnt[e * 32], RLX_AGENT); const int nt_ = (c + 255) >> 8; int inc = nt_;
#pragma unroll
                for (int o = 1; o < 32; o <<= 1) { const int t_ = __shfl_up(inc, o); if ((ln & 31) >= o) inc += t_; }
                if (ln < 32) { tcnt[e] = c; tbase[e] = inc - nt_; if (e == 31) tbase[32] = inc; for (int t_ = inc - nt_; t_ < inc; ++t_) texp[t_] = e; } }
            __syncthreads();
            NT = __builtin_amdgcn_readfirstlane(tbase[32]);
        }
        if (IN(P6 + 2)) _Pragma("unroll 1") for (int rep_ = 0; rep_ < NREP(8); ++rep_) {
            CParams* kp = kparams();
            typedef pg8::SchedMoe<256u * DM * 2u, 256u * DM * 2u, 2048u * DM * 2u, DM / 64, true> Sch;
            LAS int* rt = (LAS int*)(L + TAB_OFF + 1024);
            pg8::Gemm g{DM, DM, DM}; Sch S; S.o.init(NT, 8, ogrid(), obid()); S.A = WSP(const char, WS_H); S.B = WSP(const char, WS_WGU) + (size_t)layer * 32 * 2048 * DM * 2;
            S.texp = texp; S.tbase = tbase; S.tcnt = tcnt; S.rt = rt; S.list = WSP(int, WS_LIST); S.ctr = WSP(unsigned, WS_CTL) + CW_GUD + layer * 8192;
            S.fill_rows(rt, otid());
            pg8::EpiGateUp E{WSP(bf16_t, WS_ACT)};
            pg8::gemm_phase<pg8::EpiGateUp, Sch, true, true>(L, g, S, E);
        }
        if (IN(P6 + 2)) _Pragma("unroll 1") for (int rep_ = 0; rep_ < NREP(9); ++rep_) {
            CParams* kp = kparams();
            typedef pg8::SchedMoe<256u * DE * 2u, 256u * DE * 2u, (unsigned)DM * DE * 2u, DE / 64, false> Sch;
            pg8::Gemm g{DE, DE, DE}; Sch S; S.o.init(NT, 8, ogrid(), obid()); S.o.rot = 1; S.rem = (NT * 8) % ogrid(); S.nl = ogrid() - S.rem; S.A = WSP(const char, WS_ACT); S.B = WSP(const char, WS_WD) + (size_t)layer * 32 * DM * DE * 2;
            LAS int* rt = (LAS int*)(L + TAB_OFF + 1024);
            S.texp = texp; S.tbase = tbase; S.tcnt = tcnt; S.rt = nullptr; S.list = WSP(int, WS_LIST); S.ctr = WSP(unsigned, WS_CTL) + CW_GUD + layer * 8192;
            if (otid() == 0) { __builtin_amdgcn_fence(__ATOMIC_ACQUIRE, "agent"); asm volatile("s_waitcnt vmcnt(0)" ::: "memory"); }
            S.fill_dst(rt, WSP(float, WS_LIST) + (size_t)32 * MT, otid());
            pg8::EpiDown E{WSP(bf16_t, WS_FB), rt};
            pg8::gemm_phase<pg8::EpiDown, Sch, true, false>(L, g, S, E);
        }
        SEAM(P6 + 3);
        if (IN(P6 + 4)) _Pragma("unroll 1") for (int rep_ = 0; rep_ < NREP(10); ++rep_) {
            CParams* kp = kparams(); TIDS;
            const int row_lo = layer == 0 ? 0 : NCTX;
            const float* modl = WSP(float, WS_MOD) + (size_t)layer * 3 * 12288; const float* X1 = WSP(float, WS_X1); const bf16_t* FB = WSP(bf16_t, WS_FB);
            float* dstb = kp->out - (size_t)NCTX * DM; bf16_t* X2b = WSP(bf16_t, WS_X2);
            LAS float* vG2 = (LAS float*)L; LAS float* vLG = vG2 + 3 * DM; LAS float* vLB = vLG + DM;
            { const float* lg = kp->ln_g + (size_t)(layer * 2 + 1) * DM; const float* lb = kp->ln_b + (size_t)(layer * 2 + 1) * DM;
              float t0[12], t1[4], t2[4];
#pragma unroll
              for (int q = 0; q < 12; ++q) { const int i = tid + q * 512; t0[q] = modl[(size_t)(i >> 11) * 12288 + 5 * DM + (i & 2047)]; }
#pragma unroll
              for (int q = 0; q < 4; ++q) { const int i = tid + q * 512; t1[q] = lg[i]; t2[q] = lb[i]; }
#pragma unroll
              for (int q = 0; q < 12; ++q) vG2[tid + q * 512] = t0[q];
#pragma unroll
              for (int q = 0; q < 4; ++q) { vLG[tid + q * 512] = t1[q]; vLB[tid + q * 512] = t2[q]; } }
            __syncthreads();
            f32x4 xa[8]; v2u fa[8], fb[8];
#define P10_LOAD(row_) do { const float* xr_ = X1 + (size_t)(row_) * DM; const bf16_t* xb_ = (const bf16_t*)X1 + (size_t)(row_) * DM; const bf16_t* f0_ = FB + (size_t)((row_) * 2) * DM; \
                _Pragma("unroll") for (int j = 0; j < 8; ++j) { const int c = (j * 64 + lane) * 4; \
                    { const v2u q_ = *(const v2u*)(xb_ + c); xa[j] = (f32x4){bf2f(q_.x & 0xffffu), bf2f(q_.x >> 16), bf2f(q_.y & 0xffffu), bf2f(q_.y >> 16)}; } \
                    fa[j] = *(const v2u*)(f0_ + c); fb[j] = *(const v2u*)(f0_ + DM + c); } } while (0)
            { const int r0 = row_lo + gw; P10_LOAD(r0 < MT ? r0 : row_lo); }
            for (int row = row_lo + gw; row < MT; row += NGW) { const int cd = row_cond(row);
                f32x4 v[8]; float s = 0.f;
#pragma unroll
                for (int j = 0; j < 8; ++j) { const int c = (j * 64 + lane) * 4;
                    const f32x4 fs = {bf2f(fa[j].x & 0xffffu) + bf2f(fb[j].x & 0xffffu), bf2f(fa[j].x >> 16) + bf2f(fb[j].x >> 16), bf2f(fa[j].y & 0xffffu) + bf2f(fb[j].y & 0xffffu), bf2f(fa[j].y >> 16) + bf2f(fb[j].y >> 16)};
                    v[j] = xa[j] * ALPHA + *(const LAS f32x4*)(vG2 + cd * DM + c) * fs; s += (v[j][0] + v[j][1]) + (v[j][2] + v[j][3]); }
                if (row + NGW < MT) P10_LOAD(row + NGW);
                const float mean = wave_sum(s) * (1.0f / DM); float s2 = 0.f;
#pragma unroll
                for (int j = 0; j < 8; ++j) { v[j] = v[j] - mean; s2 += (v[j][0] * v[j][0] + v[j][1] * v[j][1]) + (v[j][2] * v[j][2] + v[j][3] * v[j][3]); }
                const float rstd = 1.0f / sqrtf(wave_sum(s2) * (1.0f / DM) + LN_EPS);
                float* dst = dstb + (size_t)row * DM;
#pragma unroll
                for (int j = 0; j < 8; ++j) { const int c = (j * 64 + lane) * 4; const f32x4 r_ = v[j] * rstd * *(const LAS f32x4*)(vLG + c) + *(const LAS f32x4*)(vLB + c);
                    if (layer == 0) { v2u w; w.x = pk2(r_[0], r_[1]); w.y = pk2(r_[2], r_[3]); *(v2u*)(X2b + (size_t)row * DM + c) = w; } else *(f32x4*)(dst + c) = r_; } }
#undef P10_LOAD
            __syncthreads();
        }
        if constexpr (layer == 0) {
            SEAM(10);
            if (IN(11)) _Pragma("unroll 1") for (int rep_ = 0; rep_ < NREP(11); ++rep_) {
                CParams* kp = kparams(); TIDS;
                const bf16_t* X2 = WSP(bf16_t, WS_X2); bf16_t* DP = WSP(bf16_t, WS_DP);
                const float* sc1 = WSP(float, WS_MOD) + (size_t)3 * 12288 + DM;
                const int c = tid * 4, gch = c >> 9, hw = 1 << gch;
                for (int chunk = bx; chunk < NLAT / 64; chunk += G) { const int b = chunk >> 7, t0 = (chunk & 127) * 64;
                    const bf16_t* base = X2 + ((size_t)NCTX + (size_t)b * SEQ) * DM + c; bf16_t* dbase = DP + ((size_t)NCTX + (size_t)b * SEQ) * DM + c;
                    const f32x4 a1 = *(const f32x4*)(sc1 + (size_t)b * 12288 + c) + 1.0f;
                    f32x4 s = {0, 0, 0, 0};
                    { v2u wv[16];
#pragma unroll
                      for (int q = 0; q < 16; ++q) { const int p_ = t0 - 8 + q; wv[q] = *(const v2u*)(base + (size_t)(p_ < 0 ? 0 : p_) * DM); }
#pragma unroll
                      for (int q = 0; q < 16; ++q) { const int p_ = t0 - 8 + q; const bool in_ = p_ >= 0 && p_ >= t0 - hw && p_ < t0 + hw; s += bf4(wv[q]) * (in_ ? 1.0f : 0.0f); } }
#pragma unroll 8
                    for (int i = 0; i < 64; ++i) { const int t = t0 + i; const int tn = t + hw, to = t - hw;
                        const f32x4 xc = bf4(*(const v2u*)(base + (size_t)t * DM));
                        const f32x4 xn = bf4(*(const v2u*)(base + (size_t)(tn < SEQ ? tn : SEQ - 1) * DM)), xo = bf4(*(const v2u*)(base + (size_t)(to >= 0 ? to : 0) * DM));
                        const int lo_ = to < 0 ? 0 : to, hi_ = tn > SEQ ? SEQ : tn;
                        const f32x4 d = a1 * (s * (1.0f / (float)(hi_ - lo_)) - xc);
                        v2u w; w.x = pk2(d[0], d[1]); w.y = pk2(d[2], d[3]); *(v2u*)(dbase + (size_t)t * DM) = w;
                        s = s + xn * (tn < SEQ ? 1.0f : 0.0f) - xo * (to >= 0 ? 1.0f : 0.0f); }
                }
            }
            SEAM(11);
            if (IN(12)) _Pragma("unroll 1") for (int rep_ = 0; rep_ < NREP(12); ++rep_) {
                CParams* kp = kparams();
                pg8::Gemm g{DM, 512, 512}; pg8::SchedPool S; S.o.init(NLAT / 256, 8, ogrid(), obid()); S.A = WSP(const char, WS_DP); S.B = WSP(const char, WS_WPOOL);
                pg8::EpiBf16 E{WSP(bf16_t, WS_Y), DM, nullptr};
                pg8::gemm_phase<pg8::EpiBf16, pg8::SchedPool, true, false>(L, g, S, E);
            }
            SEAM(12);
        }
    }

__global__ void __launch_bounds__(512, 2) mk_fwd(Params p_unused) {
    extern __shared__ __attribute__((aligned(16))) unsigned char lds[];
    LAS unsigned char* L = (LAS unsigned char*)lds;
    volatile LAS unsigned* MISC = (volatile LAS unsigned*)(L + MISC_OFF);
    LAS int* tcnt = (LAS int*)(L + TAB_OFF); LAS int* tbase = tcnt + 32; LAS int* texp = tcnt + 80;
    if (threadIdx.x < 64) MISC[threadIdx.x] = 0u;
    __syncthreads();
    int lo, hi; XcdBarrier bar;
    { CParams* kp = kparams(); lo = kp->ph_lo; hi = kp->ph_hi; unsigned* bw = (unsigned*)(kp->ws + WS_CTL) + CW_BAR;
      bar.bar = bw; bar.x = 0; bar.st = nullptr; if (hi - lo > 1) bar = xcd_barrier_post(bw, MISC + 8); }
    if (IN(0)) _Pragma("unroll 1") for (int rep_ = 0; rep_ < NREP(0); ++rep_) {
        CParams* kp = kparams(); TIDS;
        float* MOD = WSP(float, WS_MOD); float* ROPE = WSP(float, WS_ROPE);
        for (int i = bx * 512 + tid; i < 4096; i += G * 512) { const int pos = i >> 5, pp = i & 31;
            const float inv = exp2f(-(float)pp * (13.287712379549449f / 32.0f)); const float ang = (float)pos * inv;
            float sn, cs; sincosf(ang, &sn, &cs); ROPE[i] = cs; ROPE[4096 + i] = sn; }
        { const float* wrt = kp->w_router; bf16_t* WR = WSP(bf16_t, WS_WR);
          for (int i = bx * 512 + tid; i < 32 * DM; i += G * 512) { const int ii = i & 7, ln = (i >> 3) & 63, kq = (i >> 9) & 15, w = i >> 13; const int e = ln & 31, k = w * 256 + kq * 16 + 8 * (ln >> 5) + ii;
              const float wv = wrt[k * 32 + e]; const unsigned h1 = f2bf(wv); const unsigned h2 = f2bf(wv - bf2f(h1)); WR[i] = (bf16_t)h1; WR[32 * DM + i] = (bf16_t)h2; } }
        {
            LAS float* sv = (LAS float*)L;
            LAS float* red = (LAS float*)(L + 32768);
            mod_prepare(kp->c, kp->c_ctx, sv, tid);
            for (int it = bx; it < 384; it += G) mod_item(it, kp->w_mod, kp->b_mod, MOD, sv, red, tid, lane, wave);
        }
        {
            LAS float* scr = (LAS float*)(L + wave * 16384);
            constexpr int I_QKV = (DM / 64) * (QKVD / 32), I_O = (DM / 64) * (DM / 32), I_P = (512 / 64) * (512 / 32), I_G = (DM / 64) * (DE / 32), I_D = (DE / 64) * (DM / 32);
            constexpr int NITEMS = I_QKV + I_O + 4 * I_P;
            (void)I_G; (void)I_D;
            auto decode = [&](int it) { TItem d; int r = it;
                if (r < I_QKV) { d.W = kp->w_qkv; d.WT = WSP(bf16_t, WS_WQKV); d.K = DM; d.N = QKVD; d.kind = 0; }
                else if ((r -= I_QKV) < I_O) { d.W = kp->w_o; d.WT = WSP(bf16_t, WS_WO); d.K = DM; d.N = DM; d.kind = 0; }
                else { r -= I_O; const int g = r / I_P; r -= g * I_P; d.W = kp->w_pool + (size_t)g * 512 * 512; d.WT = WSP(bf16_t, WS_WPOOL) + (size_t)g * 512 * 512; d.K = 512; d.N = 512; d.kind = 0; }
                const int nblk = d.N / 32; d.k0 = 64 * (r / nblk); d.n0 = 32 * (r % nblk); return d; };
            for (int it = gw; it < NITEMS; it += 2 * NGW) {
                const TItem d0 = decode(it); f32x4 ra[8], rb[8]; t_load(d0, ra, lane);
                const bool two = it + NGW < NITEMS; TItem d1 = d0; if (two) { d1 = decode(it + NGW); t_load(d1, rb, lane); }
                t_store(d0, ra, scr, lane); if (two) t_store(d1, rb, scr, lane);
            }
        }
        __syncthreads();
    }
    SEAM(0);

    if (IN(1)) _Pragma("unroll 1") for (int rep_ = 0; rep_ < NREP(1); ++rep_) {
        CParams* kp = kparams(); TIDS;
        const float* MOD = WSP(float, WS_MOD); bf16_t* U = WSP(bf16_t, WS_U); const float* xl = kp->x; const float* xc = kp->ctx;
        const int R = (MT + NGW - 1) / NGW, r0 = gw * R, r1 = (r0 + R) < MT ? (r0 + R) : MT;
        f32x4 sa[8], sb[8], xv[8]; int cur = -1;
#define P1_LOAD(row_) do { const float* xr_ = ((row_) < NCTX) ? xc + (size_t)(row_) * DM : xl + (size_t)((row_) - NCTX) * DM; _Pragma("unroll") for (int j = 0; j < 8; ++j) xv[j] = *(const f32x4*)(xr_ + (j * 64 + lane) * 4); } while (0)
        if (r0 < r1) P1_LOAD(r0); else P1_LOAD(0);
        for (int row = r0; row < r1; ++row) { const int cd = row_cond(row);
            if (cd != cur) { const float* sh = MOD + (size_t)cd * 12288; const float* sc = sh + DM;
#pragma unroll
                for (int j = 0; j < 8; ++j) { const int c = (j * 64 + lane) * 4; sa[j] = *(const f32x4*)(sc + c) + 1.0f; sb[j] = *(const f32x4*)(sh + c); }
                cur = cd; }
            f32x4 o[8];
#pragma unroll
            for (int j = 0; j < 8; ++j) o[j] = xv[j] * sa[j] + sb[j];
            if (row + 1 < r1) P1_LOAD(row + 1);
#pragma unroll
            for (int j = 0; j < 8; ++j) { const int c = (j * 64 + lane) * 4; v2u w; w.x = pk2(o[j][0], o[j][1]); w.y = pk2(o[j][2], o[j][3]); *(v2u*)(U + (size_t)row * DM + c) = w; } }
#undef P1_LOAD
    }
    SEAM(1);

    if (IN(2)) _Pragma("unroll 1") for (int rep_ = 0; rep_ < NREP(2); ++rep_) {
        CParams* kp = kparams();
        typedef pg8::SchedSplit<256u * DM * 2u, 256u * DM * 2u, DM / 64, QKVD / 256> Sch;
        pg8::Gemm g{DM, DM, DM}; Sch S; S.init(ogrid(), obid()); S.A = WSP(const char, WS_U); S.B = WSP(const char, WS_WQKV);
        pg8::EpiQkv E{WSP(bf16_t, WS_QKVR), QKVD, WSP(float, WS_PQ), WSP(bf16_t, WS_V)};
        pg8::gemm_phase<pg8::EpiQkv, Sch, true, false>(L, g, S, E);
    }
    SEAM(2);

    if (IN(3)) _Pragma("unroll 1") for (int rep_ = 0; rep_ < NREP(3); ++rep_) {
        CParams* kp = kparams(); TIDS;
        const float* ROPE = WSP(float, WS_ROPE); const bf16_t* QKVR = WSP(bf16_t, WS_QKVR); bf16_t* Qb = WSP(bf16_t, WS_Q); bf16_t* Kb = WSP(bf16_t, WS_K); bf16_t* Vb = WSP(bf16_t, WS_V);
        const int sub = lane >> 4, l16 = lane & 15, d0 = l16 * 8, ax = l16 >> 3, hh = (l16 >> 2) & 1, p0 = (l16 & 3) * 8;
        const bool split3 = ((64 * (QKVD / 256)) % G == 0) && (2 * (QKVD / 256) * 8 <= G);
        const float* PQ = WSP(float, WS_PQ);
        float qg[8], kg[8];
        { const float* qgn = kp->q_gain; const float* kgn = kp->k_gain;
#pragma unroll
          for (int i = 0; i < 8; ++i) { qg[i] = qgn[d0 + i]; kg[i] = kgn[d0 + i]; } }
        v4u rw[6];
#define P3_LOAD(row_) do { const bf16_t* s_ = QKVR + (size_t)(row_) * QKVD + sub * 128 + d0; const bool all_ = (row_) < NCTX; _Pragma("unroll") for (int it = 0; it < 6; ++it) if (it == 4 || all_) rw[it] = *(const v4u*)(s_ + it * 512); } while (0)
        for (int r4 = NCTX + gw * 4; r4 < MT; r4 += NGW * 4) {
            v4u kr[4]; f32x4 c0[4], c1[4], s0[4], s1[4];
#pragma unroll
            for (int q = 0; q < 4; ++q) { const int row = r4 + q, t = (row - NCTX) & 8191; kr[q] = *(const v4u*)(QKVR + (size_t)row * QKVD + 2048 + sub * 128 + d0);
                const int pos = ax ? (t & 63) : (t >> 6); const float* cp_ = ROPE + pos * 32 + p0; c0[q] = *(const f32x4*)cp_; c1[q] = *(const f32x4*)(cp_ + 4); s0[q] = *(const f32x4*)(cp_ + 4096); s1[q] = *(const f32x4*)(cp_ + 4100); }
#pragma unroll
            for (int q = 0; q < 4; ++q) { const int row = r4 + q, lr = row - NCTX, b = lr >> 13, kpos = CTXL + (lr & 8191); const v4u raw = kr[q];
                float f[8], cs[8], sn[8];
#pragma unroll
                for (int i = 0; i < 4; ++i) { f[2 * i] = bf2f(raw[i] & 0xffffu); f[2 * i + 1] = bf2f(raw[i] >> 16); cs[i] = c0[q][i]; cs[4 + i] = c1[q][i]; sn[i] = hh ? s0[q][i] : -s0[q][i]; sn[4 + i] = hh ? s1[q][i] : -s1[q][i]; }
                float ss = 0.f;
#pragma unroll
                for (int i = 0; i < 8; ++i) ss += f[i] * f[i];
                ss += __shfl_xor(ss, 1); ss += __shfl_xor(ss, 2); ss += __shfl_xor(ss, 4); ss += __shfl_xor(ss, 8);
                const float r = 1.0f / sqrtf(ss * (1.0f / 128.0f) + RMS_EPS);
                float o[8];
#pragma unroll
                for (int i = 0; i < 8; ++i) { const float y = f[i] * r * kg[i]; const float pr = __shfl_xor(y, 4); o[i] = y * cs[i] + pr * sn[i]; }
                v4u w; w.x = pk2(o[0], o[1]); w.y = pk2(o[2], o[3]); w.z = pk2(o[4], o[5]); w.w = pk2(o[6], o[7]);
                *(v4u*)(Kb + (((size_t)b * NKV + sub) * SKV + kpos) * HD + d0) = w; }
        }
        P3_LOAD(gw < NCTX ? gw : 0);
        for (int row = gw; row < NCTX; row += NGW) {
            const bool lat = row >= NCTX; const int lr = row - NCTX; const int b = lat ? (lr >> 13) : (row >> 8); const int t = lat ? (lr & 8191) : 0;
            const int kpos = lat ? (CTXL + t) : (row & 255);
            v4u cur[6];
#pragma unroll
            for (int it = 0; it < 6; ++it) cur[it] = rw[it];
            if (row + NGW < NCTX) P3_LOAD(row + NGW);
            float cs[8], sn[8];
#pragma unroll
            for (int i = 0; i < 8; ++i) { cs[i] = 1.f; sn[i] = 0.f; }
            if (lat) { const int pos = ax ? (t & 63) : (t >> 6); const float* cp_ = ROPE + pos * 32 + p0;
                const f32x4 c0 = *(const f32x4*)cp_, c1 = *(const f32x4*)(cp_ + 4), s0 = *(const f32x4*)(cp_ + 4096), s1 = *(const f32x4*)(cp_ + 4100);
#pragma unroll
                for (int i = 0; i < 4; ++i) { cs[i] = c0[i]; cs[4 + i] = c1[i]; sn[i] = hh ? s0[i] : -s0[i]; sn[4 + i] = hh ? s1[i] : -s1[i]; } }
#pragma unroll
            for (int it = 0; it < 6; ++it) { const int h = it * 4 + sub;
                if (lat && it != 4) continue;
                if (it == 5 && !split3) continue;
                float f[8]; v4u raw;
                if (!lat && split3) {
                    f32x4 q0[8]; const float* pp_ = PQ + (size_t)row * QKVD + h * 128 + d0;
#pragma unroll
                    for (int ks = 0; ks < 8; ++ks) q0[ks] = *(const f32x4*)(pp_ + (size_t)ks * 512 * QKVD);
                    f32x4 a0 = q0[0];
#pragma unroll
                    for (int ks = 1; ks < 8; ++ks) a0 += q0[ks];
#pragma unroll
                    for (int ks = 0; ks < 8; ++ks) q0[ks] = *(const f32x4*)(pp_ + (size_t)ks * 512 * QKVD + 4);
                    f32x4 a1 = q0[0];
#pragma unroll
                    for (int ks = 1; ks < 8; ++ks) a1 += q0[ks];
#pragma unroll
                    for (int i = 0; i < 4; ++i) { f[i] = a0[i]; f[4 + i] = a1[i]; }
                    raw.x = pk2(f[0], f[1]); raw.y = pk2(f[2], f[3]); raw.z = pk2(f[4], f[5]); raw.w = pk2(f[6], f[7]);
#pragma unroll
                    for (int i = 0; i < 4; ++i) { f[2 * i] = bf2f(raw[i] & 0xffffu); f[2 * i + 1] = bf2f(raw[i] >> 16); }
                } else { raw = cur[it];
#pragma unroll
                    for (int i = 0; i < 4; ++i) { f[2 * i] = bf2f(raw[i] & 0xffffu); f[2 * i + 1] = bf2f(raw[i] >> 16); } }
                if (it == 5) { *(v4u*)(Vb + (((size_t)b * NKV + (h - 20)) * SKV + kpos) * HD + d0) = raw; continue; }
                float ss = 0.f;
#pragma unroll
                for (int i = 0; i < 8; ++i) ss += f[i] * f[i];
                ss += __shfl_xor(ss, 1); ss += __shfl_xor(ss, 2); ss += __shfl_xor(ss, 4); ss += __shfl_xor(ss, 8);
                const float r = 1.0f / sqrtf(ss * (1.0f / 128.0f) + RMS_EPS);
                float o[8];
#pragma unroll
                for (int i = 0; i < 8; ++i) { const float y = f[i] * r * (it < 4 ? qg[i] : kg[i]); const float pr = __shfl_xor(y, 4); o[i] = y * cs[i] + pr * sn[i]; }
                v4u w; w.x = pk2(o[0], o[1]); w.y = pk2(o[2], o[3]); w.z = pk2(o[4], o[5]); w.w = pk2(o[6], o[7]);
                bf16_t* d = (it < 4) ? Qb + (size_t)row * DM + h * 128 + d0 : Kb + (((size_t)b * NKV + (h - 16)) * SKV + kpos) * HD + d0;
                *(v4u*)d = w; }
        }
#undef P3_LOAD
    }
    SEAM(3);

    if (IN(4)) _Pragma("unroll 1") for (int rep_ = 0; rep_ < NREP(4); ++rep_) {
        CParams* kp = kparams();
        const bf16_t* Qb = WSP(bf16_t, WS_Q); const bf16_t* Kb = WSP(bf16_t, WS_K); const bf16_t* Vb = WSP(bf16_t, WS_V); bf16_t* Ob = WSP(bf16_t, WS_O);
        const bf16_t* QKVR = WSP(bf16_t, WS_QKVR); const float* ROPE = WSP(float, WS_ROPE); const float* qgn = kp->q_gain;
        const int G = ogrid(), bx = obid(); const bool fast = (G % 8) == 0;
        const int NR = fast ? (G >> 3) : G, rank = fast ? (bx >> 3) : bx, tot = fast ? 132 : 1056;
        const bool split = fast && NR == 32; const int NA = split ? 26 : NR;
        if (rank < NA) for (int i = 0;; ++i) {
            int w = rank + NA * i;
            if (split && i == 5) w = rank >= 24 ? rank + 106 : tot;
            if (w >= tot) break;
            const int combo = fast ? (bx & 7) : (w / 132), ww = fast ? w : (w % 132), b = combo >> 2, kvh = combo & 3;
            const bool isl = ww < 128; const int rbk = ww >> 2; const int h = kvh * 4 + (isl ? (ww & 3) : (ww - 128));
            const size_t row0 = isl ? ((size_t)NCTX + (size_t)b * SEQ + (size_t)rbk * 256) : ((size_t)b * CTXL);
            if (isl) att::attn_dma_body(QKVR + row0 * QKVD + h * HD, QKVD, rbk * 256, ROPE, qgn, Kb + (size_t)combo * SKV * HD, Vb + (size_t)combo * SKV * HD, Ob + row0 * DM + h * HD, SKV, (char*)lds);
            else att::attn_dma_body(Qb + row0 * DM + h * HD, DM, -1, ROPE, qgn, Kb + (size_t)combo * SKV * HD, Vb + (size_t)combo * SKV * HD, Ob + row0 * DM + h * HD, CTXL, (char*)lds);
            if (otid() == 0) { asm volatile("s_waitcnt vmcnt(0)" ::: "memory");
                (void)xb_add(WSP(unsigned, WS_CTL) + CW_DONE + 32 * (isl ? (b * 32 + rbk) : (64 + b)), 1u); }
        }
        {
            const int tid = otid(), lane = tid & 63, wave = __builtin_amdgcn_readfirstlane(tid >> 6);
            unsigned* mq = WSP(unsigned, WS_CTL) + CW_MQ; bool prepared = false;
            for (;;) {
                if (tid == 0) MISC[34] = xb_add(mq, 1u);
                __syncthreads();
                const unsigned t = MISC[34];
                __syncthreads();
                if (t >= 384u) break;
                if (!prepared) { mod_prepare(kp->c, kp->c_ctx, (LAS float*)L, tid); prepared = true; }
                mod_item(384 + (int)t, kp->w_mod, kp->b_mod, WSP(float, WS_MOD), (const LAS float*)L, (LAS float*)(L + 32768), tid, lane, wave);
            }
        }
        {
            const int tid = otid(), lane = tid & 63, wave = __builtin_amdgcn_readfirstlane(tid >> 6);
            LAS float* scr = (LAS float*)(L + wave * 16384);
            unsigned* qc = WSP(unsigned, WS_CTL) + CW_Q;
            constexpr int I_G = (DM / 64) * (DE / 32), I_D = (DE / 64) * (DM / 32), PER = 2 * I_G + I_D; constexpr unsigned NTICK = 64u * PER / 2u;
            auto decode = [&](int it) { TItem d; const int le = it / PER; int r = it - le * PER;
                if (r < I_G) { d.W = kp->w_gate + (size_t)le * DM * DE; d.WT = WSP(bf16_t, WS_WGU) + (size_t)le * 2048 * DM; d.K = DM; d.N = DE; d.kind = 1; }
                else if ((r -= I_G) < I_G) { d.W = kp->w_up + (size_t)le * DM * DE; d.WT = WSP(bf16_t, WS_WGU) + (size_t)le * 2048 * DM; d.K = DM; d.N = DE; d.kind = 2; }
                else { r -= I_G; d.W = kp->w_down + (size_t)le * DE * DM; d.WT = WSP(bf16_t, WS_WD) + (size_t)le * DM * DE; d.K = DE; d.N = DM; d.kind = 0; }
                const int nblk = d.N / 32; d.k0 = 64 * (r / nblk); d.n0 = 32 * (r % nblk); return d; };
            static_assert(NTICK % 8u == 0u, "ticket chunks");
            auto grab = [&]() { unsigned t = 0; if (lane == 0) t = __hip_atomic_fetch_add(qc, 8u, __ATOMIC_RELAXED, __HIP_MEMORY_SCOPE_AGENT); return (unsigned)__builtin_amdgcn_readfirstlane((int)t); };
            for (unsigned tb = grab(); tb < NTICK; tb = grab()) {
                _Pragma("unroll 1") for (unsigned tk = tb; tk < tb + 8u; ++tk) {
                    const TItem d0 = decode((int)(2u * tk)); TItem d1 = d0; d1.n0 += 32;
                    f32x4 ra[8], rb[8]; t_load(d0, ra, lane); t_load(d1, rb, lane);
                    t_store(d0, ra, scr, lane); t_store(d1, rb, scr, lane);
                }
            }
        }
        __syncthreads();
        {
            unsigned* wq = WSP(unsigned, WS_CTL) + CW_WQ; unsigned* done = WSP(unsigned, WS_CTL) + CW_DONE; unsigned* yd = WSP(unsigned, WS_CTL) + CW_YD; unsigned* bw = WSP(unsigned, WS_CTL) + CW_BAR;
            const char* Oc = WSP(const char, WS_O); const char* Wc = WSP(const char, WS_WO);
            pg8::Gemm g{DM, DM, DM}; pg8::EpiBf16W E{WSP(bf16_t, WS_Y), DM};
            int tail = obid(); bool queue = true;
            for (;;) {
                if (otid() == 0) { int pm = -1, pn = 0, fl = 0;
                    if (queue) { const unsigned t = xb_add(wq, 1u);
                        if (t < 416u) { const int rbk = (int)t >> 4, b = ((int)t >> 3) & 1; pn = (int)t & 7; pm = 2 + b * 32 + rbk; fl = b * 32 + rbk; }
                        else if (t < 432u) { const int c = (int)t - 416; pm = c >> 3; pn = c & 7; fl = 64 + pm; } }
                    else if (tail < 96) { const int rbk = 26 + (tail >> 4), b = (tail >> 3) & 1; pn = tail & 7; pm = 2 + b * 32 + rbk; fl = b * 32 + rbk; }
                    if (pm >= 0) { XB_SPIN(xb_ld(&done[32 * fl]) < 16u, bw);
                        __builtin_amdgcn_fence(__ATOMIC_ACQUIRE, "agent"); asm volatile("s_waitcnt vmcnt(0)" ::: "memory"); }
                    MISC[32] = (unsigned)pm; MISC[33] = (unsigned)pn; }
                __syncthreads();
                const int pm = (int)MISC[32], pn = (int)MISC[33];
                __syncthreads();
                if (pm < 0) { if (!queue) break; queue = false; continue; }
                pg8::SchedOne S; S.u.A = Oc + (size_t)((unsigned)pm * (256u * DM * 2u)); S.u.B = Wc + (size_t)((unsigned)pn * (256u * DM * 2u)); S.u.pm = pm; S.u.pn = pn; S.u.aux = 0; S.u.kt = DM / 64; S.u.rb = 0; S.u.cn = 0; S.u.ui = 0;
                pg8::gemm_phase<pg8::EpiBf16W, pg8::SchedOne, true, false>(L, g, S, E);
                if (otid() == 0) (void)xb_add(&yd[32 * pm], 1u);
                if (!queue) tail += ogrid();
            }
        }
    }


    layer_half<0>(lo, hi, bar, L, tcnt, tbase, texp);
    layer_half<1>(lo, hi, bar, L, tcnt, tbase, texp);
#undef IN
#undef SEAM
#undef TIDS
}

extern "C" void kernel_launch(void* const* d_in, const int* in_sizes, int n_in, void* d_out, int out_size, void* d_ws, size_t ws_size, hipStream_t stream) {
    static int grid = 0;
    if (grid == 0) {
        if (n_in != 19 || in_sizes[0] != NLAT * DM || out_size != NLAT * DM || ws_size < WS_END) {
            fprintf(stderr, "kernel_launch: shape mismatch: n_in %d in0 %d out %d ws %zu (need %zu); nothing launched\n", n_in, n_in > 0 ? in_sizes[0] : -1, out_size, ws_size, (size_t)WS_END); grid = -1; return; }
        int dev = 0, cus = 0, per_cu = 0;
        if (hipGetDevice(&dev) != hipSuccess || hipDeviceGetAttribute(&cus, hipDeviceAttributeMultiprocessorCount, dev) != hipSuccess) { fprintf(stderr, "kernel_launch: device query failed\n"); grid = -1; return; }
        if (hipFuncSetAttribute((const void*)mk_fwd, hipFuncAttributeMaxDynamicSharedMemorySize, LDS_BYTES) != hipSuccess) { fprintf(stderr, "kernel_launch: hipFuncSetAttribute failed\n"); grid = -1; return; }
        if (hipOccupancyMaxActiveBlocksPerMultiprocessor(&per_cu, (const void*)mk_fwd, 512, LDS_BYTES) != hipSuccess || per_cu < 1)
            fprintf(stderr, "kernel_launch: note: occupancy query reports %d workgroups per CU\n", per_cu);
        (void)hipGetLastError();
        if (cus * (pg8::RT_UNITS / 2) < MAXT * 8) { fprintf(stderr, "kernel_launch: %d CUs: the MoE phases' per-workgroup LDS row tables are sized for >= %d workgroups; nothing launched\n", cus, (MAXT * 8 + pg8::RT_UNITS / 2 - 1) / (pg8::RT_UNITS / 2)); grid = -1; return; }
        grid = cus;
    }
    if (grid < 0) return;
    if (hipMemsetAsync((char*)d_ws + WS_CTL, 0, CTL_ZERO_BYTES, stream) != hipSuccess) { fprintf(stderr, "kernel_launch: memset failed\n"); return; }
    Params p{};
    p.x = (const float*)d_in[0]; p.c = (const float*)d_in[1]; p.ctx = (const float*)d_in[2]; p.c_ctx = (const float*)d_in[3]; p.w_mod = (const float*)d_in[4]; p.b_mod = (const float*)d_in[5];
    p.ln_g = (const float*)d_in[6]; p.ln_b = (const float*)d_in[7]; p.w_qkv = (const float*)d_in[8]; p.q_gain = (const float*)d_in[9]; p.k_gain = (const float*)d_in[10]; p.w_o = (const float*)d_in[11];
    p.w_pool = (const float*)d_in[12]; p.pool_scale = (const float*)d_in[13]; p.w_router = (const float*)d_in[14]; p.router_bias = (const float*)d_in[15];
    p.w_gate = (const float*)d_in[16]; p.w_up = (const float*)d_in[17]; p.w_down = (const float*)d_in[18];
    p.out = (float*)d_out; p.ws = (unsigned char*)d_ws;
#if MK_PER_PHASE
    for (int k = 0; k < NPHASE; ++k) { p.ph_lo = k; p.ph_hi = k + 1;
        hipLaunchKernelGGL(mk_fwd, dim3(grid), dim3(512), LDS_BYTES, stream, p);
        const hipError_t le = hipPeekAtLastError(); if (le != hipSuccess) { fprintf(stderr, "kernel_launch: launch %d failed: %s\n", k, hipGetErrorName(le)); break; } }
#else
    p.ph_lo = 0; p.ph_hi = NPHASE;
    hipLaunchKernelGGL(mk_fwd, dim3(grid), dim3(512), LDS_BYTES, stream, p);
    const hipError_t le = hipPeekAtLastError(); if (le != hipSuccess) fprintf(stderr, "kernel_launch: launch failed: %s\n", hipGetErrorName(le));
#endif
}
```
